# Optimizing an MI355X kernel written in HIP

```python
import jax, jax.numpy as jnp
from jax import lax
import numpy as np

D_MODEL = 1024
BATCH = 16
SEQ = 2048
DEPTH = 1

GRID_W = 64
N_HEADS = 8
N_KV_HEADS = 2
HEAD_DIM = 64
ATTN_WIDTH = N_HEADS * HEAD_DIM
KV_WIDTH = N_KV_HEADS * HEAD_DIM
CONV_WIDTH = D_MODEL // 2
CONV_KSIZE = 31
Q_BLOCK = 128
ROPE_THETA = 10000.0
HALF_ROT = HEAD_DIM // 2
N_GROUPS = 4
EXPERTS_PER_GROUP = 8
N_EXPERTS = N_GROUPS * EXPERTS_PER_GROUP
TOP_K = 2
D_EXPERT = D_MODEL // 2
MOE_BLOCK = 128
EPS = 1e-6
SPLITS = (2 * CONV_WIDTH,
          2 * CONV_WIDTH + ATTN_WIDTH,
          2 * CONV_WIDTH + ATTN_WIDTH + KV_WIDTH,
          2 * CONV_WIDTH + ATTN_WIDTH + 2 * KV_WIDTH,
          2 * CONV_WIDTH + ATTN_WIDTH + 2 * KV_WIDTH + D_MODEL)
IN_WIDTH = 2 * CONV_WIDTH + ATTN_WIDTH + 2 * KV_WIDTH + 2 * D_MODEL

kernel_name = "hybrid_conv_axialgqa_hmoe_block"


def rmsnorm(x, g):
    xf = x.astype(jnp.float32)
    y = xf * lax.rsqrt(jnp.mean(xf * xf, axis=-1, keepdims=True) + EPS) * g.astype(jnp.float32)
    return y.astype(x.dtype)


def layernorm(x, g, b):
    xf = x.astype(jnp.float32)
    mu = jnp.mean(xf, axis=-1, keepdims=True)
    var = jnp.mean(jnp.square(xf - mu), axis=-1, keepdims=True)
    y = (xf - mu) * lax.rsqrt(var + EPS) * g.astype(jnp.float32) + b.astype(jnp.float32)
    return y.astype(x.dtype)


def depthwise_conv(u, w, b):
    pad = CONV_KSIZE // 2
    out = lax.conv_general_dilated(
        u, w[:, None, :].astype(u.dtype), window_strides=(1,), padding=[(pad, pad)],
        dimension_numbers=('NWC', 'WIO', 'NWC'), feature_group_count=u.shape[-1])
    return out + b.astype(u.dtype)


def axial_rope_angles(seq_len):
    rows = seq_len // GRID_W
    row_idx = jnp.repeat(jnp.arange(rows, dtype=jnp.int32), GRID_W).astype(jnp.float32)
    col_idx = jnp.tile(jnp.arange(GRID_W, dtype=jnp.int32), rows).astype(jnp.float32)
    inv_freq = ROPE_THETA ** (-jnp.arange(0, HALF_ROT, 2, dtype=jnp.float32) / HALF_ROT)
    return row_idx[:, None] * inv_freq, col_idx[:, None] * inv_freq


def rotate(xs, ang):
    cos = jnp.cos(ang)[None, :, None, :]
    sin = jnp.sin(ang)[None, :, None, :]
    x1, x2 = jnp.split(xs.astype(jnp.float32), 2, axis=-1)
    return jnp.concatenate([x1 * cos - x2 * sin, x2 * cos + x1 * sin], axis=-1).astype(xs.dtype)


def apply_axial_rope(x, ang_row, ang_col):
    xr, xc = jnp.split(x, 2, axis=-1)
    return jnp.concatenate([rotate(xr, ang_row), rotate(xc, ang_col)], axis=-1)


def axial_gqa_attention(q, k, v):
    B, S = q.shape[:2]
    nb = S // Q_BLOCK
    G = N_HEADS // N_KV_HEADS
    qb = q.reshape(B, nb, Q_BLOCK, N_KV_HEADS, G, HEAD_DIM).transpose(1, 0, 3, 4, 2, 5)
    kt = k.transpose(0, 2, 1, 3)
    vt = v.transpose(0, 2, 1, 3)
    scale = HEAD_DIM ** -0.5

    def block(qblk):
        s = jnp.einsum('bkgqd,bksd->bkgqs', qblk, kt).astype(jnp.float32) * scale
        p = jax.nn.softmax(s, axis=-1)
        return jnp.einsum('bkgqs,bksd->bkgqd', p.astype(vt.dtype), vt)

    o = lax.map(block, qb)
    return o.transpose(1, 0, 4, 2, 3, 5).reshape(B, S, ATTN_WIDTH)


def hierarchical_moe(h, w_group, b_group, w_router, b_router, w_gate, w_up, w_down):
    B, S, D = h.shape
    N = B * S
    xt = h.reshape(N, D)
    grp_prob = jax.nn.softmax((xt @ w_group).astype(jnp.float32) + b_group.astype(jnp.float32), axis=-1)
    grp_p, grp_idx = lax.top_k(grp_prob, 1)
    exp_logits = ((xt @ w_router).astype(jnp.float32) + b_router.astype(jnp.float32)).reshape(
        N, N_GROUPS, EXPERTS_PER_GROUP)
    in_grp = jnp.take_along_axis(exp_logits, grp_idx[:, :, None], axis=1)[:, 0]
    top_p, top_local = lax.top_k(jax.nn.softmax(in_grp, axis=-1), TOP_K)
    top_p = top_p / jnp.sum(top_p, axis=-1, keepdims=True)
    weights = grp_p * top_p
    expert_idx = grp_idx * EXPERTS_PER_GROUP + top_local

    A = N * TOP_K
    e_flat = expert_idx.reshape(A)
    w_flat = weights.reshape(A)
    tok_flat = jnp.arange(A, dtype=jnp.int32) // TOP_K
    order = jnp.argsort(e_flat)
    e_sorted = e_flat[order]
    counts = jnp.zeros((N_EXPERTS,), jnp.int32).at[e_flat].add(1)
    padded = (counts + MOE_BLOCK - 1) // MOE_BLOCK * MOE_BLOCK
    starts = jnp.cumsum(counts) - counts
    pends = jnp.cumsum(padded)
    pstarts = pends - padded
    dest = pstarts[e_sorted] + (jnp.arange(A, dtype=jnp.int32) - starts[e_sorted])
    P = A + N_EXPERTS * MOE_BLOCK
    n_blocks = P // MOE_BLOCK
    slot_tok = jnp.full((P,), N, jnp.int32).at[dest].set(tok_flat[order])
    slot_w = jnp.zeros((P,), jnp.float32).at[dest].set(w_flat[order])
    block_expert = jnp.minimum(
        jnp.searchsorted(pends, jnp.arange(n_blocks, dtype=jnp.int32) * MOE_BLOCK, side='right'),
        N_EXPERTS - 1).astype(jnp.int32)
    x_pad = jnp.concatenate([xt, jnp.zeros((1, D), xt.dtype)], axis=0)
    xb = x_pad[slot_tok].reshape(n_blocks, MOE_BLOCK, D)

    def expert_block(args):
        xblk, e = args
        return (jax.nn.silu(xblk @ w_gate[e]) * (xblk @ w_up[e])) @ w_down[e]

    yb = lax.map(expert_block, (xb, block_expert)).reshape(P, D)
    yb = yb * slot_w[:, None].astype(yb.dtype)
    y = jax.ops.segment_sum(yb, slot_tok, num_segments=N + 1)[:N]
    return y.reshape(B, S, D)


def setup_inputs(seed: int = 0) -> dict:
    key = jax.random.key(seed)
    ks = jax.random.split(key, 32)
    f32 = jnp.float32
    L, D = DEPTH, D_MODEL

    def nrm(k, shape, scale):
        return jax.random.normal(k, shape, f32) * scale

    def gain(k, shape):
        return 1.0 + 0.05 * jax.random.normal(k, shape, f32)

    return {
        "x": jax.random.normal(ks[0], (BATCH, SEQ, D), f32),
        "c": jax.random.normal(ks[1], (BATCH, D), f32),
        "w_ada": nrm(ks[2], (L, D, 6 * D), 0.5 * D ** -0.5),
        "b_ada": nrm(ks[3], (L, 6 * D), 0.02),
        "g_pre_mix": gain(ks[4], (L, D)),
        "g_post_mix": gain(ks[5], (L, D)),
        "w_in": nrm(ks[6], (L, D, IN_WIDTH), D ** -0.5),
        "w_dw": nrm(ks[7], (L, CONV_KSIZE, CONV_WIDTH), CONV_KSIZE ** -0.5),
        "b_dw": nrm(ks[8], (L, CONV_WIDTH), 0.02),
        "conv_ln_g": gain(ks[9], (L, CONV_WIDTH)),
        "conv_ln_b": nrm(ks[10], (L, CONV_WIDTH), 0.02),
        "w_conv_out": nrm(ks[11], (L, CONV_WIDTH, D), CONV_WIDTH ** -0.5),
        "q_norm_g": gain(ks[12], (L, HEAD_DIM)),
        "k_norm_g": gain(ks[13], (L, HEAD_DIM)),
        "w_attn_out": nrm(ks[14], (L, ATTN_WIDTH, D), ATTN_WIDTH ** -0.5),
        "w_out": nrm(ks[15], (L, D, D), D ** -0.5),
        "g_pre_ffn": gain(ks[16], (L, D)),
        "g_post_ffn": gain(ks[17], (L, D)),
        "w_group": nrm(ks[18], (L, D, N_GROUPS), D ** -0.5),
        "b_group": nrm(ks[19], (L, N_GROUPS), 0.01),
        "w_router": nrm(ks[20], (L, D, N_EXPERTS), D ** -0.5),
        "b_router": nrm(ks[21], (L, N_EXPERTS), 0.01),
        "w_e_gate": nrm(ks[22], (L, N_EXPERTS, D, D_EXPERT), D ** -0.5),
        "w_e_up": nrm(ks[23], (L, N_EXPERTS, D, D_EXPERT), D ** -0.5),
        "w_e_down": nrm(ks[24], (L, N_EXPERTS, D_EXPERT, D), D_EXPERT ** -0.5),
    }


def reference(x, c, w_ada, b_ada, g_pre_mix, g_post_mix, w_in, w_dw, b_dw, conv_ln_g, conv_ln_b,
              w_conv_out, q_norm_g, k_norm_g, w_attn_out, w_out, g_pre_ffn, g_post_ffn,
              w_group, b_group, w_router, b_router, w_e_gate, w_e_up, w_e_down):
    B, S, D = x.shape
    ang_row, ang_col = axial_rope_angles(S)
    for l in range(DEPTH):
        ada = jax.nn.silu(c) @ w_ada[l] + b_ada[l]
        sh1, sc1, gt1, sh2, sc2, gt2 = jnp.split(ada[:, None, :], 6, axis=-1)

        h = rmsnorm(x, g_pre_mix[l]) * (1.0 + sc1) + sh1
        z = h @ w_in[l]
        u_glu, q, k, v, g_conv, g_attn = jnp.split(z, SPLITS, axis=-1)

        a, ag = jnp.split(u_glu, 2, axis=-1)
        u = depthwise_conv(a * jax.nn.sigmoid(ag), w_dw[l], b_dw[l])
        u = layernorm(u, conv_ln_g[l], conv_ln_b[l])
        conv_out = jax.nn.silu(u) @ w_conv_out[l]

        q = apply_axial_rope(rmsnorm(q.reshape(B, S, N_HEADS, HEAD_DIM), q_norm_g[l]), ang_row, ang_col)
        k = apply_axial_rope(rmsnorm(k.reshape(B, S, N_KV_HEADS, HEAD_DIM), k_norm_g[l]), ang_row, ang_col)
        v = v.reshape(B, S, N_KV_HEADS, HEAD_DIM)
        attn_out = axial_gqa_attention(q, k, v) @ w_attn_out[l]

        merged = jax.nn.sigmoid(g_conv) * conv_out + jax.nn.sigmoid(g_attn) * attn_out
        x = x + gt1 * rmsnorm(merged @ w_out[l], g_post_mix[l])

        h = rmsnorm(x, g_pre_ffn[l]) * (1.0 + sc2) + sh2
        y = hierarchical_moe(h, w_group[l], b_group[l], w_router[l], b_router[l],
                             w_e_gate[l], w_e_up[l], w_e_down[l])
        x = x + gt2 * rmsnorm(y, g_post_ffn[l])
    return x
```

```cpp
#define MK_NPRE 10
#define MK_ONE 1
#define MK_FLAGS 0
#include <hip/hip_runtime.h>
#include <hip/hip_bf16.h>
#include <cstdint>
#include <cstdio>
#include <cmath>

#define GAS __attribute__((address_space(1)))
#define LAS __attribute__((address_space(3)))
typedef unsigned short bf16;
typedef float f32x4 __attribute__((ext_vector_type(4)));
typedef float f32x2 __attribute__((ext_vector_type(2)));
typedef unsigned u32x4 __attribute__((ext_vector_type(4)));
typedef unsigned u32x2 __attribute__((ext_vector_type(2)));
typedef short bf16x8 __attribute__((ext_vector_type(8)));
typedef float f32x16 __attribute__((ext_vector_type(16)));

constexpr int NB = 16, SEQ = 2048, D = 1024, NTOK = NB * SEQ;
constexpr int INW = 3840, CW = 512, NE = 32, DE = 512, KS = 31;
constexpr int ECAP = NTOK;
constexpr int MAXSLOT = 73728;
constexpr float EPS = 1e-6f;
constexpr float QSCALE = 0.125f * 1.4426950408889634f;

constexpr size_t MiB = 1u << 20;
constexpr size_t WS_CTL = 0, CTL_ZERO_BYTES = 64 * 1024;
constexpr size_t WS_ADA = 1 * MiB;
constexpr size_t WS_ROPE = WS_ADA + 512 * 1024;
constexpr size_t WS_WR = WS_ADA + 640 * 1024;
constexpr size_t WS_H1 = 2 * MiB;
constexpr size_t WS_GLU = 66 * MiB;
constexpr size_t WS_QKV = 98 * MiB;
constexpr size_t WS_Y1 = 66 * MiB;
constexpr size_t WS_GATES = 146 * MiB;
constexpr size_t WS_X1B = 218 * MiB;
constexpr size_t WS_CA = 282 * MiB;
constexpr size_t WS_WIN = 346 * MiB;
constexpr size_t WS_WCA = WS_WIN + (size_t)INW * D * 2;
constexpr size_t WS_WO = WS_WCA + 2 * MiB;
constexpr size_t WS_W1 = WS_WO + 2 * MiB;
constexpr size_t WS_W2 = WS_W1 + 32 * MiB;
constexpr size_t WS_H2F = WS_W2 + 16 * MiB;
constexpr size_t WS_WINF = WS_H2F + 32 * MiB;
constexpr size_t WS_WEND = WS_WINF + 4 * MiB;
constexpr size_t WS_H1F = 282 * MiB;
constexpr size_t WS_TMP = 346 * MiB;
constexpr size_t WS_LIST = 474 * MiB;
constexpr size_t WS_TOK = 478 * MiB;
constexpr size_t WS_PART = 480 * MiB;
constexpr size_t WS_Y2 = 2 * MiB;
constexpr size_t WS_END = 482 * MiB;
static_assert(WS_WEND <= WS_LIST && WS_Y2 + (size_t)MAXSLOT * D * 2 <= WS_GATES && WS_GATES + (size_t)MAXSLOT * DE * 2 <= WS_X1B && WS_X1B + (size_t)NTOK * D * 2 <= WS_CA && WS_GATES + (size_t)NTOK * 2048 * 2 <= WS_CA && WS_CA + (size_t)NTOK * D * 2 <= WS_WIN, "d_ws map");
constexpr int CW_CNT = 0, CW_OFF = 64, CW_ADA = 128, CW_BAR = 4096;

__device__ __forceinline__ float bf2f(unsigned v) { return __uint_as_float(v << 16); }
__device__ __forceinline__ unsigned f2bf(float f) { unsigned u = __float_as_uint(f); return (u + 0x7fffu + ((u >> 16) & 1u)) >> 16; }
__device__ __forceinline__ unsigned pk2(float lo, float hi) { return f2bf(lo) | (f2bf(hi) << 16); }
__device__ __forceinline__ unsigned cvt_pk_bf16(float lo, float hi) { unsigned r; asm volatile("v_cvt_pk_bf16_f32 %0, %1, %2" : "=v"(r) : "v"(lo), "v"(hi)); return r; }
template <int CTRL> __device__ __forceinline__ float dpp_mov(float v) { return __builtin_bit_cast(float, __builtin_amdgcn_update_dpp(0, __builtin_bit_cast(int, v), CTRL, 0xf, 0xf, true)); }
__device__ __forceinline__ float row16_sum(float v) {
    v += dpp_mov<0xB1>(v);
    v += dpp_mov<0x4E>(v);
    v += dpp_mov<0x141>(v);
    v += dpp_mov<0x140>(v);
    return v;
}
__device__ __forceinline__ float wave_sum(float v) {
    v = row16_sum(v);
    { auto rr = __builtin_amdgcn_permlane16_swap(__float_as_uint(v), __float_as_uint(v), false, false); v = __uint_as_float(rr[0]) + __uint_as_float(rr[1]); }
    { auto rr = __builtin_amdgcn_permlane32_swap(__float_as_uint(v), __float_as_uint(v), false, false); v = __uint_as_float(rr[0]) + __uint_as_float(rr[1]); }
    return v;
}
__device__ __forceinline__ float sigmoidf_(float v) { return 1.f / (1.f + __expf(-v)); }
__device__ __forceinline__ float siluf_(float v) { return v / (1.f + __expf(-v)); }
__device__ __forceinline__ float sig_fast(float v) { return __builtin_amdgcn_rcpf(1.f + __builtin_amdgcn_exp2f(v * -1.4426950408889634f)); }
#define LDS_WAIT() asm volatile("s_waitcnt lgkmcnt(0)" ::: "memory")
#define VM_WAIT() asm volatile("s_waitcnt vmcnt(0)" ::: "memory")

__host__ __device__ __forceinline__ int vmap_win(int n) {
    if (n < 512) return 256 * (n >> 7) + (n & 127);
    if (n < 1024) { const int j = n - 512; return 256 * (j >> 7) + 128 + (j & 127); }
    if (n < 1664) { const int idx = n - 1024, hh = idx >> 6, d = idx & 63, tile = 4 + (hh >> 2), wc = hh & 3, bj = (d >> 4) & 1, e = (d < 32) ? (d & 15) : 16 + (d & 15);
        return 256 * tile + 128 * bj + 32 * wc + e; }
    if (n < 1792) { const int idx = n - 1664, vh = idx >> 6, d = idx & 63; return 256 * 6 + 128 * (d >> 5) + 32 * (2 + vh) + (d & 31); }
    if (n < 2816) { const int j = n - 1792; return 256 * (7 + (j >> 7)) + (j & 127); }
    { const int j = n - 2816; return 256 * (7 + (j >> 7)) + 128 + (j & 127); }
}

namespace pg8 {
constexpr int BM = 256, BK = 64, HALF = 128, HTB = HALF * BK * 2  , STAGE_BYTES = 8 * HTB, NXCD = 8, WGM = 8;
__host__ __device__ __forceinline__ int lds_byte(int r, int c) { const int st = (r >> 4) * 2 + (c >> 5), rr = r & 15, cc = c & 31, ob = rr * 64 + cc * 2; return st * 1024 + (ob ^ (((ob >> 9) & 1) << 5)); }
__host__ __device__ __forceinline__ void stage_rc(int b, int& R, int& C) { const int st = b / 1024, sb = b % 1024, swz = sb ^ (((sb >> 9) & 1) << 5); R = (st >> 1) * 16 + swz / 64; C = (st & 1) * 32 + (swz % 64) / 2; }
__host__ __device__ __forceinline__ int perm32(int rho) { const int n = rho >> 4, i = rho & 15; return 8 * (i >> 2) + 4 * n + (i & 3); }

struct Unit { int pm, pn, e, ord; };

struct StaticOrder {
    const void* Bt; int KB; int nM, nN, nwg, G, c;
    __device__ void init(const void* Bt_, int KB_, int M, int N, int G_, int c_) { Bt = Bt_; KB = KB_; nM = M / BM; nN = N / BM; nwg = nM * nN; G = G_; c = c_; }
    __device__ __forceinline__ bool next(int i, Unit& u) const {
        const long L = (long)i * G + c; if (L >= nwg) return false;
        int wgid = (int)L; { const int q = nwg / NXCD, r = nwg % NXCD, xcd = wgid % NXCD, off = wgid / NXCD; wgid = (xcd < r ? xcd * (q + 1) : r * (q + 1) + (xcd - r) * q) + off; }
        const int nig = WGM * nN, gid = wgid / nig, fm = gid * WGM, gsz = (nM - fm) < WGM ? (nM - fm) : WGM;
        u.pm = fm + ((wgid % nig) % gsz); u.pn = (wgid % nig) / gsz; u.e = 0; u.ord = i; return true;
    }
    static constexpr bool GATHER = false;
    __device__ __forceinline__ int arow(const Unit& u, int r) const { return u.pm * BM + r; }
    __device__ __forceinline__ const char* bbase(const Unit& u) const { return (const char*)Bt + (size_t)u.pn * BM * KB; }
};

typedef int v8i32 __attribute__((ext_vector_type(8)));
typedef int v4i32 __attribute__((ext_vector_type(4)));
__device__ __forceinline__ void mfma_fp8_inplace(f32x4& d, const v8i32 a, const v8i32 b, const int scale) {
    asm volatile("v_mfma_scale_f32_16x16x128_f8f6f4 %0, %1, %2, %0, %3, %3 op_sel_hi:[0,0,0]" : "+v"(d) : "v"(a), "v"(b), "v"(scale));
}
__device__ __forceinline__ void mfma_bf16_inplace(f32x4& d, const bf16x8 a, const bf16x8 b) {
    asm volatile("v_mfma_f32_16x16x32_bf16 %0, %1, %2, %0" : "+v"(d) : "v"(a), "v"(b));
}
template <class Epi, class Sched, bool ALIGN_EPI, int DT = 0>
__device__ __forceinline__ void gemm_phase(LAS unsigned char* lds, const void* A, int ldaB_, int KB, const Sched& S, const Epi& E, const void* A8 = nullptr, int kbytes = 0) {
    const int tid = threadIdx.x, wid = __builtin_amdgcn_readfirstlane(tid >> 6), lane = tid & 63, wr = wid >> 2, wc = wid & 3, fr = lane & 15, fq = lane >> 4;
    const int nt_full = (kbytes ? kbytes : KB) / (BK * 2);
    const unsigned ldaB = (unsigned)ldaB_;
    unsigned voffA[2], voffB[2];
#pragma unroll
    for (int i = 0; i < 2; ++i) { int R, C; stage_rc(tid * 16 + i * 8192, R, C); const int Rb = (R & ~31) + perm32(R & 31);
        voffA[i] = (unsigned)R * ldaB + (unsigned)C * 2u; voffB[i] = (unsigned)(Rb * KB + C * 2); }
    const size_t kstep = (size_t)(BK * 2);
    const size_t hstep = (size_t)HALF * KB;
    const size_t hstepA = (size_t)HALF * ldaB;
    const unsigned ldsw = (unsigned)wid * 1024u;
    const int aoff = lds_byte(wr * 64 + fr, fq * 8), boff = lds_byte(wc * 32 + fr, fq * 8);
#define PG8_SA(b, h) (((b) * 2 + (h)) * HTB)
#define PG8_SB(b, h) ((4 + (b) * 2 + (h)) * HTB)
#define PG8_STAGE(bufoff, gbase, voff) do { _Pragma("unroll") for (int _i = 0; _i < 2; ++_i) \
        __builtin_amdgcn_global_load_lds((const unsigned*)((const char*)(gbase) + (voff)[_i]), (LAS unsigned*)(lds + (bufoff) + ldsw + _i * 8192), 16, 0, 0); } while (0)
#define PG8_LDA(dst, b, h) do { _Pragma("unroll") for (int m = 0; m < 4; ++m) _Pragma("unroll") for (int k = 0; k < 2; ++k) dst[m][k] = *(const LAS bf16x8*)(lds + PG8_SA(b, h) + aoff + m * 2048 + k * 1024); } while (0)
#define PG8_LDB(dst, b, h) do { _Pragma("unroll") for (int n = 0; n < 2; ++n) _Pragma("unroll") for (int k = 0; k < 2; ++k) dst[n][k] = *(const LAS bf16x8*)(lds + PG8_SB(b, h) + boff + n * 2048 + k * 1024); } while (0)
#define PG8_CAT(x) __builtin_shufflevector(__builtin_bit_cast(v4i32, (x)[0]), __builtin_bit_cast(v4i32, (x)[1]), 0, 1, 2, 3, 4, 5, 6, 7)
#define PG8_MMA(ai, bj, At, Bt) do { __builtin_amdgcn_s_setprio(1); \
        if (DT == 1 || (DT == 2 && f8cur)) { _Pragma("unroll") for (int m = 0; m < 4; ++m) _Pragma("unroll") for (int n = 0; n < 2; ++n) \
            mfma_fp8_inplace(acc[ai][bj][m][n], PG8_CAT(Bt[n]), PG8_CAT(At[m]), one_scale); } \
        else { _Pragma("unroll") for (int m = 0; m < 4; ++m) _Pragma("unroll") for (int n = 0; n < 2; ++n) _Pragma("unroll") for (int k = 0; k < 2; ++k) \
            { if constexpr (DT == 2) mfma_bf16_inplace(acc[ai][bj][m][n], Bt[n][k], At[m][k]); else acc[ai][bj][m][n] = __builtin_amdgcn_mfma_f32_16x16x32_bf16(Bt[n][k], At[m][k], acc[ai][bj][m][n], 0, 0, 0); } } \
        __builtin_amdgcn_s_setprio(0); } while (0)
#define PG8_WAIT_V(n) asm volatile("s_waitcnt vmcnt(" #n ")" ::: "memory")
#define PG8_WAIT_L(n) asm volatile("s_waitcnt lgkmcnt(" #n ")" ::: "memory")
#define PG8_BAR __builtin_amdgcn_s_barrier()
#define PG8_SCHED __builtin_amdgcn_sched_barrier(0)
#define PG8_MKVA(dst, u) do { _Pragma("unroll") for (int _h = 0; _h < 2; ++_h) _Pragma("unroll") for (int _p = 0; _p < 2; ++_p) { int _R, _C; stage_rc(tid * 16 + _p * 8192, _R, _C); \
        dst[_h][_p] = (unsigned)S.arow(u, _h * HALF + _R) * ldaB + (unsigned)_C * 2u; } } while (0)
#define PG8_STAGE_AC(bufoff, h, kofs) do { if constexpr (Sched::GATHER) PG8_STAGE(bufoff, Ab + (kofs), vA[h]); else PG8_STAGE(bufoff, cA + (h) * hstepA + (kofs), voffA); } while (0)
#define PG8_STAGE_AN(bufoff, h, kofs) do { if constexpr (Sched::GATHER) PG8_STAGE(bufoff, Ab + (kofs), nvA[h]); else PG8_STAGE(bufoff, nA + (h) * hstepA + (kofs), voffA); } while (0)
#define PG8_STAGE_A23(bufoff, h, w) do { if (last) PG8_STAGE_AN(bufoff, h, (size_t)(w) * kstep); else PG8_STAGE_AC(bufoff, h, (size_t)(t + 2 + (w)) * kstep); } while (0)
    Unit cur, nxt; int ui = 0;
    if (!S.next(0, cur)) return;
    f32x4 acc[2][2][4][2];
#pragma unroll
    for (int a = 0; a < 2; ++a)
#pragma unroll
        for (int b = 0; b < 2; ++b)
#pragma unroll
            for (int m = 0; m < 4; ++m)
#pragma unroll
                for (int n = 0; n < 2; ++n) acc[a][b][m][n] = (f32x4){0.f, 0.f, 0.f, 0.f};
    bf16x8 At[4][2], B0[2][2], B1[2][2];
    int one_scale = 0x7f7f7f7f; asm volatile("" : "+v"(one_scale));
    unsigned vA[2][2], nvA[2][2];
    const char* const Ab = (const char*)A;
    const char* cA = Ab; const char* nA = Ab;
    bool f8cur = (DT == 2) && cur.e != 0; int nt = (DT == 2 && f8cur) ? (nt_full >> 1) : nt_full;
#define PG8_ABASE(u) ((DT == 2 && (u).e != 0) ? (const char*)A8 : Ab)
    if constexpr (Sched::GATHER) { PG8_MKVA(vA, cur); } else { cA = PG8_ABASE(cur) + (size_t)S.arow(cur, 0) * ldaB; }
    const char* cB = S.bbase(cur);
    PG8_STAGE(PG8_SB(0, 0), cB, voffB); PG8_STAGE(PG8_SB(0, 1), cB + hstep, voffB); PG8_STAGE_AC(PG8_SA(0, 0), 0, 0); PG8_STAGE_AC(PG8_SA(0, 1), 1, 0);
    if (wr == 1) PG8_BAR;
    PG8_WAIT_V(2); PG8_BAR;
    PG8_STAGE(PG8_SB(1, 0), cB + kstep, voffB); PG8_STAGE_AC(PG8_SA(1, 0), 0, kstep); PG8_STAGE(PG8_SB(1, 1), cB + hstep + kstep, voffB);
    PG8_WAIT_V(6); PG8_BAR;
    for (;;) {
        const bool has_next = S.next(ui + 1, nxt);
        const char* nB = has_next ? S.bbase(nxt) : cB;
        if constexpr (!Sched::GATHER) nA = has_next ? PG8_ABASE(nxt) + (size_t)S.arow(nxt, 0) * ldaB : cA;
#pragma unroll 1
        for (int t = 0; t < nt; t += 2) {
            const bool last = (t == nt - 2);
            if constexpr (Epi::MID) { if (t == (nt >> 1)) { if (wr == 0) PG8_BAR; E.mid(acc, cur, wr, wc, fr, fq); if (wr == 1) PG8_BAR; } }
            if constexpr (Sched::GATHER) { if (last) { if (has_next) { PG8_MKVA(nvA, nxt); } else {
#pragma unroll
                    for (int h = 0; h < 2; ++h)
#pragma unroll
                        for (int p = 0; p < 2; ++p) nvA[h][p] = vA[h][p]; } } }
            const char* b2 = last ? nB : cB + (size_t)(t + 2) * kstep; const char* b3 = b2 + kstep;
            PG8_LDB(B0, 0, 0); PG8_LDB(B1, 0, 1); PG8_SCHED; PG8_LDA(At, 0, 0); PG8_STAGE_AC(PG8_SA(1, 1), 1, (size_t)(t + 1) * kstep);
            PG8_WAIT_V(8); PG8_WAIT_L(0); PG8_BAR; PG8_MMA(0, 0, At, B0); PG8_MMA(0, 1, At, B1); PG8_BAR; PG8_SCHED;
            PG8_LDA(At, 0, 1); PG8_STAGE(PG8_SB(0, 0), b2, voffB); PG8_STAGE(PG8_SB(0, 1), b2 + hstep, voffB); PG8_STAGE_A23(PG8_SA(0, 0), 0, 0);
            PG8_WAIT_V(8); PG8_WAIT_L(0); PG8_BAR; PG8_MMA(1, 0, At, B0); PG8_MMA(1, 1, At, B1); PG8_BAR; PG8_SCHED;
            PG8_LDB(B0, 1, 0); PG8_LDB(B1, 1, 1); PG8_SCHED; PG8_LDA(At, 1, 0); PG8_STAGE_A23(PG8_SA(0, 1), 1, 0);
            PG8_WAIT_V(8); PG8_WAIT_L(0); PG8_BAR; PG8_MMA(0, 0, At, B0); PG8_MMA(0, 1, At, B1); PG8_BAR; PG8_SCHED;
            PG8_LDA(At, 1, 1); PG8_STAGE(PG8_SB(1, 0), b3, voffB); PG8_STAGE(PG8_SB(1, 1), b3 + hstep, voffB); PG8_STAGE_A23(PG8_SA(1, 0), 0, 1);
            PG8_WAIT_V(8); PG8_WAIT_L(0); PG8_BAR; PG8_MMA(1, 0, At, B0); PG8_MMA(1, 1, At, B1); PG8_BAR; PG8_SCHED;
        }
        if constexpr (ALIGN_EPI) { if (wr == 0) PG8_BAR; }
        if constexpr (DT != 0) asm volatile("s_nop 15\n\ts_nop 15" ::: "memory");
        E(acc, cur, wr, wc, fr, fq);
        if (!has_next) break;
#pragma unroll
        for (int a = 0; a < 2; ++a)
#pragma unroll
            for (int b = 0; b < 2; ++b)
#pragma unroll
                for (int m = 0; m < 4; ++m)
#pragma unroll
                    for (int n = 0; n < 2; ++n) acc[a][b][m][n] = (f32x4){0.f, 0.f, 0.f, 0.f};
        cur = nxt; cB = nB; ++ui;
        if constexpr (DT == 2) { f8cur = cur.e != 0; nt = f8cur ? (nt_full >> 1) : nt_full; }
        if constexpr (Sched::GATHER) {
#pragma unroll
            for (int h = 0; h < 2; ++h)
#pragma unroll
                for (int p = 0; p < 2; ++p) vA[h][p] = nvA[h][p]; } else cA = nA;
        if constexpr (ALIGN_EPI) { if (wr == 1) PG8_BAR; }
    }
    PG8_WAIT_V(0);
    if constexpr (!ALIGN_EPI) { if (wr == 0) PG8_BAR; }
    PG8_BAR;
#undef PG8_ABASE
#undef PG8_STAGE_AC
#undef PG8_STAGE_AN
#undef PG8_STAGE_A23
#undef PG8_SA
#undef PG8_SB
#undef PG8_STAGE
#undef PG8_LDA
#undef PG8_LDB
#undef PG8_MMA
#undef PG8_WAIT_V
#undef PG8_WAIT_L
#undef PG8_BAR
#undef PG8_SCHED
#undef PG8_MKVA
#undef PG8_CAT
}
}
namespace pg8 {
__host__ __device__ __forceinline__ size_t gate_frag_base(int pm, int t, int w) { return ((size_t)((pm * 8 + t) * 8 + w) * 8) * 1024; }
__host__ __device__ __forceinline__ size_t gate_index(int row, int col) {
    const int pm = row >> 8, t = col >> 7, w = 4 * ((row >> 6) & 1) + ((col >> 5) & 3), k = 4 * ((row >> 7) & 1) + ((row >> 4) & 3), l = 16 * ((col >> 3) & 3) + (row & 15);
    return gate_frag_base(pm, t, w) + (size_t)k * 1024 + l * 16 + (col & 7);
}
__device__ __forceinline__ unsigned q8x4(float a, float b, float c, float d) {
    unsigned r = __builtin_amdgcn_cvt_pk_u8_f32(a * 256.f - 0.5f, 0, 0u); r = __builtin_amdgcn_cvt_pk_u8_f32(b * 256.f - 0.5f, 1, r);
    r = __builtin_amdgcn_cvt_pk_u8_f32(c * 256.f - 0.5f, 2, r); return __builtin_amdgcn_cvt_pk_u8_f32(d * 256.f - 0.5f, 3, r);
}
__device__ __forceinline__ void dq8x4(unsigned w, float (&f)[4]) { f[0] = (float)(w & 0xffu) + 0.5f; f[1] = (float)((w >> 8) & 0xffu) + 0.5f; f[2] = (float)((w >> 16) & 0xffu) + 0.5f; f[3] = (float)(w >> 24) + 0.5f; }
constexpr float WSCIN = 32.f;
struct EpiP2 {
    static constexpr bool MID = false;
    bf16* glu; bf16* qkv; bf16* gates; const float* qg; const float* kg; const f32x2* rope;
    __device__ __forceinline__ void operator()(const f32x4 (&acc)[2][2][4][2], const Unit& u, int wr, int wc, int fr, int fq) const {
        const int row0 = u.pm * BM + wr * 64 + fr;
        if (u.pn < 4) {
#pragma unroll
            for (int ai = 0; ai < 2; ++ai)
#pragma unroll
                for (int m = 0; m < 4; ++m) { const size_t row = (size_t)(row0 + ai * HALF + m * 16);
                    const f32x4 a0 = acc[ai][0][m][0], a1 = acc[ai][0][m][1], g0 = acc[ai][1][m][0], g1 = acc[ai][1][m][1];
                    u32x4 w; w.x = cvt_pk_bf16(a0[0] * sig_fast(g0[0]), a0[1] * sig_fast(g0[1])); w.y = cvt_pk_bf16(a0[2] * sig_fast(g0[2]), a0[3] * sig_fast(g0[3]));
                    w.z = cvt_pk_bf16(a1[0] * sig_fast(g1[0]), a1[1] * sig_fast(g1[1])); w.w = cvt_pk_bf16(a1[2] * sig_fast(g1[2]), a1[3] * sig_fast(g1[3]));
                    *(u32x4*)(glu + row * CW + u.pn * 128 + wc * 32 + fq * 8) = w; }
        } else if (u.pn < 7) {
            const int hs = (u.pn - 4) * 4 + wc;
            if (hs >= 10) {
#pragma unroll
                for (int ai = 0; ai < 2; ++ai)
#pragma unroll
                    for (int m = 0; m < 4; ++m) { const size_t row = (size_t)(row0 + ai * HALF + m * 16);
#pragma unroll
                        for (int bj = 0; bj < 2; ++bj) { const f32x4 v0 = acc[ai][bj][m][0], v1 = acc[ai][bj][m][1];
                            u32x4 w; w.x = cvt_pk_bf16(v0[0], v0[1]); w.y = cvt_pk_bf16(v0[2], v0[3]); w.z = cvt_pk_bf16(v1[0], v1[1]); w.w = cvt_pk_bf16(v1[2], v1[3]);
                            *(u32x4*)(qkv + row * 768 + hs * 64 + bj * 32 + fq * 8) = w; } }
            } else {
                const float* g = hs < 8 ? qg : kg; const float osc = hs < 8 ? QSCALE : 1.f;
                const int dbase = fq < 2 ? 8 * fq : 8 * fq + 16;
                float g1[8], g2[8];
#pragma unroll
                for (int i = 0; i < 8; ++i) { g1[i] = g[dbase + i] * osc; g2[i] = g[dbase + 16 + i] * osc; }
#pragma unroll
                for (int ai = 0; ai < 2; ++ai)
#pragma unroll
                    for (int m = 0; m < 4; ++m) { const int rowi = row0 + ai * HALF + m * 16; const size_t row = (size_t)rowi;
                        const int s = rowi & (SEQ - 1); const int tabrow = fq < 2 ? (s >> 6) : 32 + (s & 63);
                        const f32x2* tp = rope + tabrow * 16 + 8 * (fq & 1);
                        float ss = 0.f;
#pragma unroll
                        for (int bj = 0; bj < 2; ++bj)
#pragma unroll
                            for (int n = 0; n < 2; ++n) { const f32x4 v = acc[ai][bj][m][n]; ss += (v[0] * v[0] + v[1] * v[1]) + (v[2] * v[2] + v[3] * v[3]); }
                        ss += __shfl_xor(ss, 16); ss += __shfl_xor(ss, 32);
                        const float rstd = rsqrtf(ss * (1.f / 64.f) + EPS);
                        float o1[8], o2[8];
#pragma unroll
                        for (int n = 0; n < 2; ++n)
#pragma unroll
                            for (int j = 0; j < 4; ++j) { const f32x2 cs = tp[4 * n + j];
                                const float x1 = acc[ai][0][m][n][j] * rstd * g1[4 * n + j], x2 = acc[ai][1][m][n][j] * rstd * g2[4 * n + j];
                                o1[4 * n + j] = x1 * cs.x - x2 * cs.y; o2[4 * n + j] = x2 * cs.x + x1 * cs.y; }
                        u32x4 w1, w2;
                        w1.x = cvt_pk_bf16(o1[0], o1[1]); w1.y = cvt_pk_bf16(o1[2], o1[3]); w1.z = cvt_pk_bf16(o1[4], o1[5]); w1.w = cvt_pk_bf16(o1[6], o1[7]);
                        w2.x = cvt_pk_bf16(o2[0], o2[1]); w2.y = cvt_pk_bf16(o2[2], o2[3]); w2.z = cvt_pk_bf16(o2[4], o2[5]); w2.w = cvt_pk_bf16(o2[6], o2[7]);
                        bf16* dst = qkv + row * 768 + hs * 64 + dbase;
                        *(u32x4*)dst = w1; *(u32x4*)(dst + 16) = w2; }
            }
        } else {
            unsigned char* gr = (unsigned char*)gates + gate_frag_base(u.pm, u.pn - 7, wr * 4 + wc) + (fq * 16 + fr) * 16;
#pragma unroll
            for (int ai = 0; ai < 2; ++ai)
#pragma unroll
                for (int m = 0; m < 4; ++m) {
                    float sc[8], sa[8];
#pragma unroll
                    for (int n = 0; n < 2; ++n)
#pragma unroll
                        for (int j = 0; j < 4; ++j) {
                            const float dc = 1.f + __builtin_amdgcn_exp2f(acc[ai][0][m][n][j] * (-1.4426950408889634f / WSCIN)), da = 1.f + __builtin_amdgcn_exp2f(acc[ai][1][m][n][j] * (-1.4426950408889634f / WSCIN));
                            const float rinv = __builtin_amdgcn_rcpf(dc * da); sc[4 * n + j] = rinv * da; sa[4 * n + j] = rinv * dc; }
                    *(u32x4*)(gr + (ai * 4 + m) * 1024) = (u32x4){q8x4(sc[0], sc[1], sc[2], sc[3]), q8x4(sc[4], sc[5], sc[6], sc[7]), q8x4(sa[0], sa[1], sa[2], sa[3]), q8x4(sa[4], sa[5], sa[6], sa[7])}; }
        }
    }
};
__device__ __forceinline__ void unpack8(const u32x4 w, float (&f)[8]) {
    f[0] = bf2f(w.x & 0xffffu); f[1] = bf2f(w.x >> 16); f[2] = bf2f(w.y & 0xffffu); f[3] = bf2f(w.y >> 16);
    f[4] = bf2f(w.z & 0xffffu); f[5] = bf2f(w.z >> 16); f[6] = bf2f(w.w & 0xffffu); f[7] = bf2f(w.w >> 16);
}
struct EpiP4 {
    static constexpr bool MID = true;
    const bf16* gates; bf16* merged;
    __device__ __forceinline__ void mid(f32x4 (&acc)[2][2][4][2], const Unit& u, int wr, int wc, int fr, int fq) const {
        asm volatile("" ::: "memory");
        u32x4 rr[2][8];
#pragma unroll
        for (int bj = 0; bj < 2; ++bj) { const unsigned char* gp = (const unsigned char*)gates + gate_frag_base(u.pm, 2 * u.pn + bj, wr * 4 + wc) + (fq * 16 + fr) * 16;
#pragma unroll
            for (int k = 0; k < 8; ++k) rr[bj][k] = *(const u32x4*)(gp + k * 1024); }
#pragma unroll
        for (int bj = 0; bj < 2; ++bj)
#pragma unroll
            for (int k = 0; k < 8; ++k)
#pragma unroll
                for (int n = 0; n < 2; ++n) { float c[4], a[4]; dq8x4(n ? rr[bj][k].y : rr[bj][k].x, c); dq8x4(n ? rr[bj][k].w : rr[bj][k].z, a);
#pragma unroll
                    for (int j = 0; j < 4; ++j) acc[k >> 2][bj][k & 3][n][j] *= c[j] * __builtin_amdgcn_rcpf(a[j]); }
        asm volatile("" ::: "memory");
    }
    __device__ __forceinline__ void operator()(const f32x4 (&acc)[2][2][4][2], const Unit& u, int wr, int wc, int fr, int fq) const {
        const int row0 = u.pm * BM + wr * 64 + fr, col0 = u.pn * BM + wc * 32 + fq * 8;
        u32x2 rr[2][8];
#pragma unroll
        for (int bj = 0; bj < 2; ++bj) { const unsigned char* gp = (const unsigned char*)gates + gate_frag_base(u.pm, 2 * u.pn + bj, wr * 4 + wc) + (fq * 16 + fr) * 16 + 8;
#pragma unroll
            for (int k = 0; k < 8; ++k) rr[bj][k] = *(const u32x2*)(gp + k * 1024); }
        asm volatile("" ::: "memory");
#pragma unroll
        for (int bj = 0; bj < 2; ++bj)
#pragma unroll
            for (int k = 0; k < 8; ++k) { const size_t row = (size_t)(row0 + (k >> 2) * HALF + (k & 3) * 16);
                float a0[4], a1[4]; dq8x4(rr[bj][k].x, a0); dq8x4(rr[bj][k].y, a1); constexpr float s = 1.f / 256.f;
                const f32x4 v0 = acc[k >> 2][bj][k & 3][0] * s, v1 = acc[k >> 2][bj][k & 3][1] * s;
                u32x4 w; w.x = cvt_pk_bf16(v0[0] * a0[0], v0[1] * a0[1]); w.y = cvt_pk_bf16(v0[2] * a0[2], v0[3] * a0[3]); w.z = cvt_pk_bf16(v1[0] * a1[0], v1[1] * a1[1]); w.w = cvt_pk_bf16(v1[2] * a1[2], v1[3] * a1[3]);
                *(u32x4*)(merged + row * D + col0 + bj * HALF) = w; }
    }
};
struct EpiP5 {
    static constexpr bool MID = false;
    bf16* y1; float* part;
    __device__ __forceinline__ void operator()(const f32x4 (&acc)[2][2][4][2], const Unit& u, int wr, int wc, int fr, int fq) const {
        const int row0 = u.pm * BM + wr * 64 + fr, col0 = u.pn * BM + wc * 32 + fq * 8;
#pragma unroll
        for (int ai = 0; ai < 2; ++ai)
#pragma unroll
            for (int m = 0; m < 4; ++m) { const size_t row = (size_t)(row0 + ai * HALF + m * 16); float ss = 0.f;
#pragma unroll
                for (int bj = 0; bj < 2; ++bj) { const f32x4 v0 = acc[ai][bj][m][0], v1 = acc[ai][bj][m][1];
                    ss += (v0[0] * v0[0] + v0[1] * v0[1]) + (v0[2] * v0[2] + v0[3] * v0[3]) + (v1[0] * v1[0] + v1[1] * v1[1]) + (v1[2] * v1[2] + v1[3] * v1[3]);
                    u32x4 w; w.x = cvt_pk_bf16(v0[0], v0[1]); w.y = cvt_pk_bf16(v0[2], v0[3]); w.z = cvt_pk_bf16(v1[0], v1[1]); w.w = cvt_pk_bf16(v1[2], v1[3]);
                    *(u32x4*)(y1 + row * D + col0 + bj * HALF) = w; }
                ss += __shfl_xor(ss, 16); ss += __shfl_xor(ss, 32);
                if (fq == 0) part[row * 16 + u.pn * 4 + wc] = ss; }
    }
};
__device__ __forceinline__ unsigned pk4_fp8(float a, float b, float c, float d) { int r = __builtin_amdgcn_cvt_pk_fp8_f32(a, b, 0, false); r = __builtin_amdgcn_cvt_pk_fp8_f32(c, d, r, true); return (unsigned)r; }
constexpr float WSC1 = 32.f, WSC2 = 16.f;
struct EpiMoe1 {
    static constexpr bool MID = false;
    unsigned char* act;
    __device__ __forceinline__ void operator()(const f32x4 (&acc)[2][2][4][2], const Unit& u, int wr, int wc, int fr, int fq) const {
        const int row0 = u.pm * BM + wr * 64 + fr; constexpr float is = 1.f / WSC1;
#pragma unroll
        for (int ai = 0; ai < 2; ++ai)
#pragma unroll
            for (int m = 0; m < 4; ++m) { const size_t row = (size_t)(row0 + ai * HALF + m * 16);
                const f32x4 g0 = acc[ai][0][m][0] * is, g1 = acc[ai][0][m][1] * is, u0 = acc[ai][1][m][0] * is, u1 = acc[ai][1][m][1] * is;
                u32x2 w; w.x = pk4_fp8(g0[0] * sig_fast(g0[0]) * u0[0], g0[1] * sig_fast(g0[1]) * u0[1], g0[2] * sig_fast(g0[2]) * u0[2], g0[3] * sig_fast(g0[3]) * u0[3]);
                w.y = pk4_fp8(g1[0] * sig_fast(g1[0]) * u1[0], g1[1] * sig_fast(g1[1]) * u1[1], g1[2] * sig_fast(g1[2]) * u1[2], g1[3] * sig_fast(g1[3]) * u1[3]);
                *(u32x2*)(act + row * DE + u.pn * 128 + wc * 32 + fq * 8) = w; }
    }
};
constexpr float YSC = 8.f;
struct EpiMoe2 {
    static constexpr bool MID = false;
    unsigned char* y2;
    __device__ __forceinline__ void operator()(const f32x4 (&acc)[2][2][4][2], const Unit& u, int wr, int wc, int fr, int fq) const {
        const int row0 = u.pm * BM + wr * 64 + fr, col0 = u.pn * BM + wc * 32 + fq * 8; constexpr float is = YSC / WSC2;
#pragma unroll
        for (int ai = 0; ai < 2; ++ai)
#pragma unroll
            for (int m = 0; m < 4; ++m) { const size_t row = (size_t)(row0 + ai * HALF + m * 16);
#pragma unroll
                for (int bj = 0; bj < 2; ++bj) { const f32x4 v0 = acc[ai][bj][m][0] * is, v1 = acc[ai][bj][m][1] * is;
                    *(u32x2*)(y2 + row * D + col0 + bj * HALF) = (u32x2){pk4_fp8(v0[0], v0[1], v0[2], v0[3]), pk4_fp8(v1[0], v1[1], v1[2], v1[3])}; } }
    }
};
constexpr int MOE_MAXU = 8;
template <bool GATHER_> struct MoeOrder {
    static constexpr bool GATHER = GATHER_;
    const LAS int* UT; const LAS int* RT; const void* W; size_t estride; int KB;
    __device__ __forceinline__ bool next(int i, Unit& u) const {
        if (i >= MOE_MAXU) return false;
        const int v = __builtin_amdgcn_readfirstlane(UT[i * 4 + 3]); if (!v) return false;
        u.pm = __builtin_amdgcn_readfirstlane(UT[i * 4 + 0]); u.pn = __builtin_amdgcn_readfirstlane(UT[i * 4 + 1]); u.e = __builtin_amdgcn_readfirstlane(UT[i * 4 + 2]); u.ord = i; return true;
    }
    __device__ __forceinline__ int arow(const Unit& u, int r) const { return GATHER ? RT[u.ord * 256 + r] : u.pm * BM + r; }
    __device__ __forceinline__ const char* bbase(const Unit& u) const { return (const char*)W + (size_t)u.e * estride + (size_t)u.pn * BM * KB; }
};
template <bool F8> struct P2Order {
    static constexpr bool GATHER = false;
    const char* W; int v, G;
    __device__ __forceinline__ bool next(int i, Unit& u) const {
        u.ord = i; u.e = F8 ? 1 : 0;
        if (!F8) { int L;
            if (G == 256) { if (i >= (v < 128 ? 4 : 3)) return false; L = 256 * i + v; } else { L = i * G + v; if (L >= 896) return false; }
            u.pm = L / 7; u.pn = L - 7 * u.pm; return true; }
        int f;
        if (G == 256) { if (i >= (v < 128 ? 3 : 5)) return false; f = v >= 128 ? (v - 128) * 5 + i : 640 + 3 * v + i; } else { f = i * G + v; if (f >= 1024) return false; }
        u.pm = f >> 3; u.pn = 7 + (f & 7); return true;
    }
    __device__ __forceinline__ int arow(const Unit& u, int r) const { return u.pm * BM + r; }
    __device__ __forceinline__ const char* bbase(const Unit& u) const { return W + (size_t)(F8 ? u.pn - 7 : u.pn) * BM * 2048; }
};
struct PanelOrder {
    static constexpr bool GATHER = false;
    const char* W; int v, G, KB;
    __device__ __forceinline__ bool next(int i, Unit& u) const { const int L = G * i + v; if (L >= (NTOK / BM) * 4) return false; u.pm = L >> 2; u.pn = L & 3; u.e = 0; u.ord = i; return true; }
    __device__ __forceinline__ int arow(const Unit& u, int r) const { return u.pm * BM + r; }
    __device__ __forceinline__ const char* bbase(const Unit& u) const { return W + (size_t)u.pn * BM * KB; }
};
}
namespace attn_body {
using bf16=__hip_bfloat16;
using bf16x8=__attribute__((ext_vector_type(8)))short;
using s16x4=__attribute__((ext_vector_type(4)))short;
using f32x16=__attribute__((ext_vector_type(16)))float;
using u32x4=__attribute__((ext_vector_type(4)))unsigned;
constexpr int BATCH=16,NHEAD=8,SEQ=2048,D=64,DM=768,OPITCH=1024;
constexpr int NW=8,QBLK=32,QB=QBLK*NW,KVBLK=64,NQB=SEQ/QB;
constexpr int ATTN_UNIT_ROWS=QB;
__device__ __forceinline__ int crow(int r,int hi){return (r&3)+8*(r>>2)+4*hi;}
#define SBAR() __builtin_amdgcn_sched_barrier(0)
__device__ __forceinline__ void cmask(f32x16&p0,f32x16&p1,int jb,int qrel,int hi){
  const float NEG=-INFINITY; int kb=64*jb+4*hi;
  #pragma unroll
  for(int r=0;r<16;++r){int kv=kb+(r&3)+8*(r>>2); if(kv>qrel)p0[r]=NEG; if(kv+32>qrel)p1[r]=NEG;}
}

constexpr int NSLOT=3, SLOTB=8192;
constexpr int LDS_K=0, LDS_V=NSLOT*SLOTB, LDS_WS=2*NSLOT*SLOTB, LDS_OST=LDS_WS+NW*64*4, LDS_BYTES=LDS_OST+NW*4096;
constexpr float C2=0.125f*1.4426950408889634f;
__device__ __forceinline__ void glds16(const void*gsrc,unsigned lds_dst){unsigned keep;
  asm volatile("s_mov_b32 %0, m0\n\ts_mov_b32 m0, %2\n\ts_nop 0\n\tglobal_load_lds_dwordx4 %1, off\n\ts_mov_b32 m0, %0":"=&s"(keep):"v"(gsrc),"s"(lds_dst):"memory");}
__device__ __forceinline__ float max3f(float a,float b,float c){float r;asm("v_max3_f32 %0, %1, %2, %3":"=v"(r):"v"(a),"v"(b),"v"(c));return r;}
__device__ __forceinline__ float max2f(float a,float b){float r;asm("v_max_f32_e32 %0, %1, %2":"=v"(r):"v"(a),"v"(b));return r;}
__device__ __forceinline__ float fadd_s(float a,float b){float r;asm("v_add_f32_e32 %0, %1, %2":"=v"(r):"v"(a),"v"(b));return r;}
__device__ __forceinline__ float fsub_s(float a,float b){float r;asm("v_sub_f32_e32 %0, %1, %2":"=v"(r):"v"(a),"v"(b));return r;}
typedef float f32x2_t __attribute__((ext_vector_type(2))); typedef __bf16 bf16x2_t __attribute__((ext_vector_type(2)));
__device__ __forceinline__ unsigned cvtpk_s(float lo,float hi){f32x2_t v={lo,hi};bf16x2_t b=__builtin_convertvector(v,bf16x2_t);return __builtin_bit_cast(unsigned,b);}
#define WAIT_BAR(N) asm volatile("s_waitcnt vmcnt(" #N ") lgkmcnt(0)\n\ts_barrier":::"memory")

__device__ __forceinline__ void qkt(f32x16&p0,f32x16&p1,const char*Kslot,const bf16x8*qr,const f32x16&negm,int r32,int hi){
  const char*kb=Kslot+hi*1024+r32*16;
  #pragma unroll
  for(int d0=0;d0<4;++d0){
    const bf16x8 b0=*reinterpret_cast<const bf16x8*>(kb+d0*2048);
    const bf16x8 b1=*reinterpret_cast<const bf16x8*>(kb+d0*2048+512);
    if(d0==0){p0=__builtin_amdgcn_mfma_f32_32x32x16_bf16(b0,qr[0],negm,0,0,0);p1=__builtin_amdgcn_mfma_f32_32x32x16_bf16(b1,qr[0],negm,0,0,0);}
    else{p0=__builtin_amdgcn_mfma_f32_32x32x16_bf16(b0,qr[d0],p0,0,0,0);p1=__builtin_amdgcn_mfma_f32_32x32x16_bf16(b1,qr[d0],p1,0,0,0);}}
}
typedef __attribute__((address_space(3))) const char* lds_cptr;
typedef short v4i16_t __attribute__((ext_vector_type(4)));
__device__ __forceinline__ void kload8(bf16x8*kf,lds_cptr kp){
  kf[0]=*(const __attribute__((address_space(3))) bf16x8*)(kp);      kf[1]=*(const __attribute__((address_space(3))) bf16x8*)(kp+512);
  kf[2]=*(const __attribute__((address_space(3))) bf16x8*)(kp+2048); kf[3]=*(const __attribute__((address_space(3))) bf16x8*)(kp+2560);
  kf[4]=*(const __attribute__((address_space(3))) bf16x8*)(kp+4096); kf[5]=*(const __attribute__((address_space(3))) bf16x8*)(kp+4608);
  kf[6]=*(const __attribute__((address_space(3))) bf16x8*)(kp+6144); kf[7]=*(const __attribute__((address_space(3))) bf16x8*)(kp+6656);
}
__device__ __forceinline__ void kload2(bf16x8*kf,lds_cptr kp,int j){ kf[2*j]=*(const __attribute__((address_space(3))) bf16x8*)(kp+j*2048); kf[2*j+1]=*(const __attribute__((address_space(3))) bf16x8*)(kp+j*2048+512); }
__device__ __forceinline__ s16x4 vtr(lds_cptr p){ return __builtin_bit_cast(s16x4,__builtin_amdgcn_ds_read_tr16_b64_v4i16((__attribute__((address_space(3))) v4i16_t*)p)); }
__device__ __forceinline__ float rowmax(const f32x16&p0,const f32x16&p1){
  float a=max3f(p0[0],p0[1],p1[0]),b=max3f(p0[2],p0[3],p1[1]);a=max3f(a,p1[2],p1[3]);
  #pragma unroll
  for(int r=4;r<16;r+=4){a=max3f(a,p0[r],p0[r+1]);b=max3f(b,p0[r+2],p0[r+3]);a=max3f(a,p1[r],p1[r+1]);b=max3f(b,p1[r+2],p1[r+3]);}
  const float m=max2f(a,b);
  auto rr=__builtin_amdgcn_permlane32_swap(__float_as_uint(m),__float_as_uint(m),false,false);
  return max2f(__uint_as_float(rr[0]),__uint_as_float(rr[1]));
}
__device__ __forceinline__ void pv(f32x16*o,int vb,bf16x8 pa0,bf16x8 pa1,bf16x8 pa2,bf16x8 pa3){
  #pragma unroll
  for(int d0=0;d0<2;++d0){s16x4 lo[4],hi[4];
    #pragma unroll
    for(int ks=0;ks<4;++ks){
      asm volatile("ds_read_b64_tr_b16 %0,%1 offset:%c2":"=&v"(lo[ks]):"v"(vb),"i"(d0*4096+ks*1024):"memory");
      asm volatile("ds_read_b64_tr_b16 %0,%1 offset:%c2":"=&v"(hi[ks]):"v"(vb),"i"(d0*4096+ks*1024+512):"memory");}
    asm volatile("s_waitcnt lgkmcnt(0)":::"memory");SBAR();
    #define PK(k) (bf16x8){lo[k][0],lo[k][1],lo[k][2],lo[k][3],hi[k][0],hi[k][1],hi[k][2],hi[k][3]}
    o[d0]=__builtin_amdgcn_mfma_f32_32x32x16_bf16(pa0,PK(0),o[d0],0,0,0);
    o[d0]=__builtin_amdgcn_mfma_f32_32x32x16_bf16(pa1,PK(1),o[d0],0,0,0);
    o[d0]=__builtin_amdgcn_mfma_f32_32x32x16_bf16(pa2,PK(2),o[d0],0,0,0);
    o[d0]=__builtin_amdgcn_mfma_f32_32x32x16_bf16(pa3,PK(3),o[d0],0,0,0);
    #undef PK
  }
}

#ifndef ATTN_STORE16
#define ATTN_STORE16(p,v) (*(u32x4*)(p)=(v))
#endif
template<int THRL> __device__ __forceinline__ void attn_unit(int b,int h,int kvh,int qb,const bf16*Q,const bf16*__restrict__ K,const bf16*__restrict__ V,bf16*O,char*shm){
  const int tid=threadIdx.x,lane=tid&63,r32=lane&31,hi=lane>>5; const int wid=__builtin_amdgcn_readfirstlane(tid>>6);
  const long rowbase=(long)b*SEQ; const int q0=qb*QB;
  const bf16*Qw=Q+(rowbase+q0+wid*QBLK)*DM+h*D;
  const bf16*Kh=K+rowbase*DM+kvh*D,*Vh=V+rowbase*DM+kvh*D;
  const unsigned lds0=(unsigned)(uintptr_t)shm;
  float*wsf=(float*)(shm+LDS_WS)+wid*64;
  const bf16*ksrc=Kh+(long)lane*DM+wid*8;
  const bf16*vsrc=Vh+(long)(16*(wid&3)+(lane>>2))*DM+(wid>>2)*32+(lane&3)*8;
  const unsigned kdst=lds0+LDS_K+wid*1024, vdst=lds0+LDS_V+wid*1024;
  #define DMA_K(t,slot) glds16(ksrc+(long)(t)*KVBLK*DM,(unsigned)__builtin_amdgcn_readfirstlane(kdst+(slot)))
  #define DMA_V(t,slot) glds16(vsrc+(long)(t)*KVBLK*DM,(unsigned)__builtin_amdgcn_readfirstlane(vdst+(slot)))
  const int vb0=(int)(lds0+LDS_V)+((lane>>4)&1)*32+(lane&3)*8+(4*hi+((lane&15)>>2))*64;
  const char*Kbase=shm+LDS_K; bf16x8 kf[8];
  const lds_cptr shm3=(lds_cptr)shm; const lds_cptr kp0=shm3+LDS_K+hi*1024+r32*16; const lds_cptr vp0=shm3+LDS_V+((lane>>4)&1)*32+(lane&3)*8+(4*hi+((lane&15)>>2))*64;
  const int NT=SEQ/KVBLK;
  DMA_K(0,0);DMA_V(0,0);DMA_K(1,SLOTB);
  bf16x8 qr[4];
  #pragma unroll
  for(int d0=0;d0<4;++d0)qr[d0]=*reinterpret_cast<const bf16x8*>(&Qw[(long)r32*DM+d0*16+hi*8]);
  float mhat=0.f,l_reg=0.f;f32x16 o[2];o[0]=f32x16{};o[1]=f32x16{};f32x16 negm=f32x16{};asm volatile("":"+v"(negm));

  #define CMASK(P0,P1,t) do{}while(0)
  bool resc=false;
  #define START(P0,P1) do{ const float rm=rowmax(P0,P1); resc=false; \
    { const float dl=rm; mhat=fadd_s(mhat,dl); \
      _Pragma("unroll") for(int r=0;r<16;++r){P0[r]=fsub_s(P0[r],dl);P1[r]=fsub_s(P1[r],dl);} \
      _Pragma("unroll") for(int r=0;r<16;++r)negm[r]=-mhat; asm volatile("":"+v"(negm)); } \
    _Pragma("unroll") for(int r=0;r<16;++r)P0[r]=__builtin_amdgcn_exp2f(P0[r]); }while(0)
  #define RESC() do{ if(resc){ asm volatile("s_waitcnt lgkmcnt(0)":::"memory"); \
      _Pragma("unroll") for(int d_=0;d_<2;++d_) _Pragma("unroll") for(int r=0;r<16;++r)o[d_][r]*=wsf[crow(r,hi)]; } }while(0)
  f32x16 pA0,pA1,pB0,pB1;
  int sl_prev=0,sl_cur=0,sl_next=SLOTB;
  #define ROT() do{sl_prev=sl_cur;sl_cur=sl_next;sl_next=(sl_next==(NSLOT-1)*SLOTB)?0:sl_next+SLOTB;}while(0)
  DMA_K(2,2*SLOTB);
  WAIT_BAR(3);
  qkt(pA0,pA1,Kbase,qr,negm,r32,hi);asm volatile("s_nop 15\n\ts_nop 7":"+v"(pA0),"+v"(pA1));CMASK(pA0,pA1,0);
  START(pA0,pA1);
  _Pragma("unroll") for(int r=0;r<16;++r)pA1[r]=__builtin_amdgcn_exp2f(pA1[r]);
  WAIT_BAR(0);
  DMA_K(3,0);DMA_V(1,SLOTB);
  ROT();
  kload8(kf,kp0+sl_cur);
  WAIT_BAR(2);
  s16x4 vlo[8],vhi[8]; u32x4 pw0,pw1,pw2,pw3;
  #define PKW(P,B) cvtpk_s(P[B],P[B+1])
  #define PAF(k) __builtin_bit_cast(bf16x8,pw##k)
  #define VFR(i) (bf16x8){vlo[i][0],vlo[i][1],vlo[i][2],vlo[i][3],vhi[i][0],vhi[i][1],vhi[i][2],vhi[i][3]}
  #define PIN(x) asm volatile("":"+v"(x))
  #define MX3(a,b,c) __builtin_fmaxf(__builtin_fmaxf((a),(b)),(c))
  #define GAPA(MF,A0,A1,A2,A3,W0,W1,PW) do{ MF; sacc+=A0; sacc+=A1; sacc+=A2; sacc+=A3; PIN(sacc); W0; W1; PIN(PW); SBAR(); }while(0)
  #define EX(v) __builtin_amdgcn_exp2f(v)
  #define GAPB(MF,X,B) do{ MF; X[B]=EX(X[B]); X[B+1]=EX(X[B+1]); X[B+2]=EX(X[B+2]); X[B+3]=EX(X[B+3]); PIN(X); SBAR(); }while(0)
  #define VRD(i) do{ vlo[i]=vtr(vp_+(((i)>>2)*4096+((i)&3)*1024)); vhi[i]=vtr(vp_+(((i)>>2)*4096+((i)&3)*1024+512)); }while(0)
  #define KRD(G,j) do{ if(G){ kload2(kf,kp0+sl_next,j); SBAR(); } }while(0)
  #define STEP(C0,C1,P0,P1,t,GK,GV,GL) do{ SBAR(); \
    const lds_cptr vp_=vp0+sl_prev; \
    VRD(0); SBAR(); float sacc=(P0[0]+P0[1]); \
    GAPA(C0=__builtin_amdgcn_mfma_f32_32x32x16_bf16(kf[0],qr[0],negm,0,0,0), P0[2],P0[3],P0[4],P0[5],     pw0[0]=PKW(P0,0), pw0[1]=PKW(P0,2), pw0); \
    VRD(4); SBAR(); GAPA(C1=__builtin_amdgcn_mfma_f32_32x32x16_bf16(kf[1],qr[0],negm,0,0,0), P0[6],P0[7],P0[8],P0[9],     pw0[2]=PKW(P0,4), pw0[3]=PKW(P0,6), pw0); \
    VRD(1); SBAR(); GAPA(C0=__builtin_amdgcn_mfma_f32_32x32x16_bf16(kf[2],qr[1],C0,0,0,0),   P0[10],P0[11],P0[12],P0[13], pw1[0]=PKW(P0,8), pw1[1]=PKW(P0,10), pw1); \
    VRD(5); SBAR(); GAPA(C1=__builtin_amdgcn_mfma_f32_32x32x16_bf16(kf[3],qr[1],C1,0,0,0),   P0[14],P0[15],P1[0],P1[1],   pw1[2]=PKW(P0,12),pw1[3]=PKW(P0,14), pw1); \
    VRD(2); SBAR(); GAPA(C0=__builtin_amdgcn_mfma_f32_32x32x16_bf16(kf[4],qr[2],C0,0,0,0),   P1[2],P1[3],P1[4],P1[5],     pw2[0]=PKW(P1,0), pw2[1]=PKW(P1,2), pw2); \
    VRD(6); SBAR(); GAPA(C1=__builtin_amdgcn_mfma_f32_32x32x16_bf16(kf[5],qr[2],C1,0,0,0),   P1[6],P1[7],P1[8],P1[9],     pw2[2]=PKW(P1,4), pw2[3]=PKW(P1,6), pw2); \
    VRD(3); SBAR(); GAPA(C0=__builtin_amdgcn_mfma_f32_32x32x16_bf16(kf[6],qr[3],C0,0,0,0),   P1[10],P1[11],P1[12],P1[13], pw3[0]=PKW(P1,8), pw3[1]=PKW(P1,10), pw3); \
    VRD(7); SBAR(); GAPA(C1=__builtin_amdgcn_mfma_f32_32x32x16_bf16(kf[7],qr[3],C1,0,0,0),   P1[14],P1[15],0.f,0.f,       pw3[2]=PKW(P1,12),pw3[3]=PKW(P1,14), pw3); \
    l_reg+=sacc; \
    if(GK){DMA_K((t)+3,sl_cur);} if(GV){DMA_V((t)+1,sl_next);} \
    CMASK(C0,C1,t); \
    { float a=MX3(C0[0],C0[1],C1[0]),b=MX3(C0[2],C0[3],C1[1]); a=MX3(a,C1[2],C1[3]); \
      _Pragma("unroll") for(int r=4;r<16;r+=4){a=MX3(a,C0[r],C0[r+1]);b=MX3(b,C0[r+2],C0[r+3]);a=MX3(a,C1[r],C1[r+1]);b=MX3(b,C1[r+2],C1[r+3]);} \
      float rm=__builtin_fmaxf(a,b); { auto rr=__builtin_amdgcn_permlane32_swap(__float_as_uint(rm),__float_as_uint(rm),false,false); rm=__builtin_fmaxf(__uint_as_float(rr[0]),__uint_as_float(rr[1])); } \
      resc=false; \
      if(__builtin_expect(__any(rm>(float)THRL),0)){ const float dl=__builtin_fmaxf(rm,0.f); mhat+=dl; \
        _Pragma("unroll") for(int r=0;r<16;++r){C0[r]-=dl;C1[r]-=dl;} \
        _Pragma("unroll") for(int r=0;r<16;++r)negm[r]=-mhat; asm volatile("":"+v"(negm)); \
        const float f=__builtin_amdgcn_exp2f(-dl); l_reg*=f; if(hi==0)wsf[r32]=f; resc=true; } } \
    SBAR(); \
    GAPB(o[0]=__builtin_amdgcn_mfma_f32_32x32x16_bf16(PAF(0),VFR(0),o[0],0,0,0), C0,0); \
    GAPB(o[1]=__builtin_amdgcn_mfma_f32_32x32x16_bf16(PAF(0),VFR(4),o[1],0,0,0), C0,4); \
    KRD(GL,0); GAPB(o[0]=__builtin_amdgcn_mfma_f32_32x32x16_bf16(PAF(1),VFR(1),o[0],0,0,0), C0,8); \
    KRD(GL,1); GAPB(o[1]=__builtin_amdgcn_mfma_f32_32x32x16_bf16(PAF(1),VFR(5),o[1],0,0,0), C0,12); \
    KRD(GL,2); GAPB(o[0]=__builtin_amdgcn_mfma_f32_32x32x16_bf16(PAF(2),VFR(2),o[0],0,0,0), C1,0); \
    KRD(GL,3); GAPB(o[1]=__builtin_amdgcn_mfma_f32_32x32x16_bf16(PAF(2),VFR(6),o[1],0,0,0), C1,4); \
    GAPB(o[0]=__builtin_amdgcn_mfma_f32_32x32x16_bf16(PAF(3),VFR(3),o[0],0,0,0), C1,8); \
    GAPB(o[1]=__builtin_amdgcn_mfma_f32_32x32x16_bf16(PAF(3),VFR(7),o[1],0,0,0), C1,12); \
    }while(0)
  int t=1;
  #undef CMASK
  #define CMASK(P0,P1,t) do{}while(0)
  for(;t+5<NT;t+=2){
    STEP(pB0,pB1,pA0,pA1,t,true,true,true);     WAIT_BAR(2); RESC(); ROT();
    STEP(pA0,pA1,pB0,pB1,t+1,true,true,true);   WAIT_BAR(2); RESC(); ROT();
  }
  #undef CMASK
  #define CMASK(P0,P1,t) do{}while(0)
  #define ENDW(tt) do{ if((tt)+3<NT){WAIT_BAR(2);} else if((tt)+2<NT){WAIT_BAR(1);} else {WAIT_BAR(0);} }while(0)
  for(;t+1<NT;t+=2){
    STEP(pB0,pB1,pA0,pA1,t,(t+3<NT),(t+1<NT),(t+1<NT));       ENDW(t);   RESC(); ROT();
    STEP(pA0,pA1,pB0,pB1,t+1,(t+4<NT),(t+2<NT),(t+2<NT));     ENDW(t+1); RESC(); ROT();
  }
  STEP(pB0,pB1,pA0,pA1,NT-1,false,false,false); RESC();
  { float sacc=pB0[0]+pB0[1]; _Pragma("unroll") for(int r=2;r<16;++r)sacc+=pB0[r]; _Pragma("unroll") for(int r=0;r<16;++r)sacc+=pB1[r]; l_reg+=sacc;
    pw0=(u32x4){PKW(pB0,0),PKW(pB0,2),PKW(pB0,4),PKW(pB0,6)};pw1=(u32x4){PKW(pB0,8),PKW(pB0,10),PKW(pB0,12),PKW(pB0,14)};pw2=(u32x4){PKW(pB1,0),PKW(pB1,2),PKW(pB1,4),PKW(pB1,6)};pw3=(u32x4){PKW(pB1,8),PKW(pB1,10),PKW(pB1,12),PKW(pB1,14)};
    SBAR(); pv(o,vb0+sl_cur,PAF(0),PAF(1),PAF(2),PAF(3)); }
  #undef PKW
  #undef PAF
  #undef VFR
  #undef PIN
  #undef MX3
  #undef GAPA
  #undef GAPB
  #undef EX
  #undef VRD
  #undef KRD
  #undef STEP
  #undef ENDW
  {auto rr=__builtin_amdgcn_permlane32_swap(__float_as_uint(l_reg),__float_as_uint(l_reg),false,false);l_reg=__uint_as_float(rr[0])+__uint_as_float(rr[1]);}
  if(hi==0)wsf[32+r32]=l_reg;asm volatile("s_waitcnt lgkmcnt(0)":::"memory");
  float rli[16];
  #pragma unroll
  for(int r=0;r<16;++r)rli[r]=__builtin_amdgcn_rcpf(wsf[32+crow(r,hi)]);
  bf16*Ow=O+(rowbase+q0+wid*QBLK)*OPITCH+h*D;
  { bf16*stg=(bf16*)(shm+LDS_OST)+wid*2048;
    #pragma unroll
    for(int r=0;r<16;++r){const int orow=crow(r,hi);
      #pragma unroll
      for(int d0=0;d0<2;++d0)stg[orow*64+d0*32+r32]=__float2bfloat16(o[d0][r]*rli[r]);}
    asm volatile("s_waitcnt lgkmcnt(0)":::"memory");
    #pragma unroll
    for(int i=0;i<4;++i){const int row=i*8+(lane>>3),ch=lane&7; const u32x4 v=*(const u32x4*)(stg+row*64+ch*8); ATTN_STORE16(Ow+(long)row*OPITCH+ch*8,v);} }
  asm volatile("s_waitcnt lgkmcnt(0)\n\ts_barrier":::"memory");
  #undef DMA_K
  #undef DMA_V
  #undef CMASK
  #undef START
  #undef RESC
  #undef ROT
}
constexpr int ATTN_LDS_BYTES=LDS_BYTES;
struct AttnTensors { const bf16* Q; const bf16* K; const bf16* V; bf16* O; };
struct AttnUnit { int bh; int qb; };
struct StaticOrder {
  int vcu, G;
  __device__ __forceinline__ explicit StaticOrder(int grid,int v):vcu(v),G(grid){}
  __device__ __forceinline__ bool next(int i,AttnUnit&u)const{ const int L=i*G+vcu; if(L>=BATCH*NHEAD*NQB)return false; const int blk=L%256, rnd=L/256; u.bh=blk>>1; u.qb=(blk&1)*4+rnd; return true; }
};
template<class Sched,int THRL=8> __device__ __forceinline__ void attn_phase(char*lds,const AttnTensors&T,const Sched&S){
  AttnUnit u;
  for(int i=0;S.next(i,u);++i){ attn_unit<THRL>(u.bh/NHEAD,u.bh%NHEAD,(u.bh%NHEAD)/4,u.qb,T.Q,T.K,T.V,T.O,lds); }
}
#undef SBAR
#undef WAIT_BAR
}
#define XB_TMO      128
#define XB_XCNT(j)  (256  + 64 * (j))
#define XB_XSUB(j)  (1280 + 64 * (j))
#define XB_XGEN(j)  (2304 + 64 * (j))
#define XB_TOP      3328
#define XB_TOPGEN   3392
#define XCD_BAR_WORDS 3456
#define XB_SPIN_CAP (1u << 18)

__device__ __forceinline__ unsigned xb_ld(unsigned* p)              { return __hip_atomic_load(p, __ATOMIC_RELAXED, __HIP_MEMORY_SCOPE_AGENT); }
__device__ __forceinline__ unsigned xb_add(unsigned* p, unsigned v) { return __hip_atomic_fetch_add(p, v, __ATOMIC_RELAXED, __HIP_MEMORY_SCOPE_AGENT); }
__device__ __forceinline__ unsigned xb_xcc_id() { return (unsigned)__builtin_amdgcn_s_getreg((3 << 11) | 20) & 0xFu; }
#define XB_SPIN(cond, bar) do { unsigned _sp = 0; while (cond) { __builtin_amdgcn_s_sleep(1); \
    if ((++_sp & 255u) == 0u) { if (xb_ld(&(bar)[XB_TMO])) break; if (_sp > XB_SPIN_CAP) { atomicAdd(&(bar)[XB_TMO], 1u); break; } } } } while (0)

struct XcdBarrier {
    unsigned* bar; unsigned x;
    volatile LAS unsigned* st;
};

__device__ __forceinline__ XcdBarrier xcd_barrier_post(unsigned* bar, volatile LAS unsigned* st) {
    XcdBarrier b; b.bar = bar; b.x = xb_xcc_id(); b.st = st;
    if (threadIdx.x == 0) (void)xb_add(&bar[XB_XCNT(b.x)], 1u);
    return b;
}
__device__ __forceinline__ void xcd_barrier_complete(unsigned* bar, unsigned x, unsigned& nloc, unsigned& nx) {
    const unsigned G = gridDim.x * gridDim.y * gridDim.z;
    unsigned sum, cnt, mine, sp = 0u;
    for (;;) {
        sum = 0u; cnt = 0u; mine = 0u;
#pragma unroll
        for (unsigned j = 0; j < 16; ++j) { const unsigned c = xb_ld(&bar[XB_XCNT(j)]); sum += c; cnt += (c > 0u) ? 1u : 0u; mine = (j == x) ? c : mine; }
        if (sum == G) break;
        __builtin_amdgcn_s_sleep(1);
        if ((++sp & 255u) == 0u) { if (xb_ld(&bar[XB_TMO])) break; if (sp > XB_SPIN_CAP) { atomicAdd(&bar[XB_TMO], 1u); break; } }
    }
    nloc = mine > 0u ? mine : 1u; nx = cnt > 0u ? cnt : 1u;
}

__device__ __forceinline__ void xcd_barrier(const XcdBarrier& b) {
    asm volatile("s_waitcnt vmcnt(0)" ::: "memory");
    __syncthreads();
    if (threadIdx.x == 0) {
        unsigned* bar = b.bar;
        __builtin_amdgcn_s_waitcnt(0);
        unsigned nloc = b.st[0], nx = b.st[1];
        if (nloc == 0u) { xcd_barrier_complete(bar, b.x, nloc, nx); b.st[0] = nloc; b.st[1] = nx; }
        const unsigned old = xb_add(&bar[XB_XSUB(b.x)], 1u);
        const unsigned gen = old / nloc;
        if (old + 1u == (gen + 1u) * nloc) {
            __builtin_amdgcn_fence(__ATOMIC_RELEASE, "agent");
            asm volatile("s_waitcnt vmcnt(0)" ::: "memory");
            const unsigned og = xb_add(&bar[XB_TOP], 1u);
            const unsigned tg = og / nx;
            if (og + 1u == (tg + 1u) * nx) xb_add(&bar[XB_TOPGEN], 1u);
            else XB_SPIN(xb_ld(&bar[XB_TOPGEN]) == tg, bar);
            __builtin_amdgcn_fence(__ATOMIC_ACQUIRE, "agent");
            xb_add(&bar[XB_XGEN(b.x)], 1u);
            asm volatile("s_waitcnt vmcnt(0)" ::: "memory");
        } else {
            XB_SPIN(xb_ld(&bar[XB_XGEN(b.x)]) == gen, bar);
            __builtin_amdgcn_fence(__ATOMIC_ACQUIRE, "agent");
            asm volatile("s_waitcnt vmcnt(0)" ::: "memory");
        }
    }
    __syncthreads();
}
constexpr int NWAVES = 8, NTHR = NWAVES * 64;
constexpr int N_PHASES = 10;
constexpr int RING_OFF = 0, RING_BYTES = 131072;
constexpr int LDSCTL_OFF = RING_BYTES, MISC_OFF = LDSCTL_OFF + 320;
constexpr int TS_OFF = LDSCTL_OFF + 512;
constexpr int UT_OFF = TS_OFF + 256;
constexpr int RT_OFF = UT_OFF + 256;
constexpr int LDS_BYTES = 147456;
static_assert(RT_OFF + pg8::MOE_MAXU * 1024 <= LDS_BYTES, "LDS map");

struct Frame {
    LAS unsigned char* lds; volatile LAS unsigned* MISC; unsigned* ctl; unsigned char* ws;
    int tid, lane, wave, vcu, G;
    float* out;
};

enum { I_X = 0, I_C, I_WADA, I_BADA, I_GPRE1, I_GPOST1, I_WIN, I_WDW, I_BDW, I_CLNG, I_CLNB, I_WCO, I_QG, I_KG, I_WAO, I_WOUT, I_GPRE2, I_GPOST2, I_WGRP, I_BGRP, I_WRT, I_BRT, I_WEG, I_WEU, I_WED };

struct Args { const float* in[25]; float* out; unsigned char* ws; int ph_lo, ph_hi, use_bar, flags; };
#define CAS __attribute__((address_space(4)))
__device__ __forceinline__ const float* fin(int i) { unsigned long long p = (unsigned long long)__builtin_amdgcn_kernarg_segment_ptr(); asm volatile("" : "+s"(p)); return ((const CAS Args*)p)->in[i]; }
template <int MAP> __device__ __forceinline__ int maprow(int n) {
    if (MAP == 1) return vmap_win(n);
    if (MAP == 2) return 256 * (n >> 7) + (n & 127);
    if (MAP == 3) return 256 * (n >> 7) + 128 + (n & 127);
    return n;
}
template <int MAP>
__device__ __forceinline__ void p0_transpose_item(const float* W, int N, bf16* WT, int pitch, int koff, LAS float* scr, int item, int lane) {
    const int nblk = N / 64, kb = item / nblk, nb = item % nblk, k0 = 64 * kb, n0 = 64 * nb, lr = lane >> 4, lc = lane & 15;
    const float* src = W + (size_t)(k0 + lr) * N + n0 + 4 * lc;
    f32x4 v[16];
#pragma unroll
    for (int i = 0; i < 16; ++i) v[i] = *(const f32x4*)(src + (size_t)(4 * i) * N);
#pragma unroll
    for (int i = 0; i < 16; ++i) { const int kk = lr + 4 * i; *(LAS f32x4*)(scr + kk * 64 + 4 * (lc ^ ((kk >> 3) & 7))) = v[i]; }
    LDS_WAIT(); asm volatile("" ::: "memory");
    const int c = lane & 7;
#pragma unroll
    for (int jj = 0; jj < 8; ++jj) { const int n = (lane >> 3) + 8 * jj; const LAS float* sp = scr + (8 * c) * 64 + (n ^ (4 * c));
        u32x4 o; o.x = cvt_pk_bf16(sp[0 * 64], sp[1 * 64]); o.y = cvt_pk_bf16(sp[2 * 64], sp[3 * 64]); o.z = cvt_pk_bf16(sp[4 * 64], sp[5 * 64]); o.w = cvt_pk_bf16(sp[6 * 64], sp[7 * 64]);
        *(u32x4*)(WT + (size_t)maprow<MAP>(n0 + n) * pitch + koff + k0 + 8 * c) = o; }
    LDS_WAIT(); asm volatile("" ::: "memory");
}
struct TrDesc { const float* src; unsigned char* dst; int N, pitch; float sc; };
__device__ __forceinline__ TrDesc tr_desc(int it, const float* pweg, const float* pweu, const float* pwed, unsigned char* W1, unsigned char* W2) {
    constexpr int I_G1 = (D / 64) * (DE / 64), I_D1 = (DE / 64) * (D / 64), PER = 2 * I_G1 + I_D1;
    const int e = it / PER; int r = it - e * PER; TrDesc d;
    if (r < 2 * I_G1) { const bool up = r >= I_G1; if (up) r -= I_G1; const int nblk = DE / 64, kb = r / nblk, nb = r % nblk;
        d.src = (up ? pweu : pweg) + (size_t)e * D * DE + (size_t)(64 * kb) * DE + 64 * nb; d.N = DE; d.pitch = D; d.sc = pg8::WSC1;
        d.dst = W1 + (size_t)e * D * D + (size_t)(256 * ((64 * nb) >> 7) + (up ? 128 : 0) + ((64 * nb) & 127)) * D + 64 * kb; }
    else { r -= 2 * I_G1; const int nblk = D / 64, kb = r / nblk, nb = r % nblk;
        d.src = pwed + (size_t)e * DE * D + (size_t)(64 * kb) * D + 64 * nb; d.N = D; d.pitch = DE; d.sc = pg8::WSC2;
        d.dst = W2 + (size_t)e * D * DE + (size_t)(64 * nb) * DE + 64 * kb; }
    return d;
}
__device__ __forceinline__ void tr_load(const TrDesc& d, int lane, f32x4 (&v)[16]) {
    const float* src = d.src + (size_t)(lane >> 4) * d.N + 4 * (lane & 15);
#pragma unroll
    for (int i = 0; i < 16; ++i) v[i] = *(const f32x4*)(src + (size_t)(4 * i) * d.N);
}
__device__ __forceinline__ void tr_finish(const TrDesc& d, int lane, const f32x4 (&v)[16], LAS float* scr) {
    const int lr = lane >> 4, lc = lane & 15;
#pragma unroll
    for (int i = 0; i < 16; ++i) { const int kk = lr + 4 * i; *(LAS f32x4*)(scr + kk * 64 + 4 * (lc ^ ((kk >> 3) & 7))) = v[i] * d.sc; }
    LDS_WAIT(); asm volatile("" ::: "memory");
    const int c4 = lane & 3;
#pragma unroll
    for (int jj = 0; jj < 4; ++jj) { const int n = (lane >> 2) + 16 * jj; const LAS float* s0 = scr + (16 * c4) * 64 + (n ^ (4 * (2 * c4))), * s1 = scr + (16 * c4 + 8) * 64 + (n ^ (4 * (2 * c4 + 1)));
        u32x4 o; o.x = pg8::pk4_fp8(s0[0 * 64], s0[1 * 64], s0[2 * 64], s0[3 * 64]); o.y = pg8::pk4_fp8(s0[4 * 64], s0[5 * 64], s0[6 * 64], s0[7 * 64]);
        o.z = pg8::pk4_fp8(s1[0 * 64], s1[1 * 64], s1[2 * 64], s1[3 * 64]); o.w = pg8::pk4_fp8(s1[4 * 64], s1[5 * 64], s1[6 * 64], s1[7 * 64]);
        *(u32x4*)(d.dst + (size_t)n * d.pitch + 16 * c4) = o; }
    LDS_WAIT(); asm volatile("" ::: "memory");
}
__device__ __forceinline__ void p0_prologue(Frame& F) {
    const float* c = fin(I_C); const float* wada = fin(I_WADA); const float* bada = fin(I_BADA);
    if (blockIdx.x < 192) {
        const int cg = blockIdx.x, kh = F.lane >> 5, col = F.lane & 31;
        LAS float* scs = (LAS float*)F.lds; LAS float* red = (LAS float*)(F.lds + 65536);
        { float cv[32];
#pragma unroll
          for (int i = 0; i < 32; ++i) cv[i] = c[F.tid + NTHR * i];
#pragma unroll
          for (int i = 0; i < 32; ++i) scs[F.tid + NTHR * i] = cv[i] * sig_fast(cv[i]); }
        __syncthreads();
        float acc[16];
#pragma unroll
        for (int b = 0; b < 16; ++b) acc[b] = 0.f;
        const int kbase = 128 * F.wave + 64 * kh;
        const float* w = wada + (size_t)kbase * 6144 + 32 * cg + col;
        { float wv[64];
#pragma unroll
          for (int k = 0; k < 64; ++k) wv[k] = w[(size_t)k * 6144];
#pragma unroll
          for (int k = 0; k < 64; ++k)
#pragma unroll
              for (int b = 0; b < 16; ++b) acc[b] += scs[b * D + kbase + k] * wv[k]; }
#pragma unroll
        for (int b = 0; b < 16; ++b) red[((F.wave * 2 + kh) * 16 + b) * 32 + col] = acc[b];
        __syncthreads();
        float* ada = (float*)(F.ws + WS_ADA);
        { const int b = F.tid >> 5, l = F.tid & 31; float sm = 0.f;
#pragma unroll
          for (int p = 0; p < 16; ++p) sm += red[(p * 16 + b) * 32 + l];
          __hip_atomic_store(ada + b * 6144 + 32 * cg + l, sm + bada[32 * cg + l], __ATOMIC_RELAXED, __HIP_MEMORY_SCOPE_AGENT); }
        VM_WAIT();
        __syncthreads();
        if (F.tid == 0) __hip_atomic_fetch_add(F.ctl + CW_ADA, 1u, __ATOMIC_RELAXED, __HIP_MEMORY_SCOPE_AGENT);
    }
    {
        const int gt = F.vcu * NTHR + F.tid, NGT = F.G * NTHR; const float* wgrp = fin(I_WGRP); const float* wrt = fin(I_WRT);
        f32x2* rope = (f32x2*)(F.ws + WS_ROPE);
        for (int i = gt; i < 96 * 16; i += NGT) { const int r = i >> 4, e = i & 15; const float pos = (float)(r < 32 ? r : r - 32);
            const float invf = powf(10000.f, -(float)e / 16.f); float sn, cs; sincosf(pos * invf, &sn, &cs); rope[i] = (f32x2){cs, sn}; }
        bf16* wr = (bf16*)(F.ws + WS_WR);
        for (int i = gt; i < 64 * 1024; i += NGT) { const int n = i >> 10, k = i & 1023;
            const float v = n < 4 ? wgrp[k * 4 + n] : (n < 36 ? wrt[k * 32 + (n - 4)] : 0.f); wr[i] = (bf16)f2bf(v); }
    }
    LAS float* scr = (LAS float*)(F.lds + RING_OFF + F.wave * 16384);
    const int gw = F.vcu * NWAVES + F.wave, NGW = F.G * NWAVES;
    constexpr int I_WIN_ = (D / 64) * (INW / 64), I_WC_ = (CW / 64) * (D / 64), I_WO_ = (D / 64) * (D / 64);
    constexpr int NITEMS = I_WIN_ + 2 * I_WC_ + I_WO_;
    bf16* WIN = (bf16*)(F.ws + WS_WIN); bf16* WCA = (bf16*)(F.ws + WS_WCA); bf16* WO = (bf16*)(F.ws + WS_WO);
    const float* pwin = fin(I_WIN); const float* pwco = fin(I_WCO); const float* pwao = fin(I_WAO); const float* pwout = fin(I_WOUT);
    for (int it = gw; it < NITEMS; it += NGW) {
        int r = it;
        if (r < I_WIN_) { const int kb = r / 60, nb = r % 60;
            if (nb < 28) p0_transpose_item<1>(pwin, INW, WIN, D, 0, scr, kb * 60 + nb, F.lane);
            else { TrDesc d; const int n0 = 64 * nb; d.src = pwin + (size_t)(64 * kb) * INW + n0; d.N = INW; d.pitch = 2048; d.sc = pg8::WSCIN; d.dst = F.ws + WS_WINF + (size_t)(vmap_win(n0) - 1792) * 2048 + 64 * kb;
                   f32x4 tv[16]; tr_load(d, F.lane, tv); tr_finish(d, F.lane, tv, scr); }
            continue; } r -= I_WIN_;
        if (r < I_WC_) { p0_transpose_item<0>(pwco, D, WCA, D, 0, scr, r, F.lane); continue; } r -= I_WC_;
        if (r < I_WC_) { p0_transpose_item<0>(pwao, D, WCA, D, 512, scr, r, F.lane); continue; } r -= I_WC_;
        p0_transpose_item<0>(pwout, D, WO, D, 0, scr, r, F.lane);
    }
}
constexpr int XCONV_ITEMS = NE * (2 * (D / 64) * (DE / 64) + (DE / 64) * (D / 64));
__device__ __forceinline__ void p0_convert_experts(Frame& F, int lo, int hi, int rank, int nconv) {
    LAS float* scr = (LAS float*)(F.lds + RING_OFF + F.wave * 16384);
    constexpr int I_G1 = (D / 64) * (DE / 64), I_D1 = (DE / 64) * (D / 64), PER = 2 * I_G1 + I_D1;
    unsigned char* W1 = F.ws + WS_W1; unsigned char* W2 = F.ws + WS_W2;
    const float* pweg = fin(I_WEG); const float* pweu = fin(I_WEU); const float* pwed = fin(I_WED);
    const int step = nconv * NWAVES;
    for (int it = lo + rank * NWAVES + F.wave; it < hi; it += 2 * step) {
        const TrDesc d0 = tr_desc(it, pweg, pweu, pwed, W1, W2); const bool two = it + step < hi;
        const TrDesc d1 = tr_desc(two ? it + step : it, pweg, pweu, pwed, W1, W2);
        f32x4 v0[16], v1[16];
        tr_load(d0, F.lane, v0); tr_load(d1, F.lane, v1);
        __builtin_amdgcn_sched_barrier(0);
        tr_finish(d0, F.lane, v0, scr);
        if (two) tr_finish(d1, F.lane, v1, scr);
    }
}

__device__ __forceinline__ int rcol(int lane, int q) { return 512 * (q >> 1) + 8 * lane + 4 * (q & 1); }
__device__ __forceinline__ void row_ld_f32(const float* p, int lane, f32x4 (&v)[4]) {
#pragma unroll
    for (int q = 0; q < 4; ++q) v[q] = *(const f32x4*)(p + rcol(lane, q)); }
__device__ __forceinline__ void row_st_f32(float* p, int lane, const f32x4 (&v)[4]) {
#pragma unroll
    for (int q = 0; q < 4; ++q) *(f32x4*)(p + rcol(lane, q)) = v[q]; }
__device__ __forceinline__ void row_ld_bf16(const bf16* p, int lane, f32x4 (&v)[4]) {
#pragma unroll
    for (int j = 0; j < 2; ++j) { const u32x4 w = *(const u32x4*)(p + 512 * j + 8 * lane);
        v[2 * j] = (f32x4){bf2f(w.x & 0xffffu), bf2f(w.x >> 16), bf2f(w.y & 0xffffu), bf2f(w.y >> 16)}; v[2 * j + 1] = (f32x4){bf2f(w.z & 0xffffu), bf2f(w.z >> 16), bf2f(w.w & 0xffffu), bf2f(w.w >> 16)}; } }
__device__ __forceinline__ u32x4 row_pack(const f32x4 a, const f32x4 b) { return (u32x4){cvt_pk_bf16(a.x, a.y), cvt_pk_bf16(a.z, a.w), cvt_pk_bf16(b.x, b.y), cvt_pk_bf16(b.z, b.w)}; }
__device__ __forceinline__ float row_ss(const f32x4 (&v)[4]) { float s = 0.f;
#pragma unroll
    for (int q = 0; q < 4; ++q) s += (v[q].x * v[q].x + v[q].y * v[q].y) + (v[q].z * v[q].z + v[q].w * v[q].w);
    return s; }

__device__ __forceinline__ void p1_modnorm(Frame& F) {
    if (F.tid == 0) { unsigned sp = 0; while (__hip_atomic_load(F.ctl + CW_ADA, __ATOMIC_RELAXED, __HIP_MEMORY_SCOPE_AGENT) < 192u) { __builtin_amdgcn_s_sleep(2); if (++sp > (1u << 22)) break; }
        __builtin_amdgcn_fence(__ATOMIC_ACQUIRE, "agent"); VM_WAIT(); }
    __syncthreads();
    const float* x = fin(I_X); const float* g = fin(I_GPRE1); const float* ada = (const float*)(F.ws + WS_ADA); bf16* h1 = (bf16*)(F.ws + WS_H1); unsigned char* h1f = F.ws + WS_H1F;
    for (int chunk = blockIdx.x; chunk < NTOK / 128; chunk += F.G) {
        const int R0 = chunk * 128, b = R0 / SEQ; const float* ad = ada + b * 6144;
        f32x4 ca[4], cb[4];
#pragma unroll
        for (int q = 0; q < 4; ++q) { const int c0 = rcol(F.lane, q); ca[q] = *(const f32x4*)(g + c0) * (1.f + *(const f32x4*)(ad + 1024 + c0)); cb[q] = *(const f32x4*)(ad + c0); }
        const int rw = R0 + 16 * F.wave;
        f32x4 n0[4], n1[4];
        row_ld_f32(x + (size_t)rw * D, F.lane, n0); row_ld_f32(x + (size_t)(rw + 1) * D, F.lane, n1);
#pragma unroll
        for (int i = 0; i < 16; i += 2) {
            const int row = rw + i;
            f32x4 v0[4], v1[4];
#pragma unroll
            for (int q = 0; q < 4; ++q) { v0[q] = n0[q]; v1[q] = n1[q]; }
            if (i + 2 < 16) { row_ld_f32(x + (size_t)(row + 2) * D, F.lane, n0); row_ld_f32(x + (size_t)(row + 3) * D, F.lane, n1); }
            __builtin_amdgcn_sched_barrier(0);
            const float r0 = rsqrtf(wave_sum(row_ss(v0)) * (1.f / D) + EPS), r1 = rsqrtf(wave_sum(row_ss(v1)) * (1.f / D) + EPS);
#pragma unroll
            for (int j = 0; j < 2; ++j) {
                const f32x4 a0 = v0[2 * j] * r0 * ca[2 * j] + cb[2 * j], a1 = v0[2 * j + 1] * r0 * ca[2 * j + 1] + cb[2 * j + 1], b0 = v1[2 * j] * r1 * ca[2 * j] + cb[2 * j], b1 = v1[2 * j + 1] * r1 * ca[2 * j + 1] + cb[2 * j + 1];
                *(u32x4*)(h1 + (size_t)row * D + 512 * j + 8 * F.lane) = row_pack(a0, a1); *(u32x4*)(h1 + (size_t)(row + 1) * D + 512 * j + 8 * F.lane) = row_pack(b0, b1);
                *(u32x2*)(h1f + (size_t)row * 2048 + 512 * j + 8 * F.lane) = (u32x2){pg8::pk4_fp8(a0.x, a0.y, a0.z, a0.w), pg8::pk4_fp8(a1.x, a1.y, a1.z, a1.w)};
                *(u32x2*)(h1f + (size_t)(row + 1) * 2048 + 512 * j + 8 * F.lane) = (u32x2){pg8::pk4_fp8(b0.x, b0.y, b0.z, b0.w), pg8::pk4_fp8(b1.x, b1.y, b1.z, b1.w)}; }
            __builtin_amdgcn_sched_barrier(0);
        }
    }
}

constexpr int CV_T = 32, CV_IN = 0, CV_UT = (CV_T + KS - 1) * 1024;
static_assert(CV_UT + CV_T * CW * 4 <= RING_BYTES, "conv LDS map");
__device__ __forceinline__ void p3_conv(Frame& F) {
    const bf16* glu = (const bf16*)(F.ws + WS_GLU); bf16* ca = (bf16*)(F.ws + WS_CA);
    LAS unsigned char* IN = F.lds + RING_OFF + CV_IN; LAS float* UT = (LAS float*)(F.lds + RING_OFF + CV_UT);
    const int cp = F.tid & 255, th = F.tid >> 8;
    f32x2 w[KS];
#pragma unroll
    for (int j = 0; j < KS; ++j) w[j] = *(const f32x2*)(fin(I_WDW) + j * CW + 2 * cp);
    const f32x2 bias = *(const f32x2*)(fin(I_BDW) + 2 * cp);
    float lg[8], lb[8];
#pragma unroll
    for (int i = 0; i < 8; ++i) { lg[i] = fin(I_CLNG)[F.lane * 8 + i]; lb[i] = fin(I_CLNB)[F.lane * 8 + i]; }
    u32x4 sv[8];
#define CV_LOAD(unx) do { const int b_ = (unx) / (SEQ / CV_T), s0_ = ((unx) % (SEQ / CV_T)) * CV_T; _Pragma("unroll") for (int i = 0; i < 8; ++i) { \
        const int s_ = s0_ - KS / 2 + F.wave + NWAVES * i, sc_ = s_ < 0 ? 0 : (s_ >= SEQ ? SEQ - 1 : s_); sv[i] = *(const u32x4*)(glu + (size_t)(b_ * SEQ + sc_) * CW + F.lane * 8); } } while (0)
    if (F.vcu < NTOK / CV_T) CV_LOAD(F.vcu);
    for (int un = F.vcu; un < NTOK / CV_T; un += F.G) {
        const int b = un / (SEQ / CV_T), s0 = (un % (SEQ / CV_T)) * CV_T;
#pragma unroll
        for (int i = 0; i < 8; ++i) { const int r = F.wave + NWAVES * i, s = s0 - KS / 2 + r;
            if (r < CV_T + KS - 1) *(LAS u32x4*)(IN + r * 1024 + F.lane * 16) = (s >= 0 && s < SEQ) ? sv[i] : (u32x4){0u, 0u, 0u, 0u}; }
        __syncthreads();
        if (un + F.G < NTOK / CV_T) CV_LOAD(un + F.G);
        __builtin_amdgcn_sched_barrier(0);
#pragma unroll
        for (int g = 0; g < 2; ++g) {
            f32x2 win[38];
#pragma unroll
            for (int i = 0; i < 38; ++i) { const unsigned pw = *(const LAS unsigned*)(IN + (16 * th + 8 * g + i) * 1024 + cp * 4); win[i] = (f32x2){__uint_as_float(pw << 16), __uint_as_float(pw & 0xffff0000u)}; }
#pragma unroll
            for (int o = 0; o < 8; ++o) { f32x2 a = bias;
#pragma unroll
                for (int j = 0; j < KS; ++j) a = __builtin_elementwise_fma(win[o + j], w[j], a);
                *(LAS f32x2*)(UT + (16 * th + 8 * g + o) * CW + 2 * cp) = a; }
        }
        __syncthreads();
#pragma unroll
        for (int i = 0; i < 4; ++i) { const int t = F.wave * 4 + i;
            const f32x4 v0 = *(const LAS f32x4*)(UT + t * CW + F.lane * 8), v1 = *(const LAS f32x4*)(UT + t * CW + F.lane * 8 + 4);
            const float mu = wave_sum((v0.x + v0.y) + (v0.z + v0.w) + (v1.x + v1.y) + (v1.z + v1.w)) * (1.f / CW);
            const f32x4 d0 = v0 - mu, d1 = v1 - mu;
            const float var = wave_sum((d0.x * d0.x + d0.y * d0.y) + (d0.z * d0.z + d0.w * d0.w) + (d1.x * d1.x + d1.y * d1.y) + (d1.z * d1.z + d1.w * d1.w)) * (1.f / CW);
            const float rstd = rsqrtf(var + EPS);
            float o[8];
#pragma unroll
            for (int k = 0; k < 4; ++k) { const float a = d0[k] * rstd * lg[k] + lb[k], bq = d1[k] * rstd * lg[4 + k] + lb[4 + k]; o[k] = a * sig_fast(a); o[4 + k] = bq * sig_fast(bq); }
            u32x4 wv; wv.x = cvt_pk_bf16(o[0], o[1]); wv.y = cvt_pk_bf16(o[2], o[3]); wv.z = cvt_pk_bf16(o[4], o[5]); wv.w = cvt_pk_bf16(o[6], o[7]);
            *(u32x4*)(ca + (size_t)(b * SEQ + s0 + t) * D + F.lane * 8) = wv; }
        __syncthreads();
    }
#undef CV_LOAD
}

constexpr int WRP = 2064;
constexpr int P6_WR = 0, P6_LGW = 48 * WRP, P6_EA = P6_LGW + 8 * 16 * 48 * 4, P6_HIST = P6_EA + 128 * 32, P6_BASE = P6_HIST + 128, P6_END = P6_BASE + 128;
static_assert(P6_END <= RING_BYTES, "P6 LDS map");
struct P6Row { float pv; u32x4 y[2]; f32x4 x[4]; };
__device__ __forceinline__ void p6_ld(P6Row& r, const float* x, const bf16* y1, const float* part, int row, int lane) {
    r.pv = part[(size_t)row * 16 + (lane & 15)];
#pragma unroll
    for (int j = 0; j < 2; ++j) r.y[j] = *(const u32x4*)(y1 + (size_t)row * D + 512 * j + 8 * lane);
    row_ld_f32(x + (size_t)row * D, lane, r.x);
}
__device__ __forceinline__ void p6_do(P6Row& r, const f32x4 (&c1)[4], const f32x4 (&c2)[4], const f32x4 (&c3)[4], bf16* x1b, bf16* h2, unsigned char* h2f, int row, int lane) {
    const float pv = row16_sum(r.pv);
    const float ra = rsqrtf(pv * (1.f / D) + EPS);
    f32x4 xv[4];
#pragma unroll
    for (int j = 0; j < 2; ++j) { const u32x4 w = r.y[j];
        const f32x4 ya = (f32x4){bf2f(w.x & 0xffffu), bf2f(w.x >> 16), bf2f(w.y & 0xffffu), bf2f(w.y >> 16)}, yb = (f32x4){bf2f(w.z & 0xffffu), bf2f(w.z >> 16), bf2f(w.w & 0xffffu), bf2f(w.w >> 16)};
        xv[2 * j] = r.x[2 * j] + c1[2 * j] * (ya * ra); xv[2 * j + 1] = r.x[2 * j + 1] + c1[2 * j + 1] * (yb * ra);
        *(u32x4*)(x1b + (size_t)row * D + 512 * j + 8 * lane) = row_pack(xv[2 * j], xv[2 * j + 1]); }
    const float sa = rsqrtf(wave_sum(row_ss(xv)) * (1.f / D) + EPS);
#pragma unroll
    for (int j = 0; j < 2; ++j) { const f32x4 ha = xv[2 * j] * sa * c2[2 * j] + c3[2 * j], hb = xv[2 * j + 1] * sa * c2[2 * j + 1] + c3[2 * j + 1];
        *(u32x4*)(h2 + (size_t)row * D + 512 * j + 8 * lane) = row_pack(ha, hb);
        *(u32x2*)(h2f + (size_t)row * D + 512 * j + 8 * lane) = (u32x2){pg8::pk4_fp8(ha.x, ha.y, ha.z, ha.w), pg8::pk4_fp8(hb.x, hb.y, hb.z, hb.w)}; }
}
__device__ __forceinline__ void p6_postmix_router(Frame& F) {
    const float* x = fin(I_X); const bf16* y1 = (const bf16*)(F.ws + WS_Y1); const float* part = (const float*)(F.ws + WS_PART); const float* ada = (const float*)(F.ws + WS_ADA);
    bf16* h2 = (bf16*)(F.ws + WS_CA); unsigned char* h2f = F.ws + WS_H2F; bf16* x1b = (bf16*)(F.ws + WS_X1B); int* list = (int*)(F.ws + WS_LIST); unsigned* tokinfo = (unsigned*)(F.ws + WS_TOK); const bf16* wr = (const bf16*)(F.ws + WS_WR);
    LAS unsigned char* WR = F.lds + P6_WR; LAS float* LGW = (LAS float*)(F.lds + P6_LGW) + F.wave * 16 * 48;
    LAS unsigned* EA = (LAS unsigned*)(F.lds + P6_EA); LAS unsigned* HIST = (LAS unsigned*)(F.lds + P6_HIST); LAS unsigned* BASE = (LAS unsigned*)(F.lds + P6_BASE);
    const int fr = F.lane & 15, fq = F.lane >> 4;
    const float* gpost1 = fin(I_GPOST1); const float* gpre2 = fin(I_GPRE2); const float* bgrp = fin(I_BGRP); const float* brt = fin(I_BRT);
    {
        u32x4 t[12];
#pragma unroll
        for (int i = 0; i < 12; ++i) { const int idx = F.tid + NTHR * i; t[i] = *(const u32x4*)(wr + (size_t)(idx >> 7) * D + (idx & 127) * 8); }
#pragma unroll
        for (int i = 0; i < 12; ++i) { const int idx = F.tid + NTHR * i; *(LAS u32x4*)(WR + (idx >> 7) * WRP + (idx & 127) * 16) = t[i]; }
    }
    for (int chunk = blockIdx.x; chunk < NTOK / 128; chunk += F.G) {
        const int R0 = chunk * 128, b = R0 / SEQ, rw = R0 + 16 * F.wave; const float* ad = ada + b * 6144;
        if (F.tid < 32) HIST[F.tid] = 0u;
        f32x4 c1[4], c2[4], c3[4];
#pragma unroll
        for (int q = 0; q < 4; ++q) { const int c0 = rcol(F.lane, q);
            c1[q] = *(const f32x4*)(gpost1 + c0) * *(const f32x4*)(ad + 2048 + c0);
            c2[q] = *(const f32x4*)(gpre2 + c0) * (1.f + *(const f32x4*)(ad + 4096 + c0)); c3[q] = *(const f32x4*)(ad + 3072 + c0); }
        __syncthreads();
        {
            P6Row na, nb;
            p6_ld(na, x, y1, part, rw, F.lane); p6_ld(nb, x, y1, part, rw + 1, F.lane);
#pragma unroll
            for (int i = 0; i < 16; i += 2) {
                P6Row ra = na, rb = nb;
                if (i + 2 < 16) { p6_ld(na, x, y1, part, rw + i + 2, F.lane); p6_ld(nb, x, y1, part, rw + i + 3, F.lane); }
                __builtin_amdgcn_sched_barrier(0);
                p6_do(ra, c1, c2, c3, x1b, h2, h2f, rw + i, F.lane); p6_do(rb, c1, c2, c3, x1b, h2, h2f, rw + i + 1, F.lane);
                __builtin_amdgcn_sched_barrier(0);
            }
        }
        VM_WAIT();
        {
            f32x4 acc[3] = {(f32x4){0.f, 0.f, 0.f, 0.f}, (f32x4){0.f, 0.f, 0.f, 0.f}, (f32x4){0.f, 0.f, 0.f, 0.f}};
            bf16x8 af[32];
#pragma unroll
            for (int ks = 0; ks < 32; ++ks) af[ks] = *(const bf16x8*)(h2 + (size_t)(rw + fr) * D + 32 * ks + 8 * fq);
#pragma unroll
            for (int ks = 0; ks < 32; ++ks)
#pragma unroll
                for (int nb = 0; nb < 3; ++nb) { const bf16x8 bf = *(const LAS bf16x8*)(WR + (16 * nb + fr) * WRP + (32 * ks + 8 * fq) * 2);
                    acc[nb] = __builtin_amdgcn_mfma_f32_16x16x32_bf16(af[ks], bf, acc[nb], 0, 0, 0); }
#pragma unroll
            for (int nb = 0; nb < 3; ++nb)
#pragma unroll
                for (int j = 0; j < 4; ++j) LGW[(4 * fq + j) * 48 + 16 * nb + fr] = acc[nb][j];
        }
        LDS_WAIT();
        if (F.lane < 16) {
            const LAS float* L = LGW + F.lane * 48;
            float gl[4];
#pragma unroll
            for (int g = 0; g < 4; ++g) gl[g] = L[g] + bgrp[g];
            int gi = 0; float gm = gl[0];
#pragma unroll
            for (int g = 1; g < 4; ++g) if (gl[g] > gm) { gm = gl[g]; gi = g; }
            float den = 0.f;
#pragma unroll
            for (int g = 0; g < 4; ++g) den += __expf(gl[g] - gm);
            const float grp_p = 1.f / den;
            float E[8];
#pragma unroll
            for (int i = 0; i < 8; ++i) E[i] = L[4 + gi * 8 + i] + brt[gi * 8 + i];
            int a = 0; float am = E[0];
#pragma unroll
            for (int i = 1; i < 8; ++i) if (E[i] > am) { am = E[i]; a = i; }
            int bi = -1; float bm = -3.0e38f;
#pragma unroll
            for (int i = 0; i < 8; ++i) if (i != a && E[i] > bm) { bm = E[i]; bi = i; }
            if (bi < 0) { bi = (a == 0) ? 1 : 0; bm = E[bi]; }
            const float pb = __expf(bm - am), wa = 1.f / (1.f + pb), wb = pb / (1.f + pb);
            const unsigned e0 = (unsigned)(gi * 8 + a), e1 = (unsigned)(gi * 8 + bi);
            const unsigned k0 = __hip_atomic_fetch_add(HIST + e0, 1u, __ATOMIC_RELAXED, __HIP_MEMORY_SCOPE_WORKGROUP), k1 = __hip_atomic_fetch_add(HIST + e1, 1u, __ATOMIC_RELAXED, __HIP_MEMORY_SCOPE_WORKGROUP);
            LAS unsigned* ea = EA + (16 * F.wave + F.lane) * 8;
            ea[0] = e0; ea[1] = k0; ea[2] = e1; ea[3] = k1; ea[4] = __float_as_uint(grp_p * wa); ea[5] = __float_as_uint(grp_p * wb);
        }
        __syncthreads();
        if (F.tid < 32) BASE[F.tid] = __hip_atomic_fetch_add(F.ctl + CW_CNT + F.tid, HIST[F.tid], __ATOMIC_RELAXED, __HIP_MEMORY_SCOPE_AGENT);
        __syncthreads();
        if (F.tid < 128) { const LAS unsigned* ea = EA + F.tid * 8; const int tok = R0 + F.tid;
            const unsigned e0 = ea[0], e1 = ea[2], p0 = BASE[e0] + ea[1], p1 = BASE[e1] + ea[3];
            list[(size_t)e0 * ECAP + p0] = tok; list[(size_t)e1 * ECAP + p1] = tok;
            unsigned* ti = tokinfo + (size_t)tok * 8; *(u32x4*)ti = (u32x4){e0, p0, e1, p1}; *(u32x2*)(ti + 4) = (u32x2){ea[4], ea[5]}; }
        __syncthreads();
    }
}

__device__ __forceinline__ void moe_tstart(Frame& F) {
    LAS int* TS = (LAS int*)(F.lds + TS_OFF);
    if (F.tid == 0) { int o = 0; for (int e = 0; e < NE; ++e) { TS[e] = o; o += (int)((__hip_atomic_load(F.ctl + CW_CNT + e, __ATOMIC_RELAXED, __HIP_MEMORY_SCOPE_AGENT) + 255u) >> 8); } TS[NE] = o; }
    __syncthreads();
}
template <bool GATHER>
__device__ __forceinline__ void moe_setup(Frame& F) {
    moe_tstart(F);
    LAS int* TS = (LAS int*)(F.lds + TS_OFF); LAS int* UT = (LAS int*)(F.lds + UT_OFF); LAS int* RT = (LAS int*)(F.lds + RT_OFF);
    const int* list = (const int*)(F.ws + WS_LIST);
    if (F.tid < pg8::MOE_MAXU) {
        const int u = F.tid * F.G + F.vcu, T4 = 4 * TS[NE]; int pm = 0, pn = 0, e = 0, valid = 0;
        if (u < T4) { pm = u >> 2; pn = u & 3; valid = 1; for (int k = 1; k < NE; ++k) if (TS[k] <= pm) e = k; }
        UT[F.tid * 4 + 0] = pm; UT[F.tid * 4 + 1] = pn; UT[F.tid * 4 + 2] = e; UT[F.tid * 4 + 3] = valid;
    }
    __syncthreads();
    if (GATHER) {
        for (int idx = F.tid; idx < pg8::MOE_MAXU * 256; idx += NTHR) { const int i = idx >> 8, r = idx & 255;
            if (UT[i * 4 + 3]) { const int e = UT[i * 4 + 2], pos = (UT[i * 4 + 0] - TS[e]) * 256 + r;
                const int cnt = (int)__hip_atomic_load(F.ctl + CW_CNT + e, __ATOMIC_RELAXED, __HIP_MEMORY_SCOPE_AGENT);
                RT[idx] = pos < cnt ? list[(size_t)e * ECAP + pos] : 0; } }
        VM_WAIT();
    }
    __syncthreads();
}

struct P9Row { u32x2 ya[2], yb[2]; u32x4 xb[2]; };
__device__ __forceinline__ void p9_ld(P9Row& r, const unsigned char* y2, const bf16* x1b, unsigned s0, unsigned s1, int row, int lane) {
#pragma unroll
    for (int j = 0; j < 2; ++j) { r.ya[j] = *(const u32x2*)(y2 + (size_t)s0 * D + 512 * j + 8 * lane); r.yb[j] = *(const u32x2*)(y2 + (size_t)s1 * D + 512 * j + 8 * lane);
        r.xb[j] = *(const u32x4*)(x1b + (size_t)row * D + 512 * j + 8 * lane); }
}
__device__ __forceinline__ void up8(const u32x4 w, f32x4& a, f32x4& b) {
    a = (f32x4){bf2f(w.x & 0xffffu), bf2f(w.x >> 16), bf2f(w.y & 0xffffu), bf2f(w.y >> 16)}; b = (f32x4){bf2f(w.z & 0xffffu), bf2f(w.z >> 16), bf2f(w.w & 0xffffu), bf2f(w.w >> 16)}; }
__device__ __forceinline__ f32x4 up4_fp8(unsigned w) { const f32x2 lo = __builtin_amdgcn_cvt_pk_f32_fp8((int)w, false), hi = __builtin_amdgcn_cvt_pk_f32_fp8((int)w, true); return (f32x4){lo.x, lo.y, hi.x, hi.y}; }
__device__ __forceinline__ void p9_do(const P9Row& r, float w0, float w1, const f32x4 (&cg)[4], float* orow, int lane) {
    f32x4 y[4], xv[4];
#pragma unroll
    for (int j = 0; j < 2; ++j) { y[2 * j] = up4_fp8(r.ya[j].x) * w0 + up4_fp8(r.yb[j].x) * w1; y[2 * j + 1] = up4_fp8(r.ya[j].y) * w0 + up4_fp8(r.yb[j].y) * w1; up8(r.xb[j], xv[2 * j], xv[2 * j + 1]); }
    const float rs = rsqrtf(wave_sum(row_ss(y)) * (1.f / D) + EPS);
#pragma unroll
    for (int q = 0; q < 4; ++q) xv[q] = xv[q] + cg[q] * (y[q] * rs);
    row_st_f32(orow, lane, xv);
}
__device__ __forceinline__ void p9_final(Frame& F, bool dry) {
    moe_tstart(F);
    const LAS int* TS = (const LAS int*)(F.lds + TS_OFF);
    const unsigned char* y2 = F.ws + WS_Y2; const bf16* x1b = (const bf16*)(F.ws + WS_X1B); const unsigned* tokinfo = (const unsigned*)(F.ws + WS_TOK); const float* ada = (const float*)(F.ws + WS_ADA);
    float* obase = dry ? (float*)(F.ws + WS_CA) : F.out; const float* gpost2 = fin(I_GPOST2);
    for (int chunk = blockIdx.x; chunk < NTOK / 128; chunk += F.G) {
        const int R0 = chunk * 128, b = R0 / SEQ, rw = R0 + 16 * F.wave; const float* ad = ada + b * 6144;
        f32x4 cg[4];
#pragma unroll
        for (int q = 0; q < 4; ++q) { const int c0 = rcol(F.lane, q); cg[q] = *(const f32x4*)(gpost2 + c0) * *(const f32x4*)(ad + 5120 + c0); }
        const u32x4 ti = *(const u32x4*)(tokinfo + (size_t)(rw + (F.lane & 15)) * 8); const u32x2 tw = *(const u32x2*)(tokinfo + (size_t)(rw + (F.lane & 15)) * 8 + 4);
        const unsigned sl0 = (unsigned)TS[ti.x] * 256u + ti.y, sl1 = (unsigned)TS[ti.z] * 256u + ti.w;
#define P9_S0(i) ((unsigned)__builtin_amdgcn_readlane((int)sl0, (i)))
#define P9_S1(i) ((unsigned)__builtin_amdgcn_readlane((int)sl1, (i)))
#define P9_W0(i) (__uint_as_float((unsigned)__builtin_amdgcn_readlane((int)tw.x, (i))) * (1.f / pg8::YSC))
#define P9_W1(i) (__uint_as_float((unsigned)__builtin_amdgcn_readlane((int)tw.y, (i))) * (1.f / pg8::YSC))
        P9Row na, nb;
        p9_ld(na, y2, x1b, P9_S0(0), P9_S1(0), rw, F.lane); p9_ld(nb, y2, x1b, P9_S0(1), P9_S1(1), rw + 1, F.lane);
#pragma unroll
        for (int i = 0; i < 16; i += 2) {
            const P9Row ra = na, rb = nb;
            if (i + 2 < 16) { p9_ld(na, y2, x1b, P9_S0(i + 2), P9_S1(i + 2), rw + i + 2, F.lane); p9_ld(nb, y2, x1b, P9_S0(i + 3), P9_S1(i + 3), rw + i + 3, F.lane); }
            __builtin_amdgcn_sched_barrier(0);
            p9_do(ra, P9_W0(i), P9_W1(i), cg, obase + (size_t)(rw + i) * D, F.lane); p9_do(rb, P9_W0(i + 1), P9_W1(i + 1), cg, obase + (size_t)(rw + i + 1) * D, F.lane);
            __builtin_amdgcn_sched_barrier(0);
        }
#undef P9_S0
#undef P9_S1
#undef P9_W0
#undef P9_W1
    }
}

__global__ void __launch_bounds__(NTHR, 2) mega_fwd(Args args) {
    extern __shared__ __attribute__((aligned(16))) unsigned char lds_raw[];
    Frame F;
    F.lds = (LAS unsigned char*)lds_raw; F.MISC = (volatile LAS unsigned*)(F.lds + MISC_OFF);
    F.tid = threadIdx.x; F.lane = F.tid & 63; F.wave = __builtin_amdgcn_readfirstlane(F.tid >> 6);
    F.G = gridDim.x; { const int bx = blockIdx.x; F.vcu = (F.G % 8 == 0) ? (bx % 8) * (F.G / 8) + bx / 8 : bx; }
    F.ws = args.ws; F.ctl = (unsigned*)(args.ws + WS_CTL); F.out = args.out;
    for (int u = F.tid; u < (LDS_BYTES - LDSCTL_OFF) / 4; u += NTHR) ((LAS unsigned*)(F.lds + LDSCTL_OFF))[u] = 0u;
    __syncthreads();
    XcdBarrier bar; bar.bar = F.ctl + CW_BAR; bar.x = 0; bar.st = nullptr;
    if (args.use_bar) bar = xcd_barrier_post(F.ctl + CW_BAR, F.MISC + 8);
    const int lo = args.ph_lo, hi = args.ph_hi;
#ifndef MK_PHMASK
#define MK_PHMASK 0x3ff
#endif
#define IN(k) (((MK_PHMASK >> (k)) & 1) && lo <= (k) && (k) < hi)
#define SEAM(k) do { if (IN(k) && IN((k) + 1)) xcd_barrier(bar); } while (0)

    if (IN(0)) { p0_prologue(F); }
    if (IN(1)) { p1_modnorm(F); } SEAM(1);
    if (IN(2)) {
        pg8::EpiP2 E{(bf16*)(F.ws + WS_GLU), (bf16*)(F.ws + WS_QKV), (bf16*)(F.ws + WS_GATES), fin(I_QG), fin(I_KG), (const f32x2*)(F.ws + WS_ROPE)};
        { pg8::P2Order<false> S{(const char*)(F.ws + WS_WIN), F.vcu, F.G};
          pg8::gemm_phase<pg8::EpiP2, pg8::P2Order<false>, true, 0>(F.lds + RING_OFF, F.ws + WS_H1, D * 2, D * 2, S, E); }
        { pg8::P2Order<true> S{(const char*)(F.ws + WS_WINF), F.vcu, F.G};
          pg8::gemm_phase<pg8::EpiP2, pg8::P2Order<true>, true, 1>(F.lds + RING_OFF, F.ws + WS_H1F, D * 2, D * 2, S, E, nullptr, D); }
    } SEAM(2);
    if (IN(3)) {
        if (!(args.flags & 1)) p3_conv(F);
        if (!(args.flags & 2)) {
            const attn_body::bf16* qkv = (const attn_body::bf16*)(F.ws + WS_QKV);
            const attn_body::AttnTensors AT{qkv, qkv + 512, qkv + 640, (attn_body::bf16*)(F.ws + WS_CA) + 512};
            const attn_body::StaticOrder S((int)F.G, F.vcu);
            attn_body::AttnUnit au;
            for (int i = 0; S.next(i, au); ++i) {
                if (i == (F.vcu & 3)) { p0_convert_experts(F, 0, XCONV_ITEMS, F.vcu, F.G); VM_WAIT(); __syncthreads(); }
                attn_body::attn_unit<8>(au.bh / attn_body::NHEAD, au.bh % attn_body::NHEAD, (au.bh % attn_body::NHEAD) / 4, au.qb, AT.Q, AT.K, AT.V, AT.O, (char*)lds_raw + RING_OFF);
            }
        }
    } SEAM(3);
    if (IN(4)) {
        pg8::PanelOrder S{(const char*)(F.ws + WS_WCA), F.vcu, F.G, D * 2};
        pg8::EpiP4 E{(const bf16*)(F.ws + WS_GATES), (bf16*)(F.ws + WS_H1)};
        pg8::gemm_phase<pg8::EpiP4, pg8::PanelOrder, true>(F.lds + RING_OFF, F.ws + WS_CA, D * 2, D * 2, S, E);
    } SEAM(4);
    if (IN(5)) {
        pg8::PanelOrder S{(const char*)(F.ws + WS_WO), F.vcu, F.G, D * 2};
        pg8::EpiP5 E{(bf16*)(F.ws + WS_Y1), (float*)(F.ws + WS_PART)};
        pg8::gemm_phase<pg8::EpiP5, pg8::PanelOrder, true>(F.lds + RING_OFF, F.ws + WS_H1, D * 2, D * 2, S, E);
    } SEAM(5);
    if (IN(6)) { p6_postmix_router(F); } SEAM(6);
    if (IN(7)) {
        moe_setup<true>(F);
        pg8::MoeOrder<true> S{(const LAS int*)(F.lds + UT_OFF), (const LAS int*)(F.lds + RT_OFF), F.ws + WS_W1, (size_t)D * D, D};
        pg8::EpiMoe1 E{F.ws + WS_GATES};
        pg8::gemm_phase<pg8::EpiMoe1, pg8::MoeOrder<true>, true, true>(F.lds + RING_OFF, F.ws + WS_H2F, D, D, S, E);
    } SEAM(7);
    if (IN(8)) {
        moe_setup<false>(F);
        pg8::MoeOrder<false> S{(const LAS int*)(F.lds + UT_OFF), (const LAS int*)(F.lds + RT_OFF), F.ws + WS_W2, (size_t)D * DE, DE};
        pg8::EpiMoe2 E{F.ws + WS_Y2};
        pg8::gemm_phase<pg8::EpiMoe2, pg8::MoeOrder<false>, true, true>(F.lds + RING_OFF, F.ws + WS_GATES, DE, DE, S, E);
    } SEAM(8);
    if (IN(9)) { p9_final(F, (args.flags & 4) != 0); }
#undef IN
#undef SEAM
}
#if MK_NPRE < 10
__global__ __launch_bounds__(256) void k_ada(const float* __restrict__ c, const float* __restrict__ w, const float* __restrict__ bb, float* __restrict__ ada) {
    const int j = blockIdx.x * 256 + threadIdx.x, b = blockIdx.y;
    float acc = 0.f;
    for (int k = 0; k < D; ++k) { const float cv = c[b * D + k]; acc += siluf_(cv) * w[(size_t)k * 6144 + j]; }
    ada[b * 6144 + j] = acc + bb[j];
}

__global__ __launch_bounds__(256) void k_modnorm(const float* __restrict__ x, const float* __restrict__ g, const float* __restrict__ ada, int sh_off, int sc_off, bf16* __restrict__ out) {
    const int lane = threadIdx.x & 63, row = blockIdx.x * 4 + (threadIdx.x >> 6), b = row / SEQ;
    const f32x4* xr = (const f32x4*)(x + (size_t)row * D) + lane;
    f32x4 v[4]; float s = 0.f;
#pragma unroll
    for (int j = 0; j < 4; ++j) { v[j] = xr[64 * j]; s += (v[j].x * v[j].x + v[j].y * v[j].y) + (v[j].z * v[j].z + v[j].w * v[j].w); }
    const float rstd = rsqrtf(wave_sum(s) * (1.f / D) + EPS);
    unsigned long long* o8 = (unsigned long long*)(out + (size_t)row * D) + lane;
#pragma unroll
    for (int j = 0; j < 4; ++j) {
        const int c0 = 256 * j + 4 * lane;
        const f32x4 gg = *(const f32x4*)(g + c0), sc = *(const f32x4*)(ada + b * 6144 + sc_off + c0), sh = *(const f32x4*)(ada + b * 6144 + sh_off + c0);
        const f32x4 r = v[j] * rstd * gg * (1.f + sc) + sh;
        o8[64 * j] = (unsigned long long)pk2(r.x, r.y) | ((unsigned long long)pk2(r.z, r.w) << 32);
    }
}

template <int MODE>
__global__ __launch_bounds__(256) void k_gemm(const bf16* __restrict__ A, int lda, const int* __restrict__ rowidx, const int* __restrict__ cntp, const int* __restrict__ offp,
                                              const float* __restrict__ W, const float* __restrict__ W2, int ldw, void* Cv, int ldc, int M, int K) {
    __shared__ float As[16][68];
    __shared__ float Bs[16][68];
    __shared__ float Bs2[MODE == 1 ? 16 : 1][68];
    const int Mcnt = cntp ? *cntp : M, off = offp ? *offp : 0;
    const int m0 = blockIdx.x * 64, n0 = blockIdx.y * 64;
    if (m0 >= Mcnt) return;
    const int tid = threadIdx.x, tx = tid & 15, ty = tid >> 4;
    float acc[4][4], acc2[4][4];
#pragma unroll
    for (int i = 0; i < 4; ++i)
#pragma unroll
        for (int j = 0; j < 4; ++j) { acc[i][j] = 0.f; acc2[i][j] = 0.f; }
    const int ar = tid >> 2, ak = (tid & 3) * 4, arow = m0 + ar;
    const bool av = arow < Mcnt;
    const size_t asrc = av ? (rowidx ? (size_t)rowidx[arow] : (size_t)(off + arow)) : 0;
    const int bk = tid >> 4, bn = (tid & 15) * 4;
    for (int k0 = 0; k0 < K; k0 += 16) {
        u32x2 raw = (u32x2){0u, 0u};
        if (av) raw = *(const u32x2*)(A + asrc * lda + k0 + ak);
        As[ak + 0][ar] = bf2f(raw.x & 0xffffu); As[ak + 1][ar] = bf2f(raw.x >> 16); As[ak + 2][ar] = bf2f(raw.y & 0xffffu); As[ak + 3][ar] = bf2f(raw.y >> 16);
        const f32x4 w = *(const f32x4*)(W + (size_t)(k0 + bk) * ldw + n0 + bn);
        Bs[bk][bn + 0] = w.x; Bs[bk][bn + 1] = w.y; Bs[bk][bn + 2] = w.z; Bs[bk][bn + 3] = w.w;
        if (MODE == 1) { const f32x4 w2 = *(const f32x4*)(W2 + (size_t)(k0 + bk) * ldw + n0 + bn);
            Bs2[bk][bn + 0] = w2.x; Bs2[bk][bn + 1] = w2.y; Bs2[bk][bn + 2] = w2.z; Bs2[bk][bn + 3] = w2.w; }
        __syncthreads();
#pragma unroll
        for (int kk = 0; kk < 16; ++kk) {
            float a[4], b[4], b2[4];
#pragma unroll
            for (int i = 0; i < 4; ++i) { a[i] = As[kk][ty * 4 + i]; b[i] = Bs[kk][tx * 4 + i]; b2[i] = (MODE == 1) ? Bs2[kk][tx * 4 + i] : 0.f; }
#pragma unroll
            for (int i = 0; i < 4; ++i)
#pragma unroll
                for (int j = 0; j < 4; ++j) { acc[i][j] += a[i] * b[j]; if (MODE == 1) acc2[i][j] += a[i] * b2[j]; }
        }
        __syncthreads();
    }
#pragma unroll
    for (int i = 0; i < 4; ++i) {
        const int r = m0 + ty * 4 + i;
        if (r < Mcnt) {
            const size_t crow = (size_t)(off + r);
            if (MODE == 0) { *(f32x4*)((float*)Cv + crow * ldc + n0 + tx * 4) = (f32x4){acc[i][0], acc[i][1], acc[i][2], acc[i][3]}; }
            else {
                float o[4];
#pragma unroll
                for (int j = 0; j < 4; ++j) o[j] = (MODE == 1) ? siluf_(acc[i][j]) * acc2[i][j] : acc[i][j];
                *(u32x2*)((bf16*)Cv + crow * ldc + n0 + tx * 4) = (u32x2){pk2(o[0], o[1]), pk2(o[2], o[3])};
            }
        }
    }
}

__global__ __launch_bounds__(256) void k_glu(const float* __restrict__ t, bf16* __restrict__ glu) {
    const size_t i = (size_t)blockIdx.x * 256 + threadIdx.x;
    const size_t r = i / 512; const int c = (int)(i % 512);
    const float a = t[r * 1024 + c], ag = t[r * 1024 + 512 + c];
    glu[i] = (bf16)f2bf(a * sigmoidf_(ag));
}
__global__ __launch_bounds__(256) void k_gate(const float* __restrict__ t, bf16* __restrict__ gates, int goff) {
    const size_t i = (size_t)blockIdx.x * 256 + threadIdx.x;
    const size_t r = i / 1024; const int c = (int)(i % 1024);
    gates[r * 2048 + goff + c] = (bf16)f2bf(sigmoidf_(t[i]));
}

__global__ __launch_bounds__(512) void k_conv(const bf16* __restrict__ glu, const float* __restrict__ w_dw, const float* __restrict__ b_dw, const float* __restrict__ lg, const float* __restrict__ lb, bf16* __restrict__ ca) {
    __shared__ float red[16];
    const int t = blockIdx.x, c = threadIdx.x, b = t / SEQ, s = t % SEQ;
    float acc = b_dw[c];
    for (int j = 0; j < KS; ++j) { const int s2 = s + j - KS / 2; if (s2 >= 0 && s2 < SEQ) acc += bf2f(glu[(size_t)(b * SEQ + s2) * CW + c]) * w_dw[j * CW + c]; }
    float sm = wave_sum(acc);
    if ((c & 63) == 0) red[c >> 6] = sm;
    __syncthreads();
    float mu = 0.f;
#pragma unroll
    for (int i = 0; i < 8; ++i) mu += red[i];
    mu *= (1.f / CW);
    const float d = acc - mu;
    float sq = wave_sum(d * d);
    if ((c & 63) == 0) red[8 + (c >> 6)] = sq;
    __syncthreads();
    float var = 0.f;
#pragma unroll
    for (int i = 0; i < 8; ++i) var += red[8 + i];
    var *= (1.f / CW);
    const float u = d * rsqrtf(var + EPS) * lg[c] + lb[c];
    ca[(size_t)t * 1024 + c] = (bf16)f2bf(siluf_(u));
}

__global__ __launch_bounds__(256) void k_qkrope(const float* __restrict__ t, const float* __restrict__ qg, const float* __restrict__ kg, bf16* __restrict__ qkv) {
    const size_t i = (size_t)blockIdx.x * 256 + threadIdx.x;
    const size_t r = i / 12; const int hs = (int)(i % 12);
    const float* src = t + r * 1024 + hs * 64; bf16* dst = qkv + r * 768 + hs * 64;
    if (hs >= 10) { for (int d = 0; d < 64; ++d) dst[d] = (bf16)f2bf(src[d]); return; }
    const float* g = hs < 8 ? qg : kg;
    float ss = 0.f;
    for (int d = 0; d < 64; ++d) ss += src[d] * src[d];
    const float rstd = rsqrtf(ss * (1.f / 64.f) + EPS) , osc = hs < 8 ? QSCALE : 1.f;
    const int s = (int)(r % SEQ); const float prow = (float)(s / 64), pcol = (float)(s % 64);
    for (int half = 0; half < 2; ++half) {
        const float pos = half == 0 ? prow : pcol;
        for (int e = 0; e < 16; ++e) {
            const float invf = powf(10000.f, -(float)(2 * e) / 32.f);
            const float ang = pos * invf; float sn, cs; sincosf(ang, &sn, &cs);
            const int d1 = half * 32 + e, d2 = d1 + 16;
            const float x1 = src[d1] * rstd * g[d1], x2 = src[d2] * rstd * g[d2];
            dst[d1] = (bf16)f2bf((x1 * cs - x2 * sn) * osc);
            dst[d2] = (bf16)f2bf((x2 * cs + x1 * sn) * osc);
        }
    }
}

__global__ __launch_bounds__(256) void k_attn(const bf16* __restrict__ qkv, bf16* __restrict__ ca) {
    const int qi = blockIdx.x * 256 + threadIdx.x;
    const int h = blockIdx.y, b = blockIdx.z, kvh = h / 4;
    const size_t row = (size_t)b * SEQ + qi;
    float q[64], o[64];
    {
        const u32x4* qp = (const u32x4*)(qkv + row * 768 + h * 64);
#pragma unroll
        for (int c = 0; c < 8; ++c) { const u32x4 v = qp[c];
            q[c * 8 + 0] = bf2f(v.x & 0xffffu); q[c * 8 + 1] = bf2f(v.x >> 16); q[c * 8 + 2] = bf2f(v.y & 0xffffu); q[c * 8 + 3] = bf2f(v.y >> 16);
            q[c * 8 + 4] = bf2f(v.z & 0xffffu); q[c * 8 + 5] = bf2f(v.z >> 16); q[c * 8 + 6] = bf2f(v.w & 0xffffu); q[c * 8 + 7] = bf2f(v.w >> 16); }
    }
#pragma unroll
    for (int d = 0; d < 64; ++d) o[d] = 0.f;
    float m = -1e30f, l = 0.f;
    for (int s = 0; s < SEQ; ++s) {
        const u32x4* kp = (const u32x4*)(qkv + ((size_t)b * SEQ + s) * 768 + 512 + kvh * 64);
        const u32x4* vp = (const u32x4*)(qkv + ((size_t)b * SEQ + s) * 768 + 640 + kvh * 64);
        float sc = 0.f;
#pragma unroll
        for (int c = 0; c < 8; ++c) { const u32x4 v = kp[c];
            sc += q[c * 8 + 0] * bf2f(v.x & 0xffffu) + q[c * 8 + 1] * bf2f(v.x >> 16) + q[c * 8 + 2] * bf2f(v.y & 0xffffu) + q[c * 8 + 3] * bf2f(v.y >> 16)
                + q[c * 8 + 4] * bf2f(v.z & 0xffffu) + q[c * 8 + 5] * bf2f(v.z >> 16) + q[c * 8 + 6] * bf2f(v.w & 0xffffu) + q[c * 8 + 7] * bf2f(v.w >> 16); }
        if (sc > m) { const float f = exp2f(m - sc); l *= f;
#pragma unroll
            for (int d = 0; d < 64; ++d) o[d] *= f;
            m = sc; }
        const float p = exp2f(sc - m); l += p;
#pragma unroll
        for (int c = 0; c < 8; ++c) { const u32x4 v = vp[c];
            o[c * 8 + 0] += p * bf2f(v.x & 0xffffu); o[c * 8 + 1] += p * bf2f(v.x >> 16); o[c * 8 + 2] += p * bf2f(v.y & 0xffffu); o[c * 8 + 3] += p * bf2f(v.y >> 16);
            o[c * 8 + 4] += p * bf2f(v.z & 0xffffu); o[c * 8 + 5] += p * bf2f(v.z >> 16); o[c * 8 + 6] += p * bf2f(v.w & 0xffffu); o[c * 8 + 7] += p * bf2f(v.w >> 16); }
    }
    const float il = 1.f / l;
    u32x4* op = (u32x4*)(ca + row * 1024 + 512 + h * 64);
#pragma unroll
    for (int c = 0; c < 8; ++c) op[c] = (u32x4){pk2(o[c * 8 + 0] * il, o[c * 8 + 1] * il), pk2(o[c * 8 + 2] * il, o[c * 8 + 3] * il), pk2(o[c * 8 + 4] * il, o[c * 8 + 5] * il), pk2(o[c * 8 + 6] * il, o[c * 8 + 7] * il)};
}

__global__ __launch_bounds__(256) void k_merge(const float* __restrict__ t1, const float* __restrict__ t2, const bf16* __restrict__ gates, bf16* __restrict__ merged) {
    const size_t i = (size_t)blockIdx.x * 256 + threadIdx.x;
    const size_t r = i / 1024; const int c = (int)(i % 1024);
    if (MK_NPRE >= 3) { const unsigned char* gq = (const unsigned char*)gates; const size_t gi = pg8::gate_index((int)r, c); const float sc = ((float)gq[gi] + 0.5f) * (1.f / 256.f), sa = ((float)gq[gi + 8] + 0.5f) * (1.f / 256.f); merged[i] = (bf16)f2bf(sc * t1[i] + sa * t2[i]); }
    else merged[i] = (bf16)f2bf(bf2f(gates[r * 2048 + c]) * t1[i] + bf2f(gates[r * 2048 + 1024 + c]) * t2[i]);
}

__global__ __launch_bounds__(256) void k_postmix(const float* __restrict__ x, const float* __restrict__ y1, const float* __restrict__ ada, const float* __restrict__ g_post, const float* __restrict__ g_pre2,
                                                 const float* __restrict__ w_group, const float* __restrict__ b_group, const float* __restrict__ w_router, const float* __restrict__ b_router,
                                                 float* __restrict__ x1out, bf16* __restrict__ h2, unsigned* __restrict__ ctl, int* __restrict__ list, unsigned* __restrict__ tokinfo) {
    const int lane = threadIdx.x & 63, row = blockIdx.x * 4 + (threadIdx.x >> 6), b = row / SEQ;
    const float* ad = ada + b * 6144;
    f32x4 yv[4], xv[4]; float s = 0.f;
#pragma unroll
    for (int j = 0; j < 4; ++j) { yv[j] = ((const f32x4*)(y1 + (size_t)row * D) + lane)[64 * j]; xv[j] = ((const f32x4*)(x + (size_t)row * D) + lane)[64 * j];
        s += (yv[j].x * yv[j].x + yv[j].y * yv[j].y) + (yv[j].z * yv[j].z + yv[j].w * yv[j].w); }
    const float rstd1 = rsqrtf(wave_sum(s) * (1.f / D) + EPS);
    float s2 = 0.f;
#pragma unroll
    for (int j = 0; j < 4; ++j) { const int c0 = 256 * j + 4 * lane;
        const f32x4 gp = *(const f32x4*)(g_post + c0), gt = *(const f32x4*)(ad + 2048 + c0);
        xv[j] = xv[j] + gt * (yv[j] * rstd1 * gp);
        ((f32x4*)(x1out + (size_t)row * D) + lane)[64 * j] = xv[j];
        s2 += (xv[j].x * xv[j].x + xv[j].y * xv[j].y) + (xv[j].z * xv[j].z + xv[j].w * xv[j].w); }
    const float rstd2 = rsqrtf(wave_sum(s2) * (1.f / D) + EPS);
    float lg[36];
#pragma unroll
    for (int o = 0; o < 36; ++o) lg[o] = 0.f;
    unsigned long long* o8 = (unsigned long long*)(h2 + (size_t)row * D) + lane;
#pragma unroll
    for (int j = 0; j < 4; ++j) { const int c0 = 256 * j + 4 * lane;
        const f32x4 gg = *(const f32x4*)(g_pre2 + c0), sc = *(const f32x4*)(ad + 4096 + c0), sh = *(const f32x4*)(ad + 3072 + c0);
        const f32x4 hv = xv[j] * rstd2 * gg * (1.f + sc) + sh;
        o8[64 * j] = (unsigned long long)pk2(hv.x, hv.y) | ((unsigned long long)pk2(hv.z, hv.w) << 32);
#pragma unroll
        for (int i = 0; i < 4; ++i) { const int c = c0 + i; const float hvv = hv[i];
            const f32x4 wg = *(const f32x4*)(w_group + c * 4);
            lg[0] += hvv * wg.x; lg[1] += hvv * wg.y; lg[2] += hvv * wg.z; lg[3] += hvv * wg.w;
#pragma unroll
            for (int q = 0; q < 8; ++q) { const f32x4 wr = *(const f32x4*)(w_router + c * 32 + q * 4);
                lg[4 + q * 4 + 0] += hvv * wr.x; lg[4 + q * 4 + 1] += hvv * wr.y; lg[4 + q * 4 + 2] += hvv * wr.z; lg[4 + q * 4 + 3] += hvv * wr.w; } } }
#pragma unroll
    for (int o = 0; o < 36; ++o) lg[o] = wave_sum(lg[o]);
    float gl[4];
#pragma unroll
    for (int g = 0; g < 4; ++g) gl[g] = lg[g] + b_group[g];
    int gi = 0; float gm = gl[0];
#pragma unroll
    for (int g = 1; g < 4; ++g) if (gl[g] > gm) { gm = gl[g]; gi = g; }
    float den = 0.f;
#pragma unroll
    for (int g = 0; g < 4; ++g) den += __expf(gl[g] - gm);
    const float grp_p = 1.f / den;
    float in[8];
#pragma unroll
    for (int i = 0; i < 8; ++i) { float v = 0.f;
#pragma unroll
        for (int g = 0; g < 4; ++g) { const float cand = lg[4 + g * 8 + i] + b_router[g * 8 + i]; v = (g == gi) ? cand : v; }
        in[i] = v; }
    int a = 0; float am = in[0];
#pragma unroll
    for (int i = 1; i < 8; ++i) if (in[i] > am) { am = in[i]; a = i; }
    int bidx = -1; float bm = -3.0e38f;
#pragma unroll
    for (int i = 0; i < 8; ++i) if (i != a && in[i] > bm) { bm = in[i]; bidx = i; }
    const float pb = __expf(bm - am), wa = 1.f / (1.f + pb), wb = pb / (1.f + pb);
    if (lane == 0) {
        const int e0 = gi * 8 + a, e1 = gi * 8 + bidx;
        const unsigned p0 = atomicAdd(ctl + CW_CNT + e0, 1u), p1 = atomicAdd(ctl + CW_CNT + e1, 1u);
        list[(size_t)e0 * ECAP + p0] = row; list[(size_t)e1 * ECAP + p1] = row;
        unsigned* ti = tokinfo + (size_t)row * 8;
        ti[0] = (unsigned)e0; ti[1] = p0; ti[2] = (unsigned)e1; ti[3] = p1; ti[4] = __float_as_uint(grp_p * wa); ti[5] = __float_as_uint(grp_p * wb);
    }
}
__global__ void k_offsets(unsigned* ctl) {
    if (threadIdx.x == 0) { unsigned o = 0; for (int e = 0; e < NE; ++e) { ctl[CW_OFF + e] = o; o += (ctl[CW_CNT + e] + 255u) / 256u * 256u; } ctl[CW_OFF + NE] = o; }
}

__global__ __launch_bounds__(256) void k_final(const bf16* __restrict__ y2, const unsigned* __restrict__ tokinfo, const unsigned* __restrict__ ctl, const float* __restrict__ ada, const float* __restrict__ g_post2, float* __restrict__ out) {
    const int lane = threadIdx.x & 63, row = blockIdx.x * 4 + (threadIdx.x >> 6), b = row / SEQ;
    const unsigned* ti = tokinfo + (size_t)row * 8;
    const unsigned s0 = ctl[CW_OFF + ti[0]] + ti[1], s1 = ctl[CW_OFF + ti[2]] + ti[3];
    const float w0 = __uint_as_float(ti[4]), w1 = __uint_as_float(ti[5]);
    f32x4 yv[4]; float s = 0.f;
#pragma unroll
    for (int j = 0; j < 4; ++j) {
        const u32x2 a = ((const u32x2*)(y2 + (size_t)s0 * D) + lane)[64 * j], c = ((const u32x2*)(y2 + (size_t)s1 * D) + lane)[64 * j];
        yv[j].x = w0 * bf2f(a.x & 0xffffu) + w1 * bf2f(c.x & 0xffffu); yv[j].y = w0 * bf2f(a.x >> 16) + w1 * bf2f(c.x >> 16);
        yv[j].z = w0 * bf2f(a.y & 0xffffu) + w1 * bf2f(c.y & 0xffffu); yv[j].w = w0 * bf2f(a.y >> 16) + w1 * bf2f(c.y >> 16);
        s += (yv[j].x * yv[j].x + yv[j].y * yv[j].y) + (yv[j].z * yv[j].z + yv[j].w * yv[j].w); }
    const float rstd = rsqrtf(wave_sum(s) * (1.f / D) + EPS);
#pragma unroll
    for (int j = 0; j < 4; ++j) { const int c0 = 256 * j + 4 * lane;
        const f32x4 gp = *(const f32x4*)(g_post2 + c0), gt = *(const f32x4*)(ada + b * 6144 + 5120 + c0);
        f32x4* op = (f32x4*)(out + (size_t)row * D) + lane;
        op[64 * j] = op[64 * j] + gt * (yv[j] * rstd * gp); }
}

#endif
extern "C" void kernel_launch(void* const* d_in, const int* in_sizes, int n_in, void* d_out, int out_size, void* d_ws, size_t ws_size, hipStream_t stream) {
    static int grid = 0;
    if (grid == 0) {
        if (n_in != 25 || in_sizes[0] != NTOK * D || out_size != NTOK * D || ws_size < WS_END) { fprintf(stderr, "kernel_launch: unexpected problem (n_in %d, ws %zu); nothing launched\n", n_in, ws_size); grid = -1; return; }
        int dev = 0, cus = 0, per_cu = 0;
        if (hipGetDevice(&dev) != hipSuccess || hipDeviceGetAttribute(&cus, hipDeviceAttributeMultiprocessorCount, dev) != hipSuccess) { grid = -1; return; }
        if (hipFuncSetAttribute((const void*)mega_fwd, hipFuncAttributeMaxDynamicSharedMemorySize, LDS_BYTES) != hipSuccess) { fprintf(stderr, "kernel_launch: hipFuncSetAttribute failed\n"); grid = -1; return; }
        if (hipOccupancyMaxActiveBlocksPerMultiprocessor(&per_cu, (const void*)mega_fwd, NTHR, LDS_BYTES) != hipSuccess || per_cu < 1) { fprintf(stderr, "kernel_launch: occupancy query says %d\n", per_cu); grid = -1; return; }
        (void)hipGetLastError();
        if (cus < 256) { fprintf(stderr, "kernel_launch: built for a 256-CU device (one workgroup per CU, 256 workgroups); this one has %d\n", cus); grid = -1; return; }
        grid = 256;
    }
    if (grid < 0) return;
    unsigned char* ws = (unsigned char*)d_ws;
    if (hipMemsetAsync(ws + WS_CTL, 0, CTL_ZERO_BYTES, stream) != hipSuccess) return;
    Args a{};
    for (int i = 0; i < 25; ++i) a.in[i] = (const float*)d_in[i];
    a.out = (float*)d_out; a.ws = ws; a.flags = MK_FLAGS;
#if MK_NPRE == 10 && MK_ONE
    a.ph_lo = 0; a.ph_hi = 10; a.use_bar = 1;
    hipLaunchKernelGGL(mega_fwd, dim3(grid), dim3(NTHR), LDS_BYTES, stream, a);
#else
    for (int p = 0; p < MK_NPRE; ++p) { a.ph_lo = p; a.ph_hi = p + 1; a.use_bar = 0;
#ifdef MK_REP
        if (p == MK_REP) {
            if (p == 9) a.flags |= 4;
#ifdef MK_REPFLAGS
            a.flags |= MK_REPFLAGS;
#endif
            hipLaunchKernelGGL(mega_fwd, dim3(grid), dim3(NTHR), LDS_BYTES, stream, a);
            a.flags = MK_FLAGS;
            if (p == 6) (void)hipMemsetAsync(ws + WS_CTL, 0, 256, stream);
        }
#endif
        hipLaunchKernelGGL(mega_fwd, dim3(grid), dim3(NTHR), LDS_BYTES, stream, a); }
#endif
#if MK_NPRE < 10
    const float* x = (const float*)d_in[0]; const float* w_in = (const float*)d_in[6];
    const float* w_dw = (const float*)d_in[7]; const float* b_dw = (const float*)d_in[8]; const float* cln_g = (const float*)d_in[9]; const float* cln_b = (const float*)d_in[10];
    const float* w_conv_out = (const float*)d_in[11]; const float* q_g = (const float*)d_in[12]; const float* k_g = (const float*)d_in[13]; const float* w_attn_out = (const float*)d_in[14];
    const float* w_out = (const float*)d_in[15]; const float* g_pre_ffn = (const float*)d_in[16]; const float* g_post_ffn = (const float*)d_in[17];
    const float* w_group = (const float*)d_in[18]; const float* b_group = (const float*)d_in[19]; const float* w_router = (const float*)d_in[20]; const float* b_router = (const float*)d_in[21];
    const float* w_e_gate = (const float*)d_in[22]; const float* w_e_up = (const float*)d_in[23]; const float* w_e_down = (const float*)d_in[24];
    float* out = (float*)d_out; unsigned* ctl = (unsigned*)(ws + WS_CTL); float* ada = (float*)(ws + WS_ADA);
    bf16* h1 = (bf16*)(ws + WS_H1); bf16* merged = (bf16*)(ws + WS_H1); bf16* glu = (bf16*)(ws + WS_GLU); bf16* qkv = (bf16*)(ws + WS_QKV);
    bf16* gates = (bf16*)(ws + WS_GATES); bf16* act = (bf16*)(ws + WS_GATES); bf16* ca = (bf16*)(ws + WS_CA); bf16* h2 = (bf16*)(ws + WS_CA);
    float* tmp = (float*)(ws + WS_TMP); int* list = (int*)(ws + WS_LIST); unsigned* tokinfo = (unsigned*)(ws + WS_TOK); bf16* y2 = (bf16*)(ws + WS_Y2);
    if (MK_NPRE <= 0) k_ada<<<dim3(6144 / 256, NB), 256, 0, stream>>>((const float*)d_in[1], (const float*)d_in[2], (const float*)d_in[3], ada);
    if (MK_NPRE <= 1) k_modnorm<<<NTOK / 4, 256, 0, stream>>>(x, (const float*)d_in[4], ada, 0, 1024, h1);
    if (MK_NPRE <= 2) {
        k_gemm<0><<<dim3(NTOK / 64, 1024 / 64), 256, 0, stream>>>(h1, D, nullptr, nullptr, nullptr, w_in + 0, nullptr, INW, tmp, 1024, NTOK, D);
        k_glu<<<NTOK * 512 / 256, 256, 0, stream>>>(tmp, glu);
        k_gemm<0><<<dim3(NTOK / 64, 768 / 64), 256, 0, stream>>>(h1, D, nullptr, nullptr, nullptr, w_in + 1024, nullptr, INW, tmp, 1024, NTOK, D);
        k_qkrope<<<NTOK * 12 / 256, 256, 0, stream>>>(tmp, q_g, k_g, qkv);
        k_gemm<0><<<dim3(NTOK / 64, 1024 / 64), 256, 0, stream>>>(h1, D, nullptr, nullptr, nullptr, w_in + 1792, nullptr, INW, tmp, 1024, NTOK, D);
        k_gate<<<NTOK * 1024 / 256, 256, 0, stream>>>(tmp, gates, 0);
        k_gemm<0><<<dim3(NTOK / 64, 1024 / 64), 256, 0, stream>>>(h1, D, nullptr, nullptr, nullptr, w_in + 2816, nullptr, INW, tmp, 1024, NTOK, D);
        k_gate<<<NTOK * 1024 / 256, 256, 0, stream>>>(tmp, gates, 1024);
    }
    if (MK_NPRE <= 3 || (MK_FLAGS & 1)) k_conv<<<NTOK, 512, 0, stream>>>(glu, w_dw, b_dw, cln_g, cln_b, ca);
    if (MK_NPRE <= 3 || (MK_FLAGS & 2)) k_attn<<<dim3(SEQ / 256, 8, NB), 256, 0, stream>>>(qkv, ca);
    if (MK_NPRE <= 4) {
        k_gemm<0><<<dim3(NTOK / 64, 1024 / 64), 256, 0, stream>>>(ca, 1024, nullptr, nullptr, nullptr, w_conv_out, nullptr, D, tmp, 1024, NTOK, 512);
        k_gemm<0><<<dim3(NTOK / 64, 1024 / 64), 256, 0, stream>>>(ca + 512, 1024, nullptr, nullptr, nullptr, w_attn_out, nullptr, D, out, 1024, NTOK, 512);
        k_merge<<<NTOK * 1024 / 256, 256, 0, stream>>>(tmp, out, gates, merged);
    }
    if (MK_NPRE <= 6) {
        k_gemm<0><<<dim3(NTOK / 64, 1024 / 64), 256, 0, stream>>>(merged, D, nullptr, nullptr, nullptr, w_out, nullptr, D, tmp, 1024, NTOK, D);
        k_postmix<<<NTOK / 4, 256, 0, stream>>>(x, tmp, ada, (const float*)d_in[5], g_pre_ffn, w_group, b_group, w_router, b_router, out, h2, ctl, list, tokinfo);
    }
    k_offsets<<<1, 64, 0, stream>>>(ctl);
    if (MK_NPRE <= 8) {
        for (int e = 0; e < NE; ++e)
            k_gemm<1><<<dim3(NTOK / 64, DE / 64), 256, 0, stream>>>(h2, D, list + (size_t)e * ECAP, (const int*)ctl + CW_CNT + e, (const int*)ctl + CW_OFF + e,
                                                                  w_e_gate + (size_t)e * D * DE, w_e_up + (size_t)e * D * DE, DE, act, DE, 0, D);
        for (int e = 0; e < NE; ++e)
            k_gemm<2><<<dim3(NTOK / 64, D / 64), 256, 0, stream>>>(act, DE, nullptr, (const int*)ctl + CW_CNT + e, (const int*)ctl + CW_OFF + e,
                                                                 w_e_down + (size_t)e * DE * D, nullptr, D, y2, D, 0, DE);
    }
    k_final<<<NTOK / 4, 256, 0, stream>>>(y2, tokinfo, ctl, ada, g_post_ffn, out);
#endif
}
```

```cpp
#define MK_NPRE 10
#define MK_ONE 1
#define MK_FLAGS 0
#include <hip/hip_runtime.h>
#include <hip/hip_bf16.h>
#include <cstdint>
#include <cstdio>
#include <cmath>

#define GAS __attribute__((address_space(1)))
#define LAS __attribute__((address_space(3)))
typedef unsigned short bf16;
typedef float f32x4 __attribute__((ext_vector_type(4)));
typedef float f32x2 __attribute__((ext_vector_type(2)));
typedef unsigned u32x4 __attribute__((ext_vector_type(4)));
typedef unsigned u32x2 __attribute__((ext_vector_type(2)));
typedef short bf16x8 __attribute__((ext_vector_type(8)));
typedef float f32x16 __attribute__((ext_vector_type(16)));

constexpr int NB = 16, SEQ = 2048, D = 1024, NTOK = NB * SEQ;
constexpr int INW = 3840, CW = 512, NE = 32, DE = 512, KS = 31;
constexpr int ECAP = NTOK;
constexpr int MAXSLOT = 73728;
constexpr float EPS = 1e-6f;
constexpr float QSCALE = 0.125f * 1.4426950408889634f;

constexpr size_t MiB = 1u << 20;
constexpr size_t WS_CTL = 0, CTL_ZERO_BYTES = 64 * 1024;
constexpr size_t WS_ADA = 1 * MiB;
constexpr size_t WS_ROPE = WS_ADA + 512 * 1024;
constexpr size_t WS_WR = WS_ADA + 640 * 1024;
constexpr size_t WS_H1 = 2 * MiB;
constexpr size_t WS_GLU = 66 * MiB;
constexpr size_t WS_QKV = 98 * MiB;
constexpr size_t WS_Y1 = 66 * MiB;
constexpr size_t WS_GATES = 146 * MiB;
constexpr size_t WS_X1B = 218 * MiB;
constexpr size_t WS_CA = 282 * MiB;
constexpr size_t WS_WIN = 346 * MiB;
constexpr size_t WS_WCA = WS_WIN + (size_t)INW * D * 2;
constexpr size_t WS_WO = WS_WCA + 2 * MiB;
constexpr size_t WS_W1 = WS_WO + 2 * MiB;
constexpr size_t WS_W2 = WS_W1 + 32 * MiB;
constexpr size_t WS_H2F = WS_W2 + 16 * MiB;
constexpr size_t WS_WINF = WS_H2F + 32 * MiB;
constexpr size_t WS_WEND = WS_WINF + 6 * MiB;
constexpr size_t WS_H1F = 282 * MiB;
constexpr size_t WS_TMP = 346 * MiB;
constexpr size_t WS_LIST = 474 * MiB;
constexpr size_t WS_TOK = 478 * MiB;
constexpr size_t WS_PART = 480 * MiB;
constexpr size_t WS_Y2 = 2 * MiB;
constexpr size_t WS_END = 482 * MiB;
static_assert(WS_WEND <= WS_LIST && WS_Y2 + (size_t)MAXSLOT * D * 2 <= WS_GATES && WS_GATES + (size_t)MAXSLOT * DE * 2 <= WS_X1B && WS_X1B + (size_t)NTOK * D * 2 <= WS_CA && WS_GATES + (size_t)NTOK * 2048 * 2 <= WS_CA && WS_CA + (size_t)NTOK * D * 2 <= WS_WIN, "d_ws map");
constexpr int CW_CNT = 0, CW_OFF = 64, CW_ADA = 128, CW_BAR = 4096;

__device__ __forceinline__ float bf2f(unsigned v) { return __uint_as_float(v << 16); }
__device__ __forceinline__ unsigned f2bf(float f) { unsigned u = __float_as_uint(f); return (u + 0x7fffu + ((u >> 16) & 1u)) >> 16; }
__device__ __forceinline__ unsigned pk2(float lo, float hi) { return f2bf(lo) | (f2bf(hi) << 16); }
__device__ __forceinline__ unsigned cvt_pk_bf16(float lo, float hi) { unsigned r; asm volatile("v_cvt_pk_bf16_f32 %0, %1, %2" : "=v"(r) : "v"(lo), "v"(hi)); return r; }
template <int CTRL> __device__ __forceinline__ float dpp_mov(float v) { return __builtin_bit_cast(float, __builtin_amdgcn_update_dpp(0, __builtin_bit_cast(int, v), CTRL, 0xf, 0xf, true)); }
__device__ __forceinline__ float row16_sum(float v) {
    v += dpp_mov<0xB1>(v);
    v += dpp_mov<0x4E>(v);
    v += dpp_mov<0x141>(v);
    v += dpp_mov<0x140>(v);
    return v;
}
__device__ __forceinline__ float wave_sum(float v) {
    v = row16_sum(v);
    { auto rr = __builtin_amdgcn_permlane16_swap(__float_as_uint(v), __float_as_uint(v), false, false); v = __uint_as_float(rr[0]) + __uint_as_float(rr[1]); }
    { auto rr = __builtin_amdgcn_permlane32_swap(__float_as_uint(v), __float_as_uint(v), false, false); v = __uint_as_float(rr[0]) + __uint_as_float(rr[1]); }
    return v;
}
__device__ __forceinline__ float sigmoidf_(float v) { return 1.f / (1.f + __expf(-v)); }
__device__ __forceinline__ float siluf_(float v) { return v / (1.f + __expf(-v)); }
__device__ __forceinline__ float sig_fast(float v) { return __builtin_amdgcn_rcpf(1.f + __builtin_amdgcn_exp2f(v * -1.4426950408889634f)); }
#define LDS_WAIT() asm volatile("s_waitcnt lgkmcnt(0)" ::: "memory")
#define VM_WAIT() asm volatile("s_waitcnt vmcnt(0)" ::: "memory")

__host__ __device__ __forceinline__ int vmap_win(int n) {
    if (n < 512) return 256 * (n >> 7) + (n & 127);
    if (n < 1024) { const int j = n - 512; return 256 * (j >> 7) + 128 + (j & 127); }
    if (n < 1664) { const int idx = n - 1024, hh = idx >> 6, d = idx & 63, tile = 4 + (hh >> 2), wc = hh & 3, bj = (d >> 4) & 1, e = (d < 32) ? (d & 15) : 16 + (d & 15);
        return 256 * tile + 128 * bj + 32 * wc + e; }
    if (n < 1792) { const int idx = n - 1664, vh = idx >> 6, d = idx & 63; return 256 * 6 + 128 * (d >> 5) + 32 * (2 + vh) + (d & 31); }
    if (n < 2816) { const int j = n - 1792; return 256 * (7 + (j >> 7)) + (j & 127); }
    { const int j = n - 2816; return 256 * (7 + (j >> 7)) + 128 + (j & 127); }
}

namespace pg8 {
constexpr int BM = 256, BK = 64, HALF = 128, HTB = HALF * BK * 2  , STAGE_BYTES = 8 * HTB, NXCD = 8, WGM = 8;
__host__ __device__ __forceinline__ int lds_byte(int r, int c) { const int st = (r >> 4) * 2 + (c >> 5), rr = r & 15, cc = c & 31, ob = rr * 64 + cc * 2; return st * 1024 + (ob ^ (((ob >> 9) & 1) << 5)); }
__host__ __device__ __forceinline__ void stage_rc(int b, int& R, int& C) { const int st = b / 1024, sb = b % 1024, swz = sb ^ (((sb >> 9) & 1) << 5); R = (st >> 1) * 16 + swz / 64; C = (st & 1) * 32 + (swz % 64) / 2; }
__host__ __device__ __forceinline__ int perm32(int rho) { const int n = rho >> 4, i = rho & 15; return 8 * (i >> 2) + 4 * n + (i & 3); }

struct Unit { int pm, pn, e, ord; };

struct StaticOrder {
    const void* Bt; int KB; int nM, nN, nwg, G, c;
    __device__ void init(const void* Bt_, int KB_, int M, int N, int G_, int c_) { Bt = Bt_; KB = KB_; nM = M / BM; nN = N / BM; nwg = nM * nN; G = G_; c = c_; }
    __device__ __forceinline__ bool next(int i, Unit& u) const {
        const long L = (long)i * G + c; if (L >= nwg) return false;
        int wgid = (int)L; { const int q = nwg / NXCD, r = nwg % NXCD, xcd = wgid % NXCD, off = wgid / NXCD; wgid = (xcd < r ? xcd * (q + 1) : r * (q + 1) + (xcd - r) * q) + off; }
        const int nig = WGM * nN, gid = wgid / nig, fm = gid * WGM, gsz = (nM - fm) < WGM ? (nM - fm) : WGM;
        u.pm = fm + ((wgid % nig) % gsz); u.pn = (wgid % nig) / gsz; u.e = 0; u.ord = i; return true;
    }
    static constexpr bool GATHER = false;
    __device__ __forceinline__ int arow(const Unit& u, int r) const { return u.pm * BM + r; }
    __device__ __forceinline__ const char* bbase(const Unit& u) const { return (const char*)Bt + (size_t)u.pn * BM * KB; }
};

typedef int v8i32 __attribute__((ext_vector_type(8)));
typedef int v4i32 __attribute__((ext_vector_type(4)));
__device__ __forceinline__ void mfma_fp8_inplace(f32x4& d, const v8i32 a, const v8i32 b, const int scale) {
    asm volatile("v_mfma_scale_f32_16x16x128_f8f6f4 %0, %1, %2, %0, %3, %3 op_sel_hi:[0,0,0]" : "+v"(d) : "v"(a), "v"(b), "v"(scale));
}
__device__ __forceinline__ void mfma_bf16_inplace(f32x4& d, const bf16x8 a, const bf16x8 b) {
    asm volatile("v_mfma_f32_16x16x32_bf16 %0, %1, %2, %0" : "+v"(d) : "v"(a), "v"(b));
}
template <class Epi, class Sched, bool ALIGN_EPI, int DT = 0>
__device__ __forceinline__ void gemm_phase(LAS unsigned char* lds, const void* A, int ldaB_, int KB, const Sched& S, const Epi& E, const void* A8 = nullptr, int kbytes = 0) {
    const int tid = threadIdx.x, wid = __builtin_amdgcn_readfirstlane(tid >> 6), lane = tid & 63, wr = wid >> 2, wc = wid & 3, fr = lane & 15, fq = lane >> 4;
    const int nt_full = (kbytes ? kbytes : KB) / (BK * 2);
    const unsigned ldaB = (unsigned)ldaB_;
    unsigned voffA[2], voffB[2];
#pragma unroll
    for (int i = 0; i < 2; ++i) { int R, C; stage_rc(tid * 16 + i * 8192, R, C); const int Rb = (R & ~31) + perm32(R & 31);
        voffA[i] = (unsigned)R * ldaB + (unsigned)C * 2u; voffB[i] = (unsigned)(Rb * KB + C * 2); }
    const size_t kstep = (size_t)(BK * 2);
    const size_t hstep = (size_t)HALF * KB;
    const size_t hstepA = (size_t)HALF * ldaB;
    const unsigned ldsw = (unsigned)wid * 1024u;
    const int aoff = lds_byte(wr * 64 + fr, fq * 8), boff = lds_byte(wc * 32 + fr, fq * 8);
#define PG8_SA(b, h) (((b) * 2 + (h)) * HTB)
#define PG8_SB(b, h) ((4 + (b) * 2 + (h)) * HTB)
#define PG8_STAGE(bufoff, gbase, voff) do { _Pragma("unroll") for (int _i = 0; _i < 2; ++_i) \
        __builtin_amdgcn_global_load_lds((const unsigned*)((const char*)(gbase) + (voff)[_i]), (LAS unsigned*)(lds + (bufoff) + ldsw + _i * 8192), 16, 0, 0); } while (0)
#define PG8_LDA(dst, b, h) do { _Pragma("unroll") for (int m = 0; m < 4; ++m) _Pragma("unroll") for (int k = 0; k < 2; ++k) dst[m][k] = *(const LAS bf16x8*)(lds + PG8_SA(b, h) + aoff + m * 2048 + k * 1024); } while (0)
#define PG8_LDB(dst, b, h) do { _Pragma("unroll") for (int n = 0; n < 2; ++n) _Pragma("unroll") for (int k = 0; k < 2; ++k) dst[n][k] = *(const LAS bf16x8*)(lds + PG8_SB(b, h) + boff + n * 2048 + k * 1024); } while (0)
#define PG8_CAT(x) __builtin_shufflevector(__builtin_bit_cast(v4i32, (x)[0]), __builtin_bit_cast(v4i32, (x)[1]), 0, 1, 2, 3, 4, 5, 6, 7)
#define PG8_MMA(ai, bj, At, Bt) do { __builtin_amdgcn_s_setprio(1); \
        if (DT == 1 || (DT == 2 && f8cur)) { _Pragma("unroll") for (int m = 0; m < 4; ++m) _Pragma("unroll") for (int n = 0; n < 2; ++n) \
            mfma_fp8_inplace(acc[ai][bj][m][n], PG8_CAT(Bt[n]), PG8_CAT(At[m]), one_scale); } \
        else { _Pragma("unroll") for (int m = 0; m < 4; ++m) _Pragma("unroll") for (int n = 0; n < 2; ++n) _Pragma("unroll") for (int k = 0; k < 2; ++k) \
            { if constexpr (DT == 2) mfma_bf16_inplace(acc[ai][bj][m][n], Bt[n][k], At[m][k]); else acc[ai][bj][m][n] = __builtin_amdgcn_mfma_f32_16x16x32_bf16(Bt[n][k], At[m][k], acc[ai][bj][m][n], 0, 0, 0); } } \
        __builtin_amdgcn_s_setprio(0); } while (0)
#define PG8_WAIT_V(n) asm volatile("s_waitcnt vmcnt(" #n ")" ::: "memory")
#define PG8_WAIT_L(n) asm volatile("s_waitcnt lgkmcnt(" #n ")" ::: "memory")
#define PG8_BAR __builtin_amdgcn_s_barrier()
#define PG8_SCHED __builtin_amdgcn_sched_barrier(0)
#define PG8_MKVA(dst, u) do { _Pragma("unroll") for (int _h = 0; _h < 2; ++_h) _Pragma("unroll") for (int _p = 0; _p < 2; ++_p) { int _R, _C; stage_rc(tid * 16 + _p * 8192, _R, _C); \
        dst[_h][_p] = (unsigned)S.arow(u, _h * HALF + _R) * ldaB + (unsigned)_C * 2u; } } while (0)
#define PG8_STAGE_AC(bufoff, h, kofs) do { if constexpr (Sched::GATHER) PG8_STAGE(bufoff, Ab + (kofs), vA[h]); else PG8_STAGE(bufoff, cA + (h) * hstepA + (kofs), voffA); } while (0)
#define PG8_STAGE_AN(bufoff, h, kofs) do { if constexpr (Sched::GATHER) PG8_STAGE(bufoff, Ab + (kofs), nvA[h]); else PG8_STAGE(bufoff, nA + (h) * hstepA + (kofs), voffA); } while (0)
#define PG8_STAGE_A23(bufoff, h, w) do { if (last) PG8_STAGE_AN(bufoff, h, (size_t)(w) * kstep); else PG8_STAGE_AC(bufoff, h, (size_t)(t + 2 + (w)) * kstep); } while (0)
    Unit cur, nxt; int ui = 0;
    if (!S.next(0, cur)) return;
    f32x4 acc[2][2][4][2];
#pragma unroll
    for (int a = 0; a < 2; ++a)
#pragma unroll
        for (int b = 0; b < 2; ++b)
#pragma unroll
            for (int m = 0; m < 4; ++m)
#pragma unroll
                for (int n = 0; n < 2; ++n) acc[a][b][m][n] = (f32x4){0.f, 0.f, 0.f, 0.f};
    bf16x8 At[4][2], B0[2][2], B1[2][2];
    int one_scale = 0x7f7f7f7f; asm volatile("" : "+v"(one_scale));
    unsigned vA[2][2], nvA[2][2];
    const char* const Ab = (const char*)A;
    const char* cA = Ab; const char* nA = Ab;
    bool f8cur = (DT == 2) && cur.e != 0; int nt = (DT == 2 && f8cur) ? (nt_full >> 1) : nt_full;
#define PG8_ABASE(u) ((DT == 2 && (u).e != 0) ? (const char*)A8 : Ab)
    if constexpr (Sched::GATHER) { PG8_MKVA(vA, cur); } else { cA = PG8_ABASE(cur) + (size_t)S.arow(cur, 0) * ldaB; }
    const char* cB = S.bbase(cur);
    PG8_STAGE(PG8_SB(0, 0), cB, voffB); PG8_STAGE(PG8_SB(0, 1), cB + hstep, voffB); PG8_STAGE_AC(PG8_SA(0, 0), 0, 0); PG8_STAGE_AC(PG8_SA(0, 1), 1, 0);
    if (wr == 1) PG8_BAR;
    PG8_WAIT_V(2); PG8_BAR;
    PG8_STAGE(PG8_SB(1, 0), cB + kstep, voffB); PG8_STAGE_AC(PG8_SA(1, 0), 0, kstep); PG8_STAGE(PG8_SB(1, 1), cB + hstep + kstep, voffB);
    PG8_WAIT_V(6); PG8_BAR;
    for (;;) {
        const bool has_next = S.next(ui + 1, nxt);
        const char* nB = has_next ? S.bbase(nxt) : cB;
        if constexpr (!Sched::GATHER) nA = has_next ? PG8_ABASE(nxt) + (size_t)S.arow(nxt, 0) * ldaB : cA;
#pragma unroll 1
        for (int t = 0; t < nt; t += 2) {
            const bool last = (t == nt - 2);
            if constexpr (Epi::MID) { if (t == (nt >> 1)) { if (wr == 0) PG8_BAR; E.mid(acc, cur, wr, wc, fr, fq); if (wr == 1) PG8_BAR; } }
            if constexpr (Sched::GATHER) { if (last) { if (has_next) { PG8_MKVA(nvA, nxt); } else {
#pragma unroll
                    for (int h = 0; h < 2; ++h)
#pragma unroll
                        for (int p = 0; p < 2; ++p) nvA[h][p] = vA[h][p]; } } }
            const char* b2 = last ? nB : cB + (size_t)(t + 2) * kstep; const char* b3 = b2 + kstep;
            PG8_LDB(B0, 0, 0); PG8_LDB(B1, 0, 1); PG8_SCHED; PG8_LDA(At, 0, 0); PG8_STAGE_AC(PG8_SA(1, 1), 1, (size_t)(t + 1) * kstep);
            PG8_WAIT_V(8); PG8_WAIT_L(0); PG8_BAR; PG8_MMA(0, 0, At, B0); PG8_MMA(0, 1, At, B1); PG8_BAR; PG8_SCHED;
            PG8_LDA(At, 0, 1); PG8_STAGE(PG8_SB(0, 0), b2, voffB); PG8_STAGE(PG8_SB(0, 1), b2 + hstep, voffB); PG8_STAGE_A23(PG8_SA(0, 0), 0, 0);
            PG8_WAIT_V(8); PG8_WAIT_L(0); PG8_BAR; PG8_MMA(1, 0, At, B0); PG8_MMA(1, 1, At, B1); PG8_BAR; PG8_SCHED;
            PG8_LDB(B0, 1, 0); PG8_LDB(B1, 1, 1); PG8_SCHED; PG8_LDA(At, 1, 0); PG8_STAGE_A23(PG8_SA(0, 1), 1, 0);
            PG8_WAIT_V(8); PG8_WAIT_L(0); PG8_BAR; PG8_MMA(0, 0, At, B0); PG8_MMA(0, 1, At, B1); PG8_BAR; PG8_SCHED;
            PG8_LDA(At, 1, 1); PG8_STAGE(PG8_SB(1, 0), b3, voffB); PG8_STAGE(PG8_SB(1, 1), b3 + hstep, voffB); PG8_STAGE_A23(PG8_SA(1, 0), 0, 1);
            PG8_WAIT_V(8); PG8_WAIT_L(0); PG8_BAR; PG8_MMA(1, 0, At, B0); PG8_MMA(1, 1, At, B1); PG8_BAR; PG8_SCHED;
        }
        if constexpr (ALIGN_EPI) { if (wr == 0) PG8_BAR; }
        if constexpr (DT != 0) asm volatile("s_nop 15\n\ts_nop 15" ::: "memory");
        E(acc, cur, wr, wc, fr, fq);
        if (!has_next) break;
#pragma unroll
        for (int a = 0; a < 2; ++a)
#pragma unroll
            for (int b = 0; b < 2; ++b)
#pragma unroll
                for (int m = 0; m < 4; ++m)
#pragma unroll
                    for (int n = 0; n < 2; ++n) acc[a][b][m][n] = (f32x4){0.f, 0.f, 0.f, 0.f};
        cur = nxt; cB = nB; ++ui;
        if constexpr (DT == 2) { f8cur = cur.e != 0; nt = f8cur ? (nt_full >> 1) : nt_full; }
        if constexpr (Sched::GATHER) {
#pragma unroll
            for (int h = 0; h < 2; ++h)
#pragma unroll
                for (int p = 0; p < 2; ++p) vA[h][p] = nvA[h][p]; } else cA = nA;
        if constexpr (ALIGN_EPI) { if (wr == 1) PG8_BAR; }
    }
    PG8_WAIT_V(0);
    if constexpr (!ALIGN_EPI) { if (wr == 0) PG8_BAR; }
    PG8_BAR;
#undef PG8_ABASE
#undef PG8_STAGE_AC
#undef PG8_STAGE_AN
#undef PG8_STAGE_A23
#undef PG8_SA
#undef PG8_SB
#undef PG8_STAGE
#undef PG8_LDA
#undef PG8_LDB
#undef PG8_MMA
#undef PG8_WAIT_V
#undef PG8_WAIT_L
#undef PG8_BAR
#undef PG8_SCHED
#undef PG8_MKVA
#undef PG8_CAT
}
}
namespace pg8 {
__host__ __device__ __forceinline__ size_t gate_frag_base(int pm, int t, int w) { return ((size_t)((pm * 8 + t) * 8 + w) * 8) * 1024; }
__host__ __device__ __forceinline__ size_t gate_index(int row, int col) {
    const int pm = row >> 8, t = col >> 7, w = 4 * ((row >> 6) & 1) + ((col >> 5) & 3), k = 4 * ((row >> 7) & 1) + ((row >> 4) & 3), l = 16 * ((col >> 3) & 3) + (row & 15);
    return gate_frag_base(pm, t, w) + (size_t)k * 1024 + l * 16 + (col & 7);
}
__device__ __forceinline__ unsigned q8x4(float a, float b, float c, float d) {
    unsigned r = __builtin_amdgcn_cvt_pk_u8_f32(a * 256.f - 0.5f, 0, 0u); r = __builtin_amdgcn_cvt_pk_u8_f32(b * 256.f - 0.5f, 1, r);
    r = __builtin_amdgcn_cvt_pk_u8_f32(c * 256.f - 0.5f, 2, r); return __builtin_amdgcn_cvt_pk_u8_f32(d * 256.f - 0.5f, 3, r);
}
__device__ __forceinline__ void dq8x4(unsigned w, float (&f)[4]) { f[0] = (float)(w & 0xffu) + 0.5f; f[1] = (float)((w >> 8) & 0xffu) + 0.5f; f[2] = (float)((w >> 16) & 0xffu) + 0.5f; f[3] = (float)(w >> 24) + 0.5f; }
constexpr float WSCIN = 32.f;
struct EpiP2 {
    static constexpr bool MID = false;
    bf16* glu; bf16* qkv; bf16* gates; const float* qg; const float* kg; const f32x2* rope;
    __device__ __forceinline__ void operator()(const f32x4 (&acc)[2][2][4][2], const Unit& u, int wr, int wc, int fr, int fq) const {
        const int row0 = u.pm * BM + wr * 64 + fr;
        if (u.pn < 4) {
#pragma unroll
            for (int ai = 0; ai < 2; ++ai)
#pragma unroll
                for (int m = 0; m < 4; ++m) { const size_t row = (size_t)(row0 + ai * HALF + m * 16);
                    constexpr float isg = 1.f / WSCIN;
                    const f32x4 a0 = acc[ai][0][m][0] * isg, a1 = acc[ai][0][m][1] * isg, g0 = acc[ai][1][m][0] * isg, g1 = acc[ai][1][m][1] * isg;
                    u32x4 w; w.x = cvt_pk_bf16(a0[0] * sig_fast(g0[0]), a0[1] * sig_fast(g0[1])); w.y = cvt_pk_bf16(a0[2] * sig_fast(g0[2]), a0[3] * sig_fast(g0[3]));
                    w.z = cvt_pk_bf16(a1[0] * sig_fast(g1[0]), a1[1] * sig_fast(g1[1])); w.w = cvt_pk_bf16(a1[2] * sig_fast(g1[2]), a1[3] * sig_fast(g1[3]));
                    *(u32x4*)(glu + row * CW + u.pn * 128 + wc * 32 + fq * 8) = w; }
        } else if (u.pn < 7) {
            const int hs = (u.pn - 4) * 4 + wc;
            if (hs >= 10) {
#pragma unroll
                for (int ai = 0; ai < 2; ++ai)
#pragma unroll
                    for (int m = 0; m < 4; ++m) { const size_t row = (size_t)(row0 + ai * HALF + m * 16);
#pragma unroll
                        for (int bj = 0; bj < 2; ++bj) { const f32x4 v0 = acc[ai][bj][m][0], v1 = acc[ai][bj][m][1];
                            u32x4 w; w.x = cvt_pk_bf16(v0[0], v0[1]); w.y = cvt_pk_bf16(v0[2], v0[3]); w.z = cvt_pk_bf16(v1[0], v1[1]); w.w = cvt_pk_bf16(v1[2], v1[3]);
                            *(u32x4*)(qkv + row * 768 + hs * 64 + bj * 32 + fq * 8) = w; } }
            } else {
                const float* g = hs < 8 ? qg : kg; const float osc = hs < 8 ? QSCALE : 1.f;
                const int dbase = fq < 2 ? 8 * fq : 8 * fq + 16;
                float g1[8], g2[8];
#pragma unroll
                for (int i = 0; i < 8; ++i) { g1[i] = g[dbase + i] * osc; g2[i] = g[dbase + 16 + i] * osc; }
#pragma unroll
                for (int ai = 0; ai < 2; ++ai)
#pragma unroll
                    for (int m = 0; m < 4; ++m) { const int rowi = row0 + ai * HALF + m * 16; const size_t row = (size_t)rowi;
                        const int s = rowi & (SEQ - 1); const int tabrow = fq < 2 ? (s >> 6) : 32 + (s & 63);
                        const f32x2* tp = rope + tabrow * 16 + 8 * (fq & 1);
                        float ss = 0.f;
#pragma unroll
                        for (int bj = 0; bj < 2; ++bj)
#pragma unroll
                            for (int n = 0; n < 2; ++n) { const f32x4 v = acc[ai][bj][m][n]; ss += (v[0] * v[0] + v[1] * v[1]) + (v[2] * v[2] + v[3] * v[3]); }
                        ss += __shfl_xor(ss, 16); ss += __shfl_xor(ss, 32);
                        const float rstd = rsqrtf(ss * (1.f / 64.f) + EPS);
                        float o1[8], o2[8];
#pragma unroll
                        for (int n = 0; n < 2; ++n)
#pragma unroll
                            for (int j = 0; j < 4; ++j) { const f32x2 cs = tp[4 * n + j];
                                const float x1 = acc[ai][0][m][n][j] * rstd * g1[4 * n + j], x2 = acc[ai][1][m][n][j] * rstd * g2[4 * n + j];
                                o1[4 * n + j] = x1 * cs.x - x2 * cs.y; o2[4 * n + j] = x2 * cs.x + x1 * cs.y; }
                        u32x4 w1, w2;
                        w1.x = cvt_pk_bf16(o1[0], o1[1]); w1.y = cvt_pk_bf16(o1[2], o1[3]); w1.z = cvt_pk_bf16(o1[4], o1[5]); w1.w = cvt_pk_bf16(o1[6], o1[7]);
                        w2.x = cvt_pk_bf16(o2[0], o2[1]); w2.y = cvt_pk_bf16(o2[2], o2[3]); w2.z = cvt_pk_bf16(o2[4], o2[5]); w2.w = cvt_pk_bf16(o2[6], o2[7]);
                        bf16* dst = qkv + row * 768 + hs * 64 + dbase;
                        *(u32x4*)dst = w1; *(u32x4*)(dst + 16) = w2; }
            }
        } else {
            unsigned char* gr = (unsigned char*)gates + gate_frag_base(u.pm, u.pn - 7, wr * 4 + wc) + (fq * 16 + fr) * 16;
#pragma unroll
            for (int ai = 0; ai < 2; ++ai)
#pragma unroll
                for (int m = 0; m < 4; ++m) {
                    float sc[8], sa[8];
#pragma unroll
                    for (int n = 0; n < 2; ++n)
#pragma unroll
                        for (int j = 0; j < 4; ++j) {
                            const float dc = 1.f + __builtin_amdgcn_exp2f(acc[ai][0][m][n][j] * (-1.4426950408889634f / WSCIN)), da = 1.f + __builtin_amdgcn_exp2f(acc[ai][1][m][n][j] * (-1.4426950408889634f / WSCIN));
                            const float rinv = __builtin_amdgcn_rcpf(dc * da); sc[4 * n + j] = rinv * da; sa[4 * n + j] = rinv * dc; }
                    *(u32x4*)(gr + (ai * 4 + m) * 1024) = (u32x4){q8x4(sc[0], sc[1], sc[2], sc[3]), q8x4(sc[4], sc[5], sc[6], sc[7]), q8x4(sa[0], sa[1], sa[2], sa[3]), q8x4(sa[4], sa[5], sa[6], sa[7])}; }
        }
    }
};
__device__ __forceinline__ void unpack8(const u32x4 w, float (&f)[8]) {
    f[0] = bf2f(w.x & 0xffffu); f[1] = bf2f(w.x >> 16); f[2] = bf2f(w.y & 0xffffu); f[3] = bf2f(w.y >> 16);
    f[4] = bf2f(w.z & 0xffffu); f[5] = bf2f(w.z >> 16); f[6] = bf2f(w.w & 0xffffu); f[7] = bf2f(w.w >> 16);
}
struct EpiP4 {
    static constexpr bool MID = true;
    const bf16* gates; bf16* merged;
    __device__ __forceinline__ void mid(f32x4 (&acc)[2][2][4][2], const Unit& u, int wr, int wc, int fr, int fq) const {
        asm volatile("" ::: "memory");
        u32x4 rr[2][8];
#pragma unroll
        for (int bj = 0; bj < 2; ++bj) { const unsigned char* gp = (const unsigned char*)gates + gate_frag_base(u.pm, 2 * u.pn + bj, wr * 4 + wc) + (fq * 16 + fr) * 16;
#pragma unroll
            for (int k = 0; k < 8; ++k) rr[bj][k] = *(const u32x4*)(gp + k * 1024); }
#pragma unroll
        for (int bj = 0; bj < 2; ++bj)
#pragma unroll
            for (int k = 0; k < 8; ++k)
#pragma unroll
                for (int n = 0; n < 2; ++n) { float c[4], a[4]; dq8x4(n ? rr[bj][k].y : rr[bj][k].x, c); dq8x4(n ? rr[bj][k].w : rr[bj][k].z, a);
#pragma unroll
                    for (int j = 0; j < 4; ++j) acc[k >> 2][bj][k & 3][n][j] *= c[j] * __builtin_amdgcn_rcpf(a[j]); }
        asm volatile("" ::: "memory");
    }
    __device__ __forceinline__ void operator()(const f32x4 (&acc)[2][2][4][2], const Unit& u, int wr, int wc, int fr, int fq) const {
        const int row0 = u.pm * BM + wr * 64 + fr, col0 = u.pn * BM + wc * 32 + fq * 8;
        u32x2 rr[2][8];
#pragma unroll
        for (int bj = 0; bj < 2; ++bj) { const unsigned char* gp = (const unsigned char*)gates + gate_frag_base(u.pm, 2 * u.pn + bj, wr * 4 + wc) + (fq * 16 + fr) * 16 + 8;
#pragma unroll
            for (int k = 0; k < 8; ++k) rr[bj][k] = *(const u32x2*)(gp + k * 1024); }
        asm volatile("" ::: "memory");
#pragma unroll
        for (int bj = 0; bj < 2; ++bj)
#pragma unroll
            for (int k = 0; k < 8; ++k) { const size_t row = (size_t)(row0 + (k >> 2) * HALF + (k & 3) * 16);
                float a0[4], a1[4]; dq8x4(rr[bj][k].x, a0); dq8x4(rr[bj][k].y, a1); constexpr float s = 1.f / 256.f;
                const f32x4 v0 = acc[k >> 2][bj][k & 3][0] * s, v1 = acc[k >> 2][bj][k & 3][1] * s;
                u32x4 w; w.x = cvt_pk_bf16(v0[0] * a0[0], v0[1] * a0[1]); w.y = cvt_pk_bf16(v0[2] * a0[2], v0[3] * a0[3]); w.z = cvt_pk_bf16(v1[0] * a1[0], v1[1] * a1[1]); w.w = cvt_pk_bf16(v1[2] * a1[2], v1[3] * a1[3]);
                *(u32x4*)(merged + row * D + col0 + bj * HALF) = w; }
    }
};
struct EpiP5 {
    static constexpr bool MID = false;
    bf16* y1; float* part;
    __device__ __forceinline__ void operator()(const f32x4 (&acc)[2][2][4][2], const Unit& u, int wr, int wc, int fr, int fq) const {
        const int row0 = u.pm * BM + wr * 64 + fr, col0 = u.pn * BM + wc * 32 + fq * 8;
#pragma unroll
        for (int ai = 0; ai < 2; ++ai)
#pragma unroll
            for (int m = 0; m < 4; ++m) { const size_t row = (size_t)(row0 + ai * HALF + m * 16); float ss = 0.f;
#pragma unroll
                for (int bj = 0; bj < 2; ++bj) { const f32x4 v0 = acc[ai][bj][m][0], v1 = acc[ai][bj][m][1];
                    ss += (v0[0] * v0[0] + v0[1] * v0[1]) + (v0[2] * v0[2] + v0[3] * v0[3]) + (v1[0] * v1[0] + v1[1] * v1[1]) + (v1[2] * v1[2] + v1[3] * v1[3]);
                    u32x4 w; w.x = cvt_pk_bf16(v0[0], v0[1]); w.y = cvt_pk_bf16(v0[2], v0[3]); w.z = cvt_pk_bf16(v1[0], v1[1]); w.w = cvt_pk_bf16(v1[2], v1[3]);
                    *(u32x4*)(y1 + row * D + col0 + bj * HALF) = w; }
                ss += __shfl_xor(ss, 16); ss += __shfl_xor(ss, 32);
                if (fq == 0) part[row * 16 + u.pn * 4 + wc] = ss; }
    }
};
__device__ __forceinline__ unsigned pk4_fp8(float a, float b, float c, float d) { int r = __builtin_amdgcn_cvt_pk_fp8_f32(a, b, 0, false); r = __builtin_amdgcn_cvt_pk_fp8_f32(c, d, r, true); return (unsigned)r; }
constexpr float WSC1 = 32.f, WSC2 = 16.f;
struct EpiMoe1 {
    static constexpr bool MID = false;
    unsigned char* act;
    __device__ __forceinline__ void operator()(const f32x4 (&acc)[2][2][4][2], const Unit& u, int wr, int wc, int fr, int fq) const {
        const int row0 = u.pm * BM + wr * 64 + fr; constexpr float is = 1.f / WSC1;
#pragma unroll
        for (int ai = 0; ai < 2; ++ai)
#pragma unroll
            for (int m = 0; m < 4; ++m) { const size_t row = (size_t)(row0 + ai * HALF + m * 16);
                const f32x4 g0 = acc[ai][0][m][0] * is, g1 = acc[ai][0][m][1] * is, u0 = acc[ai][1][m][0] * is, u1 = acc[ai][1][m][1] * is;
                u32x2 w; w.x = pk4_fp8(g0[0] * sig_fast(g0[0]) * u0[0], g0[1] * sig_fast(g0[1]) * u0[1], g0[2] * sig_fast(g0[2]) * u0[2], g0[3] * sig_fast(g0[3]) * u0[3]);
                w.y = pk4_fp8(g1[0] * sig_fast(g1[0]) * u1[0], g1[1] * sig_fast(g1[1]) * u1[1], g1[2] * sig_fast(g1[2]) * u1[2], g1[3] * sig_fast(g1[3]) * u1[3]);
                *(u32x2*)(act + row * DE + u.pn * 128 + wc * 32 + fq * 8) = w; }
    }
};
constexpr float YSC = 8.f;
struct EpiMoe2 {
    static constexpr bool MID = false;
    unsigned char* y2;
    __device__ __forceinline__ void operator()(const f32x4 (&acc)[2][2][4][2], const Unit& u, int wr, int wc, int fr, int fq) const {
        const int row0 = u.pm * BM + wr * 64 + fr, col0 = u.pn * BM + wc * 32 + fq * 8; constexpr float is = YSC / WSC2;
#pragma unroll
        for (int ai = 0; ai < 2; ++ai)
#pragma unroll
            for (int m = 0; m < 4; ++m) { const size_t row = (size_t)(row0 + ai * HALF + m * 16);
#pragma unroll
                for (int bj = 0; bj < 2; ++bj) { const f32x4 v0 = acc[ai][bj][m][0] * is, v1 = acc[ai][bj][m][1] * is;
                    *(u32x2*)(y2 + row * D + col0 + bj * HALF) = (u32x2){pk4_fp8(v0[0], v0[1], v0[2], v0[3]), pk4_fp8(v1[0], v1[1], v1[2], v1[3])}; } }
    }
};
constexpr int MOE_MAXU = 8;
template <bool GATHER_> struct MoeOrder {
    static constexpr bool GATHER = GATHER_;
    const LAS int* UT; const LAS int* RT; const void* W; size_t estride; int KB;
    __device__ __forceinline__ bool next(int i, Unit& u) const {
        if (i >= MOE_MAXU) return false;
        const int v = __builtin_amdgcn_readfirstlane(UT[i * 4 + 3]); if (!v) return false;
        u.pm = __builtin_amdgcn_readfirstlane(UT[i * 4 + 0]); u.pn = __builtin_amdgcn_readfirstlane(UT[i * 4 + 1]); u.e = __builtin_amdgcn_readfirstlane(UT[i * 4 + 2]); u.ord = i; return true;
    }
    __device__ __forceinline__ int arow(const Unit& u, int r) const { return GATHER ? RT[u.ord * 256 + r] : u.pm * BM + r; }
    __device__ __forceinline__ const char* bbase(const Unit& u) const { return (const char*)W + (size_t)u.e * estride + (size_t)u.pn * BM * KB; }
};
__host__ __device__ __forceinline__ int winf_row(int vrow) { return vrow < 1024 ? vrow : vrow - 768; }
template <bool F8> struct P2Order {
    static constexpr bool GATHER = false;
    const char* W; int v, G;
    __device__ __forceinline__ bool next(int i, Unit& u) const {
        u.ord = i; u.e = F8 ? 1 : 0;
        if (!F8) { int L;
            if (G == 256) { if (i >= (v < 128 ? 2 : 1)) return false; L = 256 * i + v; } else { L = i * G + v; if (L >= 384) return false; }
            u.pm = L / 3; u.pn = 4 + (L - 3 * u.pm); return true; }
        int f;
        if (G == 256) { if (i >= (v < 128 ? 5 : 7)) return false; f = v >= 128 ? (v - 128) * 7 + i : 896 + 5 * v + i; } else { f = i * G + v; if (f >= 1536) return false; }
        u.pm = f / 12; const int t = f - 12 * u.pm; u.pn = t < 4 ? t : t + 3; return true;
    }
    __device__ __forceinline__ int arow(const Unit& u, int r) const { return u.pm * BM + r; }
    __device__ __forceinline__ const char* bbase(const Unit& u) const { return W + (size_t)(F8 ? winf_row(u.pn * BM) : u.pn * BM) * 2048; }
};
struct PanelOrder {
    static constexpr bool GATHER = false;
    const char* W; int v, G, KB;
    __device__ __forceinline__ bool next(int i, Unit& u) const { const int L = G * i + v; if (L >= (NTOK / BM) * 4) return false; u.pm = L >> 2; u.pn = L & 3; u.e = 0; u.ord = i; return true; }
    __device__ __forceinline__ int arow(const Unit& u, int r) const { return u.pm * BM + r; }
    __device__ __forceinline__ const char* bbase(const Unit& u) const { return W + (size_t)u.pn * BM * KB; }
};
}
namespace attn_body {
using bf16=__hip_bfloat16;
using bf16x8=__attribute__((ext_vector_type(8)))short;
using s16x4=__attribute__((ext_vector_type(4)))short;
using f32x16=__attribute__((ext_vector_type(16)))float;
using u32x4=__attribute__((ext_vector_type(4)))unsigned;
constexpr int BATCH=16,NHEAD=8,SEQ=2048,D=64,DM=768,OPITCH=1024;
constexpr int NW=8,QBLK=32,QB=QBLK*NW,KVBLK=64,NQB=SEQ/QB;
constexpr int ATTN_UNIT_ROWS=QB;
__device__ __forceinline__ int crow(int r,int hi){return (r&3)+8*(r>>2)+4*hi;}
#define SBAR() __builtin_amdgcn_sched_barrier(0)
__device__ __forceinline__ void cmask(f32x16&p0,f32x16&p1,int jb,int qrel,int hi){
  const float NEG=-INFINITY; int kb=64*jb+4*hi;
  #pragma unroll
  for(int r=0;r<16;++r){int kv=kb+(r&3)+8*(r>>2); if(kv>qrel)p0[r]=NEG; if(kv+32>qrel)p1[r]=NEG;}
}

constexpr int NSLOT=3, SLOTB=8192;
constexpr int LDS_K=0, LDS_V=NSLOT*SLOTB, LDS_WS=2*NSLOT*SLOTB, LDS_OST=LDS_WS+NW*64*4, LDS_BYTES=LDS_OST+NW*4096;
constexpr float C2=0.125f*1.4426950408889634f;
__device__ __forceinline__ void glds16(const void*gsrc,unsigned lds_dst){unsigned keep;
  asm volatile("s_mov_b32 %0, m0\n\ts_mov_b32 m0, %2\n\ts_nop 0\n\tglobal_load_lds_dwordx4 %1, off\n\ts_mov_b32 m0, %0":"=&s"(keep):"v"(gsrc),"s"(lds_dst):"memory");}
__device__ __forceinline__ float max3f(float a,float b,float c){float r;asm("v_max3_f32 %0, %1, %2, %3":"=v"(r):"v"(a),"v"(b),"v"(c));return r;}
__device__ __forceinline__ float max2f(float a,float b){float r;asm("v_max_f32_e32 %0, %1, %2":"=v"(r):"v"(a),"v"(b));return r;}
__device__ __forceinline__ float fadd_s(float a,float b){float r;asm("v_add_f32_e32 %0, %1, %2":"=v"(r):"v"(a),"v"(b));return r;}
__device__ __forceinline__ float fsub_s(float a,float b){float r;asm("v_sub_f32_e32 %0, %1, %2":"=v"(r):"v"(a),"v"(b));return r;}
typedef float f32x2_t __attribute__((ext_vector_type(2))); typedef __bf16 bf16x2_t __attribute__((ext_vector_type(2)));
__device__ __forceinline__ unsigned cvtpk_s(float lo,float hi){f32x2_t v={lo,hi};bf16x2_t b=__builtin_convertvector(v,bf16x2_t);return __builtin_bit_cast(unsigned,b);}
#define WAIT_BAR(N) asm volatile("s_waitcnt vmcnt(" #N ") lgkmcnt(0)\n\ts_barrier":::"memory")

__device__ __forceinline__ void qkt(f32x16&p0,f32x16&p1,const char*Kslot,const bf16x8*qr,const f32x16&negm,int r32,int hi){
  const char*kb=Kslot+hi*1024+r32*16;
  #pragma unroll
  for(int d0=0;d0<4;++d0){
    const bf16x8 b0=*reinterpret_cast<const bf16x8*>(kb+d0*2048);
    const bf16x8 b1=*reinterpret_cast<const bf16x8*>(kb+d0*2048+512);
    if(d0==0){p0=__builtin_amdgcn_mfma_f32_32x32x16_bf16(b0,qr[0],negm,0,0,0);p1=__builtin_amdgcn_mfma_f32_32x32x16_bf16(b1,qr[0],negm,0,0,0);}
    else{p0=__builtin_amdgcn_mfma_f32_32x32x16_bf16(b0,qr[d0],p0,0,0,0);p1=__builtin_amdgcn_mfma_f32_32x32x16_bf16(b1,qr[d0],p1,0,0,0);}}
}
typedef __attribute__((address_space(3))) const char* lds_cptr;
typedef short v4i16_t __attribute__((ext_vector_type(4)));
__device__ __forceinline__ void kload8(bf16x8*kf,lds_cptr kp){
  kf[0]=*(const __attribute__((address_space(3))) bf16x8*)(kp);      kf[1]=*(const __attribute__((address_space(3))) bf16x8*)(kp+512);
  kf[2]=*(const __attribute__((address_space(3))) bf16x8*)(kp+2048); kf[3]=*(const __attribute__((address_space(3))) bf16x8*)(kp+2560);
  kf[4]=*(const __attribute__((address_space(3))) bf16x8*)(kp+4096); kf[5]=*(const __attribute__((address_space(3))) bf16x8*)(kp+4608);
  kf[6]=*(const __attribute__((address_space(3))) bf16x8*)(kp+6144); kf[7]=*(const __attribute__((address_space(3))) bf16x8*)(kp+6656);
}
__device__ __forceinline__ void kload2(bf16x8*kf,lds_cptr kp,int j){ kf[2*j]=*(const __attribute__((address_space(3))) bf16x8*)(kp+j*2048); kf[2*j+1]=*(const __attribute__((address_space(3))) bf16x8*)(kp+j*2048+512); }
__device__ __forceinline__ s16x4 vtr(lds_cptr p){ return __builtin_bit_cast(s16x4,__builtin_amdgcn_ds_read_tr16_b64_v4i16((__attribute__((address_space(3))) v4i16_t*)p)); }
__device__ __forceinline__ float rowmax(const f32x16&p0,const f32x16&p1){
  float a=max3f(p0[0],p0[1],p1[0]),b=max3f(p0[2],p0[3],p1[1]);a=max3f(a,p1[2],p1[3]);
  #pragma unroll
  for(int r=4;r<16;r+=4){a=max3f(a,p0[r],p0[r+1]);b=max3f(b,p0[r+2],p0[r+3]);a=max3f(a,p1[r],p1[r+1]);b=max3f(b,p1[r+2],p1[r+3]);}
  const float m=max2f(a,b);
  auto rr=__builtin_amdgcn_permlane32_swap(__float_as_uint(m),__float_as_uint(m),false,false);
  return max2f(__uint_as_float(rr[0]),__uint_as_float(rr[1]));
}
__device__ __forceinline__ void pv(f32x16*o,int vb,bf16x8 pa0,bf16x8 pa1,bf16x8 pa2,bf16x8 pa3){
  #pragma unroll
  for(int d0=0;d0<2;++d0){s16x4 lo[4],hi[4];
    #pragma unroll
    for(int ks=0;ks<4;++ks){
      asm volatile("ds_read_b64_tr_b16 %0,%1 offset:%c2":"=&v"(lo[ks]):"v"(vb),"i"(d0*4096+ks*1024):"memory");
      asm volatile("ds_read_b64_tr_b16 %0,%1 offset:%c2":"=&v"(hi[ks]):"v"(vb),"i"(d0*4096+ks*1024+512):"memory");}
    asm volatile("s_waitcnt lgkmcnt(0)":::"memory");SBAR();
    #define PK(k) (bf16x8){lo[k][0],lo[k][1],lo[k][2],lo[k][3],hi[k][0],hi[k][1],hi[k][2],hi[k][3]}
    o[d0]=__builtin_amdgcn_mfma_f32_32x32x16_bf16(pa0,PK(0),o[d0],0,0,0);
    o[d0]=__builtin_amdgcn_mfma_f32_32x32x16_bf16(pa1,PK(1),o[d0],0,0,0);
    o[d0]=__builtin_amdgcn_mfma_f32_32x32x16_bf16(pa2,PK(2),o[d0],0,0,0);
    o[d0]=__builtin_amdgcn_mfma_f32_32x32x16_bf16(pa3,PK(3),o[d0],0,0,0);
    #undef PK
  }
}

#ifndef ATTN_STORE16
#define ATTN_STORE16(p,v) (*(u32x4*)(p)=(v))
#endif
template<int THRL> __device__ __forceinline__ void attn_unit(int b,int h,int kvh,int qb,const bf16*Q,const bf16*__restrict__ K,const bf16*__restrict__ V,bf16*O,char*shm){
  const int tid=threadIdx.x,lane=tid&63,r32=lane&31,hi=lane>>5; const int wid=__builtin_amdgcn_readfirstlane(tid>>6);
  const long rowbase=(long)b*SEQ; const int q0=qb*QB;
  const bf16*Qw=Q+(rowbase+q0+wid*QBLK)*DM+h*D;
  const bf16*Kh=K+rowbase*DM+kvh*D,*Vh=V+rowbase*DM+kvh*D;
  const unsigned lds0=(unsigned)(uintptr_t)shm;
  float*wsf=(float*)(shm+LDS_WS)+wid*64;
  const bf16*ksrc=Kh+(long)lane*DM+wid*8;
  const bf16*vsrc=Vh+(long)(16*(wid&3)+(lane>>2))*DM+(wid>>2)*32+(lane&3)*8;
  const unsigned kdst=lds0+LDS_K+wid*1024, vdst=lds0+LDS_V+wid*1024;
  #define DMA_K(t,slot) glds16(ksrc+(long)(t)*KVBLK*DM,(unsigned)__builtin_amdgcn_readfirstlane(kdst+(slot)))
  #define DMA_V(t,slot) glds16(vsrc+(long)(t)*KVBLK*DM,(unsigned)__builtin_amdgcn_readfirstlane(vdst+(slot)))
  const int vb0=(int)(lds0+LDS_V)+((lane>>4)&1)*32+(lane&3)*8+(4*hi+((lane&15)>>2))*64;
  const char*Kbase=shm+LDS_K; bf16x8 kf[8];
  const lds_cptr shm3=(lds_cptr)shm; const lds_cptr kp0=shm3+LDS_K+hi*1024+r32*16; const lds_cptr vp0=shm3+LDS_V+((lane>>4)&1)*32+(lane&3)*8+(4*hi+((lane&15)>>2))*64;
  const int NT=SEQ/KVBLK;
  DMA_K(0,0);DMA_V(0,0);DMA_K(1,SLOTB);
  bf16x8 qr[4];
  #pragma unroll
  for(int d0=0;d0<4;++d0)qr[d0]=*reinterpret_cast<const bf16x8*>(&Qw[(long)r32*DM+d0*16+hi*8]);
  float mhat=0.f,l_reg=0.f;f32x16 o[2];o[0]=f32x16{};o[1]=f32x16{};f32x16 negm=f32x16{};asm volatile("":"+v"(negm));

  #define CMASK(P0,P1,t) do{}while(0)
  bool resc=false;
  #define START(P0,P1) do{ const float rm=rowmax(P0,P1); resc=false; \
    { const float dl=rm; mhat=fadd_s(mhat,dl); \
      _Pragma("unroll") for(int r=0;r<16;++r){P0[r]=fsub_s(P0[r],dl);P1[r]=fsub_s(P1[r],dl);} \
      _Pragma("unroll") for(int r=0;r<16;++r)negm[r]=-mhat; asm volatile("":"+v"(negm)); } \
    _Pragma("unroll") for(int r=0;r<16;++r)P0[r]=__builtin_amdgcn_exp2f(P0[r]); }while(0)
  #define RESC() do{ if(resc){ asm volatile("s_waitcnt lgkmcnt(0)":::"memory"); \
      _Pragma("unroll") for(int d_=0;d_<2;++d_) _Pragma("unroll") for(int r=0;r<16;++r)o[d_][r]*=wsf[crow(r,hi)]; } }while(0)
  f32x16 pA0,pA1,pB0,pB1;
  int sl_prev=0,sl_cur=0,sl_next=SLOTB;
  #define ROT() do{sl_prev=sl_cur;sl_cur=sl_next;sl_next=(sl_next==(NSLOT-1)*SLOTB)?0:sl_next+SLOTB;}while(0)
  DMA_K(2,2*SLOTB);
  WAIT_BAR(3);
  qkt(pA0,pA1,Kbase,qr,negm,r32,hi);asm volatile("s_nop 15\n\ts_nop 7":"+v"(pA0),"+v"(pA1));CMASK(pA0,pA1,0);
  START(pA0,pA1);
  _Pragma("unroll") for(int r=0;r<16;++r)pA1[r]=__builtin_amdgcn_exp2f(pA1[r]);
  WAIT_BAR(0);
  DMA_K(3,0);DMA_V(1,SLOTB);
  ROT();
  kload8(kf,kp0+sl_cur);
  WAIT_BAR(2);
  s16x4 vlo[8],vhi[8]; u32x4 pw0,pw1,pw2,pw3;
  #define PKW(P,B) cvtpk_s(P[B],P[B+1])
  #define PAF(k) __builtin_bit_cast(bf16x8,pw##k)
  #define VFR(i) (bf16x8){vlo[i][0],vlo[i][1],vlo[i][2],vlo[i][3],vhi[i][0],vhi[i][1],vhi[i][2],vhi[i][3]}
  #define PIN(x) asm volatile("":"+v"(x))
  #define MX3(a,b,c) __builtin_fmaxf(__builtin_fmaxf((a),(b)),(c))
  #define GAPA(MF,A0,A1,A2,A3,W0,W1,PW) do{ MF; sacc+=A0; sacc+=A1; sacc+=A2; sacc+=A3; PIN(sacc); W0; W1; PIN(PW); SBAR(); }while(0)
  #define EX(v) __builtin_amdgcn_exp2f(v)
  #define GAPB(MF,X,B) do{ MF; X[B]=EX(X[B]); X[B+1]=EX(X[B+1]); X[B+2]=EX(X[B+2]); X[B+3]=EX(X[B+3]); PIN(X); SBAR(); }while(0)
  #define VRD(i) do{ vlo[i]=vtr(vp_+(((i)>>2)*4096+((i)&3)*1024)); vhi[i]=vtr(vp_+(((i)>>2)*4096+((i)&3)*1024+512)); }while(0)
  #define KRD(G,j) do{ if(G){ kload2(kf,kp0+sl_next,j); SBAR(); } }while(0)
  #define STEP(C0,C1,P0,P1,t,GK,GV,GL) do{ SBAR(); \
    const lds_cptr vp_=vp0+sl_prev; \
    VRD(0); SBAR(); float sacc=(P0[0]+P0[1]); \
    GAPA(C0=__builtin_amdgcn_mfma_f32_32x32x16_bf16(kf[0],qr[0],negm,0,0,0), P0[2],P0[3],P0[4],P0[5],     pw0[0]=PKW(P0,0), pw0[1]=PKW(P0,2), pw0); \
    VRD(4); SBAR(); GAPA(C1=__builtin_amdgcn_mfma_f32_32x32x16_bf16(kf[1],qr[0],negm,0,0,0), P0[6],P0[7],P0[8],P0[9],     pw0[2]=PKW(P0,4), pw0[3]=PKW(P0,6), pw0); \
    VRD(1); SBAR(); GAPA(C0=__builtin_amdgcn_mfma_f32_32x32x16_bf16(kf[2],qr[1],C0,0,0,0),   P0[10],P0[11],P0[12],P0[13], pw1[0]=PKW(P0,8), pw1[1]=PKW(P0,10), pw1); \
    VRD(5); SBAR(); GAPA(C1=__builtin_amdgcn_mfma_f32_32x32x16_bf16(kf[3],qr[1],C1,0,0,0),   P0[14],P0[15],P1[0],P1[1],   pw1[2]=PKW(P0,12),pw1[3]=PKW(P0,14), pw1); \
    VRD(2); SBAR(); GAPA(C0=__builtin_amdgcn_mfma_f32_32x32x16_bf16(kf[4],qr[2],C0,0,0,0),   P1[2],P1[3],P1[4],P1[5],     pw2[0]=PKW(P1,0), pw2[1]=PKW(P1,2), pw2); \
    VRD(6); SBAR(); GAPA(C1=__builtin_amdgcn_mfma_f32_32x32x16_bf16(kf[5],qr[2],C1,0,0,0),   P1[6],P1[7],P1[8],P1[9],     pw2[2]=PKW(P1,4), pw2[3]=PKW(P1,6), pw2); \
    VRD(3); SBAR(); GAPA(C0=__builtin_amdgcn_mfma_f32_32x32x16_bf16(kf[6],qr[3],C0,0,0,0),   P1[10],P1[11],P1[12],P1[13], pw3[0]=PKW(P1,8), pw3[1]=PKW(P1,10), pw3); \
    VRD(7); SBAR(); GAPA(C1=__builtin_amdgcn_mfma_f32_32x32x16_bf16(kf[7],qr[3],C1,0,0,0),   P1[14],P1[15],0.f,0.f,       pw3[2]=PKW(P1,12),pw3[3]=PKW(P1,14), pw3); \
    l_reg+=sacc; \
    if(GK){DMA_K((t)+3,sl_cur);} if(GV){DMA_V((t)+1,sl_next);} \
    CMASK(C0,C1,t); \
    { float a=MX3(C0[0],C0[1],C1[0]),b=MX3(C0[2],C0[3],C1[1]); a=MX3(a,C1[2],C1[3]); \
      _Pragma("unroll") for(int r=4;r<16;r+=4){a=MX3(a,C0[r],C0[r+1]);b=MX3(b,C0[r+2],C0[r+3]);a=MX3(a,C1[r],C1[r+1]);b=MX3(b,C1[r+2],C1[r+3]);} \
      float rm=__builtin_fmaxf(a,b); { auto rr=__builtin_amdgcn_permlane32_swap(__float_as_uint(rm),__float_as_uint(rm),false,false); rm=__builtin_fmaxf(__uint_as_float(rr[0]),__uint_as_float(rr[1])); } \
      resc=false; \
      if(__builtin_expect(__any(rm>(float)THRL),0)){ const float dl=__builtin_fmaxf(rm,0.f); mhat+=dl; \
        _Pragma("unroll") for(int r=0;r<16;++r){C0[r]-=dl;C1[r]-=dl;} \
        _Pragma("unroll") for(int r=0;r<16;++r)negm[r]=-mhat; asm volatile("":"+v"(negm)); \
        const float f=__builtin_amdgcn_exp2f(-dl); l_reg*=f; if(hi==0)wsf[r32]=f; resc=true; } } \
    SBAR(); \
    GAPB(o[0]=__builtin_amdgcn_mfma_f32_32x32x16_bf16(PAF(0),VFR(0),o[0],0,0,0), C0,0); \
    GAPB(o[1]=__builtin_amdgcn_mfma_f32_32x32x16_bf16(PAF(0),VFR(4),o[1],0,0,0), C0,4); \
    KRD(GL,0); GAPB(o[0]=__builtin_amdgcn_mfma_f32_32x32x16_bf16(PAF(1),VFR(1),o[0],0,0,0), C0,8); \
    KRD(GL,1); GAPB(o[1]=__builtin_amdgcn_mfma_f32_32x32x16_bf16(PAF(1),VFR(5),o[1],0,0,0), C0,12); \
    KRD(GL,2); GAPB(o[0]=__builtin_amdgcn_mfma_f32_32x32x16_bf16(PAF(2),VFR(2),o[0],0,0,0), C1,0); \
    KRD(GL,3); GAPB(o[1]=__builtin_amdgcn_mfma_f32_32x32x16_bf16(PAF(2),VFR(6),o[1],0,0,0), C1,4); \
    GAPB(o[0]=__builtin_amdgcn_mfma_f32_32x32x16_bf16(PAF(3),VFR(3),o[0],0,0,0), C1,8); \
    GAPB(o[1]=__builtin_amdgcn_mfma_f32_32x32x16_bf16(PAF(3),VFR(7),o[1],0,0,0), C1,12); \
    }while(0)
  int t=1;
  #undef CMASK
  #define CMASK(P0,P1,t) do{}while(0)
  for(;t+5<NT;t+=2){
    STEP(pB0,pB1,pA0,pA1,t,true,true,true);     WAIT_BAR(2); RESC(); ROT();
    STEP(pA0,pA1,pB0,pB1,t+1,true,true,true);   WAIT_BAR(2); RESC(); ROT();
  }
  #undef CMASK
  #define CMASK(P0,P1,t) do{}while(0)
  #define ENDW(tt) do{ if((tt)+3<NT){WAIT_BAR(2);} else if((tt)+2<NT){WAIT_BAR(1);} else {WAIT_BAR(0);} }while(0)
  for(;t+1<NT;t+=2){
    STEP(pB0,pB1,pA0,pA1,t,(t+3<NT),(t+1<NT),(t+1<NT));       ENDW(t);   RESC(); ROT();
    STEP(pA0,pA1,pB0,pB1,t+1,(t+4<NT),(t+2<NT),(t+2<NT));     ENDW(t+1); RESC(); ROT();
  }
  STEP(pB0,pB1,pA0,pA1,NT-1,false,false,false); RESC();
  { float sacc=pB0[0]+pB0[1]; _Pragma("unroll") for(int r=2;r<16;++r)sacc+=pB0[r]; _Pragma("unroll") for(int r=0;r<16;++r)sacc+=pB1[r]; l_reg+=sacc;
    pw0=(u32x4){PKW(pB0,0),PKW(pB0,2),PKW(pB0,4),PKW(pB0,6)};pw1=(u32x4){PKW(pB0,8),PKW(pB0,10),PKW(pB0,12),PKW(pB0,14)};pw2=(u32x4){PKW(pB1,0),PKW(pB1,2),PKW(pB1,4),PKW(pB1,6)};pw3=(u32x4){PKW(pB1,8),PKW(pB1,10),PKW(pB1,12),PKW(pB1,14)};
    SBAR(); pv(o,vb0+sl_cur,PAF(0),PAF(1),PAF(2),PAF(3)); }
  #undef PKW
  #undef PAF
  #undef VFR
  #undef PIN
  #undef MX3
  #undef GAPA
  #undef GAPB
  #undef EX
  #undef VRD
  #undef KRD
  #undef STEP
  #undef ENDW
  {auto rr=__builtin_amdgcn_permlane32_swap(__float_as_uint(l_reg),__float_as_uint(l_reg),false,false);l_reg=__uint_as_float(rr[0])+__uint_as_float(rr[1]);}
  if(hi==0)wsf[32+r32]=l_reg;asm volatile("s_waitcnt lgkmcnt(0)":::"memory");
  float rli[16];
  #pragma unroll
  for(int r=0;r<16;++r)rli[r]=__builtin_amdgcn_rcpf(wsf[32+crow(r,hi)]);
  bf16*Ow=O+(rowbase+q0+wid*QBLK)*OPITCH+h*D;
  { bf16*stg=(bf16*)(shm+LDS_OST)+wid*2048;
    #pragma unroll
    for(int r=0;r<16;++r){const int orow=crow(r,hi);
      #pragma unroll
      for(int d0=0;d0<2;++d0)stg[orow*64+d0*32+r32]=__float2bfloat16(o[d0][r]*rli[r]);}
    asm volatile("s_waitcnt lgkmcnt(0)":::"memory");
    #pragma unroll
    for(int i=0;i<4;++i){const int row=i*8+(lane>>3),ch=lane&7; const u32x4 v=*(const u32x4*)(stg+row*64+ch*8); ATTN_STORE16(Ow+(long)row*OPITCH+ch*8,v);} }
  asm volatile("s_waitcnt lgkmcnt(0)\n\ts_barrier":::"memory");
  #undef DMA_K
  #undef DMA_V
  #undef CMASK
  #undef START
  #undef RESC
  #undef ROT
}
constexpr int ATTN_LDS_BYTES=LDS_BYTES;
struct AttnTensors { const bf16* Q; const bf16* K; const bf16* V; bf16* O; };
struct AttnUnit { int bh; int qb; };
struct StaticOrder {
  int vcu, G;
  __device__ __forceinline__ explicit StaticOrder(int grid,int v):vcu(v),G(grid){}
  __device__ __forceinline__ bool next(int i,AttnUnit&u)const{ const int L=i*G+vcu; if(L>=BATCH*NHEAD*NQB)return false; const int blk=L%256, rnd=L/256; u.bh=blk>>1; u.qb=(blk&1)*4+rnd; return true; }
};
template<class Sched,int THRL=8> __device__ __forceinline__ void attn_phase(char*lds,const AttnTensors&T,const Sched&S){
  AttnUnit u;
  for(int i=0;S.next(i,u);++i){ attn_unit<THRL>(u.bh/NHEAD,u.bh%NHEAD,(u.bh%NHEAD)/4,u.qb,T.Q,T.K,T.V,T.O,lds); }
}
#undef SBAR
#undef WAIT_BAR
}
#define XB_TMO      128
#define XB_XCNT(j)  (256  + 64 * (j))
#define XB_XSUB(j)  (1280 + 64 * (j))
#define XB_XGEN(j)  (2304 + 64 * (j))
#define XB_TOP      3328
#define XB_TOPGEN   3392
#define XCD_BAR_WORDS 3456
#define XB_SPIN_CAP (1u << 18)

__device__ __forceinline__ unsigned xb_ld(unsigned* p)              { return __hip_atomic_load(p, __ATOMIC_RELAXED, __HIP_MEMORY_SCOPE_AGENT); }
__device__ __forceinline__ unsigned xb_add(unsigned* p, unsigned v) { return __hip_atomic_fetch_add(p, v, __ATOMIC_RELAXED, __HIP_MEMORY_SCOPE_AGENT); }
__device__ __forceinline__ unsigned xb_xcc_id() { return (unsigned)__builtin_amdgcn_s_getreg((3 << 11) | 20) & 0xFu; }
#define XB_SPIN(cond, bar) do { unsigned _sp = 0; while (cond) { __builtin_amdgcn_s_sleep(1); \
    if ((++_sp & 255u) == 0u) { if (xb_ld(&(bar)[XB_TMO])) break; if (_sp > XB_SPIN_CAP) { atomicAdd(&(bar)[XB_TMO], 1u); break; } } } } while (0)

struct XcdBarrier {
    unsigned* bar; unsigned x;
    volatile LAS unsigned* st;
};

__device__ __forceinline__ XcdBarrier xcd_barrier_post(unsigned* bar, volatile LAS unsigned* st) {
    XcdBarrier b; b.bar = bar; b.x = xb_xcc_id(); b.st = st;
    if (threadIdx.x == 0) (void)xb_add(&bar[XB_XCNT(b.x)], 1u);
    return b;
}
__device__ __forceinline__ void xcd_barrier_complete(unsigned* bar, unsigned x, unsigned& nloc, unsigned& nx) {
    const unsigned G = gridDim.x * gridDim.y * gridDim.z;
    unsigned sum, cnt, mine, sp = 0u;
    for (;;) {
        sum = 0u; cnt = 0u; mine = 0u;
#pragma unroll
        for (unsigned j = 0; j < 16; ++j) { const unsigned c = xb_ld(&bar[XB_XCNT(j)]); sum += c; cnt += (c > 0u) ? 1u : 0u; mine = (j == x) ? c : mine; }
        if (sum == G) break;
        __builtin_amdgcn_s_sleep(1);
        if ((++sp & 255u) == 0u) { if (xb_ld(&bar[XB_TMO])) break; if (sp > XB_SPIN_CAP) { atomicAdd(&bar[XB_TMO], 1u); break; } }
    }
    nloc = mine > 0u ? mine : 1u; nx = cnt > 0u ? cnt : 1u;
}

__device__ __forceinline__ void xcd_barrier(const XcdBarrier& b) {
    asm volatile("s_waitcnt vmcnt(0)" ::: "memory");
    __syncthreads();
    if (threadIdx.x == 0) {
        unsigned* bar = b.bar;
        __builtin_amdgcn_s_waitcnt(0);
        unsigned nloc = b.st[0], nx = b.st[1];
        if (nloc == 0u) { xcd_barrier_complete(bar, b.x, nloc, nx); b.st[0] = nloc; b.st[1] = nx; }
        const unsigned old = xb_add(&bar[XB_XSUB(b.x)], 1u);
        const unsigned gen = old / nloc;
        if (old + 1u == (gen + 1u) * nloc) {
            __builtin_amdgcn_fence(__ATOMIC_RELEASE, "agent");
            asm volatile("s_waitcnt vmcnt(0)" ::: "memory");
            const unsigned og = xb_add(&bar[XB_TOP], 1u);
            const unsigned tg = og / nx;
            if (og + 1u == (tg + 1u) * nx) xb_add(&bar[XB_TOPGEN], 1u);
            else XB_SPIN(xb_ld(&bar[XB_TOPGEN]) == tg, bar);
            __builtin_amdgcn_fence(__ATOMIC_ACQUIRE, "agent");
            xb_add(&bar[XB_XGEN(b.x)], 1u);
            asm volatile("s_waitcnt vmcnt(0)" ::: "memory");
        } else {
            XB_SPIN(xb_ld(&bar[XB_XGEN(b.x)]) == gen, bar);
            __builtin_amdgcn_fence(__ATOMIC_ACQUIRE, "agent");
            asm volatile("s_waitcnt vmcnt(0)" ::: "memory");
        }
    }
    __syncthreads();
}
constexpr int NWAVES = 8, NTHR = NWAVES * 64;
constexpr int N_PHASES = 10;
constexpr int RING_OFF = 0, RING_BYTES = 131072;
constexpr int LDSCTL_OFF = RING_BYTES, MISC_OFF = LDSCTL_OFF + 320;
constexpr int TS_OFF = LDSCTL_OFF + 512;
constexpr int UT_OFF = TS_OFF + 256;
constexpr int RT_OFF = UT_OFF + 256;
constexpr int LDS_BYTES = 147456;
static_assert(RT_OFF + pg8::MOE_MAXU * 1024 <= LDS_BYTES, "LDS map");

struct Frame {
    LAS unsigned char* lds; volatile LAS unsigned* MISC; unsigned* ctl; unsigned char* ws;
    int tid, lane, wave, vcu, G;
    float* out;
};

enum { I_X = 0, I_C, I_WADA, I_BADA, I_GPRE1, I_GPOST1, I_WIN, I_WDW, I_BDW, I_CLNG, I_CLNB, I_WCO, I_QG, I_KG, I_WAO, I_WOUT, I_GPRE2, I_GPOST2, I_WGRP, I_BGRP, I_WRT, I_BRT, I_WEG, I_WEU, I_WED };

struct Args { const float* in[25]; float* out; unsigned char* ws; int ph_lo, ph_hi, use_bar, flags; };
#define CAS __attribute__((address_space(4)))
__device__ __forceinline__ const float* fin(int i) { unsigned long long p = (unsigned long long)__builtin_amdgcn_kernarg_segment_ptr(); asm volatile("" : "+s"(p)); return ((const CAS Args*)p)->in[i]; }
template <int MAP> __device__ __forceinline__ int maprow(int n) {
    if (MAP == 1) return vmap_win(n);
    if (MAP == 2) return 256 * (n >> 7) + (n & 127);
    if (MAP == 3) return 256 * (n >> 7) + 128 + (n & 127);
    return n;
}
template <int MAP>
__device__ __forceinline__ void p0_transpose_item(const float* W, int N, bf16* WT, int pitch, int koff, LAS float* scr, int item, int lane) {
    const int nblk = N / 64, kb = item / nblk, nb = item % nblk, k0 = 64 * kb, n0 = 64 * nb, lr = lane >> 4, lc = lane & 15;
    const float* src = W + (size_t)(k0 + lr) * N + n0 + 4 * lc;
    f32x4 v[16];
#pragma unroll
    for (int i = 0; i < 16; ++i) v[i] = *(const f32x4*)(src + (size_t)(4 * i) * N);
#pragma unroll
    for (int i = 0; i < 16; ++i) { const int kk = lr + 4 * i; *(LAS f32x4*)(scr + kk * 64 + 4 * (lc ^ ((kk >> 3) & 7))) = v[i]; }
    LDS_WAIT(); asm volatile("" ::: "memory");
    const int c = lane & 7;
#pragma unroll
    for (int jj = 0; jj < 8; ++jj) { const int n = (lane >> 3) + 8 * jj; const LAS float* sp = scr + (8 * c) * 64 + (n ^ (4 * c));
        u32x4 o; o.x = cvt_pk_bf16(sp[0 * 64], sp[1 * 64]); o.y = cvt_pk_bf16(sp[2 * 64], sp[3 * 64]); o.z = cvt_pk_bf16(sp[4 * 64], sp[5 * 64]); o.w = cvt_pk_bf16(sp[6 * 64], sp[7 * 64]);
        *(u32x4*)(WT + (size_t)maprow<MAP>(n0 + n) * pitch + koff + k0 + 8 * c) = o; }
    LDS_WAIT(); asm volatile("" ::: "memory");
}
struct TrDesc { const float* src; unsigned char* dst; int N, pitch; float sc; };
__device__ __forceinline__ TrDesc tr_desc(int it, const float* pweg, const float* pweu, const float* pwed, unsigned char* W1, unsigned char* W2) {
    constexpr int I_G1 = (D / 64) * (DE / 64), I_D1 = (DE / 64) * (D / 64), PER = 2 * I_G1 + I_D1;
    const int e = it / PER; int r = it - e * PER; TrDesc d;
    if (r < 2 * I_G1) { const bool up = r >= I_G1; if (up) r -= I_G1; const int nblk = DE / 64, kb = r / nblk, nb = r % nblk;
        d.src = (up ? pweu : pweg) + (size_t)e * D * DE + (size_t)(64 * kb) * DE + 64 * nb; d.N = DE; d.pitch = D; d.sc = pg8::WSC1;
        d.dst = W1 + (size_t)e * D * D + (size_t)(256 * ((64 * nb) >> 7) + (up ? 128 : 0) + ((64 * nb) & 127)) * D + 64 * kb; }
    else { r -= 2 * I_G1; const int nblk = D / 64, kb = r / nblk, nb = r % nblk;
        d.src = pwed + (size_t)e * DE * D + (size_t)(64 * kb) * D + 64 * nb; d.N = D; d.pitch = DE; d.sc = pg8::WSC2;
        d.dst = W2 + (size_t)e * D * DE + (size_t)(64 * nb) * DE + 64 * kb; }
    return d;
}
__device__ __forceinline__ void tr_load(const TrDesc& d, int lane, f32x4 (&v)[16]) {
    const float* src = d.src + (size_t)(lane >> 4) * d.N + 4 * (lane & 15);
#pragma unroll
    for (int i = 0; i < 16; ++i) v[i] = *(const f32x4*)(src + (size_t)(4 * i) * d.N);
}
__device__ __forceinline__ void tr_finish(const TrDesc& d, int lane, const f32x4 (&v)[16], LAS float* scr) {
    const int lr = lane >> 4, lc = lane & 15;
#pragma unroll
    for (int i = 0; i < 16; ++i) { const int kk = lr + 4 * i; *(LAS f32x4*)(scr + kk * 64 + 4 * (lc ^ ((kk >> 3) & 7))) = v[i] * d.sc; }
    LDS_WAIT(); asm volatile("" ::: "memory");
    const int c4 = lane & 3;
#pragma unroll
    for (int jj = 0; jj < 4; ++jj) { const int n = (lane >> 2) + 16 * jj; const LAS float* s0 = scr + (16 * c4) * 64 + (n ^ (4 * (2 * c4))), * s1 = scr + (16 * c4 + 8) * 64 + (n ^ (4 * (2 * c4 + 1)));
        u32x4 o; o.x = pg8::pk4_fp8(s0[0 * 64], s0[1 * 64], s0[2 * 64], s0[3 * 64]); o.y = pg8::pk4_fp8(s0[4 * 64], s0[5 * 64], s0[6 * 64], s0[7 * 64]);
        o.z = pg8::pk4_fp8(s1[0 * 64], s1[1 * 64], s1[2 * 64], s1[3 * 64]); o.w = pg8::pk4_fp8(s1[4 * 64], s1[5 * 64], s1[6 * 64], s1[7 * 64]);
        *(u32x4*)(d.dst + (size_t)n * d.pitch + 16 * c4) = o; }
    LDS_WAIT(); asm volatile("" ::: "memory");
}
__device__ __forceinline__ void p0_prologue(Frame& F) {
    const float* c = fin(I_C); const float* wada = fin(I_WADA); const float* bada = fin(I_BADA);
    if (blockIdx.x < 192) {
        const int cg = blockIdx.x, kh = F.lane >> 5, col = F.lane & 31;
        LAS float* scs = (LAS float*)F.lds; LAS float* red = (LAS float*)(F.lds + 65536);
        { float cv[32];
#pragma unroll
          for (int i = 0; i < 32; ++i) cv[i] = c[F.tid + NTHR * i];
#pragma unroll
          for (int i = 0; i < 32; ++i) scs[F.tid + NTHR * i] = cv[i] * sig_fast(cv[i]); }
        __syncthreads();
        float acc[16];
#pragma unroll
        for (int b = 0; b < 16; ++b) acc[b] = 0.f;
        const int kbase = 128 * F.wave + 64 * kh;
        const float* w = wada + (size_t)kbase * 6144 + 32 * cg + col;
        { float wv[64];
#pragma unroll
          for (int k = 0; k < 64; ++k) wv[k] = w[(size_t)k * 6144];
#pragma unroll
          for (int k = 0; k < 64; ++k)
#pragma unroll
              for (int b = 0; b < 16; ++b) acc[b] += scs[b * D + kbase + k] * wv[k]; }
#pragma unroll
        for (int b = 0; b < 16; ++b) red[((F.wave * 2 + kh) * 16 + b) * 32 + col] = acc[b];
        __syncthreads();
        float* ada = (float*)(F.ws + WS_ADA);
        { const int b = F.tid >> 5, l = F.tid & 31; float sm = 0.f;
#pragma unroll
          for (int p = 0; p < 16; ++p) sm += red[(p * 16 + b) * 32 + l];
          __hip_atomic_store(ada + b * 6144 + 32 * cg + l, sm + bada[32 * cg + l], __ATOMIC_RELAXED, __HIP_MEMORY_SCOPE_AGENT); }
        VM_WAIT();
        __syncthreads();
        if (F.tid == 0) __hip_atomic_fetch_add(F.ctl + CW_ADA, 1u, __ATOMIC_RELAXED, __HIP_MEMORY_SCOPE_AGENT);
    }
    {
        const int gt = F.vcu * NTHR + F.tid, NGT = F.G * NTHR; const float* wgrp = fin(I_WGRP); const float* wrt = fin(I_WRT);
        f32x2* rope = (f32x2*)(F.ws + WS_ROPE);
        for (int i = gt; i < 96 * 16; i += NGT) { const int r = i >> 4, e = i & 15; const float pos = (float)(r < 32 ? r : r - 32);
            const float invf = powf(10000.f, -(float)e / 16.f); float sn, cs; sincosf(pos * invf, &sn, &cs); rope[i] = (f32x2){cs, sn}; }
        bf16* wr = (bf16*)(F.ws + WS_WR);
        for (int i = gt; i < 64 * 1024; i += NGT) { const int n = i >> 10, k = i & 1023;
            const float v = n < 4 ? wgrp[k * 4 + n] : (n < 36 ? wrt[k * 32 + (n - 4)] : 0.f); wr[i] = (bf16)f2bf(v); }
    }
    LAS float* scr = (LAS float*)(F.lds + RING_OFF + F.wave * 16384);
    const int gw = F.vcu * NWAVES + F.wave, NGW = F.G * NWAVES;
    constexpr int I_WIN_ = (D / 64) * (INW / 64), I_WC_ = (CW / 64) * (D / 64), I_WO_ = (D / 64) * (D / 64);
    constexpr int NITEMS = I_WIN_ + 2 * I_WC_ + I_WO_;
    bf16* WIN = (bf16*)(F.ws + WS_WIN); bf16* WCA = (bf16*)(F.ws + WS_WCA); bf16* WO = (bf16*)(F.ws + WS_WO);
    const float* pwin = fin(I_WIN); const float* pwco = fin(I_WCO); const float* pwao = fin(I_WAO); const float* pwout = fin(I_WOUT);
    for (int it = gw; it < NITEMS; it += NGW) {
        int r = it;
        if (r < I_WIN_) { const int kb = r / 60, nb = r % 60;
            if (nb >= 16 && nb < 28) p0_transpose_item<1>(pwin, INW, WIN, D, 0, scr, kb * 60 + nb, F.lane);
            else { TrDesc d; const int n0 = 64 * nb; d.src = pwin + (size_t)(64 * kb) * INW + n0; d.N = INW; d.pitch = 2048; d.sc = pg8::WSCIN; d.dst = F.ws + WS_WINF + (size_t)pg8::winf_row(vmap_win(n0)) * 2048 + 64 * kb;
                   f32x4 tv[16]; tr_load(d, F.lane, tv); tr_finish(d, F.lane, tv, scr); }
            continue; } r -= I_WIN_;
        if (r < I_WC_) { p0_transpose_item<0>(pwco, D, WCA, D, 0, scr, r, F.lane); continue; } r -= I_WC_;
        if (r < I_WC_) { p0_transpose_item<0>(pwao, D, WCA, D, 512, scr, r, F.lane); continue; } r -= I_WC_;
        p0_transpose_item<0>(pwout, D, WO, D, 0, scr, r, F.lane);
    }
}
constexpr int XCONV_ITEMS = NE * (2 * (D / 64) * (DE / 64) + (DE / 64) * (D / 64));
__device__ __forceinline__ void p0_convert_experts(Frame& F, int lo, int hi, int rank, int nconv) {
    LAS float* scr = (LAS float*)(F.lds + RING_OFF + F.wave * 16384);
    constexpr int I_G1 = (D / 64) * (DE / 64), I_D1 = (DE / 64) * (D / 64), PER = 2 * I_G1 + I_D1;
    unsigned char* W1 = F.ws + WS_W1; unsigned char* W2 = F.ws + WS_W2;
    const float* pweg = fin(I_WEG); const float* pweu = fin(I_WEU); const float* pwed = fin(I_WED);
    const int step = nconv * NWAVES;
    for (int it = lo + rank * NWAVES + F.wave; it < hi; it += 2 * step) {
        const TrDesc d0 = tr_desc(it, pweg, pweu, pwed, W1, W2); const bool two = it + step < hi;
        const TrDesc d1 = tr_desc(two ? it + step : it, pweg, pweu, pwed, W1, W2);
        f32x4 v0[16], v1[16];
        tr_load(d0, F.lane, v0); tr_load(d1, F.lane, v1);
        __builtin_amdgcn_sched_barrier(0);
        tr_finish(d0, F.lane, v0, scr);
        if (two) tr_finish(d1, F.lane, v1, scr);
    }
}

__device__ __forceinline__ int rcol(int lane, int q) { return 512 * (q >> 1) + 8 * lane + 4 * (q & 1); }
__device__ __forceinline__ void row_ld_f32(const float* p, int lane, f32x4 (&v)[4]) {
#pragma unroll
    for (int q = 0; q < 4; ++q) v[q] = *(const f32x4*)(p + rcol(lane, q)); }
__device__ __forceinline__ void row_st_f32(float* p, int lane, const f32x4 (&v)[4]) {
#pragma unroll
    for (int q = 0; q < 4; ++q) *(f32x4*)(p + rcol(lane, q)) = v[q]; }
__device__ __forceinline__ void row_ld_bf16(const bf16* p, int lane, f32x4 (&v)[4]) {
#pragma unroll
    for (int j = 0; j < 2; ++j) { const u32x4 w = *(const u32x4*)(p + 512 * j + 8 * lane);
        v[2 * j] = (f32x4){bf2f(w.x & 0xffffu), bf2f(w.x >> 16), bf2f(w.y & 0xffffu), bf2f(w.y >> 16)}; v[2 * j + 1] = (f32x4){bf2f(w.z & 0xffffu), bf2f(w.z >> 16), bf2f(w.w & 0xffffu), bf2f(w.w >> 16)}; } }
__device__ __forceinline__ u32x4 row_pack(const f32x4 a, const f32x4 b) { return (u32x4){cvt_pk_bf16(a.x, a.y), cvt_pk_bf16(a.z, a.w), cvt_pk_bf16(b.x, b.y), cvt_pk_bf16(b.z, b.w)}; }
__device__ __forceinline__ float row_ss(const f32x4 (&v)[4]) { float s = 0.f;
#pragma unroll
    for (int q = 0; q < 4; ++q) s += (v[q].x * v[q].x + v[q].y * v[q].y) + (v[q].z * v[q].z + v[q].w * v[q].w);
    return s; }

__device__ __forceinline__ void p1_modnorm(Frame& F) {
    if (F.tid == 0) { unsigned sp = 0; while (__hip_atomic_load(F.ctl + CW_ADA, __ATOMIC_RELAXED, __HIP_MEMORY_SCOPE_AGENT) < 192u) { __builtin_amdgcn_s_sleep(2); if (++sp > (1u << 22)) break; }
        __builtin_amdgcn_fence(__ATOMIC_ACQUIRE, "agent"); VM_WAIT(); }
    __syncthreads();
    const float* x = fin(I_X); const float* g = fin(I_GPRE1); const float* ada = (const float*)(F.ws + WS_ADA); bf16* h1 = (bf16*)(F.ws + WS_H1); unsigned char* h1f = F.ws + WS_H1F;
    for (int chunk = blockIdx.x; chunk < NTOK / 128; chunk += F.G) {
        const int R0 = chunk * 128, b = R0 / SEQ; const float* ad = ada + b * 6144;
        f32x4 ca[4], cb[4];
#pragma unroll
        for (int q = 0; q < 4; ++q) { const int c0 = rcol(F.lane, q); ca[q] = *(const f32x4*)(g + c0) * (1.f + *(const f32x4*)(ad + 1024 + c0)); cb[q] = *(const f32x4*)(ad + c0); }
        const int rw = R0 + 16 * F.wave;
        f32x4 n0[4], n1[4];
        row_ld_f32(x + (size_t)rw * D, F.lane, n0); row_ld_f32(x + (size_t)(rw + 1) * D, F.lane, n1);
#pragma unroll
        for (int i = 0; i < 16; i += 2) {
            const int row = rw + i;
            f32x4 v0[4], v1[4];
#pragma unroll
            for (int q = 0; q < 4; ++q) { v0[q] = n0[q]; v1[q] = n1[q]; }
            if (i + 2 < 16) { row_ld_f32(x + (size_t)(row + 2) * D, F.lane, n0); row_ld_f32(x + (size_t)(row + 3) * D, F.lane, n1); }
            __builtin_amdgcn_sched_barrier(0);
            const float r0 = rsqrtf(wave_sum(row_ss(v0)) * (1.f / D) + EPS), r1 = rsqrtf(wave_sum(row_ss(v1)) * (1.f / D) + EPS);
#pragma unroll
            for (int j = 0; j < 2; ++j) {
                const f32x4 a0 = v0[2 * j] * r0 * ca[2 * j] + cb[2 * j], a1 = v0[2 * j + 1] * r0 * ca[2 * j + 1] + cb[2 * j + 1], b0 = v1[2 * j] * r1 * ca[2 * j] + cb[2 * j], b1 = v1[2 * j + 1] * r1 * ca[2 * j + 1] + cb[2 * j + 1];
                *(u32x4*)(h1 + (size_t)row * D + 512 * j + 8 * F.lane) = row_pack(a0, a1); *(u32x4*)(h1 + (size_t)(row + 1) * D + 512 * j + 8 * F.lane) = row_pack(b0, b1);
                *(u32x2*)(h1f + (size_t)row * 2048 + 512 * j + 8 * F.lane) = (u32x2){pg8::pk4_fp8(a0.x, a0.y, a0.z, a0.w), pg8::pk4_fp8(a1.x, a1.y, a1.z, a1.w)};
                *(u32x2*)(h1f + (size_t)(row + 1) * 2048 + 512 * j + 8 * F.lane) = (u32x2){pg8::pk4_fp8(b0.x, b0.y, b0.z, b0.w), pg8::pk4_fp8(b1.x, b1.y, b1.z, b1.w)}; }
            __builtin_amdgcn_sched_barrier(0);
        }
    }
}

constexpr int CV_T = 32, CV_IN = 0, CV_UT = (CV_T + KS - 1) * 1024;
static_assert(CV_UT + CV_T * CW * 4 <= RING_BYTES, "conv LDS map");
__device__ __forceinline__ void p3_conv(Frame& F) {
    const bf16* glu = (const bf16*)(F.ws + WS_GLU); bf16* ca = (bf16*)(F.ws + WS_CA);
    LAS unsigned char* IN = F.lds + RING_OFF + CV_IN; LAS float* UT = (LAS float*)(F.lds + RING_OFF + CV_UT);
    const int cp = F.tid & 255, th = F.tid >> 8;
    f32x2 w[KS];
#pragma unroll
    for (int j = 0; j < KS; ++j) w[j] = *(const f32x2*)(fin(I_WDW) + j * CW + 2 * cp);
    const f32x2 bias = *(const f32x2*)(fin(I_BDW) + 2 * cp);
    float lg[8], lb[8];
#pragma unroll
    for (int i = 0; i < 8; ++i) { lg[i] = fin(I_CLNG)[F.lane * 8 + i]; lb[i] = fin(I_CLNB)[F.lane * 8 + i]; }
    u32x4 sv[8];
#define CV_LOAD(unx) do { const int b_ = (unx) / (SEQ / CV_T), s0_ = ((unx) % (SEQ / CV_T)) * CV_T; _Pragma("unroll") for (int i = 0; i < 8; ++i) { \
        const int s_ = s0_ - KS / 2 + F.wave + NWAVES * i, sc_ = s_ < 0 ? 0 : (s_ >= SEQ ? SEQ - 1 : s_); sv[i] = *(const u32x4*)(glu + (size_t)(b_ * SEQ + sc_) * CW + F.lane * 8); } } while (0)
    if (F.vcu < NTOK / CV_T) CV_LOAD(F.vcu);
    for (int un = F.vcu; un < NTOK / CV_T; un += F.G) {
        const int b = un / (SEQ / CV_T), s0 = (un % (SEQ / CV_T)) * CV_T;
#pragma unroll
        for (int i = 0; i < 8; ++i) { const int r = F.wave + NWAVES * i, s = s0 - KS / 2 + r;
            if (r < CV_T + KS - 1) *(LAS u32x4*)(IN + r * 1024 + F.lane * 16) = (s >= 0 && s < SEQ) ? sv[i] : (u32x4){0u, 0u, 0u, 0u}; }
        __syncthreads();
        if (un + F.G < NTOK / CV_T) CV_LOAD(un + F.G);
        __builtin_amdgcn_sched_barrier(0);
#pragma unroll
        for (int g = 0; g < 2; ++g) {
            f32x2 win[38];
#pragma unroll
            for (int i = 0; i < 38; ++i) { const unsigned pw = *(const LAS unsigned*)(IN + (16 * th + 8 * g + i) * 1024 + cp * 4); win[i] = (f32x2){__uint_as_float(pw << 16), __uint_as_float(pw & 0xffff0000u)}; }
#pragma unroll
            for (int o = 0; o < 8; ++o) { f32x2 a = bias;
#pragma unroll
                for (int j = 0; j < KS; ++j) a = __builtin_elementwise_fma(win[o + j], w[j], a);
                *(LAS f32x2*)(UT + (16 * th + 8 * g + o) * CW + 2 * cp) = a; }
        }
        __syncthreads();
#pragma unroll
        for (int i = 0; i < 4; ++i) { const int t = F.wave * 4 + i;
            const f32x4 v0 = *(const LAS f32x4*)(UT + t * CW + F.lane * 8), v1 = *(const LAS f32x4*)(UT + t * CW + F.lane * 8 + 4);
            const float mu = wave_sum((v0.x + v0.y) + (v0.z + v0.w) + (v1.x + v1.y) + (v1.z + v1.w)) * (1.f / CW);
            const f32x4 d0 = v0 - mu, d1 = v1 - mu;
            const float var = wave_sum((d0.x * d0.x + d0.y * d0.y) + (d0.z * d0.z + d0.w * d0.w) + (d1.x * d1.x + d1.y * d1.y) + (d1.z * d1.z + d1.w * d1.w)) * (1.f / CW);
            const float rstd = rsqrtf(var + EPS);
            float o[8];
#pragma unroll
            for (int k = 0; k < 4; ++k) { const float a = d0[k] * rstd * lg[k] + lb[k], bq = d1[k] * rstd * lg[4 + k] + lb[4 + k]; o[k] = a * sig_fast(a); o[4 + k] = bq * sig_fast(bq); }
            u32x4 wv; wv.x = cvt_pk_bf16(o[0], o[1]); wv.y = cvt_pk_bf16(o[2], o[3]); wv.z = cvt_pk_bf16(o[4], o[5]); wv.w = cvt_pk_bf16(o[6], o[7]);
            *(u32x4*)(ca + (size_t)(b * SEQ + s0 + t) * D + F.lane * 8) = wv; }
        __syncthreads();
    }
#undef CV_LOAD
}

constexpr int WRP = 2064;
constexpr int P6_WR = 0, P6_LGW = 48 * WRP, P6_EA = P6_LGW + 8 * 16 * 48 * 4, P6_HIST = P6_EA + 128 * 32, P6_BASE = P6_HIST + 128, P6_END = P6_BASE + 128;
static_assert(P6_END <= RING_BYTES, "P6 LDS map");
struct P6Row { float pv; u32x4 y[2]; f32x4 x[4]; };
__device__ __forceinline__ void p6_ld(P6Row& r, const float* x, const bf16* y1, const float* part, int row, int lane) {
    r.pv = part[(size_t)row * 16 + (lane & 15)];
#pragma unroll
    for (int j = 0; j < 2; ++j) r.y[j] = *(const u32x4*)(y1 + (size_t)row * D + 512 * j + 8 * lane);
    row_ld_f32(x + (size_t)row * D, lane, r.x);
}
__device__ __forceinline__ void p6_do(P6Row& r, const f32x4 (&c1)[4], const f32x4 (&c2)[4], const f32x4 (&c3)[4], bf16* x1b, bf16* h2, unsigned char* h2f, int row, int lane) {
    const float pv = row16_sum(r.pv);
    const float ra = rsqrtf(pv * (1.f / D) + EPS);
    f32x4 xv[4];
#pragma unroll
    for (int j = 0; j < 2; ++j) { const u32x4 w = r.y[j];
        const f32x4 ya = (f32x4){bf2f(w.x & 0xffffu), bf2f(w.x >> 16), bf2f(w.y & 0xffffu), bf2f(w.y >> 16)}, yb = (f32x4){bf2f(w.z & 0xffffu), bf2f(w.z >> 16), bf2f(w.w & 0xffffu), bf2f(w.w >> 16)};
        xv[2 * j] = r.x[2 * j] + c1[2 * j] * (ya * ra); xv[2 * j + 1] = r.x[2 * j + 1] + c1[2 * j + 1] * (yb * ra);
        *(u32x4*)(x1b + (size_t)row * D + 512 * j + 8 * lane) = row_pack(xv[2 * j], xv[2 * j + 1]); }
    const float sa = rsqrtf(wave_sum(row_ss(xv)) * (1.f / D) + EPS);
#pragma unroll
    for (int j = 0; j < 2; ++j) { const f32x4 ha = xv[2 * j] * sa * c2[2 * j] + c3[2 * j], hb = xv[2 * j + 1] * sa * c2[2 * j + 1] + c3[2 * j + 1];
        *(u32x4*)(h2 + (size_t)row * D + 512 * j + 8 * lane) = row_pack(ha, hb);
        *(u32x2*)(h2f + (size_t)row * D + 512 * j + 8 * lane) = (u32x2){pg8::pk4_fp8(ha.x, ha.y, ha.z, ha.w), pg8::pk4_fp8(hb.x, hb.y, hb.z, hb.w)}; }
}
__device__ __forceinline__ void p6_postmix_router(Frame& F) {
    const float* x = fin(I_X); const bf16* y1 = (const bf16*)(F.ws + WS_Y1); const float* part = (const float*)(F.ws + WS_PART); const float* ada = (const float*)(F.ws + WS_ADA);
    bf16* h2 = (bf16*)(F.ws + WS_CA); unsigned char* h2f = F.ws + WS_H2F; bf16* x1b = (bf16*)(F.ws + WS_X1B); int* list = (int*)(F.ws + WS_LIST); unsigned* tokinfo = (unsigned*)(F.ws + WS_TOK); const bf16* wr = (const bf16*)(F.ws + WS_WR);
    LAS unsigned char* WR = F.lds + P6_WR; LAS float* LGW = (LAS float*)(F.lds + P6_LGW) + F.wave * 16 * 48;
    LAS unsigned* EA = (LAS unsigned*)(F.lds + P6_EA); LAS unsigned* HIST = (LAS unsigned*)(F.lds + P6_HIST); LAS unsigned* BASE = (LAS unsigned*)(F.lds + P6_BASE);
    const int fr = F.lane & 15, fq = F.lane >> 4;
    const float* gpost1 = fin(I_GPOST1); const float* gpre2 = fin(I_GPRE2); const float* bgrp = fin(I_BGRP); const float* brt = fin(I_BRT);
    {
        u32x4 t[12];
#pragma unroll
        for (int i = 0; i < 12; ++i) { const int idx = F.tid + NTHR * i; t[i] = *(const u32x4*)(wr + (size_t)(idx >> 7) * D + (idx & 127) * 8); }
#pragma unroll
        for (int i = 0; i < 12; ++i) { const int idx = F.tid + NTHR * i; *(LAS u32x4*)(WR + (idx >> 7) * WRP + (idx & 127) * 16) = t[i]; }
    }
    for (int chunk = blockIdx.x; chunk < NTOK / 128; chunk += F.G) {
        const int R0 = chunk * 128, b = R0 / SEQ, rw = R0 + 16 * F.wave; const float* ad = ada + b * 6144;
        if (F.tid < 32) HIST[F.tid] = 0u;
        f32x4 c1[4], c2[4], c3[4];
#pragma unroll
        for (int q = 0; q < 4; ++q) { const int c0 = rcol(F.lane, q);
            c1[q] = *(const f32x4*)(gpost1 + c0) * *(const f32x4*)(ad + 2048 + c0);
            c2[q] = *(const f32x4*)(gpre2 + c0) * (1.f + *(const f32x4*)(ad + 4096 + c0)); c3[q] = *(const f32x4*)(ad + 3072 + c0); }
        __syncthreads();
        {
            P6Row na, nb;
            p6_ld(na, x, y1, part, rw, F.lane); p6_ld(nb, x, y1, part, rw + 1, F.lane);
#pragma unroll
            for (int i = 0; i < 16; i += 2) {
                P6Row ra = na, rb = nb;
                if (i + 2 < 16) { p6_ld(na, x, y1, part, rw + i + 2, F.lane); p6_ld(nb, x, y1, part, rw + i + 3, F.lane); }
                __builtin_amdgcn_sched_barrier(0);
                p6_do(ra, c1, c2, c3, x1b, h2, h2f, rw + i, F.lane); p6_do(rb, c1, c2, c3, x1b, h2, h2f, rw + i + 1, F.lane);
                __builtin_amdgcn_sched_barrier(0);
            }
        }
        VM_WAIT();
        {
            f32x4 acc[3] = {(f32x4){0.f, 0.f, 0.f, 0.f}, (f32x4){0.f, 0.f, 0.f, 0.f}, (f32x4){0.f, 0.f, 0.f, 0.f}};
            bf16x8 af[32];
#pragma unroll
            for (int ks = 0; ks < 32; ++ks) af[ks] = *(const bf16x8*)(h2 + (size_t)(rw + fr) * D + 32 * ks + 8 * fq);
#pragma unroll
            for (int ks = 0; ks < 32; ++ks)
#pragma unroll
                for (int nb = 0; nb < 3; ++nb) { const bf16x8 bf = *(const LAS bf16x8*)(WR + (16 * nb + fr) * WRP + (32 * ks + 8 * fq) * 2);
                    acc[nb] = __builtin_amdgcn_mfma_f32_16x16x32_bf16(af[ks], bf, acc[nb], 0, 0, 0); }
#pragma unroll
            for (int nb = 0; nb < 3; ++nb)
#pragma unroll
                for (int j = 0; j < 4; ++j) LGW[(4 * fq + j) * 48 + 16 * nb + fr] = acc[nb][j];
        }
        LDS_WAIT();
        if (F.lane < 16) {
            const LAS float* L = LGW + F.lane * 48;
            float gl[4];
#pragma unroll
            for (int g = 0; g < 4; ++g) gl[g] = L[g] + bgrp[g];
            int gi = 0; float gm = gl[0];
#pragma unroll
            for (int g = 1; g < 4; ++g) if (gl[g] > gm) { gm = gl[g]; gi = g; }
            float den = 0.f;
#pragma unroll
            for (int g = 0; g < 4; ++g) den += __expf(gl[g] - gm);
            const float grp_p = 1.f / den;
            float E[8];
#pragma unroll
            for (int i = 0; i < 8; ++i) E[i] = L[4 + gi * 8 + i] + brt[gi * 8 + i];
            int a = 0; float am = E[0];
#pragma unroll
            for (int i = 1; i < 8; ++i) if (E[i] > am) { am = E[i]; a = i; }
            int bi = -1; float bm = -3.0e38f;
#pragma unroll
            for (int i = 0; i < 8; ++i) if (i != a && E[i] > bm) { bm = E[i]; bi = i; }
            if (bi < 0) { bi = (a == 0) ? 1 : 0; bm = E[bi]; }
            const float pb = __expf(bm - am), wa = 1.f / (1.f + pb), wb = pb / (1.f + pb);
            const unsigned e0 = (unsigned)(gi * 8 + a), e1 = (unsigned)(gi * 8 + bi);
            const unsigned k0 = __hip_atomic_fetch_add(HIST + e0, 1u, __ATOMIC_RELAXED, __HIP_MEMORY_SCOPE_WORKGROUP), k1 = __hip_atomic_fetch_add(HIST + e1, 1u, __ATOMIC_RELAXED, __HIP_MEMORY_SCOPE_WORKGROUP);
            LAS unsigned* ea = EA + (16 * F.wave + F.lane) * 8;
            ea[0] = e0; ea[1] = k0; ea[2] = e1; ea[3] = k1; ea[4] = __float_as_uint(grp_p * wa); ea[5] = __float_as_uint(grp_p * wb);
        }
        __syncthreads();
        if (F.tid < 32) BASE[F.tid] = __hip_atomic_fetch_add(F.ctl + CW_CNT + F.tid, HIST[F.tid], __ATOMIC_RELAXED, __HIP_MEMORY_SCOPE_AGENT);
        __syncthreads();
        if (F.tid < 128) { const LAS unsigned* ea = EA + F.tid * 8; const int tok = R0 + F.tid;
            const unsigned e0 = ea[0], e1 = ea[2], p0 = BASE[e0] + ea[1], p1 = BASE[e1] + ea[3];
            list[(size_t)e0 * ECAP + p0] = tok; list[(size_t)e1 * ECAP + p1] = tok;
            unsigned* ti = tokinfo + (size_t)tok * 8; *(u32x4*)ti = (u32x4){e0, p0, e1, p1}; *(u32x2*)(ti + 4) = (u32x2){ea[4], ea[5]}; }
        __syncthreads();
    }
}

__device__ __forceinline__ void moe_tstart(Frame& F) {
    LAS int* TS = (LAS int*)(F.lds + TS_OFF);
    if (F.tid == 0) { int o = 0; for (int e = 0; e < NE; ++e) { TS[e] = o; o += (int)((__hip_atomic_load(F.ctl + CW_CNT + e, __ATOMIC_RELAXED, __HIP_MEMORY_SCOPE_AGENT) + 255u) >> 8); } TS[NE] = o; }
    __syncthreads();
}
template <bool GATHER>
__device__ __forceinline__ void moe_setup(Frame& F) {
    moe_tstart(F);
    LAS int* TS = (LAS int*)(F.lds + TS_OFF); LAS int* UT = (LAS int*)(F.lds + UT_OFF); LAS int* RT = (LAS int*)(F.lds + RT_OFF);
    const int* list = (const int*)(F.ws + WS_LIST);
    if (F.tid < pg8::MOE_MAXU) {
        const int u = F.tid * F.G + F.vcu, T4 = 4 * TS[NE]; int pm = 0, pn = 0, e = 0, valid = 0;
        if (u < T4) { pm = u >> 2; pn = u & 3; valid = 1; for (int k = 1; k < NE; ++k) if (TS[k] <= pm) e = k; }
        UT[F.tid * 4 + 0] = pm; UT[F.tid * 4 + 1] = pn; UT[F.tid * 4 + 2] = e; UT[F.tid * 4 + 3] = valid;
    }
    __syncthreads();
    if (GATHER) {
        for (int idx = F.tid; idx < pg8::MOE_MAXU * 256; idx += NTHR) { const int i = idx >> 8, r = idx & 255;
            if (UT[i * 4 + 3]) { const int e = UT[i * 4 + 2], pos = (UT[i * 4 + 0] - TS[e]) * 256 + r;
                const int cnt = (int)__hip_atomic_load(F.ctl + CW_CNT + e, __ATOMIC_RELAXED, __HIP_MEMORY_SCOPE_AGENT);
                RT[idx] = pos < cnt ? list[(size_t)e * ECAP + pos] : 0; } }
        VM_WAIT();
    }
    __syncthreads();
}

struct P9Row { u32x2 ya[2], yb[2]; u32x4 xb[2]; };
__device__ __forceinline__ void p9_ld(P9Row& r, const unsigned char* y2, const bf16* x1b, unsigned s0, unsigned s1, int row, int lane) {
#pragma unroll
    for (int j = 0; j < 2; ++j) { r.ya[j] = *(const u32x2*)(y2 + (size_t)s0 * D + 512 * j + 8 * lane); r.yb[j] = *(const u32x2*)(y2 + (size_t)s1 * D + 512 * j + 8 * lane);
        r.xb[j] = *(const u32x4*)(x1b + (size_t)row * D + 512 * j + 8 * lane); }
}
__device__ __forceinline__ void up8(const u32x4 w, f32x4& a, f32x4& b) {
    a = (f32x4){bf2f(w.x & 0xffffu), bf2f(w.x >> 16), bf2f(w.y & 0xffffu), bf2f(w.y >> 16)}; b = (f32x4){bf2f(w.z & 0xffffu), bf2f(w.z >> 16), bf2f(w.w & 0xffffu), bf2f(w.w >> 16)}; }
__device__ __forceinline__ f32x4 up4_fp8(unsigned w) { const f32x2 lo = __builtin_amdgcn_cvt_pk_f32_fp8((int)w, false), hi = __builtin_amdgcn_cvt_pk_f32_fp8((int)w, true); return (f32x4){lo.x, lo.y, hi.x, hi.y}; }
__device__ __forceinline__ void p9_do(const P9Row& r, float w0, float w1, const f32x4 (&cg)[4], float* orow, int lane) {
    f32x4 y[4], xv[4];
#pragma unroll
    for (int j = 0; j < 2; ++j) { y[2 * j] = up4_fp8(r.ya[j].x) * w0 + up4_fp8(r.yb[j].x) * w1; y[2 * j + 1] = up4_fp8(r.ya[j].y) * w0 + up4_fp8(r.yb[j].y) * w1; up8(r.xb[j], xv[2 * j], xv[2 * j + 1]); }
    const float rs = rsqrtf(wave_sum(row_ss(y)) * (1.f / D) + EPS);
#pragma unroll
    for (int q = 0; q < 4; ++q) xv[q] = xv[q] + cg[q] * (y[q] * rs);
    row_st_f32(orow, lane, xv);
}
__device__ __forceinline__ void p9_final(Frame& F, bool dry) {
    moe_tstart(F);
    const LAS int* TS = (const LAS int*)(F.lds + TS_OFF);
    const unsigned char* y2 = F.ws + WS_Y2; const bf16* x1b = (const bf16*)(F.ws + WS_X1B); const unsigned* tokinfo = (const unsigned*)(F.ws + WS_TOK); const float* ada = (const float*)(F.ws + WS_ADA);
    float* obase = dry ? (float*)(F.ws + WS_CA) : F.out; const float* gpost2 = fin(I_GPOST2);
    for (int chunk = blockIdx.x; chunk < NTOK / 128; chunk += F.G) {
        const int R0 = chunk * 128, b = R0 / SEQ, rw = R0 + 16 * F.wave; const float* ad = ada + b * 6144;
        f32x4 cg[4];
#pragma unroll
        for (int q = 0; q < 4; ++q) { const int c0 = rcol(F.lane, q); cg[q] = *(const f32x4*)(gpost2 + c0) * *(const f32x4*)(ad + 5120 + c0); }
        const u32x4 ti = *(const u32x4*)(tokinfo + (size_t)(rw + (F.lane & 15)) * 8); const u32x2 tw = *(const u32x2*)(tokinfo + (size_t)(rw + (F.lane & 15)) * 8 + 4);
        const unsigned sl0 = (unsigned)TS[ti.x] * 256u + ti.y, sl1 = (unsigned)TS[ti.z] * 256u + ti.w;
#define P9_S0(i) ((unsigned)__builtin_amdgcn_readlane((int)sl0, (i)))
#define P9_S1(i) ((unsigned)__builtin_amdgcn_readlane((int)sl1, (i)))
#define P9_W0(i) (__uint_as_float((unsigned)__builtin_amdgcn_readlane((int)tw.x, (i))) * (1.f / pg8::YSC))
#define P9_W1(i) (__uint_as_float((unsigned)__builtin_amdgcn_readlane((int)tw.y, (i))) * (1.f / pg8::YSC))
        P9Row na, nb;
        p9_ld(na, y2, x1b, P9_S0(0), P9_S1(0), rw, F.lane); p9_ld(nb, y2, x1b, P9_S0(1), P9_S1(1), rw + 1, F.lane);
#pragma unroll
        for (int i = 0; i < 16; i += 2) {
            const P9Row ra = na, rb = nb;
            if (i + 2 < 16) { p9_ld(na, y2, x1b, P9_S0(i + 2), P9_S1(i + 2), rw + i + 2, F.lane); p9_ld(nb, y2, x1b, P9_S0(i + 3), P9_S1(i + 3), rw + i + 3, F.lane); }
            __builtin_amdgcn_sched_barrier(0);
            p9_do(ra, P9_W0(i), P9_W1(i), cg, obase + (size_t)(rw + i) * D, F.lane); p9_do(rb, P9_W0(i + 1), P9_W1(i + 1), cg, obase + (size_t)(rw + i + 1) * D, F.lane);
            __builtin_amdgcn_sched_barrier(0);
        }
#undef P9_S0
#undef P9_S1
#undef P9_W0
#undef P9_W1
    }
}

__global__ void __launch_bounds__(NTHR, 2) mega_fwd(Args args) {
    extern __shared__ __attribute__((aligned(16))) unsigned char lds_raw[];
    Frame F;
    F.lds = (LAS unsigned char*)lds_raw; F.MISC = (volatile LAS unsigned*)(F.lds + MISC_OFF);
    F.tid = threadIdx.x; F.lane = F.tid & 63; F.wave = __builtin_amdgcn_readfirstlane(F.tid >> 6);
    F.G = gridDim.x; { const int bx = blockIdx.x; F.vcu = (F.G % 8 == 0) ? (bx % 8) * (F.G / 8) + bx / 8 : bx; }
    F.ws = args.ws; F.ctl = (unsigned*)(args.ws + WS_CTL); F.out = args.out;
    for (int u = F.tid; u < (LDS_BYTES - LDSCTL_OFF) / 4; u += NTHR) ((LAS unsigned*)(F.lds + LDSCTL_OFF))[u] = 0u;
    __syncthreads();
    XcdBarrier bar; bar.bar = F.ctl + CW_BAR; bar.x = 0; bar.st = nullptr;
    if (args.use_bar) bar = xcd_barrier_post(F.ctl + CW_BAR, F.MISC + 8);
    const int lo = args.ph_lo, hi = args.ph_hi;
#ifndef MK_PHMASK
#define MK_PHMASK 0x3ff
#endif
#define IN(k) (((MK_PHMASK >> (k)) & 1) && lo <= (k) && (k) < hi)
#define SEAM(k) do { if (IN(k) && IN((k) + 1)) xcd_barrier(bar); } while (0)

    if (IN(0)) { p0_prologue(F); }
    if (IN(1)) { p1_modnorm(F); } SEAM(1);
    if (IN(2)) {
        pg8::EpiP2 E{(bf16*)(F.ws + WS_GLU), (bf16*)(F.ws + WS_QKV), (bf16*)(F.ws + WS_GATES), fin(I_QG), fin(I_KG), (const f32x2*)(F.ws + WS_ROPE)};
        { pg8::P2Order<false> S{(const char*)(F.ws + WS_WIN), F.vcu, F.G};
          pg8::gemm_phase<pg8::EpiP2, pg8::P2Order<false>, true, 0>(F.lds + RING_OFF, F.ws + WS_H1, D * 2, D * 2, S, E); }
        { pg8::P2Order<true> S{(const char*)(F.ws + WS_WINF), F.vcu, F.G};
          pg8::gemm_phase<pg8::EpiP2, pg8::P2Order<true>, true, 1>(F.lds + RING_OFF, F.ws + WS_H1F, D * 2, D * 2, S, E, nullptr, D); }
    } SEAM(2);
    if (IN(3)) {
        if (!(args.flags & 1)) p3_conv(F);
        if (!(args.flags & 2)) {
            const attn_body::bf16* qkv = (const attn_body::bf16*)(F.ws + WS_QKV);
            const attn_body::AttnTensors AT{qkv, qkv + 512, qkv + 640, (attn_body::bf16*)(F.ws + WS_CA) + 512};
            const attn_body::StaticOrder S((int)F.G, F.vcu);
            attn_body::AttnUnit au;
            for (int i = 0; S.next(i, au); ++i) {
                if (i == (F.vcu & 3)) { p0_convert_experts(F, 0, XCONV_ITEMS, F.vcu, F.G); VM_WAIT(); __syncthreads(); }
                attn_body::attn_unit<8>(au.bh / attn_body::NHEAD, au.bh % attn_body::NHEAD, (au.bh % attn_body::NHEAD) / 4, au.qb, AT.Q, AT.K, AT.V, AT.O, (char*)lds_raw + RING_OFF);
            }
        }
    } SEAM(3);
    if (IN(4)) {
        pg8::PanelOrder S{(const char*)(F.ws + WS_WCA), F.vcu, F.G, D * 2};
        pg8::EpiP4 E{(const bf16*)(F.ws + WS_GATES), (bf16*)(F.ws + WS_H1)};
        pg8::gemm_phase<pg8::EpiP4, pg8::PanelOrder, true>(F.lds + RING_OFF, F.ws + WS_CA, D * 2, D * 2, S, E);
    } SEAM(4);
    if (IN(5)) {
        pg8::PanelOrder S{(const char*)(F.ws + WS_WO), F.vcu, F.G, D * 2};
        pg8::EpiP5 E{(bf16*)(F.ws + WS_Y1), (float*)(F.ws + WS_PART)};
        pg8::gemm_phase<pg8::EpiP5, pg8::PanelOrder, true>(F.lds + RING_OFF, F.ws + WS_H1, D * 2, D * 2, S, E);
    } SEAM(5);
    if (IN(6)) { p6_postmix_router(F); } SEAM(6);
    if (IN(7)) {
        moe_setup<true>(F);
        pg8::MoeOrder<true> S{(const LAS int*)(F.lds + UT_OFF), (const LAS int*)(F.lds + RT_OFF), F.ws + WS_W1, (size_t)D * D, D};
        pg8::EpiMoe1 E{F.ws + WS_GATES};
        pg8::gemm_phase<pg8::EpiMoe1, pg8::MoeOrder<true>, true, true>(F.lds + RING_OFF, F.ws + WS_H2F, D, D, S, E);
    } SEAM(7);
    if (IN(8)) {
        moe_setup<false>(F);
        pg8::MoeOrder<false> S{(const LAS int*)(F.lds + UT_OFF), (const LAS int*)(F.lds + RT_OFF), F.ws + WS_W2, (size_t)D * DE, DE};
        pg8::EpiMoe2 E{F.ws + WS_Y2};
        pg8::gemm_phase<pg8::EpiMoe2, pg8::MoeOrder<false>, true, true>(F.lds + RING_OFF, F.ws + WS_GATES, DE, DE, S, E);
    } SEAM(8);
    if (IN(9)) { p9_final(F, (args.flags & 4) != 0); }
#undef IN
#undef SEAM
}
#if MK_NPRE < 10
__global__ __launch_bounds__(256) void k_ada(const float* __restrict__ c, const float* __restrict__ w, const float* __restrict__ bb, float* __restrict__ ada) {
    const int j = blockIdx.x * 256 + threadIdx.x, b = blockIdx.y;
    float acc = 0.f;
    for (int k = 0; k < D; ++k) { const float cv = c[b * D + k]; acc += siluf_(cv) * w[(size_t)k * 6144 + j]; }
    ada[b * 6144 + j] = acc + bb[j];
}

__global__ __launch_bounds__(256) void k_modnorm(const float* __restrict__ x, const float* __restrict__ g, const float* __restrict__ ada, int sh_off, int sc_off, bf16* __restrict__ out) {
    const int lane = threadIdx.x & 63, row = blockIdx.x * 4 + (threadIdx.x >> 6), b = row / SEQ;
    const f32x4* xr = (const f32x4*)(x + (size_t)row * D) + lane;
    f32x4 v[4]; float s = 0.f;
#pragma unroll
    for (int j = 0; j < 4; ++j) { v[j] = xr[64 * j]; s += (v[j].x * v[j].x + v[j].y * v[j].y) + (v[j].z * v[j].z + v[j].w * v[j].w); }
    const float rstd = rsqrtf(wave_sum(s) * (1.f / D) + EPS);
    unsigned long long* o8 = (unsigned long long*)(out + (size_t)row * D) + lane;
#pragma unroll
    for (int j = 0; j < 4; ++j) {
        const int c0 = 256 * j + 4 * lane;
        const f32x4 gg = *(const f32x4*)(g + c0), sc = *(const f32x4*)(ada + b * 6144 + sc_off + c0), sh = *(const f32x4*)(ada + b * 6144 + sh_off + c0);
        const f32x4 r = v[j] * rstd * gg * (1.f + sc) + sh;
        o8[64 * j] = (unsigned long long)pk2(r.x, r.y) | ((unsigned long long)pk2(r.z, r.w) << 32);
    }
}

template <int MODE>
__global__ __launch_bounds__(256) void k_gemm(const bf16* __restrict__ A, int lda, const int* __restrict__ rowidx, const int* __restrict__ cntp, const int* __restrict__ offp,
                                              const float* __restrict__ W, const float* __restrict__ W2, int ldw, void* Cv, int ldc, int M, int K) {
    __shared__ float As[16][68];
    __shared__ float Bs[16][68];
    __shared__ float Bs2[MODE == 1 ? 16 : 1][68];
    const int Mcnt = cntp ? *cntp : M, off = offp ? *offp : 0;
    const int m0 = blockIdx.x * 64, n0 = blockIdx.y * 64;
    if (m0 >= Mcnt) return;
    const int tid = threadIdx.x, tx = tid & 15, ty = tid >> 4;
    float acc[4][4], acc2[4][4];
#pragma unroll
    for (int i = 0; i < 4; ++i)
#pragma unroll
        for (int j = 0; j < 4; ++j) { acc[i][j] = 0.f; acc2[i][j] = 0.f; }
    const int ar = tid >> 2, ak = (tid & 3) * 4, arow = m0 + ar;
    const bool av = arow < Mcnt;
    const size_t asrc = av ? (rowidx ? (size_t)rowidx[arow] : (size_t)(off + arow)) : 0;
    const int bk = tid >> 4, bn = (tid & 15) * 4;
    for (int k0 = 0; k0 < K; k0 += 16) {
        u32x2 raw = (u32x2){0u, 0u};
        if (av) raw = *(const u32x2*)(A + asrc * lda + k0 + ak);
        As[ak + 0][ar] = bf2f(raw.x & 0xffffu); As[ak + 1][ar] = bf2f(raw.x >> 16); As[ak + 2][ar] = bf2f(raw.y & 0xffffu); As[ak + 3][ar] = bf2f(raw.y >> 16);
        const f32x4 w = *(const f32x4*)(W + (size_t)(k0 + bk) * ldw + n0 + bn);
        Bs[bk][bn + 0] = w.x; Bs[bk][bn + 1] = w.y; Bs[bk][bn + 2] = w.z; Bs[bk][bn + 3] = w.w;
        if (MODE == 1) { const f32x4 w2 = *(const f32x4*)(W2 + (size_t)(k0 + bk) * ldw + n0 + bn);
            Bs2[bk][bn + 0] = w2.x; Bs2[bk][bn + 1] = w2.y; Bs2[bk][bn + 2] = w2.z; Bs2[bk][bn + 3] = w2.w; }
        __syncthreads();
#pragma unroll
        for (int kk = 0; kk < 16; ++kk) {
            float a[4], b[4], b2[4];
#pragma unroll
            for (int i = 0; i < 4; ++i) { a[i] = As[kk][ty * 4 + i]; b[i] = Bs[kk][tx * 4 + i]; b2[i] = (MODE == 1) ? Bs2[kk][tx * 4 + i] : 0.f; }
#pragma unroll
            for (int i = 0; i < 4; ++i)
#pragma unroll
                for (int j = 0; j < 4; ++j) { acc[i][j] += a[i] * b[j]; if (MODE == 1) acc2[i][j] += a[i] * b2[j]; }
        }
        __syncthreads();
    }
#pragma unroll
    for (int i = 0; i < 4; ++i) {
        const int r = m0 + ty * 4 + i;
        if (r < Mcnt) {
            const size_t crow = (size_t)(off + r);
            if (MODE == 0) { *(f32x4*)((float*)Cv + crow * ldc + n0 + tx * 4) = (f32x4){acc[i][0], acc[i][1], acc[i][2], acc[i][3]}; }
            else {
                float o[4];
#pragma unroll
                for (int j = 0; j < 4; ++j) o[j] = (MODE == 1) ? siluf_(acc[i][j]) * acc2[i][j] : acc[i][j];
                *(u32x2*)((bf16*)Cv + crow * ldc + n0 + tx * 4) = (u32x2){pk2(o[0], o[1]), pk2(o[2], o[3])};
            }
        }
    }
}

__global__ __launch_bounds__(256) void k_glu(const float* __restrict__ t, bf16* __restrict__ glu) {
    const size_t i = (size_t)blockIdx.x * 256 + threadIdx.x;
    const size_t r = i / 512; const int c = (int)(i % 512);
    const float a = t[r * 1024 + c], ag = t[r * 1024 + 512 + c];
    glu[i] = (bf16)f2bf(a * sigmoidf_(ag));
}
__global__ __launch_bounds__(256) void k_gate(const float* __restrict__ t, bf16* __restrict__ gates, int goff) {
    const size_t i = (size_t)blockIdx.x * 256 + threadIdx.x;
    const size_t r = i / 1024; const int c = (int)(i % 1024);
    gates[r * 2048 + goff + c] = (bf16)f2bf(sigmoidf_(t[i]));
}

__global__ __launch_bounds__(512) void k_conv(const bf16* __restrict__ glu, const float* __restrict__ w_dw, const float* __restrict__ b_dw, const float* __restrict__ lg, const float* __restrict__ lb, bf16* __restrict__ ca) {
    __shared__ float red[16];
    const int t = blockIdx.x, c = threadIdx.x, b = t / SEQ, s = t % SEQ;
    float acc = b_dw[c];
    for (int j = 0; j < KS; ++j) { const int s2 = s + j - KS / 2; if (s2 >= 0 && s2 < SEQ) acc += bf2f(glu[(size_t)(b * SEQ + s2) * CW + c]) * w_dw[j * CW + c]; }
    float sm = wave_sum(acc);
    if ((c & 63) == 0) red[c >> 6] = sm;
    __syncthreads();
    float mu = 0.f;
#pragma unroll
    for (int i = 0; i < 8; ++i) mu += red[i];
    mu *= (1.f / CW);
    const float d = acc - mu;
    float sq = wave_sum(d * d);
    if ((c & 63) == 0) red[8 + (c >> 6)] = sq;
    __syncthreads();
    float var = 0.f;
#pragma unroll
    for (int i = 0; i < 8; ++i) var += red[8 + i];
    var *= (1.f / CW);
    const float u = d * rsqrtf(var + EPS) * lg[c] + lb[c];
    ca[(size_t)t * 1024 + c] = (bf16)f2bf(siluf_(u));
}

__global__ __launch_bounds__(256) void k_qkrope(const float* __restrict__ t, const float* __restrict__ qg, const float* __restrict__ kg, bf16* __restrict__ qkv) {
    const size_t i = (size_t)blockIdx.x * 256 + threadIdx.x;
    const size_t r = i / 12; const int hs = (int)(i % 12);
    const float* src = t + r * 1024 + hs * 64; bf16* dst = qkv + r * 768 + hs * 64;
    if (hs >= 10) { for (int d = 0; d < 64; ++d) dst[d] = (bf16)f2bf(src[d]); return; }
    const float* g = hs < 8 ? qg : kg;
    float ss = 0.f;
    for (int d = 0; d < 64; ++d) ss += src[d] * src[d];
    const float rstd = rsqrtf(ss * (1.f / 64.f) + EPS) , osc = hs < 8 ? QSCALE : 1.f;
    const int s = (int)(r % SEQ); const float prow = (float)(s / 64), pcol = (float)(s % 64);
    for (int half = 0; half < 2; ++half) {
        const float pos = half == 0 ? prow : pcol;
        for (int e = 0; e < 16; ++e) {
            const float invf = powf(10000.f, -(float)(2 * e) / 32.f);
            const float ang = pos * invf; float sn, cs; sincosf(ang, &sn, &cs);
            const int d1 = half * 32 + e, d2 = d1 + 16;
            const float x1 = src[d1] * rstd * g[d1], x2 = src[d2] * rstd * g[d2];
            dst[d1] = (bf16)f2bf((x1 * cs - x2 * sn) * osc);
            dst[d2] = (bf16)f2bf((x2 * cs + x1 * sn) * osc);
        }
    }
}

__global__ __launch_bounds__(256) void k_attn(const bf16* __restrict__ qkv, bf16* __restrict__ ca) {
    const int qi = blockIdx.x * 256 + threadIdx.x;
    const int h = blockIdx.y, b = blockIdx.z, kvh = h / 4;
    const size_t row = (size_t)b * SEQ + qi;
    float q[64], o[64];
    {
        const u32x4* qp = (const u32x4*)(qkv + row * 768 + h * 64);
#pragma unroll
        for (int c = 0; c < 8; ++c) { const u32x4 v = qp[c];
            q[c * 8 + 0] = bf2f(v.x & 0xffffu); q[c * 8 + 1] = bf2f(v.x >> 16); q[c * 8 + 2] = bf2f(v.y & 0xffffu); q[c * 8 + 3] = bf2f(v.y >> 16);
            q[c * 8 + 4] = bf2f(v.z & 0xffffu); q[c * 8 + 5] = bf2f(v.z >> 16); q[c * 8 + 6] = bf2f(v.w & 0xffffu); q[c * 8 + 7] = bf2f(v.w >> 16); }
    }
#pragma unroll
    for (int d = 0; d < 64; ++d) o[d] = 0.f;
    float m = -1e30f, l = 0.f;
    for (int s = 0; s < SEQ; ++s) {
        const u32x4* kp = (const u32x4*)(qkv + ((size_t)b * SEQ + s) * 768 + 512 + kvh * 64);
        const u32x4* vp = (const u32x4*)(qkv + ((size_t)b * SEQ + s) * 768 + 640 + kvh * 64);
        float sc = 0.f;
#pragma unroll
        for (int c = 0; c < 8; ++c) { const u32x4 v = kp[c];
            sc += q[c * 8 + 0] * bf2f(v.x & 0xffffu) + q[c * 8 + 1] * bf2f(v.x >> 16) + q[c * 8 + 2] * bf2f(v.y & 0xffffu) + q[c * 8 + 3] * bf2f(v.y >> 16)
                + q[c * 8 + 4] * bf2f(v.z & 0xffffu) + q[c * 8 + 5] * bf2f(v.z >> 16) + q[c * 8 + 6] * bf2f(v.w & 0xffffu) + q[c * 8 + 7] * bf2f(v.w >> 16); }
        if (sc > m) { const float f = exp2f(m - sc); l *= f;
#pragma unroll
            for (int d = 0; d < 64; ++d) o[d] *= f;
            m = sc; }
        const float p = exp2f(sc - m); l += p;
#pragma unroll
        for (int c = 0; c < 8; ++c) { const u32x4 v = vp[c];
            o[c * 8 + 0] += p * bf2f(v.x & 0xffffu); o[c * 8 + 1] += p * bf2f(v.x >> 16); o[c * 8 + 2] += p * bf2f(v.y & 0xffffu); o[c * 8 + 3] += p * bf2f(v.y >> 16);
            o[c * 8 + 4] += p * bf2f(v.z & 0xffffu); o[c * 8 + 5] += p * bf2f(v.z >> 16); o[c * 8 + 6] += p * bf2f(v.w & 0xffffu); o[c * 8 + 7] += p * bf2f(v.w >> 16); }
    }
    const float il = 1.f / l;
    u32x4* op = (u32x4*)(ca + row * 1024 + 512 + h * 64);
#pragma unroll
    for (int c = 0; c < 8; ++c) op[c] = (u32x4){pk2(o[c * 8 + 0] * il, o[c * 8 + 1] * il), pk2(o[c * 8 + 2] * il, o[c * 8 + 3] * il), pk2(o[c * 8 + 4] * il, o[c * 8 + 5] * il), pk2(o[c * 8 + 6] * il, o[c * 8 + 7] * il)};
}

__global__ __launch_bounds__(256) void k_merge(const float* __restrict__ t1, const float* __restrict__ t2, const bf16* __restrict__ gates, bf16* __restrict__ merged) {
    const size_t i = (size_t)blockIdx.x * 256 + threadIdx.x;
    const size_t r = i / 1024; const int c = (int)(i % 1024);
    if (MK_NPRE >= 3) { const unsigned char* gq = (const unsigned char*)gates; const size_t gi = pg8::gate_index((int)r, c); const float sc = ((float)gq[gi] + 0.5f) * (1.f / 256.f), sa = ((float)gq[gi + 8] + 0.5f) * (1.f / 256.f); merged[i] = (bf16)f2bf(sc * t1[i] + sa * t2[i]); }
    else merged[i] = (bf16)f2bf(bf2f(gates[r * 2048 + c]) * t1[i] + bf2f(gates[r * 2048 + 1024 + c]) * t2[i]);
}

__global__ __launch_bounds__(256) void k_postmix(const float* __restrict__ x, const float* __restrict__ y1, const float* __restrict__ ada, const float* __restrict__ g_post, const float* __restrict__ g_pre2,
                                                 const float* __restrict__ w_group, const float* __restrict__ b_group, const float* __restrict__ w_router, const float* __restrict__ b_router,
                                                 float* __restrict__ x1out, bf16* __restrict__ h2, unsigned* __restrict__ ctl, int* __restrict__ list, unsigned* __restrict__ tokinfo) {
    const int lane = threadIdx.x & 63, row = blockIdx.x * 4 + (threadIdx.x >> 6), b = row / SEQ;
    const float* ad = ada + b * 6144;
    f32x4 yv[4], xv[4]; float s = 0.f;
#pragma unroll
    for (int j = 0; j < 4; ++j) { yv[j] = ((const f32x4*)(y1 + (size_t)row * D) + lane)[64 * j]; xv[j] = ((const f32x4*)(x + (size_t)row * D) + lane)[64 * j];
        s += (yv[j].x * yv[j].x + yv[j].y * yv[j].y) + (yv[j].z * yv[j].z + yv[j].w * yv[j].w); }
    const float rstd1 = rsqrtf(wave_sum(s) * (1.f / D) + EPS);
    float s2 = 0.f;
#pragma unroll
    for (int j = 0; j < 4; ++j) { const int c0 = 256 * j + 4 * lane;
        const f32x4 gp = *(const f32x4*)(g_post + c0), gt = *(const f32x4*)(ad + 2048 + c0);
        xv[j] = xv[j] + gt * (yv[j] * rstd1 * gp);
        ((f32x4*)(x1out + (size_t)row * D) + lane)[64 * j] = xv[j];
        s2 += (xv[j].x * xv[j].x + xv[j].y * xv[j].y) + (xv[j].z * xv[j].z + xv[j].w * xv[j].w); }
    const float rstd2 = rsqrtf(wave_sum(s2) * (1.f / D) + EPS);
    float lg[36];
#pragma unroll
    for (int o = 0; o < 36; ++o) lg[o] = 0.f;
    unsigned long long* o8 = (unsigned long long*)(h2 + (size_t)row * D) + lane;
#pragma unroll
    for (int j = 0; j < 4; ++j) { const int c0 = 256 * j + 4 * lane;
        const f32x4 gg = *(const f32x4*)(g_pre2 + c0), sc = *(const f32x4*)(ad + 4096 + c0), sh = *(const f32x4*)(ad + 3072 + c0);
        const f32x4 hv = xv[j] * rstd2 * gg * (1.f + sc) + sh;
        o8[64 * j] = (unsigned long long)pk2(hv.x, hv.y) | ((unsigned long long)pk2(hv.z, hv.w) << 32);
#pragma unroll
        for (int i = 0; i < 4; ++i) { const int c = c0 + i; const float hvv = hv[i];
            const f32x4 wg = *(const f32x4*)(w_group + c * 4);
            lg[0] += hvv * wg.x; lg[1] += hvv * wg.y; lg[2] += hvv * wg.z; lg[3] += hvv * wg.w;
#pragma unroll
            for (int q = 0; q < 8; ++q) { const f32x4 wr = *(const f32x4*)(w_router + c * 32 + q * 4);
                lg[4 + q * 4 + 0] += hvv * wr.x; lg[4 + q * 4 + 1] += hvv * wr.y; lg[4 + q * 4 + 2] += hvv * wr.z; lg[4 + q * 4 + 3] += hvv * wr.w; } } }
#pragma unroll
    for (int o = 0; o < 36; ++o) lg[o] = wave_sum(lg[o]);
    float gl[4];
#pragma unroll
    for (int g = 0; g < 4; ++g) gl[g] = lg[g] + b_group[g];
    int gi = 0; float gm = gl[0];
#pragma unroll
    for (int g = 1; g < 4; ++g) if (gl[g] > gm) { gm = gl[g]; gi = g; }
    float den = 0.f;
#pragma unroll
    for (int g = 0; g < 4; ++g) den += __expf(gl[g] - gm);
    const float grp_p = 1.f / den;
    float in[8];
#pragma unroll
    for (int i = 0; i < 8; ++i) { float v = 0.f;
#pragma unroll
        for (int g = 0; g < 4; ++g) { const float cand = lg[4 + g * 8 + i] + b_router[g * 8 + i]; v = (g == gi) ? cand : v; }
        in[i] = v; }
    int a = 0; float am = in[0];
#pragma unroll
    for (int i = 1; i < 8; ++i) if (in[i] > am) { am = in[i]; a = i; }
    int bidx = -1; float bm = -3.0e38f;
#pragma unroll
    for (int i = 0; i < 8; ++i) if (i != a && in[i] > bm) { bm = in[i]; bidx = i; }
    const float pb = __expf(bm - am), wa = 1.f / (1.f + pb), wb = pb / (1.f + pb);
    if (lane == 0) {
        const int e0 = gi * 8 + a, e1 = gi * 8 + bidx;
        const unsigned p0 = atomicAdd(ctl + CW_CNT + e0, 1u), p1 = atomicAdd(ctl + CW_CNT + e1, 1u);
        list[(size_t)e0 * ECAP + p0] = row; list[(size_t)e1 * ECAP + p1] = row;
        unsigned* ti = tokinfo + (size_t)row * 8;
        ti[0] = (unsigned)e0; ti[1] = p0; ti[2] = (unsigned)e1; ti[3] = p1; ti[4] = __float_as_uint(grp_p * wa); ti[5] = __float_as_uint(grp_p * wb);
    }
}
__global__ void k_offsets(unsigned* ctl) {
    if (threadIdx.x == 0) { unsigned o = 0; for (int e = 0; e < NE; ++e) { ctl[CW_OFF + e] = o; o += (ctl[CW_CNT + e] + 255u) / 256u * 256u; } ctl[CW_OFF + NE] = o; }
}

__global__ __launch_bounds__(256) void k_final(const bf16* __restrict__ y2, const unsigned* __restrict__ tokinfo, const unsigned* __restrict__ ctl, const float* __restrict__ ada, const float* __restrict__ g_post2, float* __restrict__ out) {
    const int lane = threadIdx.x & 63, row = blockIdx.x * 4 + (threadIdx.x >> 6), b = row / SEQ;
    const unsigned* ti = tokinfo + (size_t)row * 8;
    const unsigned s0 = ctl[CW_OFF + ti[0]] + ti[1], s1 = ctl[CW_OFF + ti[2]] + ti[3];
    const float w0 = __uint_as_float(ti[4]), w1 = __uint_as_float(ti[5]);
    f32x4 yv[4]; float s = 0.f;
#pragma unroll
    for (int j = 0; j < 4; ++j) {
        const u32x2 a = ((const u32x2*)(y2 + (size_t)s0 * D) + lane)[64 * j], c = ((const u32x2*)(y2 + (size_t)s1 * D) + lane)[64 * j];
        yv[j].x = w0 * bf2f(a.x & 0xffffu) + w1 * bf2f(c.x & 0xffffu); yv[j].y = w0 * bf2f(a.x >> 16) + w1 * bf2f(c.x >> 16);
        yv[j].z = w0 * bf2f(a.y & 0xffffu) + w1 * bf2f(c.y & 0xffffu); yv[j].w = w0 * bf2f(a.y >> 16) + w1 * bf2f(c.y >> 16);
        s += (yv[j].x * yv[j].x + yv[j].y * yv[j].y) + (yv[j].z * yv[j].z + yv[j].w * yv[j].w); }
    const float rstd = rsqrtf(wave_sum(s) * (1.f / D) + EPS);
#pragma unroll
    for (int j = 0; j < 4; ++j) { const int c0 = 256 * j + 4 * lane;
        const f32x4 gp = *(const f32x4*)(g_post2 + c0), gt = *(const f32x4*)(ada + b * 6144 + 5120 + c0);
        f32x4* op = (f32x4*)(out + (size_t)row * D) + lane;
        op[64 * j] = op[64 * j] + gt * (yv[j] * rstd * gp); }
}

#endif
extern "C" void kernel_launch(void* const* d_in, const int* in_sizes, int n_in, void* d_out, int out_size, void* d_ws, size_t ws_size, hipStream_t stream) {
    static int grid = 0;
    if (grid == 0) {
        if (n_in != 25 || in_sizes[0] != NTOK * D || out_size != NTOK * D || ws_size < WS_END) { fprintf(stderr, "kernel_launch: unexpected problem (n_in %d, ws %zu); nothing launched\n", n_in, ws_size); grid = -1; return; }
        int dev = 0, cus = 0, per_cu = 0;
        if (hipGetDevice(&dev) != hipSuccess || hipDeviceGetAttribute(&cus, hipDeviceAttributeMultiprocessorCount, dev) != hipSuccess) { grid = -1; return; }
        if (hipFuncSetAttribute((const void*)mega_fwd, hipFuncAttributeMaxDynamicSharedMemorySize, LDS_BYTES) != hipSuccess) { fprintf(stderr, "kernel_launch: hipFuncSetAttribute failed\n"); grid = -1; return; }
        if (hipOccupancyMaxActiveBlocksPerMultiprocessor(&per_cu, (const void*)mega_fwd, NTHR, LDS_BYTES) != hipSuccess || per_cu < 1) { fprintf(stderr, "kernel_launch: occupancy query says %d\n", per_cu); grid = -1; return; }
        (void)hipGetLastError();
        if (cus < 256) { fprintf(stderr, "kernel_launch: built for a 256-CU device (one workgroup per CU, 256 workgroups); this one has %d\n", cus); grid = -1; return; }
        grid = 256;
    }
    if (grid < 0) return;
    unsigned char* ws = (unsigned char*)d_ws;
    if (hipMemsetAsync(ws + WS_CTL, 0, CTL_ZERO_BYTES, stream) != hipSuccess) return;
    Args a{};
    for (int i = 0; i < 25; ++i) a.in[i] = (const float*)d_in[i];
    a.out = (float*)d_out; a.ws = ws; a.flags = MK_FLAGS;
#if MK_NPRE == 10 && MK_ONE
    a.ph_lo = 0; a.ph_hi = 10; a.use_bar = 1;
    hipLaunchKernelGGL(mega_fwd, dim3(grid), dim3(NTHR), LDS_BYTES, stream, a);
#else
    for (int p = 0; p < MK_NPRE; ++p) { a.ph_lo = p; a.ph_hi = p + 1; a.use_bar = 0;
#ifdef MK_REP
        if (p == MK_REP) {
            if (p == 9) a.flags |= 4;
#ifdef MK_REPFLAGS
            a.flags |= MK_REPFLAGS;
#endif
            hipLaunchKernelGGL(mega_fwd, dim3(grid), dim3(NTHR), LDS_BYTES, stream, a);
            a.flags = MK_FLAGS;
            if (p == 6) (void)hipMemsetAsync(ws + WS_CTL, 0, 256, stream);
        }
#endif
        hipLaunchKernelGGL(mega_fwd, dim3(grid), dim3(NTHR), LDS_BYTES, stream, a); }
#endif
#if MK_NPRE < 10
    const float* x = (const float*)d_in[0]; const float* w_in = (const float*)d_in[6];
    const float* w_dw = (const float*)d_in[7]; const float* b_dw = (const float*)d_in[8]; const float* cln_g = (const float*)d_in[9]; const float* cln_b = (const float*)d_in[10];
    const float* w_conv_out = (const float*)d_in[11]; const float* q_g = (const float*)d_in[12]; const float* k_g = (const float*)d_in[13]; const float* w_attn_out = (const float*)d_in[14];
    const float* w_out = (const float*)d_in[15]; const float* g_pre_ffn = (const float*)d_in[16]; const float* g_post_ffn = (const float*)d_in[17];
    const float* w_group = (const float*)d_in[18]; const float* b_group = (const float*)d_in[19]; const float* w_router = (const float*)d_in[20]; const float* b_router = (const float*)d_in[21];
    const float* w_e_gate = (const float*)d_in[22]; const float* w_e_up = (const float*)d_in[23]; const float* w_e_down = (const float*)d_in[24];
    float* out = (float*)d_out; unsigned* ctl = (unsigned*)(ws + WS_CTL); float* ada = (float*)(ws + WS_ADA);
    bf16* h1 = (bf16*)(ws + WS_H1); bf16* merged = (bf16*)(ws + WS_H1); bf16* glu = (bf16*)(ws + WS_GLU); bf16* qkv = (bf16*)(ws + WS_QKV);
    bf16* gates = (bf16*)(ws + WS_GATES); bf16* act = (bf16*)(ws + WS_GATES); bf16* ca = (bf16*)(ws + WS_CA); bf16* h2 = (bf16*)(ws + WS_CA);
    float* tmp = (float*)(ws + WS_TMP); int* list = (int*)(ws + WS_LIST); unsigned* tokinfo = (unsigned*)(ws + WS_TOK); bf16* y2 = (bf16*)(ws + WS_Y2);
    if (MK_NPRE <= 0) k_ada<<<dim3(6144 / 256, NB), 256, 0, stream>>>((const float*)d_in[1], (const float*)d_in[2], (const float*)d_in[3], ada);
    if (MK_NPRE <= 1) k_modnorm<<<NTOK / 4, 256, 0, stream>>>(x, (const float*)d_in[4], ada, 0, 1024, h1);
    if (MK_NPRE <= 2) {
        k_gemm<0><<<dim3(NTOK / 64, 1024 / 64), 256, 0, stream>>>(h1, D, nullptr, nullptr, nullptr, w_in + 0, nullptr, INW, tmp, 1024, NTOK, D);
        k_glu<<<NTOK * 512 / 256, 256, 0, stream>>>(tmp, glu);
        k_gemm<0><<<dim3(NTOK / 64, 768 / 64), 256, 0, stream>>>(h1, D, nullptr, nullptr, nullptr, w_in + 1024, nullptr, INW, tmp, 1024, NTOK, D);
        k_qkrope<<<NTOK * 12 / 256, 256, 0, stream>>>(tmp, q_g, k_g, qkv);
        k_gemm<0><<<dim3(NTOK / 64, 1024 / 64), 256, 0, stream>>>(h1, D, nullptr, nullptr, nullptr, w_in + 1792, nullptr, INW, tmp, 1024, NTOK, D);
        k_gate<<<NTOK * 1024 / 256, 256, 0, stream>>>(tmp, gates, 0);
        k_gemm<0><<<dim3(NTOK / 64, 1024 / 64), 256, 0, stream>>>(h1, D, nullptr, nullptr, nullptr, w_in + 2816, nullptr, INW, tmp, 1024, NTOK, D);
        k_gate<<<NTOK * 1024 / 256, 256, 0, stream>>>(tmp, gates, 1024);
    }
    if (MK_NPRE <= 3 || (MK_FLAGS & 1)) k_conv<<<NTOK, 512, 0, stream>>>(glu, w_dw, b_dw, cln_g, cln_b, ca);
    if (MK_NPRE <= 3 || (MK_FLAGS & 2)) k_attn<<<dim3(SEQ / 256, 8, NB), 256, 0, stream>>>(qkv, ca);
    if (MK_NPRE <= 4) {
        k_gemm<0><<<dim3(NTOK / 64, 1024 / 64), 256, 0, stream>>>(ca, 1024, nullptr, nullptr, nullptr, w_conv_out, nullptr, D, tmp, 1024, NTOK, 512);
        k_gemm<0><<<dim3(NTOK / 64, 1024 / 64), 256, 0, stream>>>(ca + 512, 1024, nullptr, nullptr, nullptr, w_attn_out, nullptr, D, out, 1024, NTOK, 512);
        k_merge<<<NTOK * 1024 / 256, 256, 0, stream>>>(tmp, out, gates, merged);
    }
    if (MK_NPRE <= 6) {
        k_gemm<0><<<dim3(NTOK / 64, 1024 / 64), 256, 0, stream>>>(merged, D, nullptr, nullptr, nullptr, w_out, nullptr, D, tmp, 1024, NTOK, D);
        k_postmix<<<NTOK / 4, 256, 0, stream>>>(x, tmp, ada, (const float*)d_in[5], g_pre_ffn, w_group, b_group, w_router, b_router, out, h2, ctl, list, tokinfo);
    }
    k_offsets<<<1, 64, 0, stream>>>(ctl);
    if (MK_NPRE <= 8) {
        for (int e = 0; e < NE; ++e)
            k_gemm<1><<<dim3(NTOK / 64, DE / 64), 256, 0, stream>>>(h2, D, list + (size_t)e * ECAP, (const int*)ctl + CW_CNT + e, (const int*)ctl + CW_OFF + e,
                                                                  w_e_gate + (size_t)e * D * DE, w_e_up + (size_t)e * D * DE, DE, act, DE, 0, D);
        for (int e = 0; e < NE; ++e)
            k_gemm<2><<<dim3(NTOK / 64, D / 64), 256, 0, stream>>>(act, DE, nullptr, (const int*)ctl + CW_CNT + e, (const int*)ctl + CW_OFF + e,
                                                                 w_e_down + (size_t)e * DE * D, nullptr, D, y2, D, 0, DE);
    }
    k_final<<<NTOK / 4, 256, 0, stream>>>(y2, tokinfo, ctl, ada, g_post_ffn, out);
#endif
}
```

```cpp
#define MK_NPRE 10
#define MK_ONE 1
#define MK_FLAGS 0
#include <hip/hip_runtime.h>
#include <hip/hip_bf16.h>
#include <cstdint>
#include <cstdio>
#include <cmath>

#define GAS __attribute__((address_space(1)))
#define LAS __attribute__((address_space(3)))
typedef unsigned short bf16;
typedef float f32x4 __attribute__((ext_vector_type(4)));
typedef float f32x2 __attribute__((ext_vector_type(2)));
typedef unsigned u32x4 __attribute__((ext_vector_type(4)));
typedef unsigned u32x2 __attribute__((ext_vector_type(2)));
typedef short bf16x8 __attribute__((ext_vector_type(8)));
typedef float f32x16 __attribute__((ext_vector_type(16)));

constexpr int NB = 16, SEQ = 2048, D = 1024, NTOK = NB * SEQ;
constexpr int INW = 3840, CW = 512, NE = 32, DE = 512, KS = 31;
constexpr int ECAP = NTOK;
constexpr int MAXSLOT = 73728;
constexpr float EPS = 1e-6f;
constexpr float QSCALE = 0.125f * 1.4426950408889634f;

constexpr size_t MiB = 1u << 20;
constexpr size_t WS_CTL = 0, CTL_ZERO_BYTES = 64 * 1024;
constexpr size_t WS_ADA = 1 * MiB;
constexpr size_t WS_ROPE = WS_ADA + 512 * 1024;
constexpr size_t WS_WR = WS_ADA + 640 * 1024;
constexpr size_t WS_H1 = 2 * MiB;
constexpr size_t WS_GLU = 66 * MiB;
constexpr size_t WS_QKV = 98 * MiB;
constexpr size_t WS_Y1 = 66 * MiB;
constexpr size_t WS_GATES = 146 * MiB;
constexpr size_t WS_X1B = 218 * MiB;
constexpr size_t WS_CA = 282 * MiB;
constexpr size_t WS_WIN = 346 * MiB;
constexpr size_t WS_WCA = WS_WIN + (size_t)INW * D * 2;
constexpr size_t WS_WO = WS_WCA + 2 * MiB;
constexpr size_t WS_W1 = WS_WO + 2 * MiB;
constexpr size_t WS_W2 = WS_W1 + 32 * MiB;
constexpr size_t WS_H2F = WS_W2 + 16 * MiB;
constexpr size_t WS_WINF = WS_H2F + 32 * MiB;
constexpr size_t WS_WEND = WS_WINF + 6 * MiB;
constexpr size_t WS_H1F = 282 * MiB;
constexpr size_t WS_TMP = 346 * MiB;
constexpr size_t WS_LIST = 474 * MiB;
constexpr size_t WS_TOK = 478 * MiB;
constexpr size_t WS_PART = 480 * MiB;
constexpr size_t WS_Y2 = 2 * MiB;
constexpr size_t WS_END = 482 * MiB;
static_assert(WS_WEND <= WS_LIST && WS_Y2 + (size_t)MAXSLOT * D * 2 <= WS_GATES && WS_GATES + (size_t)MAXSLOT * DE * 2 <= WS_X1B && WS_X1B + (size_t)NTOK * D * 2 <= WS_CA && WS_GATES + (size_t)NTOK * 2048 * 2 <= WS_CA && WS_CA + (size_t)NTOK * D * 2 <= WS_WIN, "d_ws map");
constexpr int CW_CNT = 0, CW_OFF = 64, CW_ADA = 128, CW_BAR = 4096;

__device__ __forceinline__ float bf2f(unsigned v) { return __uint_as_float(v << 16); }
__device__ __forceinline__ unsigned f2bf(float f) { unsigned u = __float_as_uint(f); return (u + 0x7fffu + ((u >> 16) & 1u)) >> 16; }
__device__ __forceinline__ unsigned pk2(float lo, float hi) { return f2bf(lo) | (f2bf(hi) << 16); }
__device__ __forceinline__ unsigned cvt_pk_bf16(float lo, float hi) { unsigned r; asm volatile("v_cvt_pk_bf16_f32 %0, %1, %2" : "=v"(r) : "v"(lo), "v"(hi)); return r; }
template <int CTRL> __device__ __forceinline__ float dpp_mov(float v) { return __builtin_bit_cast(float, __builtin_amdgcn_update_dpp(0, __builtin_bit_cast(int, v), CTRL, 0xf, 0xf, true)); }
__device__ __forceinline__ float row16_sum(float v) {
    v += dpp_mov<0xB1>(v);
    v += dpp_mov<0x4E>(v);
    v += dpp_mov<0x141>(v);
    v += dpp_mov<0x140>(v);
    return v;
}
__device__ __forceinline__ float wave_sum(float v) {
    v = row16_sum(v);
    { auto rr = __builtin_amdgcn_permlane16_swap(__float_as_uint(v), __float_as_uint(v), false, false); v = __uint_as_float(rr[0]) + __uint_as_float(rr[1]); }
    { auto rr = __builtin_amdgcn_permlane32_swap(__float_as_uint(v), __float_as_uint(v), false, false); v = __uint_as_float(rr[0]) + __uint_as_float(rr[1]); }
    return v;
}
__device__ __forceinline__ float sigmoidf_(float v) { return 1.f / (1.f + __expf(-v)); }
__device__ __forceinline__ float siluf_(float v) { return v / (1.f + __expf(-v)); }
__device__ __forceinline__ float sig_fast(float v) { return __builtin_amdgcn_rcpf(1.f + __builtin_amdgcn_exp2f(v * -1.4426950408889634f)); }
#define LDS_WAIT() asm volatile("s_waitcnt lgkmcnt(0)" ::: "memory")
#define VM_WAIT() asm volatile("s_waitcnt vmcnt(0)" ::: "memory")

__host__ __device__ __forceinline__ int vmap_win(int n) {
    if (n < 512) return 256 * (n >> 7) + (n & 127);
    if (n < 1024) { const int j = n - 512; return 256 * (j >> 7) + 128 + (j & 127); }
    if (n < 1664) { const int idx = n - 1024, hh = idx >> 6, d = idx & 63, tile = 4 + (hh >> 2), wc = hh & 3, bj = (d >> 4) & 1, e = (d < 32) ? (d & 15) : 16 + (d & 15);
        return 256 * tile + 128 * bj + 32 * wc + e; }
    if (n < 1792) { const int idx = n - 1664, vh = idx >> 6, d = idx & 63; return 256 * 6 + 128 * (d >> 5) + 32 * (2 + vh) + (d & 31); }
    if (n < 2816) { const int j = n - 1792; return 256 * (7 + (j >> 7)) + (j & 127); }
    { const int j = n - 2816; return 256 * (7 + (j >> 7)) + 128 + (j & 127); }
}

namespace pg8 {
constexpr int BM = 256, BK = 64, HALF = 128, HTB = HALF * BK * 2  , STAGE_BYTES = 8 * HTB, NXCD = 8, WGM = 8;
__host__ __device__ __forceinline__ int lds_byte(int r, int c) { const int st = (r >> 4) * 2 + (c >> 5), rr = r & 15, cc = c & 31, ob = rr * 64 + cc * 2; return st * 1024 + (ob ^ (((ob >> 9) & 1) << 5)); }
__host__ __device__ __forceinline__ void stage_rc(int b, int& R, int& C) { const int st = b / 1024, sb = b % 1024, swz = sb ^ (((sb >> 9) & 1) << 5); R = (st >> 1) * 16 + swz / 64; C = (st & 1) * 32 + (swz % 64) / 2; }
__host__ __device__ __forceinline__ int perm32(int rho) { const int n = rho >> 4, i = rho & 15; return 8 * (i >> 2) + 4 * n + (i & 3); }

struct Unit { int pm, pn, e, ord; };

struct StaticOrder {
    const void* Bt; int KB; int nM, nN, nwg, G, c;
    __device__ void init(const void* Bt_, int KB_, int M, int N, int G_, int c_) { Bt = Bt_; KB = KB_; nM = M / BM; nN = N / BM; nwg = nM * nN; G = G_; c = c_; }
    __device__ __forceinline__ bool next(int i, Unit& u) const {
        const long L = (long)i * G + c; if (L >= nwg) return false;
        int wgid = (int)L; { const int q = nwg / NXCD, r = nwg % NXCD, xcd = wgid % NXCD, off = wgid / NXCD; wgid = (xcd < r ? xcd * (q + 1) : r * (q + 1) + (xcd - r) * q) + off; }
        const int nig = WGM * nN, gid = wgid / nig, fm = gid * WGM, gsz = (nM - fm) < WGM ? (nM - fm) : WGM;
        u.pm = fm + ((wgid % nig) % gsz); u.pn = (wgid % nig) / gsz; u.e = 0; u.ord = i; return true;
    }
    static constexpr bool GATHER = false;
    __device__ __forceinline__ int arow(const Unit& u, int r) const { return u.pm * BM + r; }
    __device__ __forceinline__ const char* bbase(const Unit& u) const { return (const char*)Bt + (size_t)u.pn * BM * KB; }
};

typedef int v8i32 __attribute__((ext_vector_type(8)));
typedef int v4i32 __attribute__((ext_vector_type(4)));
__device__ __forceinline__ void mfma_fp8_inplace(f32x4& d, const v8i32 a, const v8i32 b, const int scale) {
    asm volatile("v_mfma_scale_f32_16x16x128_f8f6f4 %0, %1, %2, %0, %3, %3 op_sel_hi:[0,0,0]" : "+v"(d) : "v"(a), "v"(b), "v"(scale));
}
__device__ __forceinline__ void mfma_bf16_inplace(f32x4& d, const bf16x8 a, const bf16x8 b) {
    asm volatile("v_mfma_f32_16x16x32_bf16 %0, %1, %2, %0" : "+v"(d) : "v"(a), "v"(b));
}
template <class Epi, class Sched, bool ALIGN_EPI, int DT = 0>
__device__ __forceinline__ void gemm_phase(LAS unsigned char* lds, const void* A, int ldaB_, int KB, const Sched& S, const Epi& E, const void* A8 = nullptr, int kbytes = 0) {
    const int tid = threadIdx.x, wid = __builtin_amdgcn_readfirstlane(tid >> 6), lane = tid & 63, wr = wid >> 2, wc = wid & 3, fr = lane & 15, fq = lane >> 4;
    const int nt_full = (kbytes ? kbytes : KB) / (BK * 2);
    const unsigned ldaB = (unsigned)ldaB_;
    unsigned voffA[2], voffB[2];
#pragma unroll
    for (int i = 0; i < 2; ++i) { int R, C; stage_rc(tid * 16 + i * 8192, R, C); const int Rb = (R & ~31) + perm32(R & 31);
        voffA[i] = (unsigned)R * ldaB + (unsigned)C * 2u; voffB[i] = (unsigned)(Rb * KB + C * 2); }
    const size_t kstep = (size_t)(BK * 2);
    const size_t hstep = (size_t)HALF * KB;
    const size_t hstepA = (size_t)HALF * ldaB;
    const unsigned ldsw = (unsigned)wid * 1024u;
    const int aoff = lds_byte(wr * 64 + fr, fq * 8), boff = lds_byte(wc * 32 + fr, fq * 8);
#define PG8_SA(b, h) (((b) * 2 + (h)) * HTB)
#define PG8_SB(b, h) ((4 + (b) * 2 + (h)) * HTB)
#define PG8_STAGE(bufoff, gbase, voff) do { _Pragma("unroll") for (int _i = 0; _i < 2; ++_i) \
        __builtin_amdgcn_global_load_lds((const unsigned*)((const char*)(gbase) + (voff)[_i]), (LAS unsigned*)(lds + (bufoff) + ldsw + _i * 8192), 16, 0, 0); } while (0)
#define PG8_LDA(dst, b, h) do { _Pragma("unroll") for (int m = 0; m < 4; ++m) _Pragma("unroll") for (int k = 0; k < 2; ++k) dst[m][k] = *(const LAS bf16x8*)(lds + PG8_SA(b, h) + aoff + m * 2048 + k * 1024); } while (0)
#define PG8_LDB(dst, b, h) do { _Pragma("unroll") for (int n = 0; n < 2; ++n) _Pragma("unroll") for (int k = 0; k < 2; ++k) dst[n][k] = *(const LAS bf16x8*)(lds + PG8_SB(b, h) + boff + n * 2048 + k * 1024); } while (0)
#define PG8_CAT(x) __builtin_shufflevector(__builtin_bit_cast(v4i32, (x)[0]), __builtin_bit_cast(v4i32, (x)[1]), 0, 1, 2, 3, 4, 5, 6, 7)
#define PG8_MMA(ai, bj, At, Bt) do { __builtin_amdgcn_s_setprio(1); \
        if (DT == 1 || (DT == 2 && f8cur)) { _Pragma("unroll") for (int m = 0; m < 4; ++m) _Pragma("unroll") for (int n = 0; n < 2; ++n) \
            mfma_fp8_inplace(acc[ai][bj][m][n], PG8_CAT(Bt[n]), PG8_CAT(At[m]), one_scale); } \
        else { _Pragma("unroll") for (int m = 0; m < 4; ++m) _Pragma("unroll") for (int n = 0; n < 2; ++n) _Pragma("unroll") for (int k = 0; k < 2; ++k) \
            { if constexpr (DT == 2) mfma_bf16_inplace(acc[ai][bj][m][n], Bt[n][k], At[m][k]); else acc[ai][bj][m][n] = __builtin_amdgcn_mfma_f32_16x16x32_bf16(Bt[n][k], At[m][k], acc[ai][bj][m][n], 0, 0, 0); } } \
        __builtin_amdgcn_s_setprio(0); } while (0)
#define PG8_WAIT_V(n) asm volatile("s_waitcnt vmcnt(" #n ")" ::: "memory")
#define PG8_WAIT_L(n) asm volatile("s_waitcnt lgkmcnt(" #n ")" ::: "memory")
#define PG8_BAR __builtin_amdgcn_s_barrier()
#define PG8_SCHED __builtin_amdgcn_sched_barrier(0)
#define PG8_MKVA(dst, u) do { _Pragma("unroll") for (int _h = 0; _h < 2; ++_h) _Pragma("unroll") for (int _p = 0; _p < 2; ++_p) { int _R, _C; stage_rc(tid * 16 + _p * 8192, _R, _C); \
        dst[_h][_p] = (unsigned)S.arow(u, _h * HALF + _R) * ldaB + (unsigned)_C * 2u; } } while (0)
#define PG8_STAGE_AC(bufoff, h, kofs) do { if constexpr (Sched::GATHER) PG8_STAGE(bufoff, Ab + (kofs), vA[h]); else PG8_STAGE(bufoff, cA + (h) * hstepA + (kofs), voffA); } while (0)
#define PG8_STAGE_AN(bufoff, h, kofs) do { if constexpr (Sched::GATHER) PG8_STAGE(bufoff, Ab + (kofs), nvA[h]); else PG8_STAGE(bufoff, nA + (h) * hstepA + (kofs), voffA); } while (0)
#define PG8_STAGE_A23(bufoff, h, w) do { if (last) PG8_STAGE_AN(bufoff, h, (size_t)(w) * kstep); else PG8_STAGE_AC(bufoff, h, (size_t)(t + 2 + (w)) * kstep); } while (0)
    Unit cur, nxt; int ui = 0;
    if (!S.next(0, cur)) return;
    f32x4 acc[2][2][4][2];
#pragma unroll
    for (int a = 0; a < 2; ++a)
#pragma unroll
        for (int b = 0; b < 2; ++b)
#pragma unroll
            for (int m = 0; m < 4; ++m)
#pragma unroll
                for (int n = 0; n < 2; ++n) acc[a][b][m][n] = (f32x4){0.f, 0.f, 0.f, 0.f};
    bf16x8 At[4][2], B0[2][2], B1[2][2];
    int one_scale = 0x7f7f7f7f; asm volatile("" : "+v"(one_scale));
    unsigned vA[2][2], nvA[2][2];
    const char* const Ab = (const char*)A;
    const char* cA = Ab; const char* nA = Ab;
    bool f8cur = (DT == 2) && cur.e != 0; int nt = (DT == 2 && f8cur) ? (nt_full >> 1) : nt_full;
#define PG8_ABASE(u) ((DT == 2 && (u).e != 0) ? (const char*)A8 : Ab)
    if constexpr (Sched::GATHER) { PG8_MKVA(vA, cur); } else { cA = PG8_ABASE(cur) + (size_t)S.arow(cur, 0) * ldaB; }
    const char* cB = S.bbase(cur);
    PG8_STAGE(PG8_SB(0, 0), cB, voffB); PG8_STAGE(PG8_SB(0, 1), cB + hstep, voffB); PG8_STAGE_AC(PG8_SA(0, 0), 0, 0); PG8_STAGE_AC(PG8_SA(0, 1), 1, 0);
    if (wr == 1) PG8_BAR;
    PG8_WAIT_V(2); PG8_BAR;
    PG8_STAGE(PG8_SB(1, 0), cB + kstep, voffB); PG8_STAGE_AC(PG8_SA(1, 0), 0, kstep); PG8_STAGE(PG8_SB(1, 1), cB + hstep + kstep, voffB);
    PG8_WAIT_V(6); PG8_BAR;
    for (;;) {
        const bool has_next = S.next(ui + 1, nxt);
        const char* nB = has_next ? S.bbase(nxt) : cB;
        if constexpr (!Sched::GATHER) nA = has_next ? PG8_ABASE(nxt) + (size_t)S.arow(nxt, 0) * ldaB : cA;
#pragma unroll 1
        for (int t = 0; t < nt; t += 2) {
            const bool last = (t == nt - 2);
            if constexpr (Epi::MID) { if (t == (nt >> 1)) { if (wr == 0) PG8_BAR; E.mid(acc, cur, wr, wc, fr, fq); if (wr == 1) PG8_BAR; } }
            if constexpr (Sched::GATHER) { if (last) { if (has_next) { PG8_MKVA(nvA, nxt); } else {
#pragma unroll
                    for (int h = 0; h < 2; ++h)
#pragma unroll
                        for (int p = 0; p < 2; ++p) nvA[h][p] = vA[h][p]; } } }
            const char* b2 = last ? nB : cB + (size_t)(t + 2) * kstep; const char* b3 = b2 + kstep;
            PG8_LDB(B0, 0, 0); PG8_LDB(B1, 0, 1); PG8_SCHED; PG8_LDA(At, 0, 0); PG8_STAGE_AC(PG8_SA(1, 1), 1, (size_t)(t + 1) * kstep);
            PG8_WAIT_V(8); PG8_WAIT_L(0); PG8_BAR; PG8_MMA(0, 0, At, B0); PG8_MMA(0, 1, At, B1); PG8_BAR; PG8_SCHED;
            PG8_LDA(At, 0, 1); PG8_STAGE(PG8_SB(0, 0), b2, voffB); PG8_STAGE(PG8_SB(0, 1), b2 + hstep, voffB); PG8_STAGE_A23(PG8_SA(0, 0), 0, 0);
            PG8_WAIT_V(8); PG8_WAIT_L(0); PG8_BAR; PG8_MMA(1, 0, At, B0); PG8_MMA(1, 1, At, B1); PG8_BAR; PG8_SCHED;
            PG8_LDB(B0, 1, 0); PG8_LDB(B1, 1, 1); PG8_SCHED; PG8_LDA(At, 1, 0); PG8_STAGE_A23(PG8_SA(0, 1), 1, 0);
            PG8_WAIT_V(8); PG8_WAIT_L(0); PG8_BAR; PG8_MMA(0, 0, At, B0); PG8_MMA(0, 1, At, B1); PG8_BAR; PG8_SCHED;
            PG8_LDA(At, 1, 1); PG8_STAGE(PG8_SB(1, 0), b3, voffB); PG8_STAGE(PG8_SB(1, 1), b3 + hstep, voffB); PG8_STAGE_A23(PG8_SA(1, 0), 0, 1);
            PG8_WAIT_V(8); PG8_WAIT_L(0); PG8_BAR; PG8_MMA(1, 0, At, B0); PG8_MMA(1, 1, At, B1); PG8_BAR; PG8_SCHED;
        }
        if constexpr (ALIGN_EPI) { if (wr == 0) PG8_BAR; }
        if constexpr (DT != 0) asm volatile("s_nop 15\n\ts_nop 15" ::: "memory");
        E(acc, cur, wr, wc, fr, fq);
        if (!has_next) break;
#pragma unroll
        for (int a = 0; a < 2; ++a)
#pragma unroll
            for (int b = 0; b < 2; ++b)
#pragma unroll
                for (int m = 0; m < 4; ++m)
#pragma unroll
                    for (int n = 0; n < 2; ++n) acc[a][b][m][n] = (f32x4){0.f, 0.f, 0.f, 0.f};
        cur = nxt; cB = nB; ++ui;
        if constexpr (DT == 2) { f8cur = cur.e != 0; nt = f8cur ? (nt_full >> 1) : nt_full; }
        if constexpr (Sched::GATHER) {
#pragma unroll
            for (int h = 0; h < 2; ++h)
#pragma unroll
                for (int p = 0; p < 2; ++p) vA[h][p] = nvA[h][p]; } else cA = nA;
        if constexpr (ALIGN_EPI) { if (wr == 1) PG8_BAR; }
    }
    PG8_WAIT_V(0);
    if constexpr (!ALIGN_EPI) { if (wr == 0) PG8_BAR; }
    PG8_BAR;
#undef PG8_ABASE
#undef PG8_STAGE_AC
#undef PG8_STAGE_AN
#undef PG8_STAGE_A23
#undef PG8_SA
#undef PG8_SB
#undef PG8_STAGE
#undef PG8_LDA
#undef PG8_LDB
#undef PG8_MMA
#undef PG8_WAIT_V
#undef PG8_WAIT_L
#undef PG8_BAR
#undef PG8_SCHED
#undef PG8_MKVA
#undef PG8_CAT
}
}
namespace pg8 {
__host__ __device__ __forceinline__ size_t gate_frag_base(int pm, int t, int w) { return ((size_t)((pm * 8 + t) * 8 + w) * 8) * 1024; }
__host__ __device__ __forceinline__ size_t gate_index(int row, int col) {
    const int pm = row >> 8, t = col >> 7, w = 4 * ((row >> 6) & 1) + ((col >> 5) & 3), k = 4 * ((row >> 7) & 1) + ((row >> 4) & 3), l = 16 * ((col >> 3) & 3) + (row & 15);
    return gate_frag_base(pm, t, w) + (size_t)k * 1024 + l * 16 + (col & 7);
}
__device__ __forceinline__ unsigned q8x4(float a, float b, float c, float d) {
    unsigned r = __builtin_amdgcn_cvt_pk_u8_f32(a * 256.f - 0.5f, 0, 0u); r = __builtin_amdgcn_cvt_pk_u8_f32(b * 256.f - 0.5f, 1, r);
    r = __builtin_amdgcn_cvt_pk_u8_f32(c * 256.f - 0.5f, 2, r); return __builtin_amdgcn_cvt_pk_u8_f32(d * 256.f - 0.5f, 3, r);
}
__device__ __forceinline__ void dq8x4(unsigned w, float (&f)[4]) { f[0] = (float)(w & 0xffu) + 0.5f; f[1] = (float)((w >> 8) & 0xffu) + 0.5f; f[2] = (float)((w >> 16) & 0xffu) + 0.5f; f[3] = (float)(w >> 24) + 0.5f; }
constexpr float WSCIN = 32.f;
struct EpiP2 {
    static constexpr bool MID = false;
    bf16* glu; bf16* qkv; bf16* gates; const float* qg; const float* kg; const f32x2* rope;
    __device__ __forceinline__ void operator()(const f32x4 (&acc)[2][2][4][2], const Unit& u, int wr, int wc, int fr, int fq) const {
        const int row0 = u.pm * BM + wr * 64 + fr;
        if (u.pn < 4) {
#pragma unroll
            for (int ai = 0; ai < 2; ++ai)
#pragma unroll
                for (int m = 0; m < 4; ++m) { const size_t row = (size_t)(row0 + ai * HALF + m * 16);
                    constexpr float isg = 1.f / WSCIN;
                    const f32x4 a0 = acc[ai][0][m][0] * isg, a1 = acc[ai][0][m][1] * isg, g0 = acc[ai][1][m][0] * isg, g1 = acc[ai][1][m][1] * isg;
                    u32x4 w; w.x = cvt_pk_bf16(a0[0] * sig_fast(g0[0]), a0[1] * sig_fast(g0[1])); w.y = cvt_pk_bf16(a0[2] * sig_fast(g0[2]), a0[3] * sig_fast(g0[3]));
                    w.z = cvt_pk_bf16(a1[0] * sig_fast(g1[0]), a1[1] * sig_fast(g1[1])); w.w = cvt_pk_bf16(a1[2] * sig_fast(g1[2]), a1[3] * sig_fast(g1[3]));
                    *(u32x4*)(glu + row * CW + u.pn * 128 + wc * 32 + fq * 8) = w; }
        } else if (u.pn < 7) {
            const int hs = (u.pn - 4) * 4 + wc;
            if (hs >= 10) {
#pragma unroll
                for (int ai = 0; ai < 2; ++ai)
#pragma unroll
                    for (int m = 0; m < 4; ++m) { const size_t row = (size_t)(row0 + ai * HALF + m * 16);
#pragma unroll
                        for (int bj = 0; bj < 2; ++bj) { const f32x4 v0 = acc[ai][bj][m][0], v1 = acc[ai][bj][m][1];
                            u32x4 w; w.x = cvt_pk_bf16(v0[0], v0[1]); w.y = cvt_pk_bf16(v0[2], v0[3]); w.z = cvt_pk_bf16(v1[0], v1[1]); w.w = cvt_pk_bf16(v1[2], v1[3]);
                            *(u32x4*)(qkv + row * 768 + hs * 64 + bj * 32 + fq * 8) = w; } }
            } else {
                const float* g = hs < 8 ? qg : kg; const float osc = hs < 8 ? QSCALE : 1.f;
                const int dbase = fq < 2 ? 8 * fq : 8 * fq + 16;
                float g1[8], g2[8];
#pragma unroll
                for (int i = 0; i < 8; ++i) { g1[i] = g[dbase + i] * osc; g2[i] = g[dbase + 16 + i] * osc; }
#pragma unroll
                for (int ai = 0; ai < 2; ++ai)
#pragma unroll
                    for (int m = 0; m < 4; ++m) { const int rowi = row0 + ai * HALF + m * 16; const size_t row = (size_t)rowi;
                        const int s = rowi & (SEQ - 1); const int tabrow = fq < 2 ? (s >> 6) : 32 + (s & 63);
                        const f32x2* tp = rope + tabrow * 16 + 8 * (fq & 1);
                        float ss = 0.f;
#pragma unroll
                        for (int bj = 0; bj < 2; ++bj)
#pragma unroll
                            for (int n = 0; n < 2; ++n) { const f32x4 v = acc[ai][bj][m][n]; ss += (v[0] * v[0] + v[1] * v[1]) + (v[2] * v[2] + v[3] * v[3]); }
                        ss += __shfl_xor(ss, 16); ss += __shfl_xor(ss, 32);
                        const float rstd = rsqrtf(ss * (1.f / 64.f) + EPS);
                        float o1[8], o2[8];
#pragma unroll
                        for (int n = 0; n < 2; ++n)
#pragma unroll
                            for (int j = 0; j < 4; ++j) { const f32x2 cs = tp[4 * n + j];
                                const float x1 = acc[ai][0][m][n][j] * rstd * g1[4 * n + j], x2 = acc[ai][1][m][n][j] * rstd * g2[4 * n + j];
                                o1[4 * n + j] = x1 * cs.x - x2 * cs.y; o2[4 * n + j] = x2 * cs.x + x1 * cs.y; }
                        u32x4 w1, w2;
                        w1.x = cvt_pk_bf16(o1[0], o1[1]); w1.y = cvt_pk_bf16(o1[2], o1[3]); w1.z = cvt_pk_bf16(o1[4], o1[5]); w1.w = cvt_pk_bf16(o1[6], o1[7]);
                        w2.x = cvt_pk_bf16(o2[0], o2[1]); w2.y = cvt_pk_bf16(o2[2], o2[3]); w2.z = cvt_pk_bf16(o2[4], o2[5]); w2.w = cvt_pk_bf16(o2[6], o2[7]);
                        bf16* dst = qkv + row * 768 + hs * 64 + dbase;
                        *(u32x4*)dst = w1; *(u32x4*)(dst + 16) = w2; }
            }
        } else {
            unsigned char* gr = (unsigned char*)gates + gate_frag_base(u.pm, u.pn - 7, wr * 4 + wc) + (fq * 16 + fr) * 16;
#pragma unroll
            for (int ai = 0; ai < 2; ++ai)
#pragma unroll
                for (int m = 0; m < 4; ++m) {
                    float sc[8], sa[8];
#pragma unroll
                    for (int n = 0; n < 2; ++n)
#pragma unroll
                        for (int j = 0; j < 4; ++j) {
                            const float dc = 1.f + __builtin_amdgcn_exp2f(acc[ai][0][m][n][j] * (-1.4426950408889634f / WSCIN)), da = 1.f + __builtin_amdgcn_exp2f(acc[ai][1][m][n][j] * (-1.4426950408889634f / WSCIN));
                            const float rinv = __builtin_amdgcn_rcpf(dc * da); sc[4 * n + j] = rinv * da; sa[4 * n + j] = rinv * dc; }
                    *(u32x4*)(gr + (ai * 4 + m) * 1024) = (u32x4){q8x4(sc[0], sc[1], sc[2], sc[3]), q8x4(sc[4], sc[5], sc[6], sc[7]), q8x4(sa[0], sa[1], sa[2], sa[3]), q8x4(sa[4], sa[5], sa[6], sa[7])}; }
        }
    }
};
__device__ __forceinline__ void unpack8(const u32x4 w, float (&f)[8]) {
    f[0] = bf2f(w.x & 0xffffu); f[1] = bf2f(w.x >> 16); f[2] = bf2f(w.y & 0xffffu); f[3] = bf2f(w.y >> 16);
    f[4] = bf2f(w.z & 0xffffu); f[5] = bf2f(w.z >> 16); f[6] = bf2f(w.w & 0xffffu); f[7] = bf2f(w.w >> 16);
}
struct EpiP4 {
    static constexpr bool MID = true;
    const bf16* gates; bf16* merged;
    __device__ __forceinline__ void mid(f32x4 (&acc)[2][2][4][2], const Unit& u, int wr, int wc, int fr, int fq) const {
        asm volatile("" ::: "memory");
        u32x4 rr[2][8];
#pragma unroll
        for (int bj = 0; bj < 2; ++bj) { const unsigned char* gp = (const unsigned char*)gates + gate_frag_base(u.pm, 2 * u.pn + bj, wr * 4 + wc) + (fq * 16 + fr) * 16;
#pragma unroll
            for (int k = 0; k < 8; ++k) rr[bj][k] = *(const u32x4*)(gp + k * 1024); }
#pragma unroll
        for (int bj = 0; bj < 2; ++bj)
#pragma unroll
            for (int k = 0; k < 8; ++k)
#pragma unroll
                for (int n = 0; n < 2; ++n) { float c[4], a[4]; dq8x4(n ? rr[bj][k].y : rr[bj][k].x, c); dq8x4(n ? rr[bj][k].w : rr[bj][k].z, a);
#pragma unroll
                    for (int j = 0; j < 4; ++j) acc[k >> 2][bj][k & 3][n][j] *= c[j] * __builtin_amdgcn_rcpf(a[j]); }
        asm volatile("" ::: "memory");
    }
    __device__ __forceinline__ void operator()(const f32x4 (&acc)[2][2][4][2], const Unit& u, int wr, int wc, int fr, int fq) const {
        const int row0 = u.pm * BM + wr * 64 + fr, col0 = u.pn * BM + wc * 32 + fq * 8;
        u32x2 rr[2][8];
#pragma unroll
        for (int bj = 0; bj < 2; ++bj) { const unsigned char* gp = (const unsigned char*)gates + gate_frag_base(u.pm, 2 * u.pn + bj, wr * 4 + wc) + (fq * 16 + fr) * 16 + 8;
#pragma unroll
            for (int k = 0; k < 8; ++k) rr[bj][k] = *(const u32x2*)(gp + k * 1024); }
        asm volatile("" ::: "memory");
#pragma unroll
        for (int bj = 0; bj < 2; ++bj)
#pragma unroll
            for (int k = 0; k < 8; ++k) { const size_t row = (size_t)(row0 + (k >> 2) * HALF + (k & 3) * 16);
                float a0[4], a1[4]; dq8x4(rr[bj][k].x, a0); dq8x4(rr[bj][k].y, a1); constexpr float s = 1.f / 256.f;
                const f32x4 v0 = acc[k >> 2][bj][k & 3][0] * s, v1 = acc[k >> 2][bj][k & 3][1] * s;
                u32x4 w; w.x = cvt_pk_bf16(v0[0] * a0[0], v0[1] * a0[1]); w.y = cvt_pk_bf16(v0[2] * a0[2], v0[3] * a0[3]); w.z = cvt_pk_bf16(v1[0] * a1[0], v1[1] * a1[1]); w.w = cvt_pk_bf16(v1[2] * a1[2], v1[3] * a1[3]);
                *(u32x4*)(merged + row * D + col0 + bj * HALF) = w; }
    }
};
struct EpiP5 {
    static constexpr bool MID = false;
    bf16* y1; float* part;
    __device__ __forceinline__ void operator()(const f32x4 (&acc)[2][2][4][2], const Unit& u, int wr, int wc, int fr, int fq) const {
        const int row0 = u.pm * BM + wr * 64 + fr, col0 = u.pn * BM + wc * 32 + fq * 8;
#pragma unroll
        for (int ai = 0; ai < 2; ++ai)
#pragma unroll
            for (int m = 0; m < 4; ++m) { const size_t row = (size_t)(row0 + ai * HALF + m * 16); float ss = 0.f;
#pragma unroll
                for (int bj = 0; bj < 2; ++bj) { const f32x4 v0 = acc[ai][bj][m][0], v1 = acc[ai][bj][m][1];
                    ss += (v0[0] * v0[0] + v0[1] * v0[1]) + (v0[2] * v0[2] + v0[3] * v0[3]) + (v1[0] * v1[0] + v1[1] * v1[1]) + (v1[2] * v1[2] + v1[3] * v1[3]);
                    u32x4 w; w.x = cvt_pk_bf16(v0[0], v0[1]); w.y = cvt_pk_bf16(v0[2], v0[3]); w.z = cvt_pk_bf16(v1[0], v1[1]); w.w = cvt_pk_bf16(v1[2], v1[3]);
                    *(u32x4*)(y1 + row * D + col0 + bj * HALF) = w; }
                ss += __shfl_xor(ss, 16); ss += __shfl_xor(ss, 32);
                if (fq == 0) part[row * 16 + u.pn * 4 + wc] = ss; }
    }
};
__device__ __forceinline__ unsigned pk4_fp8(float a, float b, float c, float d) { int r = __builtin_amdgcn_cvt_pk_fp8_f32(a, b, 0, false); r = __builtin_amdgcn_cvt_pk_fp8_f32(c, d, r, true); return (unsigned)r; }
constexpr float WSC1 = 32.f, WSC2 = 16.f;
struct EpiMoe1 {
    static constexpr bool MID = false;
    unsigned char* act;
    __device__ __forceinline__ void operator()(const f32x4 (&acc)[2][2][4][2], const Unit& u, int wr, int wc, int fr, int fq) const {
        const int row0 = u.pm * BM + wr * 64 + fr; constexpr float is = 1.f / WSC1;
#pragma unroll
        for (int ai = 0; ai < 2; ++ai)
#pragma unroll
            for (int m = 0; m < 4; ++m) { const size_t row = (size_t)(row0 + ai * HALF + m * 16);
                const f32x4 g0 = acc[ai][0][m][0] * is, g1 = acc[ai][0][m][1] * is, u0 = acc[ai][1][m][0] * is, u1 = acc[ai][1][m][1] * is;
                u32x2 w; w.x = pk4_fp8(g0[0] * sig_fast(g0[0]) * u0[0], g0[1] * sig_fast(g0[1]) * u0[1], g0[2] * sig_fast(g0[2]) * u0[2], g0[3] * sig_fast(g0[3]) * u0[3]);
                w.y = pk4_fp8(g1[0] * sig_fast(g1[0]) * u1[0], g1[1] * sig_fast(g1[1]) * u1[1], g1[2] * sig_fast(g1[2]) * u1[2], g1[3] * sig_fast(g1[3]) * u1[3]);
                *(u32x2*)(act + row * DE + u.pn * 128 + wc * 32 + fq * 8) = w; }
    }
};
constexpr float YSC = 8.f;
struct EpiMoe2 {
    static constexpr bool MID = false;
    unsigned char* y2;
    __device__ __forceinline__ void operator()(const f32x4 (&acc)[2][2][4][2], const Unit& u, int wr, int wc, int fr, int fq) const {
        const int row0 = u.pm * BM + wr * 64 + fr, col0 = u.pn * BM + wc * 32 + fq * 8; constexpr float is = YSC / WSC2;
#pragma unroll
        for (int ai = 0; ai < 2; ++ai)
#pragma unroll
            for (int m = 0; m < 4; ++m) { const size_t row = (size_t)(row0 + ai * HALF + m * 16);
#pragma unroll
                for (int bj = 0; bj < 2; ++bj) { const f32x4 v0 = acc[ai][bj][m][0] * is, v1 = acc[ai][bj][m][1] * is;
                    *(u32x2*)(y2 + row * D + col0 + bj * HALF) = (u32x2){pk4_fp8(v0[0], v0[1], v0[2], v0[3]), pk4_fp8(v1[0], v1[1], v1[2], v1[3])}; } }
    }
};
constexpr int MOE_MAXU = 8;
template <bool GATHER_> struct MoeOrder {
    static constexpr bool GATHER = GATHER_;
    const LAS int* UT; const LAS int* RT; const void* W; size_t estride; int KB;
    __device__ __forceinline__ bool next(int i, Unit& u) const {
        if (i >= MOE_MAXU) return false;
        const int v = __builtin_amdgcn_readfirstlane(UT[i * 4 + 3]); if (!v) return false;
        u.pm = __builtin_amdgcn_readfirstlane(UT[i * 4 + 0]); u.pn = __builtin_amdgcn_readfirstlane(UT[i * 4 + 1]); u.e = __builtin_amdgcn_readfirstlane(UT[i * 4 + 2]); u.ord = i; return true;
    }
    __device__ __forceinline__ int arow(const Unit& u, int r) const { return GATHER ? RT[u.ord * 256 + r] : u.pm * BM + r; }
    __device__ __forceinline__ const char* bbase(const Unit& u) const { return (const char*)W + (size_t)u.e * estride + (size_t)u.pn * BM * KB; }
};
__host__ __device__ __forceinline__ int winf_row(int vrow) { return vrow < 1024 ? vrow : vrow - 768; }
template <bool F8> struct P2Order {
    static constexpr bool GATHER = false;
    const char* W; int v, G;
    __device__ __forceinline__ bool next(int i, Unit& u) const {
        u.ord = i; u.e = F8 ? 1 : 0;
        if (!F8) { int L;
            if (G == 256) { if (i >= (v < 128 ? 2 : 1)) return false; L = 256 * i + v; } else { L = i * G + v; if (L >= 384) return false; }
            u.pm = L / 3; u.pn = 4 + (L - 3 * u.pm); return true; }
        int f;
        if (G == 256) { if (i >= (v < 128 ? 5 : 7)) return false; f = v >= 128 ? (v - 128) * 7 + i : 896 + 5 * v + i; } else { f = i * G + v; if (f >= 1536) return false; }
        u.pm = f / 12; const int t = f - 12 * u.pm; u.pn = t < 4 ? t : t + 3; return true;
    }
    __device__ __forceinline__ int arow(const Unit& u, int r) const { return u.pm * BM + r; }
    __device__ __forceinline__ const char* bbase(const Unit& u) const { return W + (size_t)(F8 ? winf_row(u.pn * BM) : u.pn * BM) * 2048; }
};
struct PanelOrder {
    static constexpr bool GATHER = false;
    const char* W; int v, G, KB;
    __device__ __forceinline__ bool next(int i, Unit& u) const { const int L = G * i + v; if (L >= (NTOK / BM) * 4) return false; u.pm = L >> 2; u.pn = L & 3; u.e = 0; u.ord = i; return true; }
    __device__ __forceinline__ int arow(const Unit& u, int r) const { return u.pm * BM + r; }
    __device__ __forceinline__ const char* bbase(const Unit& u) const { return W + (size_t)u.pn * BM * KB; }
};
}
namespace attn_body {
using bf16=__hip_bfloat16;
using bf16x8=__attribute__((ext_vector_type(8)))short;
using s16x4=__attribute__((ext_vector_type(4)))short;
using f32x16=__attribute__((ext_vector_type(16)))float;
using u32x4=__attribute__((ext_vector_type(4)))unsigned;
constexpr int BATCH=16,NHEAD=8,SEQ=2048,D=64,DM=768,OPITCH=1024;
constexpr int NW=8,QBLK=32,QB=QBLK*NW,KVBLK=64,NQB=SEQ/QB;
constexpr int ATTN_UNIT_ROWS=QB;
__device__ __forceinline__ int crow(int r,int hi){return (r&3)+8*(r>>2)+4*hi;}
#define SBAR() __builtin_amdgcn_sched_barrier(0)
__device__ __forceinline__ void cmask(f32x16&p0,f32x16&p1,int jb,int qrel,int hi){
  const float NEG=-INFINITY; int kb=64*jb+4*hi;
  #pragma unroll
  for(int r=0;r<16;++r){int kv=kb+(r&3)+8*(r>>2); if(kv>qrel)p0[r]=NEG; if(kv+32>qrel)p1[r]=NEG;}
}

constexpr int NSLOT=3, SLOTB=8192;
constexpr int LDS_K=0, LDS_V=NSLOT*SLOTB, LDS_WS=2*NSLOT*SLOTB, LDS_OST=LDS_WS+NW*64*4, LDS_BYTES=LDS_OST+NW*4096;
constexpr float C2=0.125f*1.4426950408889634f;
__device__ __forceinline__ void glds16(const void*gsrc,unsigned lds_dst){unsigned keep;
  asm volatile("s_mov_b32 %0, m0\n\ts_mov_b32 m0, %2\n\ts_nop 0\n\tglobal_load_lds_dwordx4 %1, off\n\ts_mov_b32 m0, %0":"=&s"(keep):"v"(gsrc),"s"(lds_dst):"memory");}
__device__ __forceinline__ float max3f(float a,float b,float c){float r;asm("v_max3_f32 %0, %1, %2, %3":"=v"(r):"v"(a),"v"(b),"v"(c));return r;}
__device__ __forceinline__ float max2f(float a,float b){float r;asm("v_max_f32_e32 %0, %1, %2":"=v"(r):"v"(a),"v"(b));return r;}
__device__ __forceinline__ float fadd_s(float a,float b){float r;asm("v_add_f32_e32 %0, %1, %2":"=v"(r):"v"(a),"v"(b));return r;}
__device__ __forceinline__ float fsub_s(float a,float b){float r;asm("v_sub_f32_e32 %0, %1, %2":"=v"(r):"v"(a),"v"(b));return r;}
typedef float f32x2_t __attribute__((ext_vector_type(2))); typedef __bf16 bf16x2_t __attribute__((ext_vector_type(2)));
__device__ __forceinline__ unsigned cvtpk_s(float lo,float hi){f32x2_t v={lo,hi};bf16x2_t b=__builtin_convertvector(v,bf16x2_t);return __builtin_bit_cast(unsigned,b);}
#define WAIT_BAR(N) asm volatile("s_waitcnt vmcnt(" #N ") lgkmcnt(0)\n\ts_barrier":::"memory")

__device__ __forceinline__ void qkt(f32x16&p0,f32x16&p1,const char*Kslot,const bf16x8*qr,const f32x16&negm,int r32,int hi){
  const char*kb=Kslot+hi*1024+r32*16;
  #pragma unroll
  for(int d0=0;d0<4;++d0){
    const bf16x8 b0=*reinterpret_cast<const bf16x8*>(kb+d0*2048);
    const bf16x8 b1=*reinterpret_cast<const bf16x8*>(kb+d0*2048+512);
    if(d0==0){p0=__builtin_amdgcn_mfma_f32_32x32x16_bf16(b0,qr[0],negm,0,0,0);p1=__builtin_amdgcn_mfma_f32_32x32x16_bf16(b1,qr[0],negm,0,0,0);}
    else{p0=__builtin_amdgcn_mfma_f32_32x32x16_bf16(b0,qr[d0],p0,0,0,0);p1=__builtin_amdgcn_mfma_f32_32x32x16_bf16(b1,qr[d0],p1,0,0,0);}}
}
typedef __attribute__((address_space(3))) const char* lds_cptr;
typedef short v4i16_t __attribute__((ext_vector_type(4)));
__device__ __forceinline__ void kload8(bf16x8*kf,lds_cptr kp){
  kf[0]=*(const __attribute__((address_space(3))) bf16x8*)(kp);      kf[1]=*(const __attribute__((address_space(3))) bf16x8*)(kp+512);
  kf[2]=*(const __attribute__((address_space(3))) bf16x8*)(kp+2048); kf[3]=*(const __attribute__((address_space(3))) bf16x8*)(kp+2560);
  kf[4]=*(const __attribute__((address_space(3))) bf16x8*)(kp+4096); kf[5]=*(const __attribute__((address_space(3))) bf16x8*)(kp+4608);
  kf[6]=*(const __attribute__((address_space(3))) bf16x8*)(kp+6144); kf[7]=*(const __attribute__((address_space(3))) bf16x8*)(kp+6656);
}
__device__ __forceinline__ void kload2(bf16x8*kf,lds_cptr kp,int j){ kf[2*j]=*(const __attribute__((address_space(3))) bf16x8*)(kp+j*2048); kf[2*j+1]=*(const __attribute__((address_space(3))) bf16x8*)(kp+j*2048+512); }
__device__ __forceinline__ s16x4 vtr(lds_cptr p){ return __builtin_bit_cast(s16x4,__builtin_amdgcn_ds_read_tr16_b64_v4i16((__attribute__((address_space(3))) v4i16_t*)p)); }
__device__ __forceinline__ float rowmax(const f32x16&p0,const f32x16&p1){
  float a=max3f(p0[0],p0[1],p1[0]),b=max3f(p0[2],p0[3],p1[1]);a=max3f(a,p1[2],p1[3]);
  #pragma unroll
  for(int r=4;r<16;r+=4){a=max3f(a,p0[r],p0[r+1]);b=max3f(b,p0[r+2],p0[r+3]);a=max3f(a,p1[r],p1[r+1]);b=max3f(b,p1[r+2],p1[r+3]);}
  const float m=max2f(a,b);
  auto rr=__builtin_amdgcn_permlane32_swap(__float_as_uint(m),__float_as_uint(m),false,false);
  return max2f(__uint_as_float(rr[0]),__uint_as_float(rr[1]));
}
__device__ __forceinline__ void pv(f32x16*o,int vb,bf16x8 pa0,bf16x8 pa1,bf16x8 pa2,bf16x8 pa3){
  #pragma unroll
  for(int d0=0;d0<2;++d0){s16x4 lo[4],hi[4];
    #pragma unroll
    for(int ks=0;ks<4;++ks){
      asm volatile("ds_read_b64_tr_b16 %0,%1 offset:%c2":"=&v"(lo[ks]):"v"(vb),"i"(d0*4096+ks*1024):"memory");
      asm volatile("ds_read_b64_tr_b16 %0,%1 offset:%c2":"=&v"(hi[ks]):"v"(vb),"i"(d0*4096+ks*1024+512):"memory");}
    asm volatile("s_waitcnt lgkmcnt(0)":::"memory");SBAR();
    #define PK(k) (bf16x8){lo[k][0],lo[k][1],lo[k][2],lo[k][3],hi[k][0],hi[k][1],hi[k][2],hi[k][3]}
    o[d0]=__builtin_amdgcn_mfma_f32_32x32x16_bf16(pa0,PK(0),o[d0],0,0,0);
    o[d0]=__builtin_amdgcn_mfma_f32_32x32x16_bf16(pa1,PK(1),o[d0],0,0,0);
    o[d0]=__builtin_amdgcn_mfma_f32_32x32x16_bf16(pa2,PK(2),o[d0],0,0,0);
    o[d0]=__builtin_amdgcn_mfma_f32_32x32x16_bf16(pa3,PK(3),o[d0],0,0,0);
    #undef PK
  }
}

#ifndef ATTN_STORE16
#define ATTN_STORE16(p,v) (*(u32x4*)(p)=(v))
#endif
template<int THRL> __device__ __forceinline__ void attn_unit(int b,int h,int kvh,int qb,const bf16*Q,const bf16*__restrict__ K,const bf16*__restrict__ V,bf16*O,char*shm){
  const int tid=threadIdx.x,lane=tid&63,r32=lane&31,hi=lane>>5; const int wid=__builtin_amdgcn_readfirstlane(tid>>6);
  const long rowbase=(long)b*SEQ; const int q0=qb*QB;
  const bf16*Qw=Q+(rowbase+q0+wid*QBLK)*DM+h*D;
  const bf16*Kh=K+rowbase*DM+kvh*D,*Vh=V+rowbase*DM+kvh*D;
  const unsigned lds0=(unsigned)(uintptr_t)shm;
  float*wsf=(float*)(shm+LDS_WS)+wid*64;
  const bf16*ksrc=Kh+(long)lane*DM+wid*8;
  const bf16*vsrc=Vh+(long)(16*(wid&3)+(lane>>2))*DM+(wid>>2)*32+(lane&3)*8;
  const unsigned kdst=lds0+LDS_K+wid*1024, vdst=lds0+LDS_V+wid*1024;
  #define DMA_K(t,slot) glds16(ksrc+(long)(t)*KVBLK*DM,(unsigned)__builtin_amdgcn_readfirstlane(kdst+(slot)))
  #define DMA_V(t,slot) glds16(vsrc+(long)(t)*KVBLK*DM,(unsigned)__builtin_amdgcn_readfirstlane(vdst+(slot)))
  const int vb0=(int)(lds0+LDS_V)+((lane>>4)&1)*32+(lane&3)*8+(4*hi+((lane&15)>>2))*64;
  const char*Kbase=shm+LDS_K; bf16x8 kf[8];
  const lds_cptr shm3=(lds_cptr)shm; const lds_cptr kp0=shm3+LDS_K+hi*1024+r32*16; const lds_cptr vp0=shm3+LDS_V+((lane>>4)&1)*32+(lane&3)*8+(4*hi+((lane&15)>>2))*64;
  const int NT=SEQ/KVBLK;
  DMA_K(0,0);DMA_V(0,0);DMA_K(1,SLOTB);
  bf16x8 qr[4];
  #pragma unroll
  for(int d0=0;d0<4;++d0)qr[d0]=*reinterpret_cast<const bf16x8*>(&Qw[(long)r32*DM+d0*16+hi*8]);
  float mhat=0.f,l_reg=0.f;f32x16 o[2];o[0]=f32x16{};o[1]=f32x16{};f32x16 negm=f32x16{};asm volatile("":"+v"(negm));

  #define CMASK(P0,P1,t) do{}while(0)
  bool resc=false;
  #define START(P0,P1) do{ const float rm=rowmax(P0,P1); resc=false; \
    { const float dl=rm; mhat=fadd_s(mhat,dl); \
      _Pragma("unroll") for(int r=0;r<16;++r){P0[r]=fsub_s(P0[r],dl);P1[r]=fsub_s(P1[r],dl);} \
      _Pragma("unroll") for(int r=0;r<16;++r)negm[r]=-mhat; asm volatile("":"+v"(negm)); } \
    _Pragma("unroll") for(int r=0;r<16;++r)P0[r]=__builtin_amdgcn_exp2f(P0[r]); }while(0)
  #define RESC() do{ if(resc){ asm volatile("s_waitcnt lgkmcnt(0)":::"memory"); \
      _Pragma("unroll") for(int d_=0;d_<2;++d_) _Pragma("unroll") for(int r=0;r<16;++r)o[d_][r]*=wsf[crow(r,hi)]; } }while(0)
  f32x16 pA0,pA1,pB0,pB1;
  int sl_prev=0,sl_cur=0,sl_next=SLOTB;
  #define ROT() do{sl_prev=sl_cur;sl_cur=sl_next;sl_next=(sl_next==(NSLOT-1)*SLOTB)?0:sl_next+SLOTB;}while(0)
  DMA_K(2,2*SLOTB);
  WAIT_BAR(3);
  qkt(pA0,pA1,Kbase,qr,negm,r32,hi);asm volatile("s_nop 15\n\ts_nop 7":"+v"(pA0),"+v"(pA1));CMASK(pA0,pA1,0);
  START(pA0,pA1);
  _Pragma("unroll") for(int r=0;r<16;++r)pA1[r]=__builtin_amdgcn_exp2f(pA1[r]);
  WAIT_BAR(0);
  DMA_K(3,0);DMA_V(1,SLOTB);
  ROT();
  kload8(kf,kp0+sl_cur);
  WAIT_BAR(2);
  s16x4 vlo[8],vhi[8]; u32x4 pw0,pw1,pw2,pw3;
  #define PKW(P,B) cvtpk_s(P[B],P[B+1])
  #define PAF(k) __builtin_bit_cast(bf16x8,pw##k)
  #define VFR(i) (bf16x8){vlo[i][0],vlo[i][1],vlo[i][2],vlo[i][3],vhi[i][0],vhi[i][1],vhi[i][2],vhi[i][3]}
  #define PIN(x) asm volatile("":"+v"(x))
  #define MX3(a,b,c) __builtin_fmaxf(__builtin_fmaxf((a),(b)),(c))
  #define GAPA(MF,A0,A1,A2,A3,W0,W1,PW) do{ MF; sacc+=A0; sacc+=A1; sacc+=A2; sacc+=A3; PIN(sacc); W0; W1; PIN(PW); SBAR(); }while(0)
  #define EX(v) __builtin_amdgcn_exp2f(v)
  #define GAPB(MF,X,B) do{ MF; X[B]=EX(X[B]); X[B+1]=EX(X[B+1]); X[B+2]=EX(X[B+2]); X[B+3]=EX(X[B+3]); PIN(X); SBAR(); }while(0)
  #define VRD(i) do{ vlo[i]=vtr(vp_+(((i)>>2)*4096+((i)&3)*1024)); vhi[i]=vtr(vp_+(((i)>>2)*4096+((i)&3)*1024+512)); }while(0)
  #define KRD(G,j) do{ if(G){ kload2(kf,kp0+sl_next,j); SBAR(); } }while(0)
  #define STEP(C0,C1,P0,P1,t,GK,GV,GL) do{ SBAR(); \
    const lds_cptr vp_=vp0+sl_prev; \
    VRD(0); SBAR(); float sacc=(P0[0]+P0[1]); \
    GAPA(C0=__builtin_amdgcn_mfma_f32_32x32x16_bf16(kf[0],qr[0],negm,0,0,0), P0[2],P0[3],P0[4],P0[5],     pw0[0]=PKW(P0,0), pw0[1]=PKW(P0,2), pw0); \
    VRD(4); SBAR(); GAPA(C1=__builtin_amdgcn_mfma_f32_32x32x16_bf16(kf[1],qr[0],negm,0,0,0), P0[6],P0[7],P0[8],P0[9],     pw0[2]=PKW(P0,4), pw0[3]=PKW(P0,6), pw0); \
    VRD(1); SBAR(); GAPA(C0=__builtin_amdgcn_mfma_f32_32x32x16_bf16(kf[2],qr[1],C0,0,0,0),   P0[10],P0[11],P0[12],P0[13], pw1[0]=PKW(P0,8), pw1[1]=PKW(P0,10), pw1); \
    VRD(5); SBAR(); GAPA(C1=__builtin_amdgcn_mfma_f32_32x32x16_bf16(kf[3],qr[1],C1,0,0,0),   P0[14],P0[15],P1[0],P1[1],   pw1[2]=PKW(P0,12),pw1[3]=PKW(P0,14), pw1); \
    VRD(2); SBAR(); GAPA(C0=__builtin_amdgcn_mfma_f32_32x32x16_bf16(kf[4],qr[2],C0,0,0,0),   P1[2],P1[3],P1[4],P1[5],     pw2[0]=PKW(P1,0), pw2[1]=PKW(P1,2), pw2); \
    VRD(6); SBAR(); GAPA(C1=__builtin_amdgcn_mfma_f32_32x32x16_bf16(kf[5],qr[2],C1,0,0,0),   P1[6],P1[7],P1[8],P1[9],     pw2[2]=PKW(P1,4), pw2[3]=PKW(P1,6), pw2); \
    VRD(3); SBAR(); GAPA(C0=__builtin_amdgcn_mfma_f32_32x32x16_bf16(kf[6],qr[3],C0,0,0,0),   P1[10],P1[11],P1[12],P1[13], pw3[0]=PKW(P1,8), pw3[1]=PKW(P1,10), pw3); \
    VRD(7); SBAR(); GAPA(C1=__builtin_amdgcn_mfma_f32_32x32x16_bf16(kf[7],qr[3],C1,0,0,0),   P1[14],P1[15],0.f,0.f,       pw3[2]=PKW(P1,12),pw3[3]=PKW(P1,14), pw3); \
    l_reg+=sacc; \
    if(GK){DMA_K((t)+3,sl_cur);} if(GV){DMA_V((t)+1,sl_next);} \
    CMASK(C0,C1,t); \
    { float a=MX3(C0[0],C0[1],C1[0]),b=MX3(C0[2],C0[3],C1[1]); a=MX3(a,C1[2],C1[3]); \
      _Pragma("unroll") for(int r=4;r<16;r+=4){a=MX3(a,C0[r],C0[r+1]);b=MX3(b,C0[r+2],C0[r+3]);a=MX3(a,C1[r],C1[r+1]);b=MX3(b,C1[r+2],C1[r+3]);} \
      float rm=__builtin_fmaxf(a,b); { auto rr=__builtin_amdgcn_permlane32_swap(__float_as_uint(rm),__float_as_uint(rm),false,false); rm=__builtin_fmaxf(__uint_as_float(rr[0]),__uint_as_float(rr[1])); } \
      resc=false; \
      if(__builtin_expect(__any(rm>(float)THRL),0)){ const float dl=__builtin_fmaxf(rm,0.f); mhat+=dl; \
        _Pragma("unroll") for(int r=0;r<16;++r){C0[r]-=dl;C1[r]-=dl;} \
        _Pragma("unroll") for(int r=0;r<16;++r)negm[r]=-mhat; asm volatile("":"+v"(negm)); \
        const float f=__builtin_amdgcn_exp2f(-dl); l_reg*=f; if(hi==0)wsf[r32]=f; resc=true; } } \
    SBAR(); \
    GAPB(o[0]=__builtin_amdgcn_mfma_f32_32x32x16_bf16(PAF(0),VFR(0),o[0],0,0,0), C0,0); \
    GAPB(o[1]=__builtin_amdgcn_mfma_f32_32x32x16_bf16(PAF(0),VFR(4),o[1],0,0,0), C0,4); \
    KRD(GL,0); GAPB(o[0]=__builtin_amdgcn_mfma_f32_32x32x16_bf16(PAF(1),VFR(1),o[0],0,0,0), C0,8); \
    KRD(GL,1); GAPB(o[1]=__builtin_amdgcn_mfma_f32_32x32x16_bf16(PAF(1),VFR(5),o[1],0,0,0), C0,12); \
    KRD(GL,2); GAPB(o[0]=__builtin_amdgcn_mfma_f32_32x32x16_bf16(PAF(2),VFR(2),o[0],0,0,0), C1,0); \
    KRD(GL,3); GAPB(o[1]=__builtin_amdgcn_mfma_f32_32x32x16_bf16(PAF(2),VFR(6),o[1],0,0,0), C1,4); \
    GAPB(o[0]=__builtin_amdgcn_mfma_f32_32x32x16_bf16(PAF(3),VFR(3),o[0],0,0,0), C1,8); \
    GAPB(o[1]=__builtin_amdgcn_mfma_f32_32x32x16_bf16(PAF(3),VFR(7),o[1],0,0,0), C1,12); \
    }while(0)
  int t=1;
  #undef CMASK
  #define CMASK(P0,P1,t) do{}while(0)
  for(;t+5<NT;t+=2){
    STEP(pB0,pB1,pA0,pA1,t,true,true,true);     WAIT_BAR(2); RESC(); ROT();
    STEP(pA0,pA1,pB0,pB1,t+1,true,true,true);   WAIT_BAR(2); RESC(); ROT();
  }
  #undef CMASK
  #define CMASK(P0,P1,t) do{}while(0)
  #define ENDW(tt) do{ if((tt)+3<NT){WAIT_BAR(2);} else if((tt)+2<NT){WAIT_BAR(1);} else {WAIT_BAR(0);} }while(0)
  for(;t+1<NT;t+=2){
    STEP(pB0,pB1,pA0,pA1,t,(t+3<NT),(t+1<NT),(t+1<NT));       ENDW(t);   RESC(); ROT();
    STEP(pA0,pA1,pB0,pB1,t+1,(t+4<NT),(t+2<NT),(t+2<NT));     ENDW(t+1); RESC(); ROT();
  }
  STEP(pB0,pB1,pA0,pA1,NT-1,false,false,false); RESC();
  { float sacc=pB0[0]+pB0[1]; _Pragma("unroll") for(int r=2;r<16;++r)sacc+=pB0[r]; _Pragma("unroll") for(int r=0;r<16;++r)sacc+=pB1[r]; l_reg+=sacc;
    pw0=(u32x4){PKW(pB0,0),PKW(pB0,2),PKW(pB0,4),PKW(pB0,6)};pw1=(u32x4){PKW(pB0,8),PKW(pB0,10),PKW(pB0,12),PKW(pB0,14)};pw2=(u32x4){PKW(pB1,0),PKW(pB1,2),PKW(pB1,4),PKW(pB1,6)};pw3=(u32x4){PKW(pB1,8),PKW(pB1,10),PKW(pB1,12),PKW(pB1,14)};
    SBAR(); pv(o,vb0+sl_cur,PAF(0),PAF(1),PAF(2),PAF(3)); }
  #undef PKW
  #undef PAF
  #undef VFR
  #undef PIN
  #undef MX3
  #undef GAPA
  #undef GAPB
  #undef EX
  #undef VRD
  #undef KRD
  #undef STEP
  #undef ENDW
  {auto rr=__builtin_amdgcn_permlane32_swap(__float_as_uint(l_reg),__float_as_uint(l_reg),false,false);l_reg=__uint_as_float(rr[0])+__uint_as_float(rr[1]);}
  if(hi==0)wsf[32+r32]=l_reg;asm volatile("s_waitcnt lgkmcnt(0)":::"memory");
  float rli[16];
  #pragma unroll
  for(int r=0;r<16;++r)rli[r]=__builtin_amdgcn_rcpf(wsf[32+crow(r,hi)]);
  bf16*Ow=O+(rowbase+q0+wid*QBLK)*OPITCH+h*D;
  { bf16*stg=(bf16*)(shm+LDS_OST)+wid*2048;
    #pragma unroll
    for(int r=0;r<16;++r){const int orow=crow(r,hi);
      #pragma unroll
      for(int d0=0;d0<2;++d0)stg[orow*64+d0*32+r32]=__float2bfloat16(o[d0][r]*rli[r]);}
    asm volatile("s_waitcnt lgkmcnt(0)":::"memory");
    #pragma unroll
    for(int i=0;i<4;++i){const int row=i*8+(lane>>3),ch=lane&7; const u32x4 v=*(const u32x4*)(stg+row*64+ch*8); ATTN_STORE16(Ow+(long)row*OPITCH+ch*8,v);} }
  asm volatile("s_waitcnt lgkmcnt(0)\n\ts_barrier":::"memory");
  #undef DMA_K
  #undef DMA_V
  #undef CMASK
  #undef START
  #undef RESC
  #undef ROT
}
constexpr int ATTN_LDS_BYTES=LDS_BYTES;
struct AttnTensors { const bf16* Q; const bf16* K; const bf16* V; bf16* O; };
struct AttnUnit { int bh; int qb; };
struct StaticOrder {
  int vcu, G;
  __device__ __forceinline__ explicit StaticOrder(int grid,int v):vcu(v),G(grid){}
  __device__ __forceinline__ bool next(int i,AttnUnit&u)const{ const int L=i*G+vcu; if(L>=BATCH*NHEAD*NQB)return false; const int blk=L%256, rnd=L/256; u.bh=blk>>1; u.qb=(blk&1)*4+rnd; return true; }
};
template<class Sched,int THRL=8> __device__ __forceinline__ void attn_phase(char*lds,const AttnTensors&T,const Sched&S){
  AttnUnit u;
  for(int i=0;S.next(i,u);++i){ attn_unit<THRL>(u.bh/NHEAD,u.bh%NHEAD,(u.bh%NHEAD)/4,u.qb,T.Q,T.K,T.V,T.O,lds); }
}
#undef SBAR
#undef WAIT_BAR
}
#define XB_TMO      128
#define XB_XCNT(j)  (256  + 64 * (j))
#define XB_XSUB(j)  (1280 + 64 * (j))
#define XB_XGEN(j)  (2304 + 64 * (j))
#define XB_TOP      3328
#define XB_TOPGEN   3392
#define XCD_BAR_WORDS 3456
#define XB_SPIN_CAP (1u << 18)

__device__ __forceinline__ unsigned xb_ld(unsigned* p)              { return __hip_atomic_load(p, __ATOMIC_RELAXED, __HIP_MEMORY_SCOPE_AGENT); }
__device__ __forceinline__ unsigned xb_add(unsigned* p, unsigned v) { return __hip_atomic_fetch_add(p, v, __ATOMIC_RELAXED, __HIP_MEMORY_SCOPE_AGENT); }
__device__ __forceinline__ unsigned xb_xcc_id() { return (unsigned)__builtin_amdgcn_s_getreg((3 << 11) | 20) & 0xFu; }
#define XB_SPIN(cond, bar) do { unsigned _sp = 0; while (cond) { __builtin_amdgcn_s_sleep(1); \
    if ((++_sp & 255u) == 0u) { if (xb_ld(&(bar)[XB_TMO])) break; if (_sp > XB_SPIN_CAP) { atomicAdd(&(bar)[XB_TMO], 1u); break; } } } } while (0)

struct XcdBarrier {
    unsigned* bar; unsigned x;
    volatile LAS unsigned* st;
};

__device__ __forceinline__ XcdBarrier xcd_barrier_post(unsigned* bar, volatile LAS unsigned* st) {
    XcdBarrier b; b.bar = bar; b.x = xb_xcc_id(); b.st = st;
    if (threadIdx.x == 0) (void)xb_add(&bar[XB_XCNT(b.x)], 1u);
    return b;
}
__device__ __forceinline__ void xcd_barrier_complete(unsigned* bar, unsigned x, unsigned& nloc, unsigned& nx) {
    const unsigned G = gridDim.x * gridDim.y * gridDim.z;
    unsigned sum, cnt, mine, sp = 0u;
    for (;;) {
        sum = 0u; cnt = 0u; mine = 0u;
#pragma unroll
        for (unsigned j = 0; j < 16; ++j) { const unsigned c = xb_ld(&bar[XB_XCNT(j)]); sum += c; cnt += (c > 0u) ? 1u : 0u; mine = (j == x) ? c : mine; }
        if (sum == G) break;
        __builtin_amdgcn_s_sleep(1);
        if ((++sp & 255u) == 0u) { if (xb_ld(&bar[XB_TMO])) break; if (sp > XB_SPIN_CAP) { atomicAdd(&bar[XB_TMO], 1u); break; } }
    }
    nloc = mine > 0u ? mine : 1u; nx = cnt > 0u ? cnt : 1u;
}

__device__ __forceinline__ void xcd_barrier(const XcdBarrier& b) {
    asm volatile("s_waitcnt vmcnt(0)" ::: "memory");
    __syncthreads();
    if (threadIdx.x == 0) {
        unsigned* bar = b.bar;
        __builtin_amdgcn_s_waitcnt(0);
        unsigned nloc = b.st[0], nx = b.st[1];
        if (nloc == 0u) { xcd_barrier_complete(bar, b.x, nloc, nx); b.st[0] = nloc; b.st[1] = nx; }
        const unsigned old = xb_add(&bar[XB_XSUB(b.x)], 1u);
        const unsigned gen = old / nloc;
        if (old + 1u == (gen + 1u) * nloc) {
            __builtin_amdgcn_fence(__ATOMIC_RELEASE, "agent");
            asm volatile("s_waitcnt vmcnt(0)" ::: "memory");
            const unsigned og = xb_add(&bar[XB_TOP], 1u);
            const unsigned tg = og / nx;
            if (og + 1u == (tg + 1u) * nx) xb_add(&bar[XB_TOPGEN], 1u);
            else XB_SPIN(xb_ld(&bar[XB_TOPGEN]) == tg, bar);
            __builtin_amdgcn_fence(__ATOMIC_ACQUIRE, "agent");
            xb_add(&bar[XB_XGEN(b.x)], 1u);
            asm volatile("s_waitcnt vmcnt(0)" ::: "memory");
        } else {
            XB_SPIN(xb_ld(&bar[XB_XGEN(b.x)]) == gen, bar);
            __builtin_amdgcn_fence(__ATOMIC_ACQUIRE, "agent");
            asm volatile("s_waitcnt vmcnt(0)" ::: "memory");
        }
    }
    __syncthreads();
}
constexpr int NWAVES = 8, NTHR = NWAVES * 64;
constexpr int N_PHASES = 10;
constexpr int RING_OFF = 0, RING_BYTES = 131072;
constexpr int LDSCTL_OFF = RING_BYTES, MISC_OFF = LDSCTL_OFF + 320;
constexpr int TS_OFF = LDSCTL_OFF + 512;
constexpr int UT_OFF = TS_OFF + 256;
constexpr int RT_OFF = UT_OFF + 256;
constexpr int LDS_BYTES = 147456;
static_assert(RT_OFF + pg8::MOE_MAXU * 1024 <= LDS_BYTES, "LDS map");

struct Frame {
    LAS unsigned char* lds; volatile LAS unsigned* MISC; unsigned* ctl; unsigned char* ws;
    int tid, lane, wave, vcu, G;
    float* out;
};

enum { I_X = 0, I_C, I_WADA, I_BADA, I_GPRE1, I_GPOST1, I_WIN, I_WDW, I_BDW, I_CLNG, I_CLNB, I_WCO, I_QG, I_KG, I_WAO, I_WOUT, I_GPRE2, I_GPOST2, I_WGRP, I_BGRP, I_WRT, I_BRT, I_WEG, I_WEU, I_WED };

struct Args { const float* in[25]; float* out; unsigned char* ws; int ph_lo, ph_hi, use_bar, flags; };
#define CAS __attribute__((address_space(4)))
__device__ __forceinline__ const float* fin(int i) { unsigned long long p = (unsigned long long)__builtin_amdgcn_kernarg_segment_ptr(); asm volatile("" : "+s"(p)); return ((const CAS Args*)p)->in[i]; }
template <int MAP> __device__ __forceinline__ int maprow(int n) {
    if (MAP == 1) return vmap_win(n);
    if (MAP == 2) return 256 * (n >> 7) + (n & 127);
    if (MAP == 3) return 256 * (n >> 7) + 128 + (n & 127);
    return n;
}
template <int MAP>
__device__ __forceinline__ void p0_transpose_item(const float* W, int N, bf16* WT, int pitch, int koff, LAS float* scr, int item, int lane) {
    const int nblk = N / 64, kb = item / nblk, nb = item % nblk, k0 = 64 * kb, n0 = 64 * nb, lr = lane >> 4, lc = lane & 15;
    const float* src = W + (size_t)(k0 + lr) * N + n0 + 4 * lc;
    f32x4 v[16];
#pragma unroll
    for (int i = 0; i < 16; ++i) v[i] = *(const f32x4*)(src + (size_t)(4 * i) * N);
#pragma unroll
    for (int i = 0; i < 16; ++i) { const int kk = lr + 4 * i; *(LAS f32x4*)(scr + kk * 64 + 4 * (lc ^ ((kk >> 3) & 7))) = v[i]; }
    LDS_WAIT(); asm volatile("" ::: "memory");
    const int c = lane & 7;
#pragma unroll
    for (int jj = 0; jj < 8; ++jj) { const int n = (lane >> 3) + 8 * jj; const LAS float* sp = scr + (8 * c) * 64 + (n ^ (4 * c));
        u32x4 o; o.x = cvt_pk_bf16(sp[0 * 64], sp[1 * 64]); o.y = cvt_pk_bf16(sp[2 * 64], sp[3 * 64]); o.z = cvt_pk_bf16(sp[4 * 64], sp[5 * 64]); o.w = cvt_pk_bf16(sp[6 * 64], sp[7 * 64]);
        *(u32x4*)(WT + (size_t)maprow<MAP>(n0 + n) * pitch + koff + k0 + 8 * c) = o; }
    LDS_WAIT(); asm volatile("" ::: "memory");
}
struct TrDesc { const float* src; unsigned char* dst; int N, pitch; float sc; };
__device__ __forceinline__ TrDesc tr_desc(int it, const float* pweg, const float* pweu, const float* pwed, unsigned char* W1, unsigned char* W2) {
    constexpr int I_G1 = (D / 64) * (DE / 64), I_D1 = (DE / 64) * (D / 64), PER = 2 * I_G1 + I_D1;
    const int e = it / PER; int r = it - e * PER; TrDesc d;
    if (r < 2 * I_G1) { const bool up = r >= I_G1; if (up) r -= I_G1; const int nblk = DE / 64, kb = r / nblk, nb = r % nblk;
        d.src = (up ? pweu : pweg) + (size_t)e * D * DE + (size_t)(64 * kb) * DE + 64 * nb; d.N = DE; d.pitch = D; d.sc = pg8::WSC1;
        d.dst = W1 + (size_t)e * D * D + (size_t)(256 * ((64 * nb) >> 7) + (up ? 128 : 0) + ((64 * nb) & 127)) * D + 64 * kb; }
    else { r -= 2 * I_G1; const int nblk = D / 64, kb = r / nblk, nb = r % nblk;
        d.src = pwed + (size_t)e * DE * D + (size_t)(64 * kb) * D + 64 * nb; d.N = D; d.pitch = DE; d.sc = pg8::WSC2;
        d.dst = W2 + (size_t)e * D * DE + (size_t)(64 * nb) * DE + 64 * kb; }
    return d;
}
__device__ __forceinline__ void tr_load(const TrDesc& d, int lane, f32x4 (&v)[16]) {
    const float* src = d.src + (size_t)(lane >> 4) * d.N + 4 * (lane & 15);
#pragma unroll
    for (int i = 0; i < 16; ++i) v[i] = *(const f32x4*)(src + (size_t)(4 * i) * d.N);
}
__device__ __forceinline__ void tr_finish(const TrDesc& d, int lane, const f32x4 (&v)[16], LAS float* scr) {
    const int lr = lane >> 4, lc = lane & 15;
#pragma unroll
    for (int i = 0; i < 16; ++i) { const int kk = lr + 4 * i; *(LAS f32x4*)(scr + kk * 64 + 4 * (lc ^ ((kk >> 3) & 7))) = v[i] * d.sc; }
    LDS_WAIT(); asm volatile("" ::: "memory");
    const int c4 = lane & 3;
#pragma unroll
    for (int jj = 0; jj < 4; ++jj) { const int n = (lane >> 2) + 16 * jj; const LAS float* s0 = scr + (16 * c4) * 64 + (n ^ (4 * (2 * c4))), * s1 = scr + (16 * c4 + 8) * 64 + (n ^ (4 * (2 * c4 + 1)));
        u32x4 o; o.x = pg8::pk4_fp8(s0[0 * 64], s0[1 * 64], s0[2 * 64], s0[3 * 64]); o.y = pg8::pk4_fp8(s0[4 * 64], s0[5 * 64], s0[6 * 64], s0[7 * 64]);
        o.z = pg8::pk4_fp8(s1[0 * 64], s1[1 * 64], s1[2 * 64], s1[3 * 64]); o.w = pg8::pk4_fp8(s1[4 * 64], s1[5 * 64], s1[6 * 64], s1[7 * 64]);
        *(u32x4*)(d.dst + (size_t)n * d.pitch + 16 * c4) = o; }
    LDS_WAIT(); asm volatile("" ::: "memory");
}
__device__ __forceinline__ void p0_prologue(Frame& F) {
    const float* c = fin(I_C); const float* wada = fin(I_WADA); const float* bada = fin(I_BADA);
    if (blockIdx.x < 192) {
        const int cg = blockIdx.x, kh = F.lane >> 5, col = F.lane & 31;
        LAS float* scs = (LAS float*)F.lds; LAS float* red = (LAS float*)(F.lds + 65536);
        { float cv[32];
#pragma unroll
          for (int i = 0; i < 32; ++i) cv[i] = c[F.tid + NTHR * i];
#pragma unroll
          for (int i = 0; i < 32; ++i) scs[F.tid + NTHR * i] = cv[i] * sig_fast(cv[i]); }
        __syncthreads();
        float acc[16];
#pragma unroll
        for (int b = 0; b < 16; ++b) acc[b] = 0.f;
        const int kbase = 128 * F.wave + 64 * kh;
        const float* w = wada + (size_t)kbase * 6144 + 32 * cg + col;
        { float wv[64];
#pragma unroll
          for (int k = 0; k < 64; ++k) wv[k] = w[(size_t)k * 6144];
#pragma unroll
          for (int k = 0; k < 64; ++k)
#pragma unroll
              for (int b = 0; b < 16; ++b) acc[b] += scs[b * D + kbase + k] * wv[k]; }
#pragma unroll
        for (int b = 0; b < 16; ++b) red[((F.wave * 2 + kh) * 16 + b) * 32 + col] = acc[b];
        __syncthreads();
        float* ada = (float*)(F.ws + WS_ADA);
        { const int b = F.tid >> 5, l = F.tid & 31; float sm = 0.f;
#pragma unroll
          for (int p = 0; p < 16; ++p) sm += red[(p * 16 + b) * 32 + l];
          __hip_atomic_store(ada + b * 6144 + 32 * cg + l, sm + bada[32 * cg + l], __ATOMIC_RELAXED, __HIP_MEMORY_SCOPE_AGENT); }
        VM_WAIT();
        __syncthreads();
        if (F.tid == 0) __hip_atomic_fetch_add(F.ctl + CW_ADA, 1u, __ATOMIC_RELAXED, __HIP_MEMORY_SCOPE_AGENT);
    }
    {
        const int gt = F.vcu * NTHR + F.tid, NGT = F.G * NTHR; const float* wgrp = fin(I_WGRP); const float* wrt = fin(I_WRT);
        f32x2* rope = (f32x2*)(F.ws + WS_ROPE);
        for (int i = gt; i < 96 * 16; i += NGT) { const int r = i >> 4, e = i & 15; const float pos = (float)(r < 32 ? r : r - 32);
            const float invf = powf(10000.f, -(float)e / 16.f); float sn, cs; sincosf(pos * invf, &sn, &cs); rope[i] = (f32x2){cs, sn}; }
        bf16* wr = (bf16*)(F.ws + WS_WR);
        for (int i = gt; i < 64 * 1024; i += NGT) { const int n = i >> 10, k = i & 1023;
            const float v = n < 4 ? wgrp[k * 4 + n] : (n < 36 ? wrt[k * 32 + (n - 4)] : 0.f); wr[i] = (bf16)f2bf(v); }
    }
    LAS float* scr = (LAS float*)(F.lds + RING_OFF + F.wave * 16384);
    const int gw = F.vcu * NWAVES + F.wave, NGW = F.G * NWAVES;
    constexpr int I_WIN_ = (D / 64) * (INW / 64), I_WC_ = (CW / 64) * (D / 64), I_WO_ = (D / 64) * (D / 64);
    constexpr int NITEMS = I_WIN_ + 2 * I_WC_ + I_WO_;
    bf16* WIN = (bf16*)(F.ws + WS_WIN); bf16* WCA = (bf16*)(F.ws + WS_WCA); bf16* WO = (bf16*)(F.ws + WS_WO);
    const float* pwin = fin(I_WIN); const float* pwco = fin(I_WCO); const float* pwao = fin(I_WAO); const float* pwout = fin(I_WOUT);
    for (int it = gw; it < NITEMS; it += NGW) {
        int r = it;
        if (r < I_WIN_) { const int kb = r / 60, nb = r % 60;
            if (nb >= 16 && nb < 28) p0_transpose_item<1>(pwin, INW, WIN, D, 0, scr, kb * 60 + nb, F.lane);
            else { TrDesc d; const int n0 = 64 * nb; d.src = pwin + (size_t)(64 * kb) * INW + n0; d.N = INW; d.pitch = 2048; d.sc = pg8::WSCIN; d.dst = F.ws + WS_WINF + (size_t)pg8::winf_row(vmap_win(n0)) * 2048 + 64 * kb;
                   f32x4 tv[16]; tr_load(d, F.lane, tv); tr_finish(d, F.lane, tv, scr); }
            continue; } r -= I_WIN_;
        if (r < I_WC_) { p0_transpose_item<0>(pwco, D, WCA, D, 0, scr, r, F.lane); continue; } r -= I_WC_;
        if (r < I_WC_) { p0_transpose_item<0>(pwao, D, WCA, D, 512, scr, r, F.lane); continue; } r -= I_WC_;
        p0_transpose_item<0>(pwout, D, WO, D, 0, scr, r, F.lane);
    }
}
constexpr int XCONV_ITEMS = NE * (2 * (D / 64) * (DE / 64) + (DE / 64) * (D / 64));
__device__ __forceinline__ void p0_convert_experts(Frame& F, int lo, int hi, int rank, int nconv) {
    LAS float* scr = (LAS float*)(F.lds + RING_OFF + F.wave * 16384);
    constexpr int I_G1 = (D / 64) * (DE / 64), I_D1 = (DE / 64) * (D / 64), PER = 2 * I_G1 + I_D1;
    unsigned char* W1 = F.ws + WS_W1; unsigned char* W2 = F.ws + WS_W2;
    const float* pweg = fin(I_WEG); const float* pweu = fin(I_WEU); const float* pwed = fin(I_WED);
    const int step = nconv * NWAVES;
    for (int it = lo + rank * NWAVES + F.wave; it < hi; it += 2 * step) {
        const TrDesc d0 = tr_desc(it, pweg, pweu, pwed, W1, W2); const bool two = it + step < hi;
        const TrDesc d1 = tr_desc(two ? it + step : it, pweg, pweu, pwed, W1, W2);
        f32x4 v0[16], v1[16];
        tr_load(d0, F.lane, v0); tr_load(d1, F.lane, v1);
        __builtin_amdgcn_sched_barrier(0);
        tr_finish(d0, F.lane, v0, scr);
        if (two) tr_finish(d1, F.lane, v1, scr);
    }
}

__device__ __forceinline__ int rcol(int lane, int q) { return 512 * (q >> 1) + 8 * lane + 4 * (q & 1); }
__device__ __forceinline__ void row_ld_f32(const float* p, int lane, f32x4 (&v)[4]) {
#pragma unroll
    for (int q = 0; q < 4; ++q) v[q] = *(const f32x4*)(p + rcol(lane, q)); }
__device__ __forceinline__ void row_st_f32(float* p, int lane, const f32x4 (&v)[4]) {
#pragma unroll
    for (int q = 0; q < 4; ++q) *(f32x4*)(p + rcol(lane, q)) = v[q]; }
__device__ __forceinline__ void row_ld_bf16(const bf16* p, int lane, f32x4 (&v)[4]) {
#pragma unroll
    for (int j = 0; j < 2; ++j) { const u32x4 w = *(const u32x4*)(p + 512 * j + 8 * lane);
        v[2 * j] = (f32x4){bf2f(w.x & 0xffffu), bf2f(w.x >> 16), bf2f(w.y & 0xffffu), bf2f(w.y >> 16)}; v[2 * j + 1] = (f32x4){bf2f(w.z & 0xffffu), bf2f(w.z >> 16), bf2f(w.w & 0xffffu), bf2f(w.w >> 16)}; } }
__device__ __forceinline__ u32x4 row_pack(const f32x4 a, const f32x4 b) { return (u32x4){cvt_pk_bf16(a.x, a.y), cvt_pk_bf16(a.z, a.w), cvt_pk_bf16(b.x, b.y), cvt_pk_bf16(b.z, b.w)}; }
__device__ __forceinline__ float row_ss(const f32x4 (&v)[4]) { float s = 0.f;
#pragma unroll
    for (int q = 0; q < 4; ++q) s += (v[q].x * v[q].x + v[q].y * v[q].y) + (v[q].z * v[q].z + v[q].w * v[q].w);
    return s; }

__device__ __forceinline__ void p1_modnorm(Frame& F) {
    if (F.tid == 0) { unsigned sp = 0; while (__hip_atomic_load(F.ctl + CW_ADA, __ATOMIC_RELAXED, __HIP_MEMORY_SCOPE_AGENT) < 192u) { __builtin_amdgcn_s_sleep(2); if (++sp > (1u << 22)) break; }
        __builtin_amdgcn_fence(__ATOMIC_ACQUIRE, "agent"); VM_WAIT(); }
    __syncthreads();
    const float* x = fin(I_X); const float* g = fin(I_GPRE1); const float* ada = (const float*)(F.ws + WS_ADA); bf16* h1 = (bf16*)(F.ws + WS_H1); unsigned char* h1f = F.ws + WS_H1F;
    for (int chunk = blockIdx.x; chunk < NTOK / 128; chunk += F.G) {
        const int R0 = chunk * 128, b = R0 / SEQ; const float* ad = ada + b * 6144;
        f32x4 ca[4], cb[4];
#pragma unroll
        for (int q = 0; q < 4; ++q) { const int c0 = rcol(F.lane, q); ca[q] = *(const f32x4*)(g + c0) * (1.f + *(const f32x4*)(ad + 1024 + c0)); cb[q] = *(const f32x4*)(ad + c0); }
        const int rw = R0 + 16 * F.wave;
        f32x4 n0[4], n1[4];
        row_ld_f32(x + (size_t)rw * D, F.lane, n0); row_ld_f32(x + (size_t)(rw + 1) * D, F.lane, n1);
#pragma unroll
        for (int i = 0; i < 16; i += 2) {
            const int row = rw + i;
            f32x4 v0[4], v1[4];
#pragma unroll
            for (int q = 0; q < 4; ++q) { v0[q] = n0[q]; v1[q] = n1[q]; }
            if (i + 2 < 16) { row_ld_f32(x + (size_t)(row + 2) * D, F.lane, n0); row_ld_f32(x + (size_t)(row + 3) * D, F.lane, n1); }
            __builtin_amdgcn_sched_barrier(0);
            const float r0 = rsqrtf(wave_sum(row_ss(v0)) * (1.f / D) + EPS), r1 = rsqrtf(wave_sum(row_ss(v1)) * (1.f / D) + EPS);
#pragma unroll
            for (int j = 0; j < 2; ++j) {
                const f32x4 a0 = v0[2 * j] * r0 * ca[2 * j] + cb[2 * j], a1 = v0[2 * j + 1] * r0 * ca[2 * j + 1] + cb[2 * j + 1], b0 = v1[2 * j] * r1 * ca[2 * j] + cb[2 * j], b1 = v1[2 * j + 1] * r1 * ca[2 * j + 1] + cb[2 * j + 1];
                *(u32x4*)(h1 + (size_t)row * D + 512 * j + 8 * F.lane) = row_pack(a0, a1); *(u32x4*)(h1 + (size_t)(row + 1) * D + 512 * j + 8 * F.lane) = row_pack(b0, b1);
                *(u32x2*)(h1f + (size_t)row * 2048 + 512 * j + 8 * F.lane) = (u32x2){pg8::pk4_fp8(a0.x, a0.y, a0.z, a0.w), pg8::pk4_fp8(a1.x, a1.y, a1.z, a1.w)};
                *(u32x2*)(h1f + (size_t)(row + 1) * 2048 + 512 * j + 8 * F.lane) = (u32x2){pg8::pk4_fp8(b0.x, b0.y, b0.z, b0.w), pg8::pk4_fp8(b1.x, b1.y, b1.z, b1.w)}; }
            __builtin_amdgcn_sched_barrier(0);
        }
    }
}

constexpr int CV_T = 32, CV_IN = 0, CV_UT = (CV_T + KS - 1) * 1024;
static_assert(CV_UT + CV_T * CW * 4 <= RING_BYTES, "conv LDS map");
__device__ __forceinline__ void p3_conv(Frame& F) {
    const bf16* glu = (const bf16*)(F.ws + WS_GLU); bf16* ca = (bf16*)(F.ws + WS_CA);
    LAS unsigned char* IN = F.lds + RING_OFF + CV_IN; LAS float* UT = (LAS float*)(F.lds + RING_OFF + CV_UT);
    const int cp = F.tid & 255, th = F.tid >> 8;
    f32x2 w[KS];
#pragma unroll
    for (int j = 0; j < KS; ++j) w[j] = *(const f32x2*)(fin(I_WDW) + j * CW + 2 * cp);
    const f32x2 bias = *(const f32x2*)(fin(I_BDW) + 2 * cp);
    float lg[8], lb[8];
#pragma unroll
    for (int i = 0; i < 8; ++i) { lg[i] = fin(I_CLNG)[F.lane * 8 + i]; lb[i] = fin(I_CLNB)[F.lane * 8 + i]; }
    u32x4 sv[8];
#define CV_LOAD(unx) do { const int b_ = (unx) / (SEQ / CV_T), s0_ = ((unx) % (SEQ / CV_T)) * CV_T; _Pragma("unroll") for (int i = 0; i < 8; ++i) { \
        const int s_ = s0_ - KS / 2 + F.wave + NWAVES * i, sc_ = s_ < 0 ? 0 : (s_ >= SEQ ? SEQ - 1 : s_); sv[i] = *(const u32x4*)(glu + (size_t)(b_ * SEQ + sc_) * CW + F.lane * 8); } } while (0)
    if (F.vcu < NTOK / CV_T) CV_LOAD(F.vcu);
    for (int un = F.vcu; un < NTOK / CV_T; un += F.G) {
        const int b = un / (SEQ / CV_T), s0 = (un % (SEQ / CV_T)) * CV_T;
#pragma unroll
        for (int i = 0; i < 8; ++i) { const int r = F.wave + NWAVES * i, s = s0 - KS / 2 + r;
            if (r < CV_T + KS - 1) *(LAS u32x4*)(IN + r * 1024 + F.lane * 16) = (s >= 0 && s < SEQ) ? sv[i] : (u32x4){0u, 0u, 0u, 0u}; }
        __syncthreads();
        if (un + F.G < NTOK / CV_T) CV_LOAD(un + F.G);
        __builtin_amdgcn_sched_barrier(0);
#pragma unroll
        for (int g = 0; g < 2; ++g) {
            f32x2 win[38];
#pragma unroll
            for (int i = 0; i < 38; ++i) { const unsigned pw = *(const LAS unsigned*)(IN + (16 * th + 8 * g + i) * 1024 + cp * 4); win[i] = (f32x2){__uint_as_float(pw << 16), __uint_as_float(pw & 0xffff0000u)}; }
#pragma unroll
            for (int o = 0; o < 8; ++o) { f32x2 a = bias;
#pragma unroll
                for (int j = 0; j < KS; ++j) a = __builtin_elementwise_fma(win[o + j], w[j], a);
                *(LAS f32x2*)(UT + (16 * th + 8 * g + o) * CW + 2 * cp) = a; }
        }
        __syncthreads();
#pragma unroll
        for (int i = 0; i < 4; ++i) { const int t = F.wave * 4 + i;
            const f32x4 v0 = *(const LAS f32x4*)(UT + t * CW + F.lane * 8), v1 = *(const LAS f32x4*)(UT + t * CW + F.lane * 8 + 4);
            const float mu = wave_sum((v0.x + v0.y) + (v0.z + v0.w) + (v1.x + v1.y) + (v1.z + v1.w)) * (1.f / CW);
            const f32x4 d0 = v0 - mu, d1 = v1 - mu;
            const float var = wave_sum((d0.x * d0.x + d0.y * d0.y) + (d0.z * d0.z + d0.w * d0.w) + (d1.x * d1.x + d1.y * d1.y) + (d1.z * d1.z + d1.w * d1.w)) * (1.f / CW);
            const float rstd = rsqrtf(var + EPS);
            float o[8];
#pragma unroll
            for (int k = 0; k < 4; ++k) { const float a = d0[k] * rstd * lg[k] + lb[k], bq = d1[k] * rstd * lg[4 + k] + lb[4 + k]; o[k] = a * sig_fast(a); o[4 + k] = bq * sig_fast(bq); }
            u32x4 wv; wv.x = cvt_pk_bf16(o[0], o[1]); wv.y = cvt_pk_bf16(o[2], o[3]); wv.z = cvt_pk_bf16(o[4], o[5]); wv.w = cvt_pk_bf16(o[6], o[7]);
            *(u32x4*)(ca + (size_t)(b * SEQ + s0 + t) * D + F.lane * 8) = wv; }
        __syncthreads();
    }
#undef CV_LOAD
}

constexpr int WRP = 2064;
constexpr int P6_WR = 0, P6_LGW = 48 * WRP, P6_EA = P6_LGW + 8 * 16 * 48 * 4, P6_HIST = P6_EA + 128 * 32, P6_BASE = P6_HIST + 128, P6_END = P6_BASE + 128;
constexpr int P6_RS2 = P6_END, P6_BIAS = P6_RS2 + 512, P6_BPART = P6_BIAS + 256, P6_END2 = P6_BPART + 8 * 48 * 4;
static_assert(P6_END2 <= RING_BYTES, "P6 LDS map");
struct P6Row { float pv; u32x4 y[2]; f32x4 x[4]; };
__device__ __forceinline__ void p6_ld(P6Row& r, const float* x, const bf16* y1, const float* part, int row, int lane) {
    r.pv = part[(size_t)row * 16 + (lane & 15)];
#pragma unroll
    for (int j = 0; j < 2; ++j) r.y[j] = *(const u32x4*)(y1 + (size_t)row * D + 512 * j + 8 * lane);
    row_ld_f32(x + (size_t)row * D, lane, r.x);
}
__device__ __forceinline__ void p6_do(P6Row& r, const f32x4 (&c1)[4], const f32x4 (&c2)[4], const f32x4 (&c3)[4], bf16* x1b, unsigned char* h2f, LAS float* rs2, int row, int lane) {
    const float pv = row16_sum(r.pv);
    const float ra = rsqrtf(pv * (1.f / D) + EPS);
    f32x4 xv[4];
#pragma unroll
    for (int j = 0; j < 2; ++j) { const u32x4 w = r.y[j];
        const f32x4 ya = (f32x4){bf2f(w.x & 0xffffu), bf2f(w.x >> 16), bf2f(w.y & 0xffffu), bf2f(w.y >> 16)}, yb = (f32x4){bf2f(w.z & 0xffffu), bf2f(w.z >> 16), bf2f(w.w & 0xffffu), bf2f(w.w >> 16)};
        xv[2 * j] = r.x[2 * j] + c1[2 * j] * (ya * ra); xv[2 * j + 1] = r.x[2 * j + 1] + c1[2 * j + 1] * (yb * ra);
        *(u32x4*)(x1b + (size_t)row * D + 512 * j + 8 * lane) = row_pack(xv[2 * j], xv[2 * j + 1]); }
    const float sa = rsqrtf(wave_sum(row_ss(xv)) * (1.f / D) + EPS);
    if (lane == 0) *rs2 = sa;
#pragma unroll
    for (int j = 0; j < 2; ++j) { const f32x4 ha = xv[2 * j] * sa * c2[2 * j] + c3[2 * j], hb = xv[2 * j + 1] * sa * c2[2 * j + 1] + c3[2 * j + 1];
        *(u32x2*)(h2f + (size_t)row * D + 512 * j + 8 * lane) = (u32x2){pg8::pk4_fp8(ha.x, ha.y, ha.z, ha.w), pg8::pk4_fp8(hb.x, hb.y, hb.z, hb.w)}; }
}
__device__ __forceinline__ void p6_postmix_router(Frame& F) {
    const float* x = fin(I_X); const bf16* y1 = (const bf16*)(F.ws + WS_Y1); const float* part = (const float*)(F.ws + WS_PART); const float* ada = (const float*)(F.ws + WS_ADA);
    unsigned char* h2f = F.ws + WS_H2F; bf16* x1b = (bf16*)(F.ws + WS_X1B); int* list = (int*)(F.ws + WS_LIST); unsigned* tokinfo = (unsigned*)(F.ws + WS_TOK);
    LAS unsigned char* WR = F.lds + P6_WR; LAS float* LGW = (LAS float*)(F.lds + P6_LGW) + F.wave * 16 * 48;
    LAS unsigned* EA = (LAS unsigned*)(F.lds + P6_EA); LAS unsigned* HIST = (LAS unsigned*)(F.lds + P6_HIST); LAS unsigned* BASE = (LAS unsigned*)(F.lds + P6_BASE);
    LAS float* RS2 = (LAS float*)(F.lds + P6_RS2) + F.wave * 16; LAS float* BIAS = (LAS float*)(F.lds + P6_BIAS); LAS float* BPART = (LAS float*)(F.lds + P6_BPART);
    const int fr = F.lane & 15, fq = F.lane >> 4;
    const float* gpost1 = fin(I_GPOST1); const float* gpre2 = fin(I_GPRE2); const float* bgrp = fin(I_BGRP); const float* brt = fin(I_BRT); const float* wgrp = fin(I_WGRP); const float* wrt = fin(I_WRT);
    for (int i = F.tid; i < 12 * WRP / 4; i += NTHR) ((LAS unsigned*)(WR + 36 * WRP))[i] = 0u;
    for (int chunk = blockIdx.x; chunk < NTOK / 128; chunk += F.G) {
        const int R0 = chunk * 128, b = R0 / SEQ, rw = R0 + 16 * F.wave; const float* ad = ada + b * 6144;
        if (F.tid < 32) HIST[F.tid] = 0u;
        {
            float bp[36];
#pragma unroll
            for (int n = 0; n < 36; ++n) bp[n] = 0.f;
#pragma unroll
            for (int h = 0; h < 2; ++h) { const int kk = F.tid + NTHR * h; const float c2k = gpre2[kk] * (1.f + ad[4096 + kk]), c3k = ad[3072 + kk];
                const f32x4 wg = *(const f32x4*)(wgrp + kk * 4);
#pragma unroll
                for (int n = 0; n < 4; ++n) { *(LAS unsigned short*)(WR + n * WRP + kk * 2) = (unsigned short)f2bf(wg[n] * c2k); bp[n] += c3k * wg[n]; }
#pragma unroll
                for (int q = 0; q < 8; ++q) { const f32x4 wv = *(const f32x4*)(wrt + kk * 32 + q * 4);
#pragma unroll
                    for (int n = 0; n < 4; ++n) { *(LAS unsigned short*)(WR + (4 + 4 * q + n) * WRP + kk * 2) = (unsigned short)f2bf(wv[n] * c2k); bp[4 + 4 * q + n] += c3k * wv[n]; } } }
#pragma unroll
            for (int n = 0; n < 36; ++n) { const float t = wave_sum(bp[n]); if (F.lane == 0) BPART[F.wave * 48 + n] = t; }
        }
        f32x4 c1[4], c2[4], c3[4];
#pragma unroll
        for (int q = 0; q < 4; ++q) { const int c0 = rcol(F.lane, q);
            c1[q] = *(const f32x4*)(gpost1 + c0) * *(const f32x4*)(ad + 2048 + c0);
            c2[q] = *(const f32x4*)(gpre2 + c0) * (1.f + *(const f32x4*)(ad + 4096 + c0)); c3[q] = *(const f32x4*)(ad + 3072 + c0); }
        __syncthreads();
        if (F.tid < 48) { float t = 0.f;
            if (F.tid < 36) {
#pragma unroll
                for (int w = 0; w < 8; ++w) t += BPART[w * 48 + F.tid];
                t += F.tid < 4 ? bgrp[F.tid] : brt[F.tid - 4]; }
            BIAS[F.tid] = t; }
        {
            P6Row na, nb;
            p6_ld(na, x, y1, part, rw, F.lane); p6_ld(nb, x, y1, part, rw + 1, F.lane);
#pragma unroll
            for (int i = 0; i < 16; i += 2) {
                P6Row ra = na, rb = nb;
                if (i + 2 < 16) { p6_ld(na, x, y1, part, rw + i + 2, F.lane); p6_ld(nb, x, y1, part, rw + i + 3, F.lane); }
                __builtin_amdgcn_sched_barrier(0);
                p6_do(ra, c1, c2, c3, x1b, h2f, RS2 + i, rw + i, F.lane); p6_do(rb, c1, c2, c3, x1b, h2f, RS2 + i + 1, rw + i + 1, F.lane);
                __builtin_amdgcn_sched_barrier(0);
            }
        }
        VM_WAIT();
        __syncthreads();
        {
            f32x4 acc[3] = {(f32x4){0.f, 0.f, 0.f, 0.f}, (f32x4){0.f, 0.f, 0.f, 0.f}, (f32x4){0.f, 0.f, 0.f, 0.f}};
            bf16x8 af[32];
#pragma unroll
            for (int ks = 0; ks < 32; ++ks) af[ks] = *(const bf16x8*)(x1b + (size_t)(rw + fr) * D + 32 * ks + 8 * fq);
#pragma unroll
            for (int ks = 0; ks < 32; ++ks)
#pragma unroll
                for (int nb = 0; nb < 3; ++nb) { const bf16x8 bf = *(const LAS bf16x8*)(WR + (16 * nb + fr) * WRP + (32 * ks + 8 * fq) * 2);
                    acc[nb] = __builtin_amdgcn_mfma_f32_16x16x32_bf16(af[ks], bf, acc[nb], 0, 0, 0); }
#pragma unroll
            for (int nb = 0; nb < 3; ++nb)
#pragma unroll
                for (int j = 0; j < 4; ++j) LGW[(4 * fq + j) * 48 + 16 * nb + fr] = acc[nb][j] * RS2[4 * fq + j] + BIAS[16 * nb + fr];
        }
        LDS_WAIT();
        if (F.lane < 16) {
            const LAS float* L = LGW + F.lane * 48;
            float gl[4];
#pragma unroll
            for (int g = 0; g < 4; ++g) gl[g] = L[g];
            int gi = 0; float gm = gl[0];
#pragma unroll
            for (int g = 1; g < 4; ++g) if (gl[g] > gm) { gm = gl[g]; gi = g; }
            float den = 0.f;
#pragma unroll
            for (int g = 0; g < 4; ++g) den += __expf(gl[g] - gm);
            const float grp_p = 1.f / den;
            float E[8];
#pragma unroll
            for (int i = 0; i < 8; ++i) E[i] = L[4 + gi * 8 + i];
            int a = 0; float am = E[0];
#pragma unroll
            for (int i = 1; i < 8; ++i) if (E[i] > am) { am = E[i]; a = i; }
            int bi = -1; float bm = -3.0e38f;
#pragma unroll
            for (int i = 0; i < 8; ++i) if (i != a && E[i] > bm) { bm = E[i]; bi = i; }
            if (bi < 0) { bi = (a == 0) ? 1 : 0; bm = E[bi]; }
            const float pb = __expf(bm - am), wa = 1.f / (1.f + pb), wb = pb / (1.f + pb);
            const unsigned e0 = (unsigned)(gi * 8 + a), e1 = (unsigned)(gi * 8 + bi);
            const unsigned k0 = __hip_atomic_fetch_add(HIST + e0, 1u, __ATOMIC_RELAXED, __HIP_MEMORY_SCOPE_WORKGROUP), k1 = __hip_atomic_fetch_add(HIST + e1, 1u, __ATOMIC_RELAXED, __HIP_MEMORY_SCOPE_WORKGROUP);
            LAS unsigned* ea = EA + (16 * F.wave + F.lane) * 8;
            ea[0] = e0; ea[1] = k0; ea[2] = e1; ea[3] = k1; ea[4] = __float_as_uint(grp_p * wa); ea[5] = __float_as_uint(grp_p * wb);
        }
        __syncthreads();
        if (F.tid < 32) BASE[F.tid] = __hip_atomic_fetch_add(F.ctl + CW_CNT + F.tid, HIST[F.tid], __ATOMIC_RELAXED, __HIP_MEMORY_SCOPE_AGENT);
        __syncthreads();
        if (F.tid < 128) { const LAS unsigned* ea = EA + F.tid * 8; const int tok = R0 + F.tid;
            const unsigned e0 = ea[0], e1 = ea[2], p0 = BASE[e0] + ea[1], p1 = BASE[e1] + ea[3];
            list[(size_t)e0 * ECAP + p0] = tok; list[(size_t)e1 * ECAP + p1] = tok;
            unsigned* ti = tokinfo + (size_t)tok * 8; *(u32x4*)ti = (u32x4){e0, p0, e1, p1}; *(u32x2*)(ti + 4) = (u32x2){ea[4], ea[5]}; }
        __syncthreads();
    }
}

__device__ __forceinline__ void moe_tstart(Frame& F) {
    LAS int* TS = (LAS int*)(F.lds + TS_OFF);
    if (F.tid == 0) { int o = 0; for (int e = 0; e < NE; ++e) { TS[e] = o; o += (int)((__hip_atomic_load(F.ctl + CW_CNT + e, __ATOMIC_RELAXED, __HIP_MEMORY_SCOPE_AGENT) + 255u) >> 8); } TS[NE] = o; }
    __syncthreads();
}
template <bool GATHER>
__device__ __forceinline__ void moe_setup(Frame& F) {
    moe_tstart(F);
    LAS int* TS = (LAS int*)(F.lds + TS_OFF); LAS int* UT = (LAS int*)(F.lds + UT_OFF); LAS int* RT = (LAS int*)(F.lds + RT_OFF);
    const int* list = (const int*)(F.ws + WS_LIST);
    if (F.tid < pg8::MOE_MAXU) {
        const int u = F.tid * F.G + F.vcu, T4 = 4 * TS[NE]; int pm = 0, pn = 0, e = 0, valid = 0;
        if (u < T4) { pm = u >> 2; pn = u & 3; valid = 1; for (int k = 1; k < NE; ++k) if (TS[k] <= pm) e = k; }
        UT[F.tid * 4 + 0] = pm; UT[F.tid * 4 + 1] = pn; UT[F.tid * 4 + 2] = e; UT[F.tid * 4 + 3] = valid;
    }
    __syncthreads();
    if (GATHER) {
        for (int idx = F.tid; idx < pg8::MOE_MAXU * 256; idx += NTHR) { const int i = idx >> 8, r = idx & 255;
            if (UT[i * 4 + 3]) { const int e = UT[i * 4 + 2], pos = (UT[i * 4 + 0] - TS[e]) * 256 + r;
                const int cnt = (int)__hip_atomic_load(F.ctl + CW_CNT + e, __ATOMIC_RELAXED, __HIP_MEMORY_SCOPE_AGENT);
                RT[idx] = pos < cnt ? list[(size_t)e * ECAP + pos] : 0; } }
        VM_WAIT();
    }
    __syncthreads();
}

struct P9Row { u32x2 ya[2], yb[2]; u32x4 xb[2]; };
__device__ __forceinline__ void p9_ld(P9Row& r, const unsigned char* y2, const bf16* x1b, unsigned s0, unsigned s1, int row, int lane) {
#pragma unroll
    for (int j = 0; j < 2; ++j) { r.ya[j] = *(const u32x2*)(y2 + (size_t)s0 * D + 512 * j + 8 * lane); r.yb[j] = *(const u32x2*)(y2 + (size_t)s1 * D + 512 * j + 8 * lane);
        r.xb[j] = *(const u32x4*)(x1b + (size_t)row * D + 512 * j + 8 * lane); }
}
__device__ __forceinline__ void up8(const u32x4 w, f32x4& a, f32x4& b) {
    a = (f32x4){bf2f(w.x & 0xffffu), bf2f(w.x >> 16), bf2f(w.y & 0xffffu), bf2f(w.y >> 16)}; b = (f32x4){bf2f(w.z & 0xffffu), bf2f(w.z >> 16), bf2f(w.w & 0xffffu), bf2f(w.w >> 16)}; }
__device__ __forceinline__ f32x4 up4_fp8(unsigned w) { const f32x2 lo = __builtin_amdgcn_cvt_pk_f32_fp8((int)w, false), hi = __builtin_amdgcn_cvt_pk_f32_fp8((int)w, true); return (f32x4){lo.x, lo.y, hi.x, hi.y}; }
__device__ __forceinline__ void p9_do(const P9Row& r, float w0, float w1, const f32x4 (&cg)[4], float* orow, int lane) {
    f32x4 y[4], xv[4];
#pragma unroll
    for (int j = 0; j < 2; ++j) { y[2 * j] = up4_fp8(r.ya[j].x) * w0 + up4_fp8(r.yb[j].x) * w1; y[2 * j + 1] = up4_fp8(r.ya[j].y) * w0 + up4_fp8(r.yb[j].y) * w1; up8(r.xb[j], xv[2 * j], xv[2 * j + 1]); }
    const float rs = rsqrtf(wave_sum(row_ss(y)) * (1.f / D) + EPS);
#pragma unroll
    for (int q = 0; q < 4; ++q) xv[q] = xv[q] + cg[q] * (y[q] * rs);
    row_st_f32(orow, lane, xv);
}
__device__ __forceinline__ void p9_final(Frame& F, bool dry) {
    moe_tstart(F);
    const LAS int* TS = (const LAS int*)(F.lds + TS_OFF);
    const unsigned char* y2 = F.ws + WS_Y2; const bf16* x1b = (const bf16*)(F.ws + WS_X1B); const unsigned* tokinfo = (const unsigned*)(F.ws + WS_TOK); const float* ada = (const float*)(F.ws + WS_ADA);
    float* obase = dry ? (float*)(F.ws + WS_CA) : F.out; const float* gpost2 = fin(I_GPOST2);
    for (int chunk = blockIdx.x; chunk < NTOK / 128; chunk += F.G) {
        const int R0 = chunk * 128, b = R0 / SEQ, rw = R0 + 16 * F.wave; const float* ad = ada + b * 6144;
        f32x4 cg[4];
#pragma unroll
        for (int q = 0; q < 4; ++q) { const int c0 = rcol(F.lane, q); cg[q] = *(const f32x4*)(gpost2 + c0) * *(const f32x4*)(ad + 5120 + c0); }
        const u32x4 ti = *(const u32x4*)(tokinfo + (size_t)(rw + (F.lane & 15)) * 8); const u32x2 tw = *(const u32x2*)(tokinfo + (size_t)(rw + (F.lane & 15)) * 8 + 4);
        const unsigned sl0 = (unsigned)TS[ti.x] * 256u + ti.y, sl1 = (unsigned)TS[ti.z] * 256u + ti.w;
#define P9_S0(i) ((unsigned)__builtin_amdgcn_readlane((int)sl0, (i)))
#define P9_S1(i) ((unsigned)__builtin_amdgcn_readlane((int)sl1, (i)))
#define P9_W0(i) (__uint_as_float((unsigned)__builtin_amdgcn_readlane((int)tw.x, (i))) * (1.f / pg8::YSC))
#define P9_W1(i) (__uint_as_float((unsigned)__builtin_amdgcn_readlane((int)tw.y, (i))) * (1.f / pg8::YSC))
        P9Row na, nb;
        p9_ld(na, y2, x1b, P9_S0(0), P9_S1(0), rw, F.lane); p9_ld(nb, y2, x1b, P9_S0(1), P9_S1(1), rw + 1, F.lane);
#pragma unroll
        for (int i = 0; i < 16; i += 2) {
            const P9Row ra = na, rb = nb;
            if (i + 2 < 16) { p9_ld(na, y2, x1b, P9_S0(i + 2), P9_S1(i + 2), rw + i + 2, F.lane); p9_ld(nb, y2, x1b, P9_S0(i + 3), P9_S1(i + 3), rw + i + 3, F.lane); }
            __builtin_amdgcn_sched_barrier(0);
            p9_do(ra, P9_W0(i), P9_W1(i), cg, obase + (size_t)(rw + i) * D, F.lane); p9_do(rb, P9_W0(i + 1), P9_W1(i + 1), cg, obase + (size_t)(rw + i + 1) * D, F.lane);
            __builtin_amdgcn_sched_barrier(0);
        }
#undef P9_S0
#undef P9_S1
#undef P9_W0
#undef P9_W1
    }
}

__global__ void __launch_bounds__(NTHR, 2) mega_fwd(Args args) {
    extern __shared__ __attribute__((aligned(16))) unsigned char lds_raw[];
    Frame F;
    F.lds = (LAS unsigned char*)lds_raw; F.MISC = (volatile LAS unsigned*)(F.lds + MISC_OFF);
    F.tid = threadIdx.x; F.lane = F.tid & 63; F.wave = __builtin_amdgcn_readfirstlane(F.tid >> 6);
    F.G = gridDim.x; { const int bx = blockIdx.x; F.vcu = (F.G % 8 == 0) ? (bx % 8) * (F.G / 8) + bx / 8 : bx; }
    F.ws = args.ws; F.ctl = (unsigned*)(args.ws + WS_CTL); F.out = args.out;
    for (int u = F.tid; u < (LDS_BYTES - LDSCTL_OFF) / 4; u += NTHR) ((LAS unsigned*)(F.lds + LDSCTL_OFF))[u] = 0u;
    __syncthreads();
    XcdBarrier bar; bar.bar = F.ctl + CW_BAR; bar.x = 0; bar.st = nullptr;
    if (args.use_bar) bar = xcd_barrier_post(F.ctl + CW_BAR, F.MISC + 8);
    const int lo = args.ph_lo, hi = args.ph_hi;
#ifndef MK_PHMASK
#define MK_PHMASK 0x3ff
#endif
#define IN(k) (((MK_PHMASK >> (k)) & 1) && lo <= (k) && (k) < hi)
#define SEAM(k) do { if (IN(k) && IN((k) + 1)) xcd_barrier(bar); } while (0)

    if (IN(0)) { p0_prologue(F); }
    if (IN(1)) { p1_modnorm(F); } SEAM(1);
    if (IN(2)) {
        pg8::EpiP2 E{(bf16*)(F.ws + WS_GLU), (bf16*)(F.ws + WS_QKV), (bf16*)(F.ws + WS_GATES), fin(I_QG), fin(I_KG), (const f32x2*)(F.ws + WS_ROPE)};
        { pg8::P2Order<false> S{(const char*)(F.ws + WS_WIN), F.vcu, F.G};
          pg8::gemm_phase<pg8::EpiP2, pg8::P2Order<false>, true, 0>(F.lds + RING_OFF, F.ws + WS_H1, D * 2, D * 2, S, E); }
        { pg8::P2Order<true> S{(const char*)(F.ws + WS_WINF), F.vcu, F.G};
          pg8::gemm_phase<pg8::EpiP2, pg8::P2Order<true>, true, 1>(F.lds + RING_OFF, F.ws + WS_H1F, D * 2, D * 2, S, E, nullptr, D); }
    } SEAM(2);
    if (IN(3)) {
        if (!(args.flags & 1)) p3_conv(F);
        if (!(args.flags & 2)) {
            const attn_body::bf16* qkv = (const attn_body::bf16*)(F.ws + WS_QKV);
            const attn_body::AttnTensors AT{qkv, qkv + 512, qkv + 640, (attn_body::bf16*)(F.ws + WS_CA) + 512};
            const attn_body::StaticOrder S((int)F.G, F.vcu);
            attn_body::AttnUnit au;
            for (int i = 0; S.next(i, au); ++i) {
                if (i == (F.vcu & 3)) { p0_convert_experts(F, 0, XCONV_ITEMS, F.vcu, F.G); VM_WAIT(); __syncthreads(); }
                attn_body::attn_unit<8>(au.bh / attn_body::NHEAD, au.bh % attn_body::NHEAD, (au.bh % attn_body::NHEAD) / 4, au.qb, AT.Q, AT.K, AT.V, AT.O, (char*)lds_raw + RING_OFF);
            }
        }
    } SEAM(3);
    if (IN(4)) {
        pg8::PanelOrder S{(const char*)(F.ws + WS_WCA), F.vcu, F.G, D * 2};
        pg8::EpiP4 E{(const bf16*)(F.ws + WS_GATES), (bf16*)(F.ws + WS_H1)};
        pg8::gemm_phase<pg8::EpiP4, pg8::PanelOrder, true>(F.lds + RING_OFF, F.ws + WS_CA, D * 2, D * 2, S, E);
    } SEAM(4);
    if (IN(5)) {
        pg8::PanelOrder S{(const char*)(F.ws + WS_WO), F.vcu, F.G, D * 2};
        pg8::EpiP5 E{(bf16*)(F.ws + WS_Y1), (float*)(F.ws + WS_PART)};
        pg8::gemm_phase<pg8::EpiP5, pg8::PanelOrder, true>(F.lds + RING_OFF, F.ws + WS_H1, D * 2, D * 2, S, E);
    } SEAM(5);
    if (IN(6)) { p6_postmix_router(F); } SEAM(6);
    if (IN(7)) {
        moe_setup<true>(F);
        pg8::MoeOrder<true> S{(const LAS int*)(F.lds + UT_OFF), (const LAS int*)(F.lds + RT_OFF), F.ws + WS_W1, (size_t)D * D, D};
        pg8::EpiMoe1 E{F.ws + WS_GATES};
        pg8::gemm_phase<pg8::EpiMoe1, pg8::MoeOrder<true>, true, true>(F.lds + RING_OFF, F.ws + WS_H2F, D, D, S, E);
    } SEAM(7);
    if (IN(8)) {
        moe_setup<false>(F);
        pg8::MoeOrder<false> S{(const LAS int*)(F.lds + UT_OFF), (const LAS int*)(F.lds + RT_OFF), F.ws + WS_W2, (size_t)D * DE, DE};
        pg8::EpiMoe2 E{F.ws + WS_Y2};
        pg8::gemm_phase<pg8::EpiMoe2, pg8::MoeOrder<false>, true, true>(F.lds + RING_OFF, F.ws + WS_GATES, DE, DE, S, E);
    } SEAM(8);
    if (IN(9)) { p9_final(F, (args.flags & 4) != 0); }
#undef IN
#undef SEAM
}
#if MK_NPRE < 10
__global__ __launch_bounds__(256) void k_ada(const float* __restrict__ c, const float* __restrict__ w, const float* __restrict__ bb, float* __restrict__ ada) {
    const int j = blockIdx.x * 256 + threadIdx.x, b = blockIdx.y;
    float acc = 0.f;
    for (int k = 0; k < D; ++k) { const float cv = c[b * D + k]; acc += siluf_(cv) * w[(size_t)k * 6144 + j]; }
    ada[b * 6144 + j] = acc + bb[j];
}

__global__ __launch_bounds__(256) void k_modnorm(const float* __restrict__ x, const float* __restrict__ g, const float* __restrict__ ada, int sh_off, int sc_off, bf16* __restrict__ out) {
    const int lane = threadIdx.x & 63, row = blockIdx.x * 4 + (threadIdx.x >> 6), b = row / SEQ;
    const f32x4* xr = (const f32x4*)(x + (size_t)row * D) + lane;
    f32x4 v[4]; float s = 0.f;
#pragma unroll
    for (int j = 0; j < 4; ++j) { v[j] = xr[64 * j]; s += (v[j].x * v[j].x + v[j].y * v[j].y) + (v[j].z * v[j].z + v[j].w * v[j].w); }
    const float rstd = rsqrtf(wave_sum(s) * (1.f / D) + EPS);
    unsigned long long* o8 = (unsigned long long*)(out + (size_t)row * D) + lane;
#pragma unroll
    for (int j = 0; j < 4; ++j) {
        const int c0 = 256 * j + 4 * lane;
        const f32x4 gg = *(const f32x4*)(g + c0), sc = *(const f32x4*)(ada + b * 6144 + sc_off + c0), sh = *(const f32x4*)(ada + b * 6144 + sh_off + c0);
        const f32x4 r = v[j] * rstd * gg * (1.f + sc) + sh;
        o8[64 * j] = (unsigned long long)pk2(r.x, r.y) | ((unsigned long long)pk2(r.z, r.w) << 32);
    }
}

template <int MODE>
__global__ __launch_bounds__(256) void k_gemm(const bf16* __restrict__ A, int lda, const int* __restrict__ rowidx, const int* __restrict__ cntp, const int* __restrict__ offp,
                                              const float* __restrict__ W, const float* __restrict__ W2, int ldw, void* Cv, int ldc, int M, int K) {
    __shared__ float As[16][68];
    __shared__ float Bs[16][68];
    __shared__ float Bs2[MODE == 1 ? 16 : 1][68];
    const int Mcnt = cntp ? *cntp : M, off = offp ? *offp : 0;
    const int m0 = blockIdx.x * 64, n0 = blockIdx.y * 64;
    if (m0 >= Mcnt) return;
    const int tid = threadIdx.x, tx = tid & 15, ty = tid >> 4;
    float acc[4][4], acc2[4][4];
#pragma unroll
    for (int i = 0; i < 4; ++i)
#pragma unroll
        for (int j = 0; j < 4; ++j) { acc[i][j] = 0.f; acc2[i][j] = 0.f; }
    const int ar = tid >> 2, ak = (tid & 3) * 4, arow = m0 + ar;
    const bool av = arow < Mcnt;
    const size_t asrc = av ? (rowidx ? (size_t)rowidx[arow] : (size_t)(off + arow)) : 0;
    const int bk = tid >> 4, bn = (tid & 15) * 4;
    for (int k0 = 0; k0 < K; k0 += 16) {
        u32x2 raw = (u32x2){0u, 0u};
        if (av) raw = *(const u32x2*)(A + asrc * lda + k0 + ak);
        As[ak + 0][ar] = bf2f(raw.x & 0xffffu); As[ak + 1][ar] = bf2f(raw.x >> 16); As[ak + 2][ar] = bf2f(raw.y & 0xffffu); As[ak + 3][ar] = bf2f(raw.y >> 16);
        const f32x4 w = *(const f32x4*)(W + (size_t)(k0 + bk) * ldw + n0 + bn);
        Bs[bk][bn + 0] = w.x; Bs[bk][bn + 1] = w.y; Bs[bk][bn + 2] = w.z; Bs[bk][bn + 3] = w.w;
        if (MODE == 1) { const f32x4 w2 = *(const f32x4*)(W2 + (size_t)(k0 + bk) * ldw + n0 + bn);
            Bs2[bk][bn + 0] = w2.x; Bs2[bk][bn + 1] = w2.y; Bs2[bk][bn + 2] = w2.z; Bs2[bk][bn + 3] = w2.w; }
        __syncthreads();
#pragma unroll
        for (int kk = 0; kk < 16; ++kk) {
            float a[4], b[4], b2[4];
#pragma unroll
            for (int i = 0; i < 4; ++i) { a[i] = As[kk][ty * 4 + i]; b[i] = Bs[kk][tx * 4 + i]; b2[i] = (MODE == 1) ? Bs2[kk][tx * 4 + i] : 0.f; }
#pragma unroll
            for (int i = 0; i < 4; ++i)
#pragma unroll
                for (int j = 0; j < 4; ++j) { acc[i][j] += a[i] * b[j]; if (MODE == 1) acc2[i][j] += a[i] * b2[j]; }
        }
        __syncthreads();
    }
#pragma unroll
    for (int i = 0; i < 4; ++i) {
        const int r = m0 + ty * 4 + i;
        if (r < Mcnt) {
            const size_t crow = (size_t)(off + r);
            if (MODE == 0) { *(f32x4*)((float*)Cv + crow * ldc + n0 + tx * 4) = (f32x4){acc[i][0], acc[i][1], acc[i][2], acc[i][3]}; }
            else {
                float o[4];
#pragma unroll
                for (int j = 0; j < 4; ++j) o[j] = (MODE == 1) ? siluf_(acc[i][j]) * acc2[i][j] : acc[i][j];
                *(u32x2*)((bf16*)Cv + crow * ldc + n0 + tx * 4) = (u32x2){pk2(o[0], o[1]), pk2(o[2], o[3])};
            }
        }
    }
}

__global__ __launch_bounds__(256) void k_glu(const float* __restrict__ t, bf16* __restrict__ glu) {
    const size_t i = (size_t)blockIdx.x * 256 + threadIdx.x;
    const size_t r = i / 512; const int c = (int)(i % 512);
    const float a = t[r * 1024 + c], ag = t[r * 1024 + 512 + c];
    glu[i] = (bf16)f2bf(a * sigmoidf_(ag));
}
__global__ __launch_bounds__(256) void k_gate(const float* __restrict__ t, bf16* __restrict__ gates, int goff) {
    const size_t i = (size_t)blockIdx.x * 256 + threadIdx.x;
    const size_t r = i / 1024; const int c = (int)(i % 1024);
    gates[r * 2048 + goff + c] = (bf16)f2bf(sigmoidf_(t[i]));
}

__global__ __launch_bounds__(512) void k_conv(const bf16* __restrict__ glu, const float* __restrict__ w_dw, const float* __restrict__ b_dw, const float* __restrict__ lg, const float* __restrict__ lb, bf16* __restrict__ ca) {
    __shared__ float red[16];
    const int t = blockIdx.x, c = threadIdx.x, b = t / SEQ, s = t % SEQ;
    float acc = b_dw[c];
    for (int j = 0; j < KS; ++j) { const int s2 = s + j - KS / 2; if (s2 >= 0 && s2 < SEQ) acc += bf2f(glu[(size_t)(b * SEQ + s2) * CW + c]) * w_dw[j * CW + c]; }
    float sm = wave_sum(acc);
    if ((c & 63) == 0) red[c >> 6] = sm;
    __syncthreads();
    float mu = 0.f;
#pragma unroll
    for (int i = 0; i < 8; ++i) mu += red[i];
    mu *= (1.f / CW);
    const float d = acc - mu;
    float sq = wave_sum(d * d);
    if ((c & 63) == 0) red[8 + (c >> 6)] = sq;
    __syncthreads();
    float var = 0.f;
#pragma unroll
    for (int i = 0; i < 8; ++i) var += red[8 + i];
    var *= (1.f / CW);
    const float u = d * rsqrtf(var + EPS) * lg[c] + lb[c];
    ca[(size_t)t * 1024 + c] = (bf16)f2bf(siluf_(u));
}

__global__ __launch_bounds__(256) void k_qkrope(const float* __restrict__ t, const float* __restrict__ qg, const float* __restrict__ kg, bf16* __restrict__ qkv) {
    const size_t i = (size_t)blockIdx.x * 256 + threadIdx.x;
    const size_t r = i / 12; const int hs = (int)(i % 12);
    const float* src = t + r * 1024 + hs * 64; bf16* dst = qkv + r * 768 + hs * 64;
    if (hs >= 10) { for (int d = 0; d < 64; ++d) dst[d] = (bf16)f2bf(src[d]); return; }
    const float* g = hs < 8 ? qg : kg;
    float ss = 0.f;
    for (int d = 0; d < 64; ++d) ss += src[d] * src[d];
    const float rstd = rsqrtf(ss * (1.f / 64.f) + EPS) , osc = hs < 8 ? QSCALE : 1.f;
    const int s = (int)(r % SEQ); const float prow = (float)(s / 64), pcol = (float)(s % 64);
    for (int half = 0; half < 2; ++half) {
        const float pos = half == 0 ? prow : pcol;
        for (int e = 0; e < 16; ++e) {
            const float invf = powf(10000.f, -(float)(2 * e) / 32.f);
            const float ang = pos * invf; float sn, cs; sincosf(ang, &sn, &cs);
            const int d1 = half * 32 + e, d2 = d1 + 16;
            const float x1 = src[d1] * rstd * g[d1], x2 = src[d2] * rstd * g[d2];
            dst[d1] = (bf16)f2bf((x1 * cs - x2 * sn) * osc);
            dst[d2] = (bf16)f2bf((x2 * cs + x1 * sn) * osc);
        }
    }
}

__global__ __launch_bounds__(256) void k_attn(const bf16* __restrict__ qkv, bf16* __restrict__ ca) {
    const int qi = blockIdx.x * 256 + threadIdx.x;
    const int h = blockIdx.y, b = blockIdx.z, kvh = h / 4;
    const size_t row = (size_t)b * SEQ + qi;
    float q[64], o[64];
    {
        const u32x4* qp = (const u32x4*)(qkv + row * 768 + h * 64);
#pragma unroll
        for (int c = 0; c < 8; ++c) { const u32x4 v = qp[c];
            q[c * 8 + 0] = bf2f(v.x & 0xffffu); q[c * 8 + 1] = bf2f(v.x >> 16); q[c * 8 + 2] = bf2f(v.y & 0xffffu); q[c * 8 + 3] = bf2f(v.y >> 16);
            q[c * 8 + 4] = bf2f(v.z & 0xffffu); q[c * 8 + 5] = bf2f(v.z >> 16); q[c * 8 + 6] = bf2f(v.w & 0xffffu); q[c * 8 + 7] = bf2f(v.w >> 16); }
    }
#pragma unroll
    for (int d = 0; d < 64; ++d) o[d] = 0.f;
    float m = -1e30f, l = 0.f;
    for (int s = 0; s < SEQ; ++s) {
        const u32x4* kp = (const u32x4*)(qkv + ((size_t)b * SEQ + s) * 768 + 512 + kvh * 64);
        const u32x4* vp = (const u32x4*)(qkv + ((size_t)b * SEQ + s) * 768 + 640 + kvh * 64);
        float sc = 0.f;
#pragma unroll
        for (int c = 0; c < 8; ++c) { const u32x4 v = kp[c];
            sc += q[c * 8 + 0] * bf2f(v.x & 0xffffu) + q[c * 8 + 1] * bf2f(v.x >> 16) + q[c * 8 + 2] * bf2f(v.y & 0xffffu) + q[c * 8 + 3] * bf2f(v.y >> 16)
                + q[c * 8 + 4] * bf2f(v.z & 0xffffu) + q[c * 8 + 5] * bf2f(v.z >> 16) + q[c * 8 + 6] * bf2f(v.w & 0xffffu) + q[c * 8 + 7] * bf2f(v.w >> 16); }
        if (sc > m) { const float f = exp2f(m - sc); l *= f;
#pragma unroll
            for (int d = 0; d < 64; ++d) o[d] *= f;
            m = sc; }
        const float p = exp2f(sc - m); l += p;
#pragma unroll
        for (int c = 0; c < 8; ++c) { const u32x4 v = vp[c];
            o[c * 8 + 0] += p * bf2f(v.x & 0xffffu); o[c * 8 + 1] += p * bf2f(v.x >> 16); o[c * 8 + 2] += p * bf2f(v.y & 0xffffu); o[c * 8 + 3] += p * bf2f(v.y >> 16);
            o[c * 8 + 4] += p * bf2f(v.z & 0xffffu); o[c * 8 + 5] += p * bf2f(v.z >> 16); o[c * 8 + 6] += p * bf2f(v.w & 0xffffu); o[c * 8 + 7] += p * bf2f(v.w >> 16); }
    }
    const float il = 1.f / l;
    u32x4* op = (u32x4*)(ca + row * 1024 + 512 + h * 64);
#pragma unroll
    for (int c = 0; c < 8; ++c) op[c] = (u32x4){pk2(o[c * 8 + 0] * il, o[c * 8 + 1] * il), pk2(o[c * 8 + 2] * il, o[c * 8 + 3] * il), pk2(o[c * 8 + 4] * il, o[c * 8 + 5] * il), pk2(o[c * 8 + 6] * il, o[c * 8 + 7] * il)};
}

__global__ __launch_bounds__(256) void k_merge(const float* __restrict__ t1, const float* __restrict__ t2, const bf16* __restrict__ gates, bf16* __restrict__ merged) {
    const size_t i = (size_t)blockIdx.x * 256 + threadIdx.x;
    const size_t r = i / 1024; const int c = (int)(i % 1024);
    if (MK_NPRE >= 3) { const unsigned char* gq = (const unsigned char*)gates; const size_t gi = pg8::gate_index((int)r, c); const float sc = ((float)gq[gi] + 0.5f) * (1.f / 256.f), sa = ((float)gq[gi + 8] + 0.5f) * (1.f / 256.f); merged[i] = (bf16)f2bf(sc * t1[i] + sa * t2[i]); }
    else merged[i] = (bf16)f2bf(bf2f(gates[r * 2048 + c]) * t1[i] + bf2f(gates[r * 2048 + 1024 + c]) * t2[i]);
}

__global__ __launch_bounds__(256) void k_postmix(const float* __restrict__ x, const float* __restrict__ y1, const float* __restrict__ ada, const float* __restrict__ g_post, const float* __restrict__ g_pre2,
                                                 const float* __restrict__ w_group, const float* __restrict__ b_group, const float* __restrict__ w_router, const float* __restrict__ b_router,
                                                 float* __restrict__ x1out, bf16* __restrict__ h2, unsigned* __restrict__ ctl, int* __restrict__ list, unsigned* __restrict__ tokinfo) {
    const int lane = threadIdx.x & 63, row = blockIdx.x * 4 + (threadIdx.x >> 6), b = row / SEQ;
    const float* ad = ada + b * 6144;
    f32x4 yv[4], xv[4]; float s = 0.f;
#pragma unroll
    for (int j = 0; j < 4; ++j) { yv[j] = ((const f32x4*)(y1 + (size_t)row * D) + lane)[64 * j]; xv[j] = ((const f32x4*)(x + (size_t)row * D) + lane)[64 * j];
        s += (yv[j].x * yv[j].x + yv[j].y * yv[j].y) + (yv[j].z * yv[j].z + yv[j].w * yv[j].w); }
    const float rstd1 = rsqrtf(wave_sum(s) * (1.f / D) + EPS);
    float s2 = 0.f;
#pragma unroll
    for (int j = 0; j < 4; ++j) { const int c0 = 256 * j + 4 * lane;
        const f32x4 gp = *(const f32x4*)(g_post + c0), gt = *(const f32x4*)(ad + 2048 + c0);
        xv[j] = xv[j] + gt * (yv[j] * rstd1 * gp);
        ((f32x4*)(x1out + (size_t)row * D) + lane)[64 * j] = xv[j];
        s2 += (xv[j].x * xv[j].x + xv[j].y * xv[j].y) + (xv[j].z * xv[j].z + xv[j].w * xv[j].w); }
    const float rstd2 = rsqrtf(wave_sum(s2) * (1.f / D) + EPS);
    float lg[36];
#pragma unroll
    for (int o = 0; o < 36; ++o) lg[o] = 0.f;
    unsigned long long* o8 = (unsigned long long*)(h2 + (size_t)row * D) + lane;
#pragma unroll
    for (int j = 0; j < 4; ++j) { const int c0 = 256 * j + 4 * lane;
        const f32x4 gg = *(const f32x4*)(g_pre2 + c0), sc = *(const f32x4*)(ad + 4096 + c0), sh = *(const f32x4*)(ad + 3072 + c0);
        const f32x4 hv = xv[j] * rstd2 * gg * (1.f + sc) + sh;
        o8[64 * j] = (unsigned long long)pk2(hv.x, hv.y) | ((unsigned long long)pk2(hv.z, hv.w) << 32);
#pragma unroll
        for (int i = 0; i < 4; ++i) { const int c = c0 + i; const float hvv = hv[i];
            const f32x4 wg = *(const f32x4*)(w_group + c * 4);
            lg[0] += hvv * wg.x; lg[1] += hvv * wg.y; lg[2] += hvv * wg.z; lg[3] += hvv * wg.w;
#pragma unroll
            for (int q = 0; q < 8; ++q) { const f32x4 wr = *(const f32x4*)(w_router + c * 32 + q * 4);
                lg[4 + q * 4 + 0] += hvv * wr.x; lg[4 + q * 4 + 1] += hvv * wr.y; lg[4 + q * 4 + 2] += hvv * wr.z; lg[4 + q * 4 + 3] += hvv * wr.w; } } }
#pragma unroll
    for (int o = 0; o < 36; ++o) lg[o] = wave_sum(lg[o]);
    float gl[4];
#pragma unroll
    for (int g = 0; g < 4; ++g) gl[g] = lg[g] + b_group[g];
    int gi = 0; float gm = gl[0];
#pragma unroll
    for (int g = 1; g < 4; ++g) if (gl[g] > gm) { gm = gl[g]; gi = g; }
    float den = 0.f;
#pragma unroll
    for (int g = 0; g < 4; ++g) den += __expf(gl[g] - gm);
    const float grp_p = 1.f / den;
    float in[8];
#pragma unroll
    for (int i = 0; i < 8; ++i) { float v = 0.f;
#pragma unroll
        for (int g = 0; g < 4; ++g) { const float cand = lg[4 + g * 8 + i] + b_router[g * 8 + i]; v = (g == gi) ? cand : v; }
        in[i] = v; }
    int a = 0; float am = in[0];
#pragma unroll
    for (int i = 1; i < 8; ++i) if (in[i] > am) { am = in[i]; a = i; }
    int bidx = -1; float bm = -3.0e38f;
#pragma unroll
    for (int i = 0; i < 8; ++i) if (i != a && in[i] > bm) { bm = in[i]; bidx = i; }
    const float pb = __expf(bm - am), wa = 1.f / (1.f + pb), wb = pb / (1.f + pb);
    if (lane == 0) {
        const int e0 = gi * 8 + a, e1 = gi * 8 + bidx;
        const unsigned p0 = atomicAdd(ctl + CW_CNT + e0, 1u), p1 = atomicAdd(ctl + CW_CNT + e1, 1u);
        list[(size_t)e0 * ECAP + p0] = row; list[(size_t)e1 * ECAP + p1] = row;
        unsigned* ti = tokinfo + (size_t)row * 8;
        ti[0] = (unsigned)e0; ti[1] = p0; ti[2] = (unsigned)e1; ti[3] = p1; ti[4] = __float_as_uint(grp_p * wa); ti[5] = __float_as_uint(grp_p * wb);
    }
}
__global__ void k_offsets(unsigned* ctl) {
    if (threadIdx.x == 0) { unsigned o = 0; for (int e = 0; e < NE; ++e) { ctl[CW_OFF + e] = o; o += (ctl[CW_CNT + e] + 255u) / 256u * 256u; } ctl[CW_OFF + NE] = o; }
}

__global__ __launch_bounds__(256) void k_final(const bf16* __restrict__ y2, const unsigned* __restrict__ tokinfo, const unsigned* __restrict__ ctl, const float* __restrict__ ada, const float* __restrict__ g_post2, float* __restrict__ out) {
    const int lane = threadIdx.x & 63, row = blockIdx.x * 4 + (threadIdx.x >> 6), b = row / SEQ;
    const unsigned* ti = tokinfo + (size_t)row * 8;
    const unsigned s0 = ctl[CW_OFF + ti[0]] + ti[1], s1 = ctl[CW_OFF + ti[2]] + ti[3];
    const float w0 = __uint_as_float(ti[4]), w1 = __uint_as_float(ti[5]);
    f32x4 yv[4]; float s = 0.f;
#pragma unroll
    for (int j = 0; j < 4; ++j) {
        const u32x2 a = ((const u32x2*)(y2 + (size_t)s0 * D) + lane)[64 * j], c = ((const u32x2*)(y2 + (size_t)s1 * D) + lane)[64 * j];
        yv[j].x = w0 * bf2f(a.x & 0xffffu) + w1 * bf2f(c.x & 0xffffu); yv[j].y = w0 * bf2f(a.x >> 16) + w1 * bf2f(c.x >> 16);
        yv[j].z = w0 * bf2f(a.y & 0xffffu) + w1 * bf2f(c.y & 0xffffu); yv[j].w = w0 * bf2f(a.y >> 16) + w1 * bf2f(c.y >> 16);
        s += (yv[j].x * yv[j].x + yv[j].y * yv[j].y) + (yv[j].z * yv[j].z + yv[j].w * yv[j].w); }
    const float rstd = rsqrtf(wave_sum(s) * (1.f / D) + EPS);
#pragma unroll
    for (int j = 0; j < 4; ++j) { const int c0 = 256 * j + 4 * lane;
        const f32x4 gp = *(const f32x4*)(g_post2 + c0), gt = *(const f32x4*)(ada + b * 6144 + 5120 + c0);
        f32x4* op = (f32x4*)(out + (size_t)row * D) + lane;
        op[64 * j] = op[64 * j] + gt * (yv[j] * rstd * gp); }
}

#endif
extern "C" void kernel_launch(void* const* d_in, const int* in_sizes, int n_in, void* d_out, int out_size, void* d_ws, size_t ws_size, hipStream_t stream) {
    static int grid = 0;
    if (grid == 0) {
        if (n_in != 25 || in_sizes[0] != NTOK * D || out_size != NTOK * D || ws_size < WS_END) { fprintf(stderr, "kernel_launch: unexpected problem (n_in %d, ws %zu); nothing launched\n", n_in, ws_size); grid = -1; return; }
        int dev = 0, cus = 0, per_cu = 0;
        if (hipGetDevice(&dev) != hipSuccess || hipDeviceGetAttribute(&cus, hipDeviceAttributeMultiprocessorCount, dev) != hipSuccess) { grid = -1; return; }
        if (hipFuncSetAttribute((const void*)mega_fwd, hipFuncAttributeMaxDynamicSharedMemorySize, LDS_BYTES) != hipSuccess) { fprintf(stderr, "kernel_launch: hipFuncSetAttribute failed\n"); grid = -1; return; }
        if (hipOccupancyMaxActiveBlocksPerMultiprocessor(&per_cu, (const void*)mega_fwd, NTHR, LDS_BYTES) != hipSuccess || per_cu < 1) { fprintf(stderr, "kernel_launch: occupancy query says %d\n", per_cu); grid = -1; return; }
        (void)hipGetLastError();
        if (cus < 256) { fprintf(stderr, "kernel_launch: built for a 256-CU device (one workgroup per CU, 256 workgroups); this one has %d\n", cus); grid = -1; return; }
        grid = 256;
    }
    if (grid < 0) return;
    unsigned char* ws = (unsigned char*)d_ws;
    if (hipMemsetAsync(ws + WS_CTL, 0, CTL_ZERO_BYTES, stream) != hipSuccess) return;
    Args a{};
    for (int i = 0; i < 25; ++i) a.in[i] = (const float*)d_in[i];
    a.out = (float*)d_out; a.ws = ws; a.flags = MK_FLAGS;
#if MK_NPRE == 10 && MK_ONE
    a.ph_lo = 0; a.ph_hi = 10; a.use_bar = 1;
    hipLaunchKernelGGL(mega_fwd, dim3(grid), dim3(NTHR), LDS_BYTES, stream, a);
#else
    for (int p = 0; p < MK_NPRE; ++p) { a.ph_lo = p; a.ph_hi = p + 1; a.use_bar = 0;
#ifdef MK_REP
        if (p == MK_REP) {
            if (p == 9) a.flags |= 4;
#ifdef MK_REPFLAGS
            a.flags |= MK_REPFLAGS;
#endif
            hipLaunchKernelGGL(mega_fwd, dim3(grid), dim3(NTHR), LDS_BYTES, stream, a);
            a.flags = MK_FLAGS;
            if (p == 6) (void)hipMemsetAsync(ws + WS_CTL, 0, 256, stream);
        }
#endif
        hipLaunchKernelGGL(mega_fwd, dim3(grid), dim3(NTHR), LDS_BYTES, stream, a); }
#endif
#if MK_NPRE < 10
    const float* x = (const float*)d_in[0]; const float* w_in = (const float*)d_in[6];
    const float* w_dw = (const float*)d_in[7]; const float* b_dw = (const float*)d_in[8]; const float* cln_g = (const float*)d_in[9]; const float* cln_b = (const float*)d_in[10];
    const float* w_conv_out = (const float*)d_in[11]; const float* q_g = (const float*)d_in[12]; const float* k_g = (const float*)d_in[13]; const float* w_attn_out = (const float*)d_in[14];
    const float* w_out = (const float*)d_in[15]; const float* g_pre_ffn = (const float*)d_in[16]; const float* g_post_ffn = (const float*)d_in[17];
    const float* w_group = (const float*)d_in[18]; const float* b_group = (const float*)d_in[19]; const float* w_router = (const float*)d_in[20]; const float* b_router = (const float*)d_in[21];
    const float* w_e_gate = (const float*)d_in[22]; const float* w_e_up = (const float*)d_in[23]; const float* w_e_down = (const float*)d_in[24];
    float* out = (float*)d_out; unsigned* ctl = (unsigned*)(ws + WS_CTL); float* ada = (float*)(ws + WS_ADA);
    bf16* h1 = (bf16*)(ws + WS_H1); bf16* merged = (bf16*)(ws + WS_H1); bf16* glu = (bf16*)(ws + WS_GLU); bf16* qkv = (bf16*)(ws + WS_QKV);
    bf16* gates = (bf16*)(ws + WS_GATES); bf16* act = (bf16*)(ws + WS_GATES); bf16* ca = (bf16*)(ws + WS_CA); bf16* h2 = (bf16*)(ws + WS_CA);
    float* tmp = (float*)(ws + WS_TMP); int* list = (int*)(ws + WS_LIST); unsigned* tokinfo = (unsigned*)(ws + WS_TOK); bf16* y2 = (bf16*)(ws + WS_Y2);
    if (MK_NPRE <= 0) k_ada<<<dim3(6144 / 256, NB), 256, 0, stream>>>((const float*)d_in[1], (const float*)d_in[2], (const float*)d_in[3], ada);
    if (MK_NPRE <= 1) k_modnorm<<<NTOK / 4, 256, 0, stream>>>(x, (const float*)d_in[4], ada, 0, 1024, h1);
    if (MK_NPRE <= 2) {
        k_gemm<0><<<dim3(NTOK / 64, 1024 / 64), 256, 0, stream>>>(h1, D, nullptr, nullptr, nullptr, w_in + 0, nullptr, INW, tmp, 1024, NTOK, D);
        k_glu<<<NTOK * 512 / 256, 256, 0, stream>>>(tmp, glu);
        k_gemm<0><<<dim3(NTOK / 64, 768 / 64), 256, 0, stream>>>(h1, D, nullptr, nullptr, nullptr, w_in + 1024, nullptr, INW, tmp, 1024, NTOK, D);
        k_qkrope<<<NTOK * 12 / 256, 256, 0, stream>>>(tmp, q_g, k_g, qkv);
        k_gemm<0><<<dim3(NTOK / 64, 1024 / 64), 256, 0, stream>>>(h1, D, nullptr, nullptr, nullptr, w_in + 1792, nullptr, INW, tmp, 1024, NTOK, D);
        k_gate<<<NTOK * 1024 / 256, 256, 0, stream>>>(tmp, gates, 0);
        k_gemm<0><<<dim3(NTOK / 64, 1024 / 64), 256, 0, stream>>>(h1, D, nullptr, nullptr, nullptr, w_in + 2816, nullptr, INW, tmp, 1024, NTOK, D);
        k_gate<<<NTOK * 1024 / 256, 256, 0, stream>>>(tmp, gates, 1024);
    }
    if (MK_NPRE <= 3 || (MK_FLAGS & 1)) k_conv<<<NTOK, 512, 0, stream>>>(glu, w_dw, b_dw, cln_g, cln_b, ca);
    if (MK_NPRE <= 3 || (MK_FLAGS & 2)) k_attn<<<dim3(SEQ / 256, 8, NB), 256, 0, stream>>>(qkv, ca);
    if (MK_NPRE <= 4) {
        k_gemm<0><<<dim3(NTOK / 64, 1024 / 64), 256, 0, stream>>>(ca, 1024, nullptr, nullptr, nullptr, w_conv_out, nullptr, D, tmp, 1024, NTOK, 512);
        k_gemm<0><<<dim3(NTOK / 64, 1024 / 64), 256, 0, stream>>>(ca + 512, 1024, nullptr, nullptr, nullptr, w_attn_out, nullptr, D, out, 1024, NTOK, 512);
        k_merge<<<NTOK * 1024 / 256, 256, 0, stream>>>(tmp, out, gates, merged);
    }
    if (MK_NPRE <= 6) {
        k_gemm<0><<<dim3(NTOK / 64, 1024 / 64), 256, 0, stream>>>(merged, D, nullptr, nullptr, nullptr, w_out, nullptr, D, tmp, 1024, NTOK, D);
        k_postmix<<<NTOK / 4, 256, 0, stream>>>(x, tmp, ada, (const float*)d_in[5], g_pre_ffn, w_group, b_group, w_router, b_router, out, h2, ctl, list, tokinfo);
    }
    k_offsets<<<1, 64, 0, stream>>>(ctl);
    if (MK_NPRE <= 8) {
        for (int e = 0; e < NE; ++e)
            k_gemm<1><<<dim3(NTOK / 64, DE / 64), 256, 0, stream>>>(h2, D, list + (size_t)e * ECAP, (const int*)ctl + CW_CNT + e, (const int*)ctl + CW_OFF + e,
                                                                  w_e_gate + (size_t)e * D * DE, w_e_up + (size_t)e * D * DE, DE, act, DE, 0, D);
        for (int e = 0; e < NE; ++e)
            k_gemm<2><<<dim3(NTOK / 64, D / 64), 256, 0, stream>>>(act, DE, nullptr, (const int*)ctl + CW_CNT + e, (const int*)ctl + CW_OFF + e,
                                                                 w_e_down + (size_t)e * DE * D, nullptr, D, y2, D, 0, DE);
    }
    k_final<<<NTOK / 4, 256, 0, stream>>>(y2, tokinfo, ctl, ada, g_post_ffn, out);
#endif
}
```

```cpp
#define MK_NPRE 10
#define MK_ONE 1
#define MK_FLAGS 0
#include <hip/hip_runtime.h>
#include <hip/hip_bf16.h>
#include <cstdint>
#include <cstdio>
#include <cmath>

#define GAS __attribute__((address_space(1)))
#define LAS __attribute__((address_space(3)))
typedef unsigned short bf16;
typedef float f32x4 __attribute__((ext_vector_type(4)));
typedef float f32x2 __attribute__((ext_vector_type(2)));
typedef unsigned u32x4 __attribute__((ext_vector_type(4)));
typedef unsigned u32x2 __attribute__((ext_vector_type(2)));
typedef short bf16x8 __attribute__((ext_vector_type(8)));
typedef float f32x16 __attribute__((ext_vector_type(16)));

constexpr int NB = 16, SEQ = 2048, D = 1024, NTOK = NB * SEQ;
constexpr int INW = 3840, CW = 512, NE = 32, DE = 512, KS = 31;
constexpr int ECAP = NTOK;
constexpr int MAXSLOT = 73728;
constexpr float EPS = 1e-6f;
constexpr float QSCALE = 0.125f * 1.4426950408889634f;

constexpr size_t MiB = 1u << 20;
constexpr size_t WS_CTL = 0, CTL_ZERO_BYTES = 64 * 1024;
constexpr size_t WS_ADA = 1 * MiB;
constexpr size_t WS_ROPE = WS_ADA + 512 * 1024;
constexpr size_t WS_WR = WS_ADA + 640 * 1024;
constexpr size_t WS_H1 = 2 * MiB;
constexpr size_t WS_GLU = 66 * MiB;
constexpr size_t WS_QKV = 98 * MiB;
constexpr size_t WS_Y1 = 66 * MiB;
constexpr size_t WS_GATES = 146 * MiB;
constexpr size_t WS_X1B = 218 * MiB;
constexpr size_t WS_CA = 282 * MiB;
constexpr size_t WS_WIN = 346 * MiB;
constexpr size_t WS_WCA = WS_WIN + (size_t)INW * D * 2;
constexpr size_t WS_WO = WS_WCA + 2 * MiB;
constexpr size_t WS_W1 = WS_WO + 2 * MiB;
constexpr size_t WS_W2 = WS_W1 + 32 * MiB;
constexpr size_t WS_H2F = WS_W2 + 16 * MiB;
constexpr size_t WS_WINF = WS_H2F + 32 * MiB;
constexpr size_t WS_WEND = WS_WINF + 6 * MiB;
constexpr size_t WS_H1F = 282 * MiB;
constexpr size_t WS_TMP = 346 * MiB;
constexpr size_t WS_LIST = 474 * MiB;
constexpr size_t WS_TOK = 478 * MiB;
constexpr size_t WS_PART = 480 * MiB;
constexpr size_t WS_Y2 = 2 * MiB;
constexpr size_t WS_END = 482 * MiB;
static_assert(WS_WEND <= WS_LIST && WS_Y2 + (size_t)MAXSLOT * D * 2 <= WS_GATES && WS_GATES + (size_t)MAXSLOT * DE * 2 <= WS_X1B && WS_X1B + (size_t)NTOK * D * 2 <= WS_CA && WS_GATES + (size_t)NTOK * 2048 * 2 <= WS_CA && WS_CA + (size_t)NTOK * D * 2 <= WS_WIN, "d_ws map");
constexpr int CW_CNT = 0, CW_OFF = 64, CW_ADA = 128, CW_BAR = 4096;

__device__ __forceinline__ float bf2f(unsigned v) { return __uint_as_float(v << 16); }
__device__ __forceinline__ unsigned f2bf(float f) { unsigned u = __float_as_uint(f); return (u + 0x7fffu + ((u >> 16) & 1u)) >> 16; }
__device__ __forceinline__ unsigned pk2(float lo, float hi) { return f2bf(lo) | (f2bf(hi) << 16); }
__device__ __forceinline__ unsigned cvt_pk_bf16(float lo, float hi) { unsigned r; asm volatile("v_cvt_pk_bf16_f32 %0, %1, %2" : "=v"(r) : "v"(lo), "v"(hi)); return r; }
template <int CTRL> __device__ __forceinline__ float dpp_mov(float v) { return __builtin_bit_cast(float, __builtin_amdgcn_update_dpp(0, __builtin_bit_cast(int, v), CTRL, 0xf, 0xf, true)); }
__device__ __forceinline__ float row16_sum(float v) {
    v += dpp_mov<0xB1>(v);
    v += dpp_mov<0x4E>(v);
    v += dpp_mov<0x141>(v);
    v += dpp_mov<0x140>(v);
    return v;
}
__device__ __forceinline__ float wave_sum(float v) {
    v = row16_sum(v);
    { auto rr = __builtin_amdgcn_permlane16_swap(__float_as_uint(v), __float_as_uint(v), false, false); v = __uint_as_float(rr[0]) + __uint_as_float(rr[1]); }
    { auto rr = __builtin_amdgcn_permlane32_swap(__float_as_uint(v), __float_as_uint(v), false, false); v = __uint_as_float(rr[0]) + __uint_as_float(rr[1]); }
    return v;
}
__device__ __forceinline__ float sigmoidf_(float v) { return 1.f / (1.f + __expf(-v)); }
__device__ __forceinline__ float siluf_(float v) { return v / (1.f + __expf(-v)); }
__device__ __forceinline__ float sig_fast(float v) { return __builtin_amdgcn_rcpf(1.f + __builtin_amdgcn_exp2f(v * -1.4426950408889634f)); }
#define LDS_WAIT() asm volatile("s_waitcnt lgkmcnt(0)" ::: "memory")
#define VM_WAIT() asm volatile("s_waitcnt vmcnt(0)" ::: "memory")

__host__ __device__ __forceinline__ int vmap_win(int n) {
    if (n < 512) return 256 * (n >> 7) + (n & 127);
    if (n < 1024) { const int j = n - 512; return 256 * (j >> 7) + 128 + (j & 127); }
    if (n < 1664) { const int idx = n - 1024, hh = idx >> 6, d = idx & 63, tile = 4 + (hh >> 2), wc = hh & 3, bj = (d >> 4) & 1, e = (d < 32) ? (d & 15) : 16 + (d & 15);
        return 256 * tile + 128 * bj + 32 * wc + e; }
    if (n < 1792) { const int idx = n - 1664, vh = idx >> 6, d = idx & 63; return 256 * 6 + 128 * (d >> 5) + 32 * (2 + vh) + (d & 31); }
    if (n < 2816) { const int j = n - 1792; return 256 * (7 + (j >> 7)) + (j & 127); }
    { const int j = n - 2816; return 256 * (7 + (j >> 7)) + 128 + (j & 127); }
}

namespace pg8 {
constexpr int BM = 256, BK = 64, HALF = 128, HTB = HALF * BK * 2  , STAGE_BYTES = 8 * HTB, NXCD = 8, WGM = 8;
__host__ __device__ __forceinline__ int lds_byte(int r, int c) { const int st = (r >> 4) * 2 + (c >> 5), rr = r & 15, cc = c & 31, ob = rr * 64 + cc * 2; return st * 1024 + (ob ^ (((ob >> 9) & 1) << 5)); }
__host__ __device__ __forceinline__ void stage_rc(int b, int& R, int& C) { const int st = b / 1024, sb = b % 1024, swz = sb ^ (((sb >> 9) & 1) << 5); R = (st >> 1) * 16 + swz / 64; C = (st & 1) * 32 + (swz % 64) / 2; }
__host__ __device__ __forceinline__ int perm32(int rho) { const int n = rho >> 4, i = rho & 15; return 8 * (i >> 2) + 4 * n + (i & 3); }

struct Unit { int pm, pn, e, ord; };

struct StaticOrder {
    const void* Bt; int KB; int nM, nN, nwg, G, c;
    __device__ void init(const void* Bt_, int KB_, int M, int N, int G_, int c_) { Bt = Bt_; KB = KB_; nM = M / BM; nN = N / BM; nwg = nM * nN; G = G_; c = c_; }
    __device__ __forceinline__ bool next(int i, Unit& u) const {
        const long L = (long)i * G + c; if (L >= nwg) return false;
        int wgid = (int)L; { const int q = nwg / NXCD, r = nwg % NXCD, xcd = wgid % NXCD, off = wgid / NXCD; wgid = (xcd < r ? xcd * (q + 1) : r * (q + 1) + (xcd - r) * q) + off; }
        const int nig = WGM * nN, gid = wgid / nig, fm = gid * WGM, gsz = (nM - fm) < WGM ? (nM - fm) : WGM;
        u.pm = fm + ((wgid % nig) % gsz); u.pn = (wgid % nig) / gsz; u.e = 0; u.ord = i; return true;
    }
    static constexpr bool GATHER = false;
    __device__ __forceinline__ int arow(const Unit& u, int r) const { return u.pm * BM + r; }
    __device__ __forceinline__ const char* bbase(const Unit& u) const { return (const char*)Bt + (size_t)u.pn * BM * KB; }
};

typedef int v8i32 __attribute__((ext_vector_type(8)));
typedef int v4i32 __attribute__((ext_vector_type(4)));
__device__ __forceinline__ void mfma_fp8_inplace(f32x4& d, const v8i32 a, const v8i32 b, const int scale) {
    asm volatile("v_mfma_scale_f32_16x16x128_f8f6f4 %0, %1, %2, %0, %3, %3 op_sel_hi:[0,0,0]" : "+v"(d) : "v"(a), "v"(b), "v"(scale));
}
__device__ __forceinline__ void mfma_bf16_inplace(f32x4& d, const bf16x8 a, const bf16x8 b) {
    asm volatile("v_mfma_f32_16x16x32_bf16 %0, %1, %2, %0" : "+v"(d) : "v"(a), "v"(b));
}
template <class Epi, class Sched, bool ALIGN_EPI, int DT = 0>
__device__ __forceinline__ void gemm_phase(LAS unsigned char* lds, const void* A, int ldaB_, int KB, const Sched& S, const Epi& E, const void* A8 = nullptr, int kbytes = 0) {
    const int tid = threadIdx.x, wid = __builtin_amdgcn_readfirstlane(tid >> 6), lane = tid & 63, wr = wid >> 2, wc = wid & 3, fr = lane & 15, fq = lane >> 4;
    const int nt_full = (kbytes ? kbytes : KB) / (BK * 2);
    const unsigned ldaB = (unsigned)ldaB_;
    unsigned voffA[2], voffB[2];
#pragma unroll
    for (int i = 0; i < 2; ++i) { int R, C; stage_rc(tid * 16 + i * 8192, R, C); const int Rb = (R & ~31) + perm32(R & 31);
        voffA[i] = (unsigned)R * ldaB + (unsigned)C * 2u; voffB[i] = (unsigned)(Rb * KB + C * 2); }
    const size_t kstep = (size_t)(BK * 2);
    const size_t hstep = (size_t)HALF * KB;
    const size_t hstepA = (size_t)HALF * ldaB;
    const unsigned ldsw = (unsigned)wid * 1024u;
    const int aoff = lds_byte(wr * 64 + fr, fq * 8), boff = lds_byte(wc * 32 + fr, fq * 8);
#define PG8_SA(b, h) (((b) * 2 + (h)) * HTB)
#define PG8_SB(b, h) ((4 + (b) * 2 + (h)) * HTB)
#define PG8_STAGE(bufoff, gbase, voff) do { _Pragma("unroll") for (int _i = 0; _i < 2; ++_i) \
        __builtin_amdgcn_global_load_lds((const unsigned*)((const char*)(gbase) + (voff)[_i]), (LAS unsigned*)(lds + (bufoff) + ldsw + _i * 8192), 16, 0, 0); } while (0)
#define PG8_LDA(dst, b, h) do { _Pragma("unroll") for (int m = 0; m < 4; ++m) _Pragma("unroll") for (int k = 0; k < 2; ++k) dst[m][k] = *(const LAS bf16x8*)(lds + PG8_SA(b, h) + aoff + m * 2048 + k * 1024); } while (0)
#define PG8_LDB(dst, b, h) do { _Pragma("unroll") for (int n = 0; n < 2; ++n) _Pragma("unroll") for (int k = 0; k < 2; ++k) dst[n][k] = *(const LAS bf16x8*)(lds + PG8_SB(b, h) + boff + n * 2048 + k * 1024); } while (0)
#define PG8_CAT(x) __builtin_shufflevector(__builtin_bit_cast(v4i32, (x)[0]), __builtin_bit_cast(v4i32, (x)[1]), 0, 1, 2, 3, 4, 5, 6, 7)
#define PG8_MMA(ai, bj, At, Bt) do { __builtin_amdgcn_s_setprio(1); \
        if (DT == 1 || (DT == 2 && f8cur)) { _Pragma("unroll") for (int m = 0; m < 4; ++m) _Pragma("unroll") for (int n = 0; n < 2; ++n) \
            mfma_fp8_inplace(acc[ai][bj][m][n], PG8_CAT(Bt[n]), PG8_CAT(At[m]), one_scale); } \
        else { _Pragma("unroll") for (int m = 0; m < 4; ++m) _Pragma("unroll") for (int n = 0; n < 2; ++n) _Pragma("unroll") for (int k = 0; k < 2; ++k) \
            { if constexpr (DT == 2) mfma_bf16_inplace(acc[ai][bj][m][n], Bt[n][k], At[m][k]); else acc[ai][bj][m][n] = __builtin_amdgcn_mfma_f32_16x16x32_bf16(Bt[n][k], At[m][k], acc[ai][bj][m][n], 0, 0, 0); } } \
        __builtin_amdgcn_s_setprio(0); } while (0)
#define PG8_WAIT_V(n) asm volatile("s_waitcnt vmcnt(" #n ")" ::: "memory")
#define PG8_WAIT_L(n) asm volatile("s_waitcnt lgkmcnt(" #n ")" ::: "memory")
#define PG8_BAR __builtin_amdgcn_s_barrier()
#define PG8_SCHED __builtin_amdgcn_sched_barrier(0)
#define PG8_MKVA(dst, u) do { _Pragma("unroll") for (int _h = 0; _h < 2; ++_h) _Pragma("unroll") for (int _p = 0; _p < 2; ++_p) { int _R, _C; stage_rc(tid * 16 + _p * 8192, _R, _C); \
        dst[_h][_p] = (unsigned)S.arow(u, _h * HALF + _R) * ldaB + (unsigned)_C * 2u; } } while (0)
#define PG8_STAGE_AC(bufoff, h, kofs) do { if constexpr (Sched::GATHER) PG8_STAGE(bufoff, Ab + (kofs), vA[h]); else PG8_STAGE(bufoff, cA + (h) * hstepA + (kofs), voffA); } while (0)
#define PG8_STAGE_AN(bufoff, h, kofs) do { if constexpr (Sched::GATHER) PG8_STAGE(bufoff, Ab + (kofs), nvA[h]); else PG8_STAGE(bufoff, nA + (h) * hstepA + (kofs), voffA); } while (0)
#define PG8_STAGE_A23(bufoff, h, w) do { if (last) PG8_STAGE_AN(bufoff, h, (size_t)(w) * kstep); else PG8_STAGE_AC(bufoff, h, (size_t)(t + 2 + (w)) * kstep); } while (0)
    Unit cur, nxt; int ui = 0;
    if (!S.next(0, cur)) return;
    f32x4 acc[2][2][4][2];
#pragma unroll
    for (int a = 0; a < 2; ++a)
#pragma unroll
        for (int b = 0; b < 2; ++b)
#pragma unroll
            for (int m = 0; m < 4; ++m)
#pragma unroll
                for (int n = 0; n < 2; ++n) acc[a][b][m][n] = (f32x4){0.f, 0.f, 0.f, 0.f};
    bf16x8 At[4][2], B0[2][2], B1[2][2];
    int one_scale = 0x7f7f7f7f; asm volatile("" : "+v"(one_scale));
    unsigned vA[2][2], nvA[2][2];
    const char* const Ab = (const char*)A;
    const char* cA = Ab; const char* nA = Ab;
    bool f8cur = (DT == 2) && cur.e != 0; int nt = (DT == 2 && f8cur) ? (nt_full >> 1) : nt_full;
#define PG8_ABASE(u) ((DT == 2 && (u).e != 0) ? (const char*)A8 : Ab)
    if constexpr (Sched::GATHER) { PG8_MKVA(vA, cur); } else { cA = PG8_ABASE(cur) + (size_t)S.arow(cur, 0) * ldaB; }
    const char* cB = S.bbase(cur);
    PG8_STAGE(PG8_SB(0, 0), cB, voffB); PG8_STAGE(PG8_SB(0, 1), cB + hstep, voffB); PG8_STAGE_AC(PG8_SA(0, 0), 0, 0); PG8_STAGE_AC(PG8_SA(0, 1), 1, 0);
    if (wr == 1) PG8_BAR;
    PG8_WAIT_V(2); PG8_BAR;
    PG8_STAGE(PG8_SB(1, 0), cB + kstep, voffB); PG8_STAGE_AC(PG8_SA(1, 0), 0, kstep); PG8_STAGE(PG8_SB(1, 1), cB + hstep + kstep, voffB);
    PG8_WAIT_V(6); PG8_BAR;
    for (;;) {
        const bool has_next = S.next(ui + 1, nxt);
        const char* nB = has_next ? S.bbase(nxt) : cB;
        if constexpr (!Sched::GATHER) nA = has_next ? PG8_ABASE(nxt) + (size_t)S.arow(nxt, 0) * ldaB : cA;
#pragma unroll 1
        for (int t = 0; t < nt; t += 2) {
            const bool last = (t == nt - 2);
            if constexpr (Epi::MID) { if (t == (nt >> 1)) { if (wr == 0) PG8_BAR; if constexpr (DT != 0) asm volatile("s_nop 15\n\ts_nop 15" ::: "memory"); E.mid(acc, cur, wr, wc, fr, fq); if (wr == 1) PG8_BAR; } }
            if constexpr (Sched::GATHER) { if (last) { if (has_next) { PG8_MKVA(nvA, nxt); } else {
#pragma unroll
                    for (int h = 0; h < 2; ++h)
#pragma unroll
                        for (int p = 0; p < 2; ++p) nvA[h][p] = vA[h][p]; } } }
            const char* b2 = last ? nB : cB + (size_t)(t + 2) * kstep; const char* b3 = b2 + kstep;
            PG8_LDB(B0, 0, 0); PG8_LDB(B1, 0, 1); PG8_SCHED; PG8_LDA(At, 0, 0); PG8_STAGE_AC(PG8_SA(1, 1), 1, (size_t)(t + 1) * kstep);
            PG8_WAIT_V(8); PG8_WAIT_L(0); PG8_BAR; PG8_MMA(0, 0, At, B0); PG8_MMA(0, 1, At, B1); PG8_BAR; PG8_SCHED;
            PG8_LDA(At, 0, 1); PG8_STAGE(PG8_SB(0, 0), b2, voffB); PG8_STAGE(PG8_SB(0, 1), b2 + hstep, voffB); PG8_STAGE_A23(PG8_SA(0, 0), 0, 0);
            PG8_WAIT_V(8); PG8_WAIT_L(0); PG8_BAR; PG8_MMA(1, 0, At, B0); PG8_MMA(1, 1, At, B1); PG8_BAR; PG8_SCHED;
            PG8_LDB(B0, 1, 0); PG8_LDB(B1, 1, 1); PG8_SCHED; PG8_LDA(At, 1, 0); PG8_STAGE_A23(PG8_SA(0, 1), 1, 0);
            PG8_WAIT_V(8); PG8_WAIT_L(0); PG8_BAR; PG8_MMA(0, 0, At, B0); PG8_MMA(0, 1, At, B1); PG8_BAR; PG8_SCHED;
            PG8_LDA(At, 1, 1); PG8_STAGE(PG8_SB(1, 0), b3, voffB); PG8_STAGE(PG8_SB(1, 1), b3 + hstep, voffB); PG8_STAGE_A23(PG8_SA(1, 0), 0, 1);
            PG8_WAIT_V(8); PG8_WAIT_L(0); PG8_BAR; PG8_MMA(1, 0, At, B0); PG8_MMA(1, 1, At, B1); PG8_BAR; PG8_SCHED;
        }
        if constexpr (ALIGN_EPI) { if (wr == 0) PG8_BAR; }
        if constexpr (DT != 0) asm volatile("s_nop 15\n\ts_nop 15" ::: "memory");
        E(acc, cur, wr, wc, fr, fq);
        if (!has_next) break;
#pragma unroll
        for (int a = 0; a < 2; ++a)
#pragma unroll
            for (int b = 0; b < 2; ++b)
#pragma unroll
                for (int m = 0; m < 4; ++m)
#pragma unroll
                    for (int n = 0; n < 2; ++n) acc[a][b][m][n] = (f32x4){0.f, 0.f, 0.f, 0.f};
        cur = nxt; cB = nB; ++ui;
        if constexpr (DT == 2) { f8cur = cur.e != 0; nt = f8cur ? (nt_full >> 1) : nt_full; }
        if constexpr (Sched::GATHER) {
#pragma unroll
            for (int h = 0; h < 2; ++h)
#pragma unroll
                for (int p = 0; p < 2; ++p) vA[h][p] = nvA[h][p]; } else cA = nA;
        if constexpr (ALIGN_EPI) { if (wr == 1) PG8_BAR; }
    }
    PG8_WAIT_V(0);
    if constexpr (!ALIGN_EPI) { if (wr == 0) PG8_BAR; }
    PG8_BAR;
#undef PG8_ABASE
#undef PG8_STAGE_AC
#undef PG8_STAGE_AN
#undef PG8_STAGE_A23
#undef PG8_SA
#undef PG8_SB
#undef PG8_STAGE
#undef PG8_LDA
#undef PG8_LDB
#undef PG8_MMA
#undef PG8_WAIT_V
#undef PG8_WAIT_L
#undef PG8_BAR
#undef PG8_SCHED
#undef PG8_MKVA
#undef PG8_CAT
}
}
namespace pg8 {
__host__ __device__ __forceinline__ size_t gate_frag_base(int pm, int t, int w) { return ((size_t)((pm * 8 + t) * 8 + w) * 8) * 1024; }
__host__ __device__ __forceinline__ size_t gate_index(int row, int col) {
    const int pm = row >> 8, t = col >> 7, w = 4 * ((row >> 6) & 1) + ((col >> 5) & 3), k = 4 * ((row >> 7) & 1) + ((row >> 4) & 3), l = 16 * ((col >> 3) & 3) + (row & 15);
    return gate_frag_base(pm, t, w) + (size_t)k * 1024 + l * 16 + (col & 7);
}
__device__ __forceinline__ unsigned q8x4(float a, float b, float c, float d) {
    unsigned r = __builtin_amdgcn_cvt_pk_u8_f32(a * 256.f - 0.5f, 0, 0u); r = __builtin_amdgcn_cvt_pk_u8_f32(b * 256.f - 0.5f, 1, r);
    r = __builtin_amdgcn_cvt_pk_u8_f32(c * 256.f - 0.5f, 2, r); return __builtin_amdgcn_cvt_pk_u8_f32(d * 256.f - 0.5f, 3, r);
}
__device__ __forceinline__ void dq8x4(unsigned w, float (&f)[4]) { f[0] = (float)(w & 0xffu) + 0.5f; f[1] = (float)((w >> 8) & 0xffu) + 0.5f; f[2] = (float)((w >> 16) & 0xffu) + 0.5f; f[3] = (float)(w >> 24) + 0.5f; }
constexpr float WSCIN = 32.f, WSCO = 32.f, MSC = 8.f, WSCCA = 16.f, CSC = 8.f, ASC = 32.f;
__device__ __forceinline__ unsigned pk4_fp8(float a, float b, float c, float d) { int r = __builtin_amdgcn_cvt_pk_fp8_f32(a, b, 0, false); r = __builtin_amdgcn_cvt_pk_fp8_f32(c, d, r, true); return (unsigned)r; }
struct EpiP2 {
    static constexpr bool MID = false;
    bf16* glu; bf16* qkv; bf16* gates; const float* qg; const float* kg; const f32x2* rope;
    __device__ __forceinline__ void operator()(const f32x4 (&acc)[2][2][4][2], const Unit& u, int wr, int wc, int fr, int fq) const {
        const int row0 = u.pm * BM + wr * 64 + fr;
        if (u.pn < 4) {
#pragma unroll
            for (int ai = 0; ai < 2; ++ai)
#pragma unroll
                for (int m = 0; m < 4; ++m) { const size_t row = (size_t)(row0 + ai * HALF + m * 16);
                    constexpr float isg = 1.f / WSCIN;
                    const f32x4 a0 = acc[ai][0][m][0] * isg, a1 = acc[ai][0][m][1] * isg, g0 = acc[ai][1][m][0] * isg, g1 = acc[ai][1][m][1] * isg;
                    u32x4 w; w.x = cvt_pk_bf16(a0[0] * sig_fast(g0[0]), a0[1] * sig_fast(g0[1])); w.y = cvt_pk_bf16(a0[2] * sig_fast(g0[2]), a0[3] * sig_fast(g0[3]));
                    w.z = cvt_pk_bf16(a1[0] * sig_fast(g1[0]), a1[1] * sig_fast(g1[1])); w.w = cvt_pk_bf16(a1[2] * sig_fast(g1[2]), a1[3] * sig_fast(g1[3]));
                    *(u32x4*)(glu + row * CW + u.pn * 128 + wc * 32 + fq * 8) = w; }
        } else if (u.pn < 7) {
            const int hs = (u.pn - 4) * 4 + wc;
            if (hs >= 10) {
#pragma unroll
                for (int ai = 0; ai < 2; ++ai)
#pragma unroll
                    for (int m = 0; m < 4; ++m) { const size_t row = (size_t)(row0 + ai * HALF + m * 16);
#pragma unroll
                        for (int bj = 0; bj < 2; ++bj) { const f32x4 v0 = acc[ai][bj][m][0], v1 = acc[ai][bj][m][1];
                            u32x4 w; w.x = cvt_pk_bf16(v0[0], v0[1]); w.y = cvt_pk_bf16(v0[2], v0[3]); w.z = cvt_pk_bf16(v1[0], v1[1]); w.w = cvt_pk_bf16(v1[2], v1[3]);
                            *(u32x4*)(qkv + row * 768 + hs * 64 + bj * 32 + fq * 8) = w; } }
            } else {
                const float* g = hs < 8 ? qg : kg; const float osc = hs < 8 ? QSCALE : 1.f;
                const int dbase = fq < 2 ? 8 * fq : 8 * fq + 16;
                float g1[8], g2[8];
#pragma unroll
                for (int i = 0; i < 8; ++i) { g1[i] = g[dbase + i] * osc; g2[i] = g[dbase + 16 + i] * osc; }
#pragma unroll
                for (int ai = 0; ai < 2; ++ai)
#pragma unroll
                    for (int m = 0; m < 4; ++m) { const int rowi = row0 + ai * HALF + m * 16; const size_t row = (size_t)rowi;
                        const int s = rowi & (SEQ - 1); const int tabrow = fq < 2 ? (s >> 6) : 32 + (s & 63);
                        const f32x2* tp = rope + tabrow * 16 + 8 * (fq & 1);
                        float ss = 0.f;
#pragma unroll
                        for (int bj = 0; bj < 2; ++bj)
#pragma unroll
                            for (int n = 0; n < 2; ++n) { const f32x4 v = acc[ai][bj][m][n]; ss += (v[0] * v[0] + v[1] * v[1]) + (v[2] * v[2] + v[3] * v[3]); }
                        ss += __shfl_xor(ss, 16); ss += __shfl_xor(ss, 32);
                        const float rstd = rsqrtf(ss * (1.f / 64.f) + EPS);
                        float o1[8], o2[8];
#pragma unroll
                        for (int n = 0; n < 2; ++n)
#pragma unroll
                            for (int j = 0; j < 4; ++j) { const f32x2 cs = tp[4 * n + j];
                                const float x1 = acc[ai][0][m][n][j] * rstd * g1[4 * n + j], x2 = acc[ai][1][m][n][j] * rstd * g2[4 * n + j];
                                o1[4 * n + j] = x1 * cs.x - x2 * cs.y; o2[4 * n + j] = x2 * cs.x + x1 * cs.y; }
                        u32x4 w1, w2;
                        w1.x = cvt_pk_bf16(o1[0], o1[1]); w1.y = cvt_pk_bf16(o1[2], o1[3]); w1.z = cvt_pk_bf16(o1[4], o1[5]); w1.w = cvt_pk_bf16(o1[6], o1[7]);
                        w2.x = cvt_pk_bf16(o2[0], o2[1]); w2.y = cvt_pk_bf16(o2[2], o2[3]); w2.z = cvt_pk_bf16(o2[4], o2[5]); w2.w = cvt_pk_bf16(o2[6], o2[7]);
                        bf16* dst = qkv + row * 768 + hs * 64 + dbase;
                        *(u32x4*)dst = w1; *(u32x4*)(dst + 16) = w2; }
            }
        } else {
            unsigned char* gr = (unsigned char*)gates + gate_frag_base(u.pm, u.pn - 7, wr * 4 + wc) + (fq * 16 + fr) * 16;
#pragma unroll
            for (int ai = 0; ai < 2; ++ai)
#pragma unroll
                for (int m = 0; m < 4; ++m) {
                    float sc[8], sa[8];
#pragma unroll
                    for (int n = 0; n < 2; ++n)
#pragma unroll
                        for (int j = 0; j < 4; ++j) {
                            const float dc = 1.f + __builtin_amdgcn_exp2f(acc[ai][0][m][n][j] * (-1.4426950408889634f / WSCIN)), da = 1.f + __builtin_amdgcn_exp2f(acc[ai][1][m][n][j] * (-1.4426950408889634f / WSCIN));
                            const float rinv = __builtin_amdgcn_rcpf(dc * da); sc[4 * n + j] = rinv * da; sa[4 * n + j] = rinv * dc; }
                    *(u32x4*)(gr + (ai * 4 + m) * 1024) = (u32x4){q8x4(sc[0], sc[1], sc[2], sc[3]), q8x4(sc[4], sc[5], sc[6], sc[7]), q8x4(sa[0], sa[1], sa[2], sa[3]), q8x4(sa[4], sa[5], sa[6], sa[7])}; }
        }
    }
};
__device__ __forceinline__ void unpack8(const u32x4 w, float (&f)[8]) {
    f[0] = bf2f(w.x & 0xffffu); f[1] = bf2f(w.x >> 16); f[2] = bf2f(w.y & 0xffffu); f[3] = bf2f(w.y >> 16);
    f[4] = bf2f(w.z & 0xffffu); f[5] = bf2f(w.z >> 16); f[6] = bf2f(w.w & 0xffffu); f[7] = bf2f(w.w >> 16);
}
struct EpiP4 {
    static constexpr bool MID = true;
    const bf16* gates; bf16* merged;
    __device__ __forceinline__ void mid(f32x4 (&acc)[2][2][4][2], const Unit& u, int wr, int wc, int fr, int fq) const {
        asm volatile("" ::: "memory");
        u32x4 rr[2][8];
#pragma unroll
        for (int bj = 0; bj < 2; ++bj) { const unsigned char* gp = (const unsigned char*)gates + gate_frag_base(u.pm, 2 * u.pn + bj, wr * 4 + wc) + (fq * 16 + fr) * 16;
#pragma unroll
            for (int k = 0; k < 8; ++k) rr[bj][k] = *(const u32x4*)(gp + k * 1024); }
#pragma unroll
        for (int bj = 0; bj < 2; ++bj)
#pragma unroll
            for (int k = 0; k < 8; ++k)
#pragma unroll
                for (int n = 0; n < 2; ++n) { float c[4], a[4]; dq8x4(n ? rr[bj][k].y : rr[bj][k].x, c); dq8x4(n ? rr[bj][k].w : rr[bj][k].z, a);
#pragma unroll
                    for (int j = 0; j < 4; ++j) acc[k >> 2][bj][k & 3][n][j] *= (c[j] * (ASC / CSC)) * __builtin_amdgcn_rcpf(a[j]); }
        asm volatile("" ::: "memory");
    }
    __device__ __forceinline__ void operator()(const f32x4 (&acc)[2][2][4][2], const Unit& u, int wr, int wc, int fr, int fq) const {
        const int row0 = u.pm * BM + wr * 64 + fr, col0 = u.pn * BM + wc * 32 + fq * 8;
        u32x2 rr[2][8];
#pragma unroll
        for (int bj = 0; bj < 2; ++bj) { const unsigned char* gp = (const unsigned char*)gates + gate_frag_base(u.pm, 2 * u.pn + bj, wr * 4 + wc) + (fq * 16 + fr) * 16 + 8;
#pragma unroll
            for (int k = 0; k < 8; ++k) rr[bj][k] = *(const u32x2*)(gp + k * 1024); }
        asm volatile("" ::: "memory");
#pragma unroll
        for (int bj = 0; bj < 2; ++bj)
#pragma unroll
            for (int k = 0; k < 8; ++k) { const size_t row = (size_t)(row0 + (k >> 2) * HALF + (k & 3) * 16);
                float a0[4], a1[4]; dq8x4(rr[bj][k].x, a0); dq8x4(rr[bj][k].y, a1); constexpr float s = MSC / (256.f * ASC * WSCCA);
                const f32x4 v0 = acc[k >> 2][bj][k & 3][0] * s, v1 = acc[k >> 2][bj][k & 3][1] * s;
                *(u32x2*)((unsigned char*)merged + row * D + col0 + bj * HALF) = (u32x2){pk4_fp8(v0[0] * a0[0], v0[1] * a0[1], v0[2] * a0[2], v0[3] * a0[3]), pk4_fp8(v1[0] * a1[0], v1[1] * a1[1], v1[2] * a1[2], v1[3] * a1[3])}; }
    }
};
struct EpiP5 {
    static constexpr bool MID = false;
    bf16* y1; float* part;
    __device__ __forceinline__ void operator()(const f32x4 (&acc)[2][2][4][2], const Unit& u, int wr, int wc, int fr, int fq) const {
        const int row0 = u.pm * BM + wr * 64 + fr, col0 = u.pn * BM + wc * 32 + fq * 8;
#pragma unroll
        for (int ai = 0; ai < 2; ++ai)
#pragma unroll
            for (int m = 0; m < 4; ++m) { const size_t row = (size_t)(row0 + ai * HALF + m * 16); float ss = 0.f;
#pragma unroll
                for (int bj = 0; bj < 2; ++bj) { constexpr float is5 = 1.f / (WSCO * MSC); const f32x4 v0 = acc[ai][bj][m][0] * is5, v1 = acc[ai][bj][m][1] * is5;
                    ss += (v0[0] * v0[0] + v0[1] * v0[1]) + (v0[2] * v0[2] + v0[3] * v0[3]) + (v1[0] * v1[0] + v1[1] * v1[1]) + (v1[2] * v1[2] + v1[3] * v1[3]);
                    u32x4 w; w.x = cvt_pk_bf16(v0[0], v0[1]); w.y = cvt_pk_bf16(v0[2], v0[3]); w.z = cvt_pk_bf16(v1[0], v1[1]); w.w = cvt_pk_bf16(v1[2], v1[3]);
                    *(u32x4*)(y1 + row * D + col0 + bj * HALF) = w; }
                ss += __shfl_xor(ss, 16); ss += __shfl_xor(ss, 32);
                if (fq == 0) part[row * 16 + u.pn * 4 + wc] = ss; }
    }
};
constexpr float WSC1 = 32.f, WSC2 = 16.f;
struct EpiMoe1 {
    static constexpr bool MID = false;
    unsigned char* act;
    __device__ __forceinline__ void operator()(const f32x4 (&acc)[2][2][4][2], const Unit& u, int wr, int wc, int fr, int fq) const {
        const int row0 = u.pm * BM + wr * 64 + fr; constexpr float is = 1.f / WSC1;
#pragma unroll
        for (int ai = 0; ai < 2; ++ai)
#pragma unroll
            for (int m = 0; m < 4; ++m) { const size_t row = (size_t)(row0 + ai * HALF + m * 16);
                const f32x4 g0 = acc[ai][0][m][0] * is, g1 = acc[ai][0][m][1] * is, u0 = acc[ai][1][m][0] * is, u1 = acc[ai][1][m][1] * is;
                u32x2 w; w.x = pk4_fp8(g0[0] * sig_fast(g0[0]) * u0[0], g0[1] * sig_fast(g0[1]) * u0[1], g0[2] * sig_fast(g0[2]) * u0[2], g0[3] * sig_fast(g0[3]) * u0[3]);
                w.y = pk4_fp8(g1[0] * sig_fast(g1[0]) * u1[0], g1[1] * sig_fast(g1[1]) * u1[1], g1[2] * sig_fast(g1[2]) * u1[2], g1[3] * sig_fast(g1[3]) * u1[3]);
                *(u32x2*)(act + row * DE + u.pn * 128 + wc * 32 + fq * 8) = w; }
    }
};
constexpr float YSC = 8.f;
struct EpiMoe2 {
    static constexpr bool MID = false;
    unsigned char* y2;
    __device__ __forceinline__ void operator()(const f32x4 (&acc)[2][2][4][2], const Unit& u, int wr, int wc, int fr, int fq) const {
        const int row0 = u.pm * BM + wr * 64 + fr, col0 = u.pn * BM + wc * 32 + fq * 8; constexpr float is = YSC / WSC2;
#pragma unroll
        for (int ai = 0; ai < 2; ++ai)
#pragma unroll
            for (int m = 0; m < 4; ++m) { const size_t row = (size_t)(row0 + ai * HALF + m * 16);
#pragma unroll
                for (int bj = 0; bj < 2; ++bj) { const f32x4 v0 = acc[ai][bj][m][0] * is, v1 = acc[ai][bj][m][1] * is;
                    *(u32x2*)(y2 + row * D + col0 + bj * HALF) = (u32x2){pk4_fp8(v0[0], v0[1], v0[2], v0[3]), pk4_fp8(v1[0], v1[1], v1[2], v1[3])}; } }
    }
};
constexpr int MOE_MAXU = 8;
template <bool GATHER_> struct MoeOrder {
    static constexpr bool GATHER = GATHER_;
    const LAS int* UT; const LAS int* RT; const void* W; size_t estride; int KB;
    __device__ __forceinline__ bool next(int i, Unit& u) const {
        if (i >= MOE_MAXU) return false;
        const int v = __builtin_amdgcn_readfirstlane(UT[i * 4 + 3]); if (!v) return false;
        u.pm = __builtin_amdgcn_readfirstlane(UT[i * 4 + 0]); u.pn = __builtin_amdgcn_readfirstlane(UT[i * 4 + 1]); u.e = __builtin_amdgcn_readfirstlane(UT[i * 4 + 2]); u.ord = i; return true;
    }
    __device__ __forceinline__ int arow(const Unit& u, int r) const { return GATHER ? RT[u.ord * 256 + r] : u.pm * BM + r; }
    __device__ __forceinline__ const char* bbase(const Unit& u) const { return (const char*)W + (size_t)u.e * estride + (size_t)u.pn * BM * KB; }
};
__host__ __device__ __forceinline__ int winf_row(int vrow) { return vrow < 1024 ? vrow : vrow - 768; }
template <bool F8> struct P2Order {
    static constexpr bool GATHER = false;
    const char* W; int v, G;
    __device__ __forceinline__ bool next(int i, Unit& u) const {
        u.ord = i; u.e = F8 ? 1 : 0;
        if (!F8) { int L;
            if (G == 256) { if (i >= (v < 128 ? 2 : 1)) return false; L = 256 * i + v; } else { L = i * G + v; if (L >= 384) return false; }
            u.pm = L / 3; u.pn = 4 + (L - 3 * u.pm); return true; }
        int f;
        if (G == 256) { if (i >= (v < 128 ? 5 : 7)) return false; f = v >= 128 ? (v - 128) * 7 + i : 896 + 5 * v + i; } else { f = i * G + v; if (f >= 1536) return false; }
        u.pm = f / 12; const int t = f - 12 * u.pm; u.pn = t < 4 ? t : t + 3; return true;
    }
    __device__ __forceinline__ int arow(const Unit& u, int r) const { return u.pm * BM + r; }
    __device__ __forceinline__ const char* bbase(const Unit& u) const { return W + (size_t)(F8 ? winf_row(u.pn * BM) : u.pn * BM) * 2048; }
};
struct PanelOrder {
    static constexpr bool GATHER = false;
    const char* W; int v, G, KB;
    __device__ __forceinline__ bool next(int i, Unit& u) const { const int L = G * i + v; if (L >= (NTOK / BM) * 4) return false; u.pm = L >> 2; u.pn = L & 3; u.e = 0; u.ord = i; return true; }
    __device__ __forceinline__ int arow(const Unit& u, int r) const { return u.pm * BM + r; }
    __device__ __forceinline__ const char* bbase(const Unit& u) const { return W + (size_t)u.pn * BM * KB; }
};
}
namespace attn_body {
using bf16=__hip_bfloat16;
using bf16x8=__attribute__((ext_vector_type(8)))short;
using s16x4=__attribute__((ext_vector_type(4)))short;
using f32x16=__attribute__((ext_vector_type(16)))float;
using u32x4=__attribute__((ext_vector_type(4)))unsigned;
constexpr int BATCH=16,NHEAD=8,SEQ=2048,D=64,DM=768,OPITCH=1024;
constexpr int NW=8,QBLK=32,QB=QBLK*NW,KVBLK=64,NQB=SEQ/QB;
constexpr int ATTN_UNIT_ROWS=QB;
__device__ __forceinline__ int crow(int r,int hi){return (r&3)+8*(r>>2)+4*hi;}
#define SBAR() __builtin_amdgcn_sched_barrier(0)
__device__ __forceinline__ void cmask(f32x16&p0,f32x16&p1,int jb,int qrel,int hi){
  const float NEG=-INFINITY; int kb=64*jb+4*hi;
  #pragma unroll
  for(int r=0;r<16;++r){int kv=kb+(r&3)+8*(r>>2); if(kv>qrel)p0[r]=NEG; if(kv+32>qrel)p1[r]=NEG;}
}

constexpr int NSLOT=3, SLOTB=8192;
constexpr int LDS_K=0, LDS_V=NSLOT*SLOTB, LDS_WS=2*NSLOT*SLOTB, LDS_OST=LDS_WS+NW*64*4, LDS_BYTES=LDS_OST+NW*4096;
constexpr float C2=0.125f*1.4426950408889634f;
__device__ __forceinline__ void glds16(const void*gsrc,unsigned lds_dst){unsigned keep;
  asm volatile("s_mov_b32 %0, m0\n\ts_mov_b32 m0, %2\n\ts_nop 0\n\tglobal_load_lds_dwordx4 %1, off\n\ts_mov_b32 m0, %0":"=&s"(keep):"v"(gsrc),"s"(lds_dst):"memory");}
__device__ __forceinline__ float max3f(float a,float b,float c){float r;asm("v_max3_f32 %0, %1, %2, %3":"=v"(r):"v"(a),"v"(b),"v"(c));return r;}
__device__ __forceinline__ float max2f(float a,float b){float r;asm("v_max_f32_e32 %0, %1, %2":"=v"(r):"v"(a),"v"(b));return r;}
__device__ __forceinline__ float fadd_s(float a,float b){float r;asm("v_add_f32_e32 %0, %1, %2":"=v"(r):"v"(a),"v"(b));return r;}
__device__ __forceinline__ float fsub_s(float a,float b){float r;asm("v_sub_f32_e32 %0, %1, %2":"=v"(r):"v"(a),"v"(b));return r;}
typedef float f32x2_t __attribute__((ext_vector_type(2))); typedef __bf16 bf16x2_t __attribute__((ext_vector_type(2)));
__device__ __forceinline__ unsigned cvtpk_s(float lo,float hi){f32x2_t v={lo,hi};bf16x2_t b=__builtin_convertvector(v,bf16x2_t);return __builtin_bit_cast(unsigned,b);}
#define WAIT_BAR(N) asm volatile("s_waitcnt vmcnt(" #N ") lgkmcnt(0)\n\ts_barrier":::"memory")

__device__ __forceinline__ void qkt(f32x16&p0,f32x16&p1,const char*Kslot,const bf16x8*qr,const f32x16&negm,int r32,int hi){
  const char*kb=Kslot+hi*1024+r32*16;
  #pragma unroll
  for(int d0=0;d0<4;++d0){
    const bf16x8 b0=*reinterpret_cast<const bf16x8*>(kb+d0*2048);
    const bf16x8 b1=*reinterpret_cast<const bf16x8*>(kb+d0*2048+512);
    if(d0==0){p0=__builtin_amdgcn_mfma_f32_32x32x16_bf16(b0,qr[0],negm,0,0,0);p1=__builtin_amdgcn_mfma_f32_32x32x16_bf16(b1,qr[0],negm,0,0,0);}
    else{p0=__builtin_amdgcn_mfma_f32_32x32x16_bf16(b0,qr[d0],p0,0,0,0);p1=__builtin_amdgcn_mfma_f32_32x32x16_bf16(b1,qr[d0],p1,0,0,0);}}
}
typedef __attribute__((address_space(3))) const char* lds_cptr;
typedef short v4i16_t __attribute__((ext_vector_type(4)));
__device__ __forceinline__ void kload8(bf16x8*kf,lds_cptr kp){
  kf[0]=*(const __attribute__((address_space(3))) bf16x8*)(kp);      kf[1]=*(const __attribute__((address_space(3))) bf16x8*)(kp+512);
  kf[2]=*(const __attribute__((address_space(3))) bf16x8*)(kp+2048); kf[3]=*(const __attribute__((address_space(3))) bf16x8*)(kp+2560);
  kf[4]=*(const __attribute__((address_space(3))) bf16x8*)(kp+4096); kf[5]=*(const __attribute__((address_space(3))) bf16x8*)(kp+4608);
  kf[6]=*(const __attribute__((address_space(3))) bf16x8*)(kp+6144); kf[7]=*(const __attribute__((address_space(3))) bf16x8*)(kp+6656);
}
__device__ __forceinline__ void kload2(bf16x8*kf,lds_cptr kp,int j){ kf[2*j]=*(const __attribute__((address_space(3))) bf16x8*)(kp+j*2048); kf[2*j+1]=*(const __attribute__((address_space(3))) bf16x8*)(kp+j*2048+512); }
__device__ __forceinline__ s16x4 vtr(lds_cptr p){ return __builtin_bit_cast(s16x4,__builtin_amdgcn_ds_read_tr16_b64_v4i16((__attribute__((address_space(3))) v4i16_t*)p)); }
__device__ __forceinline__ float rowmax(const f32x16&p0,const f32x16&p1){
  float a=max3f(p0[0],p0[1],p1[0]),b=max3f(p0[2],p0[3],p1[1]);a=max3f(a,p1[2],p1[3]);
  #pragma unroll
  for(int r=4;r<16;r+=4){a=max3f(a,p0[r],p0[r+1]);b=max3f(b,p0[r+2],p0[r+3]);a=max3f(a,p1[r],p1[r+1]);b=max3f(b,p1[r+2],p1[r+3]);}
  const float m=max2f(a,b);
  auto rr=__builtin_amdgcn_permlane32_swap(__float_as_uint(m),__float_as_uint(m),false,false);
  return max2f(__uint_as_float(rr[0]),__uint_as_float(rr[1]));
}
__device__ __forceinline__ void pv(f32x16*o,int vb,bf16x8 pa0,bf16x8 pa1,bf16x8 pa2,bf16x8 pa3){
  #pragma unroll
  for(int d0=0;d0<2;++d0){s16x4 lo[4],hi[4];
    #pragma unroll
    for(int ks=0;ks<4;++ks){
      asm volatile("ds_read_b64_tr_b16 %0,%1 offset:%c2":"=&v"(lo[ks]):"v"(vb),"i"(d0*4096+ks*1024):"memory");
      asm volatile("ds_read_b64_tr_b16 %0,%1 offset:%c2":"=&v"(hi[ks]):"v"(vb),"i"(d0*4096+ks*1024+512):"memory");}
    asm volatile("s_waitcnt lgkmcnt(0)":::"memory");SBAR();
    #define PK(k) (bf16x8){lo[k][0],lo[k][1],lo[k][2],lo[k][3],hi[k][0],hi[k][1],hi[k][2],hi[k][3]}
    o[d0]=__builtin_amdgcn_mfma_f32_32x32x16_bf16(pa0,PK(0),o[d0],0,0,0);
    o[d0]=__builtin_amdgcn_mfma_f32_32x32x16_bf16(pa1,PK(1),o[d0],0,0,0);
    o[d0]=__builtin_amdgcn_mfma_f32_32x32x16_bf16(pa2,PK(2),o[d0],0,0,0);
    o[d0]=__builtin_amdgcn_mfma_f32_32x32x16_bf16(pa3,PK(3),o[d0],0,0,0);
    #undef PK
  }
}

#ifndef ATTN_STORE16
#define ATTN_STORE16(p,v) (*(u32x4*)(p)=(v))
#endif
template<int THRL> __device__ __forceinline__ void attn_unit(int b,int h,int kvh,int qb,const bf16*Q,const bf16*__restrict__ K,const bf16*__restrict__ V,bf16*O,char*shm){
  const int tid=threadIdx.x,lane=tid&63,r32=lane&31,hi=lane>>5; const int wid=__builtin_amdgcn_readfirstlane(tid>>6);
  const long rowbase=(long)b*SEQ; const int q0=qb*QB;
  const bf16*Qw=Q+(rowbase+q0+wid*QBLK)*DM+h*D;
  const bf16*Kh=K+rowbase*DM+kvh*D,*Vh=V+rowbase*DM+kvh*D;
  const unsigned lds0=(unsigned)(uintptr_t)shm;
  float*wsf=(float*)(shm+LDS_WS)+wid*64;
  const bf16*ksrc=Kh+(long)lane*DM+wid*8;
  const bf16*vsrc=Vh+(long)(16*(wid&3)+(lane>>2))*DM+(wid>>2)*32+(lane&3)*8;
  const unsigned kdst=lds0+LDS_K+wid*1024, vdst=lds0+LDS_V+wid*1024;
  #define DMA_K(t,slot) glds16(ksrc+(long)(t)*KVBLK*DM,(unsigned)__builtin_amdgcn_readfirstlane(kdst+(slot)))
  #define DMA_V(t,slot) glds16(vsrc+(long)(t)*KVBLK*DM,(unsigned)__builtin_amdgcn_readfirstlane(vdst+(slot)))
  const int vb0=(int)(lds0+LDS_V)+((lane>>4)&1)*32+(lane&3)*8+(4*hi+((lane&15)>>2))*64;
  const char*Kbase=shm+LDS_K; bf16x8 kf[8];
  const lds_cptr shm3=(lds_cptr)shm; const lds_cptr kp0=shm3+LDS_K+hi*1024+r32*16; const lds_cptr vp0=shm3+LDS_V+((lane>>4)&1)*32+(lane&3)*8+(4*hi+((lane&15)>>2))*64;
  const int NT=SEQ/KVBLK;
  DMA_K(0,0);DMA_V(0,0);DMA_K(1,SLOTB);
  bf16x8 qr[4];
  #pragma unroll
  for(int d0=0;d0<4;++d0)qr[d0]=*reinterpret_cast<const bf16x8*>(&Qw[(long)r32*DM+d0*16+hi*8]);
  float mhat=0.f,l_reg=0.f;f32x16 o[2];o[0]=f32x16{};o[1]=f32x16{};f32x16 negm=f32x16{};asm volatile("":"+v"(negm));

  #define CMASK(P0,P1,t) do{}while(0)
  bool resc=false;
  #define START(P0,P1) do{ const float rm=rowmax(P0,P1); resc=false; \
    { const float dl=rm; mhat=fadd_s(mhat,dl); \
      _Pragma("unroll") for(int r=0;r<16;++r){P0[r]=fsub_s(P0[r],dl);P1[r]=fsub_s(P1[r],dl);} \
      _Pragma("unroll") for(int r=0;r<16;++r)negm[r]=-mhat; asm volatile("":"+v"(negm)); } \
    _Pragma("unroll") for(int r=0;r<16;++r)P0[r]=__builtin_amdgcn_exp2f(P0[r]); }while(0)
  #define RESC() do{ if(resc){ asm volatile("s_waitcnt lgkmcnt(0)":::"memory"); \
      _Pragma("unroll") for(int d_=0;d_<2;++d_) _Pragma("unroll") for(int r=0;r<16;++r)o[d_][r]*=wsf[crow(r,hi)]; } }while(0)
  f32x16 pA0,pA1,pB0,pB1;
  int sl_prev=0,sl_cur=0,sl_next=SLOTB;
  #define ROT() do{sl_prev=sl_cur;sl_cur=sl_next;sl_next=(sl_next==(NSLOT-1)*SLOTB)?0:sl_next+SLOTB;}while(0)
  DMA_K(2,2*SLOTB);
  WAIT_BAR(3);
  qkt(pA0,pA1,Kbase,qr,negm,r32,hi);asm volatile("s_nop 15\n\ts_nop 7":"+v"(pA0),"+v"(pA1));CMASK(pA0,pA1,0);
  START(pA0,pA1);
  _Pragma("unroll") for(int r=0;r<16;++r)pA1[r]=__builtin_amdgcn_exp2f(pA1[r]);
  WAIT_BAR(0);
  DMA_K(3,0);DMA_V(1,SLOTB);
  ROT();
  kload8(kf,kp0+sl_cur);
  WAIT_BAR(2);
  s16x4 vlo[8],vhi[8]; u32x4 pw0,pw1,pw2,pw3;
  #define PKW(P,B) cvtpk_s(P[B],P[B+1])
  #define PAF(k) __builtin_bit_cast(bf16x8,pw##k)
  #define VFR(i) (bf16x8){vlo[i][0],vlo[i][1],vlo[i][2],vlo[i][3],vhi[i][0],vhi[i][1],vhi[i][2],vhi[i][3]}
  #define PIN(x) asm volatile("":"+v"(x))
  #define MX3(a,b,c) __builtin_fmaxf(__builtin_fmaxf((a),(b)),(c))
  #define GAPA(MF,A0,A1,A2,A3,W0,W1,PW) do{ MF; sacc+=A0; sacc+=A1; sacc+=A2; sacc+=A3; PIN(sacc); W0; W1; PIN(PW); SBAR(); }while(0)
  #define EX(v) __builtin_amdgcn_exp2f(v)
  #define GAPB(MF,X,B) do{ MF; X[B]=EX(X[B]); X[B+1]=EX(X[B+1]); X[B+2]=EX(X[B+2]); X[B+3]=EX(X[B+3]); PIN(X); SBAR(); }while(0)
  #define VRD(i) do{ vlo[i]=vtr(vp_+(((i)>>2)*4096+((i)&3)*1024)); vhi[i]=vtr(vp_+(((i)>>2)*4096+((i)&3)*1024+512)); }while(0)
  #define KRD(G,j) do{ if(G){ kload2(kf,kp0+sl_next,j); SBAR(); } }while(0)
  #define STEP(C0,C1,P0,P1,t,GK,GV,GL) do{ SBAR(); \
    const lds_cptr vp_=vp0+sl_prev; \
    VRD(0); SBAR(); float sacc=(P0[0]+P0[1]); \
    GAPA(C0=__builtin_amdgcn_mfma_f32_32x32x16_bf16(kf[0],qr[0],negm,0,0,0), P0[2],P0[3],P0[4],P0[5],     pw0[0]=PKW(P0,0), pw0[1]=PKW(P0,2), pw0); \
    VRD(4); SBAR(); GAPA(C1=__builtin_amdgcn_mfma_f32_32x32x16_bf16(kf[1],qr[0],negm,0,0,0), P0[6],P0[7],P0[8],P0[9],     pw0[2]=PKW(P0,4), pw0[3]=PKW(P0,6), pw0); \
    VRD(1); SBAR(); GAPA(C0=__builtin_amdgcn_mfma_f32_32x32x16_bf16(kf[2],qr[1],C0,0,0,0),   P0[10],P0[11],P0[12],P0[13], pw1[0]=PKW(P0,8), pw1[1]=PKW(P0,10), pw1); \
    VRD(5); SBAR(); GAPA(C1=__builtin_amdgcn_mfma_f32_32x32x16_bf16(kf[3],qr[1],C1,0,0,0),   P0[14],P0[15],P1[0],P1[1],   pw1[2]=PKW(P0,12),pw1[3]=PKW(P0,14), pw1); \
    VRD(2); SBAR(); GAPA(C0=__builtin_amdgcn_mfma_f32_32x32x16_bf16(kf[4],qr[2],C0,0,0,0),   P1[2],P1[3],P1[4],P1[5],     pw2[0]=PKW(P1,0), pw2[1]=PKW(P1,2), pw2); \
    VRD(6); SBAR(); GAPA(C1=__builtin_amdgcn_mfma_f32_32x32x16_bf16(kf[5],qr[2],C1,0,0,0),   P1[6],P1[7],P1[8],P1[9],     pw2[2]=PKW(P1,4), pw2[3]=PKW(P1,6), pw2); \
    VRD(3); SBAR(); GAPA(C0=__builtin_amdgcn_mfma_f32_32x32x16_bf16(kf[6],qr[3],C0,0,0,0),   P1[10],P1[11],P1[12],P1[13], pw3[0]=PKW(P1,8), pw3[1]=PKW(P1,10), pw3); \
    VRD(7); SBAR(); GAPA(C1=__builtin_amdgcn_mfma_f32_32x32x16_bf16(kf[7],qr[3],C1,0,0,0),   P1[14],P1[15],0.f,0.f,       pw3[2]=PKW(P1,12),pw3[3]=PKW(P1,14), pw3); \
    l_reg+=sacc; \
    if(GK){DMA_K((t)+3,sl_cur);} if(GV){DMA_V((t)+1,sl_next);} \
    CMASK(C0,C1,t); \
    { float a=MX3(C0[0],C0[1],C1[0]),b=MX3(C0[2],C0[3],C1[1]); a=MX3(a,C1[2],C1[3]); \
      _Pragma("unroll") for(int r=4;r<16;r+=4){a=MX3(a,C0[r],C0[r+1]);b=MX3(b,C0[r+2],C0[r+3]);a=MX3(a,C1[r],C1[r+1]);b=MX3(b,C1[r+2],C1[r+3]);} \
      float rm=__builtin_fmaxf(a,b); { auto rr=__builtin_amdgcn_permlane32_swap(__float_as_uint(rm),__float_as_uint(rm),false,false); rm=__builtin_fmaxf(__uint_as_float(rr[0]),__uint_as_float(rr[1])); } \
      resc=false; \
      if(__builtin_expect(__any(rm>(float)THRL),0)){ const float dl=__builtin_fmaxf(rm,0.f); mhat+=dl; \
        _Pragma("unroll") for(int r=0;r<16;++r){C0[r]-=dl;C1[r]-=dl;} \
        _Pragma("unroll") for(int r=0;r<16;++r)negm[r]=-mhat; asm volatile("":"+v"(negm)); \
        const float f=__builtin_amdgcn_exp2f(-dl); l_reg*=f; if(hi==0)wsf[r32]=f; resc=true; } } \
    SBAR(); \
    GAPB(o[0]=__builtin_amdgcn_mfma_f32_32x32x16_bf16(PAF(0),VFR(0),o[0],0,0,0), C0,0); \
    GAPB(o[1]=__builtin_amdgcn_mfma_f32_32x32x16_bf16(PAF(0),VFR(4),o[1],0,0,0), C0,4); \
    KRD(GL,0); GAPB(o[0]=__builtin_amdgcn_mfma_f32_32x32x16_bf16(PAF(1),VFR(1),o[0],0,0,0), C0,8); \
    KRD(GL,1); GAPB(o[1]=__builtin_amdgcn_mfma_f32_32x32x16_bf16(PAF(1),VFR(5),o[1],0,0,0), C0,12); \
    KRD(GL,2); GAPB(o[0]=__builtin_amdgcn_mfma_f32_32x32x16_bf16(PAF(2),VFR(2),o[0],0,0,0), C1,0); \
    KRD(GL,3); GAPB(o[1]=__builtin_amdgcn_mfma_f32_32x32x16_bf16(PAF(2),VFR(6),o[1],0,0,0), C1,4); \
    GAPB(o[0]=__builtin_amdgcn_mfma_f32_32x32x16_bf16(PAF(3),VFR(3),o[0],0,0,0), C1,8); \
    GAPB(o[1]=__builtin_amdgcn_mfma_f32_32x32x16_bf16(PAF(3),VFR(7),o[1],0,0,0), C1,12); \
    }while(0)
  int t=1;
  #undef CMASK
  #define CMASK(P0,P1,t) do{}while(0)
  for(;t+5<NT;t+=2){
    STEP(pB0,pB1,pA0,pA1,t,true,true,true);     WAIT_BAR(2); RESC(); ROT();
    STEP(pA0,pA1,pB0,pB1,t+1,true,true,true);   WAIT_BAR(2); RESC(); ROT();
  }
  #undef CMASK
  #define CMASK(P0,P1,t) do{}while(0)
  #define ENDW(tt) do{ if((tt)+3<NT){WAIT_BAR(2);} else if((tt)+2<NT){WAIT_BAR(1);} else {WAIT_BAR(0);} }while(0)
  for(;t+1<NT;t+=2){
    STEP(pB0,pB1,pA0,pA1,t,(t+3<NT),(t+1<NT),(t+1<NT));       ENDW(t);   RESC(); ROT();
    STEP(pA0,pA1,pB0,pB1,t+1,(t+4<NT),(t+2<NT),(t+2<NT));     ENDW(t+1); RESC(); ROT();
  }
  STEP(pB0,pB1,pA0,pA1,NT-1,false,false,false); RESC();
  { float sacc=pB0[0]+pB0[1]; _Pragma("unroll") for(int r=2;r<16;++r)sacc+=pB0[r]; _Pragma("unroll") for(int r=0;r<16;++r)sacc+=pB1[r]; l_reg+=sacc;
    pw0=(u32x4){PKW(pB0,0),PKW(pB0,2),PKW(pB0,4),PKW(pB0,6)};pw1=(u32x4){PKW(pB0,8),PKW(pB0,10),PKW(pB0,12),PKW(pB0,14)};pw2=(u32x4){PKW(pB1,0),PKW(pB1,2),PKW(pB1,4),PKW(pB1,6)};pw3=(u32x4){PKW(pB1,8),PKW(pB1,10),PKW(pB1,12),PKW(pB1,14)};
    SBAR(); pv(o,vb0+sl_cur,PAF(0),PAF(1),PAF(2),PAF(3)); }
  #undef PKW
  #undef PAF
  #undef VFR
  #undef PIN
  #undef MX3
  #undef GAPA
  #undef GAPB
  #undef EX
  #undef VRD
  #undef KRD
  #undef STEP
  #undef ENDW
  {auto rr=__builtin_amdgcn_permlane32_swap(__float_as_uint(l_reg),__float_as_uint(l_reg),false,false);l_reg=__uint_as_float(rr[0])+__uint_as_float(rr[1]);}
  if(hi==0)wsf[32+r32]=l_reg;asm volatile("s_waitcnt lgkmcnt(0)":::"memory");
  float rli[16];
  #pragma unroll
  for(int r=0;r<16;++r)rli[r]=__builtin_amdgcn_rcpf(wsf[32+crow(r,hi)])*pg8::ASC;
  unsigned char*Ow=(unsigned char*)O+(long)(rowbase+q0+wid*QBLK)*OPITCH+h*D;
  { bf16*stg=(bf16*)(shm+LDS_OST)+wid*2048;
    #pragma unroll
    for(int r=0;r<16;++r){const int orow=crow(r,hi);
      #pragma unroll
      for(int d0=0;d0<2;++d0)stg[orow*64+d0*32+r32]=__float2bfloat16(o[d0][r]*rli[r]);}
    asm volatile("s_waitcnt lgkmcnt(0)":::"memory");
    #pragma unroll
    for(int i=0;i<4;++i){const int row=i*8+(lane>>3),ch=lane&7; const u32x4 v=*(const u32x4*)(stg+row*64+ch*8);
      #define BLO(w) __uint_as_float((w)<<16)
      #define BHI(w) __uint_as_float((w)&0xffff0000u)
      *(u32x2*)(Ow+(long)row*OPITCH+ch*8)=(u32x2){pg8::pk4_fp8(BLO(v.x),BHI(v.x),BLO(v.y),BHI(v.y)),pg8::pk4_fp8(BLO(v.z),BHI(v.z),BLO(v.w),BHI(v.w))};
      #undef BLO
      #undef BHI
    } }
  asm volatile("s_waitcnt lgkmcnt(0)\n\ts_barrier":::"memory");
  #undef DMA_K
  #undef DMA_V
  #undef CMASK
  #undef START
  #undef RESC
  #undef ROT
}
constexpr int ATTN_LDS_BYTES=LDS_BYTES;
struct AttnTensors { const bf16* Q; const bf16* K; const bf16* V; bf16* O; };
struct AttnUnit { int bh; int qb; };
struct StaticOrder {
  int vcu, G;
  __device__ __forceinline__ explicit StaticOrder(int grid,int v):vcu(v),G(grid){}
  __device__ __forceinline__ bool next(int i,AttnUnit&u)const{ const int L=i*G+vcu; if(L>=BATCH*NHEAD*NQB)return false; const int blk=L%256, rnd=L/256; u.bh=blk>>1; u.qb=(blk&1)*4+rnd; return true; }
};
template<class Sched,int THRL=8> __device__ __forceinline__ void attn_phase(char*lds,const AttnTensors&T,const Sched&S){
  AttnUnit u;
  for(int i=0;S.next(i,u);++i){ attn_unit<THRL>(u.bh/NHEAD,u.bh%NHEAD,(u.bh%NHEAD)/4,u.qb,T.Q,T.K,T.V,T.O,lds); }
}
#undef SBAR
#undef WAIT_BAR
}
#define XB_TMO      128
#define XB_XCNT(j)  (256  + 64 * (j))
#define XB_XSUB(j)  (1280 + 64 * (j))
#define XB_XGEN(j)  (2304 + 64 * (j))
#define XB_TOP      3328
#define XB_TOPGEN   3392
#define XCD_BAR_WORDS 3456
#define XB_SPIN_CAP (1u << 18)

__device__ __forceinline__ unsigned xb_ld(unsigned* p)              { return __hip_atomic_load(p, __ATOMIC_RELAXED, __HIP_MEMORY_SCOPE_AGENT); }
__device__ __forceinline__ unsigned xb_add(unsigned* p, unsigned v) { return __hip_atomic_fetch_add(p, v, __ATOMIC_RELAXED, __HIP_MEMORY_SCOPE_AGENT); }
__device__ __forceinline__ unsigned xb_xcc_id() { return (unsigned)__builtin_amdgcn_s_getreg((3 << 11) | 20) & 0xFu; }
#define XB_SPIN(cond, bar) do { unsigned _sp = 0; while (cond) { __builtin_amdgcn_s_sleep(1); \
    if ((++_sp & 255u) == 0u) { if (xb_ld(&(bar)[XB_TMO])) break; if (_sp > XB_SPIN_CAP) { atomicAdd(&(bar)[XB_TMO], 1u); break; } } } } while (0)

struct XcdBarrier {
    unsigned* bar; unsigned x;
    volatile LAS unsigned* st;
};

__device__ __forceinline__ XcdBarrier xcd_barrier_post(unsigned* bar, volatile LAS unsigned* st) {
    XcdBarrier b; b.bar = bar; b.x = xb_xcc_id(); b.st = st;
    if (threadIdx.x == 0) (void)xb_add(&bar[XB_XCNT(b.x)], 1u);
    return b;
}
__device__ __forceinline__ void xcd_barrier_complete(unsigned* bar, unsigned x, unsigned& nloc, unsigned& nx) {
    const unsigned G = gridDim.x * gridDim.y * gridDim.z;
    unsigned sum, cnt, mine, sp = 0u;
    for (;;) {
        sum = 0u; cnt = 0u; mine = 0u;
#pragma unroll
        for (unsigned j = 0; j < 16; ++j) { const unsigned c = xb_ld(&bar[XB_XCNT(j)]); sum += c; cnt += (c > 0u) ? 1u : 0u; mine = (j == x) ? c : mine; }
        if (sum == G) break;
        __builtin_amdgcn_s_sleep(1);
        if ((++sp & 255u) == 0u) { if (xb_ld(&bar[XB_TMO])) break; if (sp > XB_SPIN_CAP) { atomicAdd(&bar[XB_TMO], 1u); break; } }
    }
    nloc = mine > 0u ? mine : 1u; nx = cnt > 0u ? cnt : 1u;
}

__device__ __forceinline__ void xcd_barrier(const XcdBarrier& b) {
    asm volatile("s_waitcnt vmcnt(0)" ::: "memory");
    __syncthreads();
    if (threadIdx.x == 0) {
        unsigned* bar = b.bar;
        __builtin_amdgcn_s_waitcnt(0);
        unsigned nloc = b.st[0], nx = b.st[1];
        if (nloc == 0u) { xcd_barrier_complete(bar, b.x, nloc, nx); b.st[0] = nloc; b.st[1] = nx; }
        const unsigned old = xb_add(&bar[XB_XSUB(b.x)], 1u);
        const unsigned gen = old / nloc;
        if (old + 1u == (gen + 1u) * nloc) {
            __builtin_amdgcn_fence(__ATOMIC_RELEASE, "agent");
            asm volatile("s_waitcnt vmcnt(0)" ::: "memory");
            const unsigned og = xb_add(&bar[XB_TOP], 1u);
            const unsigned tg = og / nx;
            if (og + 1u == (tg + 1u) * nx) xb_add(&bar[XB_TOPGEN], 1u);
            else XB_SPIN(xb_ld(&bar[XB_TOPGEN]) == tg, bar);
            __builtin_amdgcn_fence(__ATOMIC_ACQUIRE, "agent");
            asm volatile("s_waitcnt vmcnt(0)" ::: "memory");
        } else {
            XB_SPIN(xb_ld(&bar[XB_TOPGEN]) == gen, bar);
            __builtin_amdgcn_fence(__ATOMIC_ACQUIRE, "agent");
            asm volatile("s_waitcnt vmcnt(0)" ::: "memory");
        }
    }
    __syncthreads();
}
constexpr int NWAVES = 8, NTHR = NWAVES * 64;
constexpr int N_PHASES = 10;
constexpr int RING_OFF = 0, RING_BYTES = 131072;
constexpr int LDSCTL_OFF = RING_BYTES, MISC_OFF = LDSCTL_OFF + 320;
constexpr int TS_OFF = LDSCTL_OFF + 512;
constexpr int UT_OFF = TS_OFF + 256;
constexpr int RT_OFF = UT_OFF + 256;
constexpr int LDS_BYTES = 147456;
static_assert(RT_OFF + pg8::MOE_MAXU * 1024 <= LDS_BYTES, "LDS map");

struct Frame {
    LAS unsigned char* lds; volatile LAS unsigned* MISC; unsigned* ctl; unsigned char* ws;
    int tid, lane, wave, vcu, G;
    float* out;
};

enum { I_X = 0, I_C, I_WADA, I_BADA, I_GPRE1, I_GPOST1, I_WIN, I_WDW, I_BDW, I_CLNG, I_CLNB, I_WCO, I_QG, I_KG, I_WAO, I_WOUT, I_GPRE2, I_GPOST2, I_WGRP, I_BGRP, I_WRT, I_BRT, I_WEG, I_WEU, I_WED };

struct Args { const float* in[25]; float* out; unsigned char* ws; int ph_lo, ph_hi, use_bar, flags; };
#define CAS __attribute__((address_space(4)))
__device__ __forceinline__ const float* fin(int i) { unsigned long long p = (unsigned long long)__builtin_amdgcn_kernarg_segment_ptr(); asm volatile("" : "+s"(p)); return ((const CAS Args*)p)->in[i]; }
template <int MAP> __device__ __forceinline__ int maprow(int n) {
    if (MAP == 1) return vmap_win(n);
    if (MAP == 2) return 256 * (n >> 7) + (n & 127);
    if (MAP == 3) return 256 * (n >> 7) + 128 + (n & 127);
    return n;
}
template <int MAP>
__device__ __forceinline__ void p0_transpose_item(const float* W, int N, bf16* WT, int pitch, int koff, LAS float* scr, int item, int lane) {
    const int nblk = N / 64, kb = item / nblk, nb = item % nblk, k0 = 64 * kb, n0 = 64 * nb, lr = lane >> 4, lc = lane & 15;
    const float* src = W + (size_t)(k0 + lr) * N + n0 + 4 * lc;
    f32x4 v[16];
#pragma unroll
    for (int i = 0; i < 16; ++i) v[i] = *(const f32x4*)(src + (size_t)(4 * i) * N);
#pragma unroll
    for (int i = 0; i < 16; ++i) { const int kk = lr + 4 * i; *(LAS f32x4*)(scr + kk * 64 + 4 * (lc ^ ((kk >> 3) & 7))) = v[i]; }
    LDS_WAIT(); asm volatile("" ::: "memory");
    const int c = lane & 7;
#pragma unroll
    for (int jj = 0; jj < 8; ++jj) { const int n = (lane >> 3) + 8 * jj; const LAS float* sp = scr + (8 * c) * 64 + (n ^ (4 * c));
        u32x4 o; o.x = cvt_pk_bf16(sp[0 * 64], sp[1 * 64]); o.y = cvt_pk_bf16(sp[2 * 64], sp[3 * 64]); o.z = cvt_pk_bf16(sp[4 * 64], sp[5 * 64]); o.w = cvt_pk_bf16(sp[6 * 64], sp[7 * 64]);
        *(u32x4*)(WT + (size_t)maprow<MAP>(n0 + n) * pitch + koff + k0 + 8 * c) = o; }
    LDS_WAIT(); asm volatile("" ::: "memory");
}
struct TrDesc { const float* src; unsigned char* dst; int N, pitch; float sc; };
__device__ __forceinline__ TrDesc tr_desc(int it, const float* pweg, const float* pweu, const float* pwed, unsigned char* W1, unsigned char* W2) {
    constexpr int I_G1 = (D / 64) * (DE / 64), I_D1 = (DE / 64) * (D / 64), PER = 2 * I_G1 + I_D1;
    const int e = it / PER; int r = it - e * PER; TrDesc d;
    if (r < 2 * I_G1) { const bool up = r >= I_G1; if (up) r -= I_G1; const int nblk = DE / 64, kb = r / nblk, nb = r % nblk;
        d.src = (up ? pweu : pweg) + (size_t)e * D * DE + (size_t)(64 * kb) * DE + 64 * nb; d.N = DE; d.pitch = D; d.sc = pg8::WSC1;
        d.dst = W1 + (size_t)e * D * D + (size_t)(256 * ((64 * nb) >> 7) + (up ? 128 : 0) + ((64 * nb) & 127)) * D + 64 * kb; }
    else { r -= 2 * I_G1; const int nblk = D / 64, kb = r / nblk, nb = r % nblk;
        d.src = pwed + (size_t)e * DE * D + (size_t)(64 * kb) * D + 64 * nb; d.N = D; d.pitch = DE; d.sc = pg8::WSC2;
        d.dst = W2 + (size_t)e * D * DE + (size_t)(64 * nb) * DE + 64 * kb; }
    return d;
}
__device__ __forceinline__ void tr_load(const TrDesc& d, int lane, f32x4 (&v)[16]) {
    const float* src = d.src + (size_t)(lane >> 4) * d.N + 4 * (lane & 15);
#pragma unroll
    for (int i = 0; i < 16; ++i) v[i] = *(const f32x4*)(src + (size_t)(4 * i) * d.N);
}
__device__ __forceinline__ void tr_finish(const TrDesc& d, int lane, const f32x4 (&v)[16], LAS float* scr) {
    const int lr = lane >> 4, lc = lane & 15;
#pragma unroll
    for (int i = 0; i < 16; ++i) { const int kk = lr + 4 * i; *(LAS f32x4*)(scr + kk * 64 + 4 * (lc ^ ((kk >> 3) & 7))) = v[i] * d.sc; }
    LDS_WAIT(); asm volatile("" ::: "memory");
    const int c4 = lane & 3;
#pragma unroll
    for (int jj = 0; jj < 4; ++jj) { const int n = (lane >> 2) + 16 * jj; const LAS float* s0 = scr + (16 * c4) * 64 + (n ^ (4 * (2 * c4))), * s1 = scr + (16 * c4 + 8) * 64 + (n ^ (4 * (2 * c4 + 1)));
        u32x4 o; o.x = pg8::pk4_fp8(s0[0 * 64], s0[1 * 64], s0[2 * 64], s0[3 * 64]); o.y = pg8::pk4_fp8(s0[4 * 64], s0[5 * 64], s0[6 * 64], s0[7 * 64]);
        o.z = pg8::pk4_fp8(s1[0 * 64], s1[1 * 64], s1[2 * 64], s1[3 * 64]); o.w = pg8::pk4_fp8(s1[4 * 64], s1[5 * 64], s1[6 * 64], s1[7 * 64]);
        *(u32x4*)(d.dst + (size_t)n * d.pitch + 16 * c4) = o; }
    LDS_WAIT(); asm volatile("" ::: "memory");
}
__device__ __forceinline__ void p0_prologue(Frame& F) {
    const float* c = fin(I_C); const float* wada = fin(I_WADA); const float* bada = fin(I_BADA);
    if (blockIdx.x < 192) {
        const int cg = blockIdx.x, kh = F.lane >> 5, col = F.lane & 31;
        LAS float* scs = (LAS float*)F.lds; LAS float* red = (LAS float*)(F.lds + 65536);
        { float cv[32];
#pragma unroll
          for (int i = 0; i < 32; ++i) cv[i] = c[F.tid + NTHR * i];
#pragma unroll
          for (int i = 0; i < 32; ++i) scs[F.tid + NTHR * i] = cv[i] * sig_fast(cv[i]); }
        __syncthreads();
        float acc[16];
#pragma unroll
        for (int b = 0; b < 16; ++b) acc[b] = 0.f;
        const int kbase = 128 * F.wave + 64 * kh;
        const float* w = wada + (size_t)kbase * 6144 + 32 * cg + col;
        { float wv[64];
#pragma unroll
          for (int k = 0; k < 64; ++k) wv[k] = w[(size_t)k * 6144];
#pragma unroll
          for (int k = 0; k < 64; ++k)
#pragma unroll
              for (int b = 0; b < 16; ++b) acc[b] += scs[b * D + kbase + k] * wv[k]; }
#pragma unroll
        for (int b = 0; b < 16; ++b) red[((F.wave * 2 + kh) * 16 + b) * 32 + col] = acc[b];
        __syncthreads();
        float* ada = (float*)(F.ws + WS_ADA);
        { const int b = F.tid >> 5, l = F.tid & 31; float sm = 0.f;
#pragma unroll
          for (int p = 0; p < 16; ++p) sm += red[(p * 16 + b) * 32 + l];
          __hip_atomic_store(ada + b * 6144 + 32 * cg + l, sm + bada[32 * cg + l], __ATOMIC_RELAXED, __HIP_MEMORY_SCOPE_AGENT); }
        VM_WAIT();
        __syncthreads();
        if (F.tid == 0) __hip_atomic_fetch_add(F.ctl + CW_ADA, 1u, __ATOMIC_RELAXED, __HIP_MEMORY_SCOPE_AGENT);
    }
    {
        const int gt = F.vcu * NTHR + F.tid, NGT = F.G * NTHR; const float* wgrp = fin(I_WGRP); const float* wrt = fin(I_WRT);
        f32x2* rope = (f32x2*)(F.ws + WS_ROPE);
        for (int i = gt; i < 96 * 16; i += NGT) { const int r = i >> 4, e = i & 15; const float pos = (float)(r < 32 ? r : r - 32);
            const float invf = powf(10000.f, -(float)e / 16.f); float sn, cs; sincosf(pos * invf, &sn, &cs); rope[i] = (f32x2){cs, sn}; }
        bf16* wr = (bf16*)(F.ws + WS_WR);
        for (int i = gt; i < 64 * 1024; i += NGT) { const int n = i >> 10, k = i & 1023;
            const float v = n < 4 ? wgrp[k * 4 + n] : (n < 36 ? wrt[k * 32 + (n - 4)] : 0.f); wr[i] = (bf16)f2bf(v); }
    }
    LAS float* scr = (LAS float*)(F.lds + RING_OFF + F.wave * 16384);
    const int gw = F.vcu * NWAVES + F.wave, NGW = F.G * NWAVES;
    constexpr int I_WIN_ = (D / 64) * (INW / 64), I_WC_ = (CW / 64) * (D / 64), I_WO_ = (D / 64) * (D / 64);
    constexpr int NITEMS = I_WIN_ + 2 * I_WC_ + I_WO_;
    bf16* WIN = (bf16*)(F.ws + WS_WIN); bf16* WCA = (bf16*)(F.ws + WS_WCA); bf16* WO = (bf16*)(F.ws + WS_WO);
    const float* pwin = fin(I_WIN); const float* pwco = fin(I_WCO); const float* pwao = fin(I_WAO); const float* pwout = fin(I_WOUT);
    for (int it = gw; it < NITEMS; it += NGW) {
        int r = it;
        if (r < I_WIN_) { const int kb = r / 60, nb = r % 60;
            if (nb >= 16 && nb < 28) p0_transpose_item<1>(pwin, INW, WIN, D, 0, scr, kb * 60 + nb, F.lane);
            else { TrDesc d; const int n0 = 64 * nb; d.src = pwin + (size_t)(64 * kb) * INW + n0; d.N = INW; d.pitch = 2048; d.sc = pg8::WSCIN; d.dst = F.ws + WS_WINF + (size_t)pg8::winf_row(vmap_win(n0)) * 2048 + 64 * kb;
                   f32x4 tv[16]; tr_load(d, F.lane, tv); tr_finish(d, F.lane, tv, scr); }
            continue; } r -= I_WIN_;
        if (r < 2 * I_WC_) { const bool at = r >= I_WC_; if (at) r -= I_WC_;
            TrDesc d; const int kb = r / (D / 64), nb = r % (D / 64); d.src = (at ? pwao : pwco) + (size_t)(64 * kb) * D + 64 * nb; d.N = D; d.pitch = D; d.sc = pg8::WSCCA;
            d.dst = F.ws + WS_WCA + (size_t)(64 * nb) * D + (at ? 512 : 0) + 64 * kb;
            f32x4 tv[16]; tr_load(d, F.lane, tv); tr_finish(d, F.lane, tv, scr); continue; } r -= 2 * I_WC_;
        { TrDesc d; const int kb = r / (D / 64), nb = r % (D / 64); d.src = pwout + (size_t)(64 * kb) * D + 64 * nb; d.N = D; d.pitch = D; d.sc = pg8::WSCO; d.dst = F.ws + WS_WO + (size_t)(64 * nb) * D + 64 * kb;
          f32x4 tv[16]; tr_load(d, F.lane, tv); tr_finish(d, F.lane, tv, scr); }
    }
}
constexpr int XCONV_ITEMS = NE * (2 * (D / 64) * (DE / 64) + (DE / 64) * (D / 64));
__device__ __forceinline__ void p0_convert_experts(Frame& F, int lo, int hi, int rank, int nconv) {
    LAS float* scr = (LAS float*)(F.lds + RING_OFF + F.wave * 16384);
    constexpr int I_G1 = (D / 64) * (DE / 64), I_D1 = (DE / 64) * (D / 64), PER = 2 * I_G1 + I_D1;
    unsigned char* W1 = F.ws + WS_W1; unsigned char* W2 = F.ws + WS_W2;
    const float* pweg = fin(I_WEG); const float* pweu = fin(I_WEU); const float* pwed = fin(I_WED);
    const int step = nconv * NWAVES;
    for (int it = lo + rank * NWAVES + F.wave; it < hi; it += 2 * step) {
        const TrDesc d0 = tr_desc(it, pweg, pweu, pwed, W1, W2); const bool two = it + step < hi;
        const TrDesc d1 = tr_desc(two ? it + step : it, pweg, pweu, pwed, W1, W2);
        f32x4 v0[16], v1[16];
        tr_load(d0, F.lane, v0); tr_load(d1, F.lane, v1);
        __builtin_amdgcn_sched_barrier(0);
        tr_finish(d0, F.lane, v0, scr);
        if (two) tr_finish(d1, F.lane, v1, scr);
    }
}

__device__ __forceinline__ int rcol(int lane, int q) { return 512 * (q >> 1) + 8 * lane + 4 * (q & 1); }
__device__ __forceinline__ void row_ld_f32(const float* p, int lane, f32x4 (&v)[4]) {
#pragma unroll
    for (int q = 0; q < 4; ++q) v[q] = *(const f32x4*)(p + rcol(lane, q)); }
__device__ __forceinline__ void row_st_f32(float* p, int lane, const f32x4 (&v)[4]) {
#pragma unroll
    for (int q = 0; q < 4; ++q) *(f32x4*)(p + rcol(lane, q)) = v[q]; }
__device__ __forceinline__ void row_ld_bf16(const bf16* p, int lane, f32x4 (&v)[4]) {
#pragma unroll
    for (int j = 0; j < 2; ++j) { const u32x4 w = *(const u32x4*)(p + 512 * j + 8 * lane);
        v[2 * j] = (f32x4){bf2f(w.x & 0xffffu), bf2f(w.x >> 16), bf2f(w.y & 0xffffu), bf2f(w.y >> 16)}; v[2 * j + 1] = (f32x4){bf2f(w.z & 0xffffu), bf2f(w.z >> 16), bf2f(w.w & 0xffffu), bf2f(w.w >> 16)}; } }
__device__ __forceinline__ u32x4 row_pack(const f32x4 a, const f32x4 b) { return (u32x4){cvt_pk_bf16(a.x, a.y), cvt_pk_bf16(a.z, a.w), cvt_pk_bf16(b.x, b.y), cvt_pk_bf16(b.z, b.w)}; }
__device__ __forceinline__ float row_ss(const f32x4 (&v)[4]) { float s = 0.f;
#pragma unroll
    for (int q = 0; q < 4; ++q) s += (v[q].x * v[q].x + v[q].y * v[q].y) + (v[q].z * v[q].z + v[q].w * v[q].w);
    return s; }

__device__ __forceinline__ void p1_modnorm(Frame& F) {
    if (F.tid == 0) { unsigned sp = 0; while (__hip_atomic_load(F.ctl + CW_ADA, __ATOMIC_RELAXED, __HIP_MEMORY_SCOPE_AGENT) < 192u) { __builtin_amdgcn_s_sleep(2); if (++sp > (1u << 22)) break; }
        __builtin_amdgcn_fence(__ATOMIC_ACQUIRE, "agent"); VM_WAIT(); }
    __syncthreads();
    const float* x = fin(I_X); const float* g = fin(I_GPRE1); const float* ada = (const float*)(F.ws + WS_ADA); bf16* h1 = (bf16*)(F.ws + WS_H1); unsigned char* h1f = F.ws + WS_H1F;
    for (int chunk = blockIdx.x; chunk < NTOK / 128; chunk += F.G) {
        const int R0 = chunk * 128, b = R0 / SEQ; const float* ad = ada + b * 6144;
        f32x4 ca[4], cb[4];
#pragma unroll
        for (int q = 0; q < 4; ++q) { const int c0 = rcol(F.lane, q); ca[q] = *(const f32x4*)(g + c0) * (1.f + *(const f32x4*)(ad + 1024 + c0)); cb[q] = *(const f32x4*)(ad + c0); }
        const int rw = R0 + 16 * F.wave;
        f32x4 n0[4], n1[4];
        row_ld_f32(x + (size_t)rw * D, F.lane, n0); row_ld_f32(x + (size_t)(rw + 1) * D, F.lane, n1);
#pragma unroll
        for (int i = 0; i < 16; i += 2) {
            const int row = rw + i;
            f32x4 v0[4], v1[4];
#pragma unroll
            for (int q = 0; q < 4; ++q) { v0[q] = n0[q]; v1[q] = n1[q]; }
            if (i + 2 < 16) { row_ld_f32(x + (size_t)(row + 2) * D, F.lane, n0); row_ld_f32(x + (size_t)(row + 3) * D, F.lane, n1); }
            __builtin_amdgcn_sched_barrier(0);
            const float r0 = rsqrtf(wave_sum(row_ss(v0)) * (1.f / D) + EPS), r1 = rsqrtf(wave_sum(row_ss(v1)) * (1.f / D) + EPS);
#pragma unroll
            for (int j = 0; j < 2; ++j) {
                const f32x4 a0 = v0[2 * j] * r0 * ca[2 * j] + cb[2 * j], a1 = v0[2 * j + 1] * r0 * ca[2 * j + 1] + cb[2 * j + 1], b0 = v1[2 * j] * r1 * ca[2 * j] + cb[2 * j], b1 = v1[2 * j + 1] * r1 * ca[2 * j + 1] + cb[2 * j + 1];
                *(u32x4*)(h1 + (size_t)row * D + 512 * j + 8 * F.lane) = row_pack(a0, a1); *(u32x4*)(h1 + (size_t)(row + 1) * D + 512 * j + 8 * F.lane) = row_pack(b0, b1);
                *(u32x2*)(h1f + (size_t)row * 2048 + 512 * j + 8 * F.lane) = (u32x2){pg8::pk4_fp8(a0.x, a0.y, a0.z, a0.w), pg8::pk4_fp8(a1.x, a1.y, a1.z, a1.w)};
                *(u32x2*)(h1f + (size_t)(row + 1) * 2048 + 512 * j + 8 * F.lane) = (u32x2){pg8::pk4_fp8(b0.x, b0.y, b0.z, b0.w), pg8::pk4_fp8(b1.x, b1.y, b1.z, b1.w)}; }
            __builtin_amdgcn_sched_barrier(0);
        }
    }
}

constexpr int CV_T = 32, CV_IN = 0, CV_UT = (CV_T + KS - 1) * 1024;
static_assert(CV_UT + CV_T * CW * 4 <= RING_BYTES, "conv LDS map");
__device__ __forceinline__ void p3_conv(Frame& F) {
    const bf16* glu = (const bf16*)(F.ws + WS_GLU); bf16* ca = (bf16*)(F.ws + WS_CA);
    LAS unsigned char* IN = F.lds + RING_OFF + CV_IN; LAS float* UT = (LAS float*)(F.lds + RING_OFF + CV_UT);
    const int cp = F.tid & 255, th = F.tid >> 8;
    f32x2 w[KS];
#pragma unroll
    for (int j = 0; j < KS; ++j) w[j] = *(const f32x2*)(fin(I_WDW) + j * CW + 2 * cp);
    const f32x2 bias = *(const f32x2*)(fin(I_BDW) + 2 * cp);
    float lg[8], lb[8];
#pragma unroll
    for (int i = 0; i < 8; ++i) { lg[i] = fin(I_CLNG)[F.lane * 8 + i]; lb[i] = fin(I_CLNB)[F.lane * 8 + i]; }
    u32x4 sv[8];
#define CV_LOAD(unx) do { const int b_ = (unx) / (SEQ / CV_T), s0_ = ((unx) % (SEQ / CV_T)) * CV_T; _Pragma("unroll") for (int i = 0; i < 8; ++i) { \
        const int s_ = s0_ - KS / 2 + F.wave + NWAVES * i, sc_ = s_ < 0 ? 0 : (s_ >= SEQ ? SEQ - 1 : s_); sv[i] = *(const u32x4*)(glu + (size_t)(b_ * SEQ + sc_) * CW + F.lane * 8); } } while (0)
    if (F.vcu < NTOK / CV_T) CV_LOAD(F.vcu);
    for (int un = F.vcu; un < NTOK / CV_T; un += F.G) {
        const int b = un / (SEQ / CV_T), s0 = (un % (SEQ / CV_T)) * CV_T;
#pragma unroll
        for (int i = 0; i < 8; ++i) { const int r = F.wave + NWAVES * i, s = s0 - KS / 2 + r;
            if (r < CV_T + KS - 1) *(LAS u32x4*)(IN + r * 1024 + F.lane * 16) = (s >= 0 && s < SEQ) ? sv[i] : (u32x4){0u, 0u, 0u, 0u}; }
        __syncthreads();
        if (un + F.G < NTOK / CV_T) CV_LOAD(un + F.G);
        __builtin_amdgcn_sched_barrier(0);
#pragma unroll
        for (int g = 0; g < 2; ++g) {
            f32x2 win[38];
#pragma unroll
            for (int i = 0; i < 38; ++i) { const unsigned pw = *(const LAS unsigned*)(IN + (16 * th + 8 * g + i) * 1024 + cp * 4); win[i] = (f32x2){__uint_as_float(pw << 16), __uint_as_float(pw & 0xffff0000u)}; }
#pragma unroll
            for (int o = 0; o < 8; ++o) { f32x2 a = bias;
#pragma unroll
                for (int j = 0; j < KS; ++j) a = __builtin_elementwise_fma(win[o + j], w[j], a);
                *(LAS f32x2*)(UT + (16 * th + 8 * g + o) * CW + 2 * cp) = a; }
        }
        __syncthreads();
#pragma unroll
        for (int i = 0; i < 4; ++i) { const int t = F.wave * 4 + i;
            const f32x4 v0 = *(const LAS f32x4*)(UT + t * CW + F.lane * 8), v1 = *(const LAS f32x4*)(UT + t * CW + F.lane * 8 + 4);
            const float mu = wave_sum((v0.x + v0.y) + (v0.z + v0.w) + (v1.x + v1.y) + (v1.z + v1.w)) * (1.f / CW);
            const f32x4 d0 = v0 - mu, d1 = v1 - mu;
            const float var = wave_sum((d0.x * d0.x + d0.y * d0.y) + (d0.z * d0.z + d0.w * d0.w) + (d1.x * d1.x + d1.y * d1.y) + (d1.z * d1.z + d1.w * d1.w)) * (1.f / CW);
            const float rstd = rsqrtf(var + EPS);
            float o[8];
#pragma unroll
            for (int k = 0; k < 4; ++k) { const float a = d0[k] * rstd * lg[k] + lb[k], bq = d1[k] * rstd * lg[4 + k] + lb[4 + k]; o[k] = a * sig_fast(a); o[4 + k] = bq * sig_fast(bq); }
            *(u32x2*)((unsigned char*)ca + (size_t)(b * SEQ + s0 + t) * D + F.lane * 8) = (u32x2){pg8::pk4_fp8(o[0] * pg8::CSC, o[1] * pg8::CSC, o[2] * pg8::CSC, o[3] * pg8::CSC),
                                                                                                  pg8::pk4_fp8(o[4] * pg8::CSC, o[5] * pg8::CSC, o[6] * pg8::CSC, o[7] * pg8::CSC)}; }
        __syncthreads();
    }
#undef CV_LOAD
}

constexpr int WRP = 2064;
constexpr int P6_WR = 0, P6_LGW = 48 * WRP, P6_EA = P6_LGW + 8 * 16 * 48 * 4, P6_HIST = P6_EA + 128 * 32, P6_BASE = P6_HIST + 128, P6_END = P6_BASE + 128;
constexpr int P6_RS2 = P6_END, P6_BIAS = P6_RS2 + 512, P6_BPART = P6_BIAS + 256, P6_END2 = P6_BPART + 8 * 48 * 4;
static_assert(P6_END2 <= RING_BYTES, "P6 LDS map");
struct P6Row { float pv; u32x4 y[2]; f32x4 x[4]; };
__device__ __forceinline__ void p6_ld(P6Row& r, const float* x, const bf16* y1, const float* part, int row, int lane) {
    r.pv = part[(size_t)row * 16 + (lane & 15)];
#pragma unroll
    for (int j = 0; j < 2; ++j) r.y[j] = *(const u32x4*)(y1 + (size_t)row * D + 512 * j + 8 * lane);
    row_ld_f32(x + (size_t)row * D, lane, r.x);
}
__device__ __forceinline__ void p6_do(P6Row& r, const f32x4 (&c1)[4], const f32x4 (&c2)[4], const f32x4 (&c3)[4], bf16* x1b, unsigned char* h2f, LAS float* rs2, int row, int lane) {
    const float pv = row16_sum(r.pv);
    const float ra = rsqrtf(pv * (1.f / D) + EPS);
    f32x4 xv[4];
#pragma unroll
    for (int j = 0; j < 2; ++j) { const u32x4 w = r.y[j];
        const f32x4 ya = (f32x4){bf2f(w.x & 0xffffu), bf2f(w.x >> 16), bf2f(w.y & 0xffffu), bf2f(w.y >> 16)}, yb = (f32x4){bf2f(w.z & 0xffffu), bf2f(w.z >> 16), bf2f(w.w & 0xffffu), bf2f(w.w >> 16)};
        xv[2 * j] = r.x[2 * j] + c1[2 * j] * (ya * ra); xv[2 * j + 1] = r.x[2 * j + 1] + c1[2 * j + 1] * (yb * ra);
        *(u32x4*)(x1b + (size_t)row * D + 512 * j + 8 * lane) = row_pack(xv[2 * j], xv[2 * j + 1]); }
    const float sa = rsqrtf(wave_sum(row_ss(xv)) * (1.f / D) + EPS);
    if (lane == 0) *rs2 = sa;
#pragma unroll
    for (int j = 0; j < 2; ++j) { const f32x4 ha = xv[2 * j] * sa * c2[2 * j] + c3[2 * j], hb = xv[2 * j + 1] * sa * c2[2 * j + 1] + c3[2 * j + 1];
        *(u32x2*)(h2f + (size_t)row * D + 512 * j + 8 * lane) = (u32x2){pg8::pk4_fp8(ha.x, ha.y, ha.z, ha.w), pg8::pk4_fp8(hb.x, hb.y, hb.z, hb.w)}; }
}
__device__ __forceinline__ void p6_postmix_router(Frame& F) {
    const float* x = fin(I_X); const bf16* y1 = (const bf16*)(F.ws + WS_Y1); const float* part = (const float*)(F.ws + WS_PART); const float* ada = (const float*)(F.ws + WS_ADA);
    unsigned char* h2f = F.ws + WS_H2F; bf16* x1b = (bf16*)(F.ws + WS_X1B); int* list = (int*)(F.ws + WS_LIST); unsigned* tokinfo = (unsigned*)(F.ws + WS_TOK);
    LAS unsigned char* WR = F.lds + P6_WR; LAS float* LGW = (LAS float*)(F.lds + P6_LGW) + F.wave * 16 * 48;
    LAS unsigned* EA = (LAS unsigned*)(F.lds + P6_EA); LAS unsigned* HIST = (LAS unsigned*)(F.lds + P6_HIST); LAS unsigned* BASE = (LAS unsigned*)(F.lds + P6_BASE);
    LAS float* RS2 = (LAS float*)(F.lds + P6_RS2) + F.wave * 16; LAS float* BIAS = (LAS float*)(F.lds + P6_BIAS); LAS float* BPART = (LAS float*)(F.lds + P6_BPART);
    const int fr = F.lane & 15, fq = F.lane >> 4;
    const float* gpost1 = fin(I_GPOST1); const float* gpre2 = fin(I_GPRE2); const float* bgrp = fin(I_BGRP); const float* brt = fin(I_BRT); const float* wgrp = fin(I_WGRP); const float* wrt = fin(I_WRT);
    for (int i = F.tid; i < 12 * WRP / 4; i += NTHR) ((LAS unsigned*)(WR + 36 * WRP))[i] = 0u;
    for (int chunk = blockIdx.x; chunk < NTOK / 128; chunk += F.G) {
        const int R0 = chunk * 128, b = R0 / SEQ, rw = R0 + 16 * F.wave; const float* ad = ada + b * 6144;
        if (F.tid < 32) HIST[F.tid] = 0u;
        {
            float bp[36];
#pragma unroll
            for (int n = 0; n < 36; ++n) bp[n] = 0.f;
#pragma unroll
            for (int h = 0; h < 2; ++h) { const int kk = F.tid + NTHR * h; const float c2k = gpre2[kk] * (1.f + ad[4096 + kk]), c3k = ad[3072 + kk];
                const f32x4 wg = *(const f32x4*)(wgrp + kk * 4);
#pragma unroll
                for (int n = 0; n < 4; ++n) { *(LAS unsigned short*)(WR + n * WRP + kk * 2) = (unsigned short)f2bf(wg[n] * c2k); bp[n] += c3k * wg[n]; }
#pragma unroll
                for (int q = 0; q < 8; ++q) { const f32x4 wv = *(const f32x4*)(wrt + kk * 32 + q * 4);
#pragma unroll
                    for (int n = 0; n < 4; ++n) { *(LAS unsigned short*)(WR + (4 + 4 * q + n) * WRP + kk * 2) = (unsigned short)f2bf(wv[n] * c2k); bp[4 + 4 * q + n] += c3k * wv[n]; } } }
#pragma unroll
            for (int n = 0; n < 36; ++n) { const float t = wave_sum(bp[n]); if (F.lane == 0) BPART[F.wave * 48 + n] = t; }
        }
        f32x4 c1[4], c2[4], c3[4];
#pragma unroll
        for (int q = 0; q < 4; ++q) { const int c0 = rcol(F.lane, q);
            c1[q] = *(const f32x4*)(gpost1 + c0) * *(const f32x4*)(ad + 2048 + c0);
            c2[q] = *(const f32x4*)(gpre2 + c0) * (1.f + *(const f32x4*)(ad + 4096 + c0)); c3[q] = *(const f32x4*)(ad + 3072 + c0); }
        __syncthreads();
        if (F.tid < 48) { float t = 0.f;
            if (F.tid < 36) {
#pragma unroll
                for (int w = 0; w < 8; ++w) t += BPART[w * 48 + F.tid];
                t += F.tid < 4 ? bgrp[F.tid] : brt[F.tid - 4]; }
            BIAS[F.tid] = t; }
        {
            P6Row na, nb;
            p6_ld(na, x, y1, part, rw, F.lane); p6_ld(nb, x, y1, part, rw + 1, F.lane);
#pragma unroll
            for (int i = 0; i < 16; i += 2) {
                P6Row ra = na, rb = nb;
                if (i + 2 < 16) { p6_ld(na, x, y1, part, rw + i + 2, F.lane); p6_ld(nb, x, y1, part, rw + i + 3, F.lane); }
                __builtin_amdgcn_sched_barrier(0);
                p6_do(ra, c1, c2, c3, x1b, h2f, RS2 + i, rw + i, F.lane); p6_do(rb, c1, c2, c3, x1b, h2f, RS2 + i + 1, rw + i + 1, F.lane);
                __builtin_amdgcn_sched_barrier(0);
            }
        }
        VM_WAIT();
        __syncthreads();
        {
            f32x4 acc[3] = {(f32x4){0.f, 0.f, 0.f, 0.f}, (f32x4){0.f, 0.f, 0.f, 0.f}, (f32x4){0.f, 0.f, 0.f, 0.f}};
            bf16x8 af[32];
#pragma unroll
            for (int ks = 0; ks < 32; ++ks) af[ks] = *(const bf16x8*)(x1b + (size_t)(rw + fr) * D + 32 * ks + 8 * fq);
#pragma unroll
            for (int ks = 0; ks < 32; ++ks)
#pragma unroll
                for (int nb = 0; nb < 3; ++nb) { const bf16x8 bf = *(const LAS bf16x8*)(WR + (16 * nb + fr) * WRP + (32 * ks + 8 * fq) * 2);
                    acc[nb] = __builtin_amdgcn_mfma_f32_16x16x32_bf16(af[ks], bf, acc[nb], 0, 0, 0); }
#pragma unroll
            for (int nb = 0; nb < 3; ++nb)
#pragma unroll
                for (int j = 0; j < 4; ++j) LGW[(4 * fq + j) * 48 + 16 * nb + fr] = acc[nb][j] * RS2[4 * fq + j] + BIAS[16 * nb + fr];
        }
        LDS_WAIT();
        if (F.lane < 16) {
            const LAS float* L = LGW + F.lane * 48;
            float gl[4];
#pragma unroll
            for (int g = 0; g < 4; ++g) gl[g] = L[g];
            int gi = 0; float gm = gl[0];
#pragma unroll
            for (int g = 1; g < 4; ++g) if (gl[g] > gm) { gm = gl[g]; gi = g; }
            float den = 0.f;
#pragma unroll
            for (int g = 0; g < 4; ++g) den += __expf(gl[g] - gm);
            const float grp_p = 1.f / den;
            float E[8];
#pragma unroll
            for (int i = 0; i < 8; ++i) E[i] = L[4 + gi * 8 + i];
            int a = 0; float am = E[0];
#pragma unroll
            for (int i = 1; i < 8; ++i) if (E[i] > am) { am = E[i]; a = i; }
            int bi = -1; float bm = -3.0e38f;
#pragma unroll
            for (int i = 0; i < 8; ++i) if (i != a && E[i] > bm) { bm = E[i]; bi = i; }
            if (bi < 0) { bi = (a == 0) ? 1 : 0; bm = E[bi]; }
            const float pb = __expf(bm - am), wa = 1.f / (1.f + pb), wb = pb / (1.f + pb);
            const unsigned e0 = (unsigned)(gi * 8 + a), e1 = (unsigned)(gi * 8 + bi);
            const unsigned k0 = __hip_atomic_fetch_add(HIST + e0, 1u, __ATOMIC_RELAXED, __HIP_MEMORY_SCOPE_WORKGROUP), k1 = __hip_atomic_fetch_add(HIST + e1, 1u, __ATOMIC_RELAXED, __HIP_MEMORY_SCOPE_WORKGROUP);
            LAS unsigned* ea = EA + (16 * F.wave + F.lane) * 8;
            ea[0] = e0; ea[1] = k0; ea[2] = e1; ea[3] = k1; ea[4] = __float_as_uint(grp_p * wa); ea[5] = __float_as_uint(grp_p * wb);
        }
        __syncthreads();
        if (F.tid < 32) BASE[F.tid] = __hip_atomic_fetch_add(F.ctl + CW_CNT + F.tid, HIST[F.tid], __ATOMIC_RELAXED, __HIP_MEMORY_SCOPE_AGENT);
        __syncthreads();
        if (F.tid < 128) { const LAS unsigned* ea = EA + F.tid * 8; const int tok = R0 + F.tid;
            const unsigned e0 = ea[0], e1 = ea[2], p0 = BASE[e0] + ea[1], p1 = BASE[e1] + ea[3];
            list[(size_t)e0 * ECAP + p0] = tok; list[(size_t)e1 * ECAP + p1] = tok;
            unsigned* ti = tokinfo + (size_t)tok * 8; *(u32x4*)ti = (u32x4){e0, p0, e1, p1}; *(u32x2*)(ti + 4) = (u32x2){ea[4], ea[5]}; }
        __syncthreads();
    }
}

__device__ __forceinline__ void moe_tstart(Frame& F) {
    LAS int* TS = (LAS int*)(F.lds + TS_OFF);
    if (F.tid == 0) { int o = 0; for (int e = 0; e < NE; ++e) { TS[e] = o; o += (int)((__hip_atomic_load(F.ctl + CW_CNT + e, __ATOMIC_RELAXED, __HIP_MEMORY_SCOPE_AGENT) + 255u) >> 8); } TS[NE] = o; }
    __syncthreads();
}
template <bool GATHER>
__device__ __forceinline__ void moe_setup(Frame& F) {
    moe_tstart(F);
    LAS int* TS = (LAS int*)(F.lds + TS_OFF); LAS int* UT = (LAS int*)(F.lds + UT_OFF); LAS int* RT = (LAS int*)(F.lds + RT_OFF);
    const int* list = (const int*)(F.ws + WS_LIST);
    if (F.tid < pg8::MOE_MAXU) {
        const int u = F.tid * F.G + F.vcu, T4 = 4 * TS[NE]; int pm = 0, pn = 0, e = 0, valid = 0;
        if (u < T4) { pm = u >> 2; pn = u & 3; valid = 1; for (int k = 1; k < NE; ++k) if (TS[k] <= pm) e = k; }
        UT[F.tid * 4 + 0] = pm; UT[F.tid * 4 + 1] = pn; UT[F.tid * 4 + 2] = e; UT[F.tid * 4 + 3] = valid;
    }
    __syncthreads();
    if (GATHER) {
        for (int idx = F.tid; idx < pg8::MOE_MAXU * 256; idx += NTHR) { const int i = idx >> 8, r = idx & 255;
            if (UT[i * 4 + 3]) { const int e = UT[i * 4 + 2], pos = (UT[i * 4 + 0] - TS[e]) * 256 + r;
                const int cnt = (int)__hip_atomic_load(F.ctl + CW_CNT + e, __ATOMIC_RELAXED, __HIP_MEMORY_SCOPE_AGENT);
                RT[idx] = pos < cnt ? list[(size_t)e * ECAP + pos] : 0; } }
        VM_WAIT();
    }
    __syncthreads();
}

struct P9Row { u32x2 ya[2], yb[2]; u32x4 xb[2]; };
__device__ __forceinline__ void p9_ld(P9Row& r, const unsigned char* y2, const bf16* x1b, unsigned s0, unsigned s1, int row, int lane) {
#pragma unroll
    for (int j = 0; j < 2; ++j) { r.ya[j] = *(const u32x2*)(y2 + (size_t)s0 * D + 512 * j + 8 * lane); r.yb[j] = *(const u32x2*)(y2 + (size_t)s1 * D + 512 * j + 8 * lane);
        r.xb[j] = *(const u32x4*)(x1b + (size_t)row * D + 512 * j + 8 * lane); }
}
__device__ __forceinline__ void up8(const u32x4 w, f32x4& a, f32x4& b) {
    a = (f32x4){bf2f(w.x & 0xffffu), bf2f(w.x >> 16), bf2f(w.y & 0xffffu), bf2f(w.y >> 16)}; b = (f32x4){bf2f(w.z & 0xffffu), bf2f(w.z >> 16), bf2f(w.w & 0xffffu), bf2f(w.w >> 16)}; }
__device__ __forceinline__ f32x4 up4_fp8(unsigned w) { const f32x2 lo = __builtin_amdgcn_cvt_pk_f32_fp8((int)w, false), hi = __builtin_amdgcn_cvt_pk_f32_fp8((int)w, true); return (f32x4){lo.x, lo.y, hi.x, hi.y}; }
__device__ __forceinline__ void p9_do(const P9Row& r, float w0, float w1, const f32x4 (&cg)[4], float* orow, int lane) {
    f32x4 y[4], xv[4];
#pragma unroll
    for (int j = 0; j < 2; ++j) { y[2 * j] = up4_fp8(r.ya[j].x) * w0 + up4_fp8(r.yb[j].x) * w1; y[2 * j + 1] = up4_fp8(r.ya[j].y) * w0 + up4_fp8(r.yb[j].y) * w1; up8(r.xb[j], xv[2 * j], xv[2 * j + 1]); }
    const float rs = rsqrtf(wave_sum(row_ss(y)) * (1.f / D) + EPS);
#pragma unroll
    for (int q = 0; q < 4; ++q) xv[q] = xv[q] + cg[q] * (y[q] * rs);
    row_st_f32(orow, lane, xv);
}
__device__ __forceinline__ void p9_final(Frame& F, bool dry) {
    moe_tstart(F);
    const LAS int* TS = (const LAS int*)(F.lds + TS_OFF);
    const unsigned char* y2 = F.ws + WS_Y2; const bf16* x1b = (const bf16*)(F.ws + WS_X1B); const unsigned* tokinfo = (const unsigned*)(F.ws + WS_TOK); const float* ada = (const float*)(F.ws + WS_ADA);
    float* obase = dry ? (float*)(F.ws + WS_CA) : F.out; const float* gpost2 = fin(I_GPOST2);
    for (int chunk = blockIdx.x; chunk < NTOK / 128; chunk += F.G) {
        const int R0 = chunk * 128, b = R0 / SEQ, rw = R0 + 16 * F.wave; const float* ad = ada + b * 6144;
        f32x4 cg[4];
#pragma unroll
        for (int q = 0; q < 4; ++q) { const int c0 = rcol(F.lane, q); cg[q] = *(const f32x4*)(gpost2 + c0) * *(const f32x4*)(ad + 5120 + c0); }
        const u32x4 ti = *(const u32x4*)(tokinfo + (size_t)(rw + (F.lane & 15)) * 8); const u32x2 tw = *(const u32x2*)(tokinfo + (size_t)(rw + (F.lane & 15)) * 8 + 4);
        const unsigned sl0 = (unsigned)TS[ti.x] * 256u + ti.y, sl1 = (unsigned)TS[ti.z] * 256u + ti.w;
#define P9_S0(i) ((unsigned)__builtin_amdgcn_readlane((int)sl0, (i)))
#define P9_S1(i) ((unsigned)__builtin_amdgcn_readlane((int)sl1, (i)))
#define P9_W0(i) (__uint_as_float((unsigned)__builtin_amdgcn_readlane((int)tw.x, (i))) * (1.f / pg8::YSC))
#define P9_W1(i) (__uint_as_float((unsigned)__builtin_amdgcn_readlane((int)tw.y, (i))) * (1.f / pg8::YSC))
        P9Row na, nb;
        p9_ld(na, y2, x1b, P9_S0(0), P9_S1(0), rw, F.lane); p9_ld(nb, y2, x1b, P9_S0(1), P9_S1(1), rw + 1, F.lane);
#pragma unroll
        for (int i = 0; i < 16; i += 2) {
            const P9Row ra = na, rb = nb;
            if (i + 2 < 16) { p9_ld(na, y2, x1b, P9_S0(i + 2), P9_S1(i + 2), rw + i + 2, F.lane); p9_ld(nb, y2, x1b, P9_S0(i + 3), P9_S1(i + 3), rw + i + 3, F.lane); }
            __builtin_amdgcn_sched_barrier(0);
            p9_do(ra, P9_W0(i), P9_W1(i), cg, obase + (size_t)(rw + i) * D, F.lane); p9_do(rb, P9_W0(i + 1), P9_W1(i + 1), cg, obase + (size_t)(rw + i + 1) * D, F.lane);
            __builtin_amdgcn_sched_barrier(0);
        }
#undef P9_S0
#undef P9_S1
#undef P9_W0
#undef P9_W1
    }
}

#ifndef MK_STAG
#define MK_STAG 0
#endif
#ifndef MK_STAGMASK
#define MK_STAGMASK 0x3ff
#endif
#ifndef MK_STAGGRP
#define MK_STAGGRP 3
#endif
#define STAG_AT(p) (((MK_STAGMASK >> (p)) & 1) ? MK_STAG : 0)
__device__ __forceinline__ void stagger(int ticks) {
    if (ticks > 0) { const unsigned long long t0 = __builtin_amdgcn_s_memrealtime(); const unsigned long long d = (unsigned long long)(((blockIdx.x >> 3) & MK_STAGGRP) * ticks);
        while (__builtin_amdgcn_s_memrealtime() - t0 < d) __builtin_amdgcn_s_sleep(4); }
}

__global__ void __launch_bounds__(NTHR, 2) mega_fwd(Args args) {
    extern __shared__ __attribute__((aligned(16))) unsigned char lds_raw[];
    Frame F;
    F.lds = (LAS unsigned char*)lds_raw; F.MISC = (volatile LAS unsigned*)(F.lds + MISC_OFF);
    F.tid = threadIdx.x; F.lane = F.tid & 63; F.wave = __builtin_amdgcn_readfirstlane(F.tid >> 6);
    F.G = gridDim.x; { const int bx = blockIdx.x; F.vcu = (F.G % 8 == 0) ? (bx % 8) * (F.G / 8) + bx / 8 : bx; }
    F.ws = args.ws; F.ctl = (unsigned*)(args.ws + WS_CTL); F.out = args.out;
    for (int u = F.tid; u < (LDS_BYTES - LDSCTL_OFF) / 4; u += NTHR) ((LAS unsigned*)(F.lds + LDSCTL_OFF))[u] = 0u;
    __syncthreads();
    XcdBarrier bar; bar.bar = F.ctl + CW_BAR; bar.x = 0; bar.st = nullptr;
    if (args.use_bar) bar = xcd_barrier_post(F.ctl + CW_BAR, F.MISC + 8);
    const int lo = args.ph_lo, hi = args.ph_hi;
#ifndef MK_PHMASK
#define MK_PHMASK 0x3ff
#endif
#define IN(k) (((MK_PHMASK >> (k)) & 1) && lo <= (k) && (k) < hi)
#define SEAM(k) do { if (IN(k) && IN((k) + 1)) xcd_barrier(bar); } while (0)

    if (IN(0)) { p0_prologue(F); }
    if (IN(1)) { p1_modnorm(F); } SEAM(1);
    if (IN(2)) {
        pg8::EpiP2 E{(bf16*)(F.ws + WS_GLU), (bf16*)(F.ws + WS_QKV), (bf16*)(F.ws + WS_GATES), fin(I_QG), fin(I_KG), (const f32x2*)(F.ws + WS_ROPE)};
        stagger(STAG_AT(2));
        { pg8::P2Order<false> S{(const char*)(F.ws + WS_WIN), F.vcu, F.G};
          pg8::gemm_phase<pg8::EpiP2, pg8::P2Order<false>, true, 0>(F.lds + RING_OFF, F.ws + WS_H1, D * 2, D * 2, S, E); }
        { pg8::P2Order<true> S{(const char*)(F.ws + WS_WINF), F.vcu, F.G};
          pg8::gemm_phase<pg8::EpiP2, pg8::P2Order<true>, true, 1>(F.lds + RING_OFF, F.ws + WS_H1F, D * 2, D * 2, S, E, nullptr, D); }
    } SEAM(2);
    if (IN(3)) {
        if (!(args.flags & 1)) p3_conv(F);
        if (!(args.flags & 2)) {
            const attn_body::bf16* qkv = (const attn_body::bf16*)(F.ws + WS_QKV);
            const attn_body::AttnTensors AT{qkv, qkv + 512, qkv + 640, (attn_body::bf16*)(F.ws + WS_CA + 512)};
            const attn_body::StaticOrder S((int)F.G, F.vcu);
            attn_body::AttnUnit au;
            for (int i = 0; S.next(i, au); ++i) {
                if (i == (F.vcu & 3)) { p0_convert_experts(F, 0, XCONV_ITEMS, F.vcu, F.G); VM_WAIT(); __syncthreads(); }
                attn_body::attn_unit<8>(au.bh / attn_body::NHEAD, au.bh % attn_body::NHEAD, (au.bh % attn_body::NHEAD) / 4, au.qb, AT.Q, AT.K, AT.V, AT.O, (char*)lds_raw + RING_OFF);
            }
        }
    } SEAM(3);
    if (IN(4)) {
        pg8::PanelOrder S{(const char*)(F.ws + WS_WCA), F.vcu, F.G, D};
        pg8::EpiP4 E{(const bf16*)(F.ws + WS_GATES), (bf16*)(F.ws + WS_H1)};
        stagger(STAG_AT(4));
        pg8::gemm_phase<pg8::EpiP4, pg8::PanelOrder, true, 1>(F.lds + RING_OFF, F.ws + WS_CA, D, D, S, E);
    } SEAM(4);
    if (IN(5)) {
        pg8::PanelOrder S{(const char*)(F.ws + WS_WO), F.vcu, F.G, D};
        pg8::EpiP5 E{(bf16*)(F.ws + WS_Y1), (float*)(F.ws + WS_PART)};
        stagger(STAG_AT(5));
        pg8::gemm_phase<pg8::EpiP5, pg8::PanelOrder, true, 1>(F.lds + RING_OFF, F.ws + WS_H1, D, D, S, E);
    } SEAM(5);
    if (IN(6)) { p6_postmix_router(F); } SEAM(6);
    if (IN(7)) {
        moe_setup<true>(F);
        pg8::MoeOrder<true> S{(const LAS int*)(F.lds + UT_OFF), (const LAS int*)(F.lds + RT_OFF), F.ws + WS_W1, (size_t)D * D, D};
        pg8::EpiMoe1 E{F.ws + WS_GATES};
        stagger(STAG_AT(7));
        pg8::gemm_phase<pg8::EpiMoe1, pg8::MoeOrder<true>, true, true>(F.lds + RING_OFF, F.ws + WS_H2F, D, D, S, E);
    } SEAM(7);
    if (IN(8)) {
        moe_setup<false>(F);
        pg8::MoeOrder<false> S{(const LAS int*)(F.lds + UT_OFF), (const LAS int*)(F.lds + RT_OFF), F.ws + WS_W2, (size_t)D * DE, DE};
        pg8::EpiMoe2 E{F.ws + WS_Y2};
        stagger(STAG_AT(8));
        pg8::gemm_phase<pg8::EpiMoe2, pg8::MoeOrder<false>, true, true>(F.lds + RING_OFF, F.ws + WS_GATES, DE, DE, S, E);
    } SEAM(8);
    if (IN(9)) { p9_final(F, (args.flags & 4) != 0); }
#undef IN
#undef SEAM
}
#if MK_NPRE < 10
__global__ __launch_bounds__(256) void k_ada(const float* __restrict__ c, const float* __restrict__ w, const float* __restrict__ bb, float* __restrict__ ada) {
    const int j = blockIdx.x * 256 + threadIdx.x, b = blockIdx.y;
    float acc = 0.f;
    for (int k = 0; k < D; ++k) { const float cv = c[b * D + k]; acc += siluf_(cv) * w[(size_t)k * 6144 + j]; }
    ada[b * 6144 + j] = acc + bb[j];
}

__global__ __launch_bounds__(256) void k_modnorm(const float* __restrict__ x, const float* __restrict__ g, const float* __restrict__ ada, int sh_off, int sc_off, bf16* __restrict__ out) {
    const int lane = threadIdx.x & 63, row = blockIdx.x * 4 + (threadIdx.x >> 6), b = row / SEQ;
    const f32x4* xr = (const f32x4*)(x + (size_t)row * D) + lane;
    f32x4 v[4]; float s = 0.f;
#pragma unroll
    for (int j = 0; j < 4; ++j) { v[j] = xr[64 * j]; s += (v[j].x * v[j].x + v[j].y * v[j].y) + (v[j].z * v[j].z + v[j].w * v[j].w); }
    const float rstd = rsqrtf(wave_sum(s) * (1.f / D) + EPS);
    unsigned long long* o8 = (unsigned long long*)(out + (size_t)row * D) + lane;
#pragma unroll
    for (int j = 0; j < 4; ++j) {
        const int c0 = 256 * j + 4 * lane;
        const f32x4 gg = *(const f32x4*)(g + c0), sc = *(const f32x4*)(ada + b * 6144 + sc_off + c0), sh = *(const f32x4*)(ada + b * 6144 + sh_off + c0);
        const f32x4 r = v[j] * rstd * gg * (1.f + sc) + sh;
        o8[64 * j] = (unsigned long long)pk2(r.x, r.y) | ((unsigned long long)pk2(r.z, r.w) << 32);
    }
}

template <int MODE>
__global__ __launch_bounds__(256) void k_gemm(const bf16* __restrict__ A, int lda, const int* __restrict__ rowidx, const int* __restrict__ cntp, const int* __restrict__ offp,
                                              const float* __restrict__ W, const float* __restrict__ W2, int ldw, void* Cv, int ldc, int M, int K) {
    __shared__ float As[16][68];
    __shared__ float Bs[16][68];
    __shared__ float Bs2[MODE == 1 ? 16 : 1][68];
    const int Mcnt = cntp ? *cntp : M, off = offp ? *offp : 0;
    const int m0 = blockIdx.x * 64, n0 = blockIdx.y * 64;
    if (m0 >= Mcnt) return;
    const int tid = threadIdx.x, tx = tid & 15, ty = tid >> 4;
    float acc[4][4], acc2[4][4];
#pragma unroll
    for (int i = 0; i < 4; ++i)
#pragma unroll
        for (int j = 0; j < 4; ++j) { acc[i][j] = 0.f; acc2[i][j] = 0.f; }
    const int ar = tid >> 2, ak = (tid & 3) * 4, arow = m0 + ar;
    const bool av = arow < Mcnt;
    const size_t asrc = av ? (rowidx ? (size_t)rowidx[arow] : (size_t)(off + arow)) : 0;
    const int bk = tid >> 4, bn = (tid & 15) * 4;
    for (int k0 = 0; k0 < K; k0 += 16) {
        u32x2 raw = (u32x2){0u, 0u};
        if (av) raw = *(const u32x2*)(A + asrc * lda + k0 + ak);
        As[ak + 0][ar] = bf2f(raw.x & 0xffffu); As[ak + 1][ar] = bf2f(raw.x >> 16); As[ak + 2][ar] = bf2f(raw.y & 0xffffu); As[ak + 3][ar] = bf2f(raw.y >> 16);
        const f32x4 w = *(const f32x4*)(W + (size_t)(k0 + bk) * ldw + n0 + bn);
        Bs[bk][bn + 0] = w.x; Bs[bk][bn + 1] = w.y; Bs[bk][bn + 2] = w.z; Bs[bk][bn + 3] = w.w;
        if (MODE == 1) { const f32x4 w2 = *(const f32x4*)(W2 + (size_t)(k0 + bk) * ldw + n0 + bn);
            Bs2[bk][bn + 0] = w2.x; Bs2[bk][bn + 1] = w2.y; Bs2[bk][bn + 2] = w2.z; Bs2[bk][bn + 3] = w2.w; }
        __syncthreads();
#pragma unroll
        for (int kk = 0; kk < 16; ++kk) {
            float a[4], b[4], b2[4];
#pragma unroll
            for (int i = 0; i < 4; ++i) { a[i] = As[kk][ty * 4 + i]; b[i] = Bs[kk][tx * 4 + i]; b2[i] = (MODE == 1) ? Bs2[kk][tx * 4 + i] : 0.f; }
#pragma unroll
            for (int i = 0; i < 4; ++i)
#pragma unroll
                for (int j = 0; j < 4; ++j) { acc[i][j] += a[i] * b[j]; if (MODE == 1) acc2[i][j] += a[i] * b2[j]; }
        }
        __syncthreads();
    }
#pragma unroll
    for (int i = 0; i < 4; ++i) {
        const int r = m0 + ty * 4 + i;
        if (r < Mcnt) {
            const size_t crow = (size_t)(off + r);
            if (MODE == 0) { *(f32x4*)((float*)Cv + crow * ldc + n0 + tx * 4) = (f32x4){acc[i][0], acc[i][1], acc[i][2], acc[i][3]}; }
            else {
                float o[4];
#pragma unroll
                for (int j = 0; j < 4; ++j) o[j] = (MODE == 1) ? siluf_(acc[i][j]) * acc2[i][j] : acc[i][j];
                *(u32x2*)((bf16*)Cv + crow * ldc + n0 + tx * 4) = (u32x2){pk2(o[0], o[1]), pk2(o[2], o[3])};
            }
        }
    }
}

__global__ __launch_bounds__(256) void k_glu(const float* __restrict__ t, bf16* __restrict__ glu) {
    const size_t i = (size_t)blockIdx.x * 256 + threadIdx.x;
    const size_t r = i / 512; const int c = (int)(i % 512);
    const float a = t[r * 1024 + c], ag = t[r * 1024 + 512 + c];
    glu[i] = (bf16)f2bf(a * sigmoidf_(ag));
}
__global__ __launch_bounds__(256) void k_gate(const float* __restrict__ t, bf16* __restrict__ gates, int goff) {
    const size_t i = (size_t)blockIdx.x * 256 + threadIdx.x;
    const size_t r = i / 1024; const int c = (int)(i % 1024);
    gates[r * 2048 + goff + c] = (bf16)f2bf(sigmoidf_(t[i]));
}

__global__ __launch_bounds__(512) void k_conv(const bf16* __restrict__ glu, const float* __restrict__ w_dw, const float* __restrict__ b_dw, const float* __restrict__ lg, const float* __restrict__ lb, bf16* __restrict__ ca) {
    __shared__ float red[16];
    const int t = blockIdx.x, c = threadIdx.x, b = t / SEQ, s = t % SEQ;
    float acc = b_dw[c];
    for (int j = 0; j < KS; ++j) { const int s2 = s + j - KS / 2; if (s2 >= 0 && s2 < SEQ) acc += bf2f(glu[(size_t)(b * SEQ + s2) * CW + c]) * w_dw[j * CW + c]; }
    float sm = wave_sum(acc);
    if ((c & 63) == 0) red[c >> 6] = sm;
    __syncthreads();
    float mu = 0.f;
#pragma unroll
    for (int i = 0; i < 8; ++i) mu += red[i];
    mu *= (1.f / CW);
    const float d = acc - mu;
    float sq = wave_sum(d * d);
    if ((c & 63) == 0) red[8 + (c >> 6)] = sq;
    __syncthreads();
    float var = 0.f;
#pragma unroll
    for (int i = 0; i < 8; ++i) var += red[8 + i];
    var *= (1.f / CW);
    const float u = d * rsqrtf(var + EPS) * lg[c] + lb[c];
    ca[(size_t)t * 1024 + c] = (bf16)f2bf(siluf_(u));
}

__global__ __launch_bounds__(256) void k_qkrope(const float* __restrict__ t, const float* __restrict__ qg, const float* __restrict__ kg, bf16* __restrict__ qkv) {
    const size_t i = (size_t)blockIdx.x * 256 + threadIdx.x;
    const size_t r = i / 12; const int hs = (int)(i % 12);
    const float* src = t + r * 1024 + hs * 64; bf16* dst = qkv + r * 768 + hs * 64;
    if (hs >= 10) { for (int d = 0; d < 64; ++d) dst[d] = (bf16)f2bf(src[d]); return; }
    const float* g = hs < 8 ? qg : kg;
    float ss = 0.f;
    for (int d = 0; d < 64; ++d) ss += src[d] * src[d];
    const float rstd = rsqrtf(ss * (1.f / 64.f) + EPS) , osc = hs < 8 ? QSCALE : 1.f;
    const int s = (int)(r % SEQ); const float prow = (float)(s / 64), pcol = (float)(s % 64);
    for (int half = 0; half < 2; ++half) {
        const float pos = half == 0 ? prow : pcol;
        for (int e = 0; e < 16; ++e) {
            const float invf = powf(10000.f, -(float)(2 * e) / 32.f);
            const float ang = pos * invf; float sn, cs; sincosf(ang, &sn, &cs);
            const int d1 = half * 32 + e, d2 = d1 + 16;
            const float x1 = src[d1] * rstd * g[d1], x2 = src[d2] * rstd * g[d2];
            dst[d1] = (bf16)f2bf((x1 * cs - x2 * sn) * osc);
            dst[d2] = (bf16)f2bf((x2 * cs + x1 * sn) * osc);
        }
    }
}

__global__ __launch_bounds__(256) void k_attn(const bf16* __restrict__ qkv, bf16* __restrict__ ca) {
    const int qi = blockIdx.x * 256 + threadIdx.x;
    const int h = blockIdx.y, b = blockIdx.z, kvh = h / 4;
    const size_t row = (size_t)b * SEQ + qi;
    float q[64], o[64];
    {
        const u32x4* qp = (const u32x4*)(qkv + row * 768 + h * 64);
#pragma unroll
        for (int c = 0; c < 8; ++c) { const u32x4 v = qp[c];
            q[c * 8 + 0] = bf2f(v.x & 0xffffu); q[c * 8 + 1] = bf2f(v.x >> 16); q[c * 8 + 2] = bf2f(v.y & 0xffffu); q[c * 8 + 3] = bf2f(v.y >> 16);
            q[c * 8 + 4] = bf2f(v.z & 0xffffu); q[c * 8 + 5] = bf2f(v.z >> 16); q[c * 8 + 6] = bf2f(v.w & 0xffffu); q[c * 8 + 7] = bf2f(v.w >> 16); }
    }
#pragma unroll
    for (int d = 0; d < 64; ++d) o[d] = 0.f;
    float m = -1e30f, l = 0.f;
    for (int s = 0; s < SEQ; ++s) {
        const u32x4* kp = (const u32x4*)(qkv + ((size_t)b * SEQ + s) * 768 + 512 + kvh * 64);
        const u32x4* vp = (const u32x4*)(qkv + ((size_t)b * SEQ + s) * 768 + 640 + kvh * 64);
        float sc = 0.f;
#pragma unroll
        for (int c = 0; c < 8; ++c) { const u32x4 v = kp[c];
            sc += q[c * 8 + 0] * bf2f(v.x & 0xffffu) + q[c * 8 + 1] * bf2f(v.x >> 16) + q[c * 8 + 2] * bf2f(v.y & 0xffffu) + q[c * 8 + 3] * bf2f(v.y >> 16)
                + q[c * 8 + 4] * bf2f(v.z & 0xffffu) + q[c * 8 + 5] * bf2f(v.z >> 16) + q[c * 8 + 6] * bf2f(v.w & 0xffffu) + q[c * 8 + 7] * bf2f(v.w >> 16); }
        if (sc > m) { const float f = exp2f(m - sc); l *= f;
#pragma unroll
            for (int d = 0; d < 64; ++d) o[d] *= f;
            m = sc; }
        const float p = exp2f(sc - m); l += p;
#pragma unroll
        for (int c = 0; c < 8; ++c) { const u32x4 v = vp[c];
            o[c * 8 + 0] += p * bf2f(v.x & 0xffffu); o[c * 8 + 1] += p * bf2f(v.x >> 16); o[c * 8 + 2] += p * bf2f(v.y & 0xffffu); o[c * 8 + 3] += p * bf2f(v.y >> 16);
            o[c * 8 + 4] += p * bf2f(v.z & 0xffffu); o[c * 8 + 5] += p * bf2f(v.z >> 16); o[c * 8 + 6] += p * bf2f(v.w & 0xffffu); o[c * 8 + 7] += p * bf2f(v.w >> 16); }
    }
    const float il = 1.f / l;
    u32x4* op = (u32x4*)(ca + row * 1024 + 512 + h * 64);
#pragma unroll
    for (int c = 0; c < 8; ++c) op[c] = (u32x4){pk2(o[c * 8 + 0] * il, o[c * 8 + 1] * il), pk2(o[c * 8 + 2] * il, o[c * 8 + 3] * il), pk2(o[c * 8 + 4] * il, o[c * 8 + 5] * il), pk2(o[c * 8 + 6] * il, o[c * 8 + 7] * il)};
}

__global__ __launch_bounds__(256) void k_merge(const float* __restrict__ t1, const float* __restrict__ t2, const bf16* __restrict__ gates, bf16* __restrict__ merged) {
    const size_t i = (size_t)blockIdx.x * 256 + threadIdx.x;
    const size_t r = i / 1024; const int c = (int)(i % 1024);
    if (MK_NPRE >= 3) { const unsigned char* gq = (const unsigned char*)gates; const size_t gi = pg8::gate_index((int)r, c); const float sc = ((float)gq[gi] + 0.5f) * (1.f / 256.f), sa = ((float)gq[gi + 8] + 0.5f) * (1.f / 256.f); merged[i] = (bf16)f2bf(sc * t1[i] + sa * t2[i]); }
    else merged[i] = (bf16)f2bf(bf2f(gates[r * 2048 + c]) * t1[i] + bf2f(gates[r * 2048 + 1024 + c]) * t2[i]);
}

__global__ __launch_bounds__(256) void k_postmix(const float* __restrict__ x, const float* __restrict__ y1, const float* __restrict__ ada, const float* __restrict__ g_post, const float* __restrict__ g_pre2,
                                                 const float* __restrict__ w_group, const float* __restrict__ b_group, const float* __restrict__ w_router, const float* __restrict__ b_router,
                                                 float* __restrict__ x1out, bf16* __restrict__ h2, unsigned* __restrict__ ctl, int* __restrict__ list, unsigned* __restrict__ tokinfo) {
    const int lane = threadIdx.x & 63, row = blockIdx.x * 4 + (threadIdx.x >> 6), b = row / SEQ;
    const float* ad = ada + b * 6144;
    f32x4 yv[4], xv[4]; float s = 0.f;
#pragma unroll
    for (int j = 0; j < 4; ++j) { yv[j] = ((const f32x4*)(y1 + (size_t)row * D) + lane)[64 * j]; xv[j] = ((const f32x4*)(x + (size_t)row * D) + lane)[64 * j];
        s += (yv[j].x * yv[j].x + yv[j].y * yv[j].y) + (yv[j].z * yv[j].z + yv[j].w * yv[j].w); }
    const float rstd1 = rsqrtf(wave_sum(s) * (1.f / D) + EPS);
    float s2 = 0.f;
#pragma unroll
    for (int j = 0; j < 4; ++j) { const int c0 = 256 * j + 4 * lane;
        const f32x4 gp = *(const f32x4*)(g_post + c0), gt = *(const f32x4*)(ad + 2048 + c0);
        xv[j] = xv[j] + gt * (yv[j] * rstd1 * gp);
        ((f32x4*)(x1out + (size_t)row * D) + lane)[64 * j] = xv[j];
        s2 += (xv[j].x * xv[j].x + xv[j].y * xv[j].y) + (xv[j].z * xv[j].z + xv[j].w * xv[j].w); }
    const float rstd2 = rsqrtf(wave_sum(s2) * (1.f / D) + EPS);
    float lg[36];
#pragma unroll
    for (int o = 0; o < 36; ++o) lg[o] = 0.f;
    unsigned long long* o8 = (unsigned long long*)(h2 + (size_t)row * D) + lane;
#pragma unroll
    for (int j = 0; j < 4; ++j) { const int c0 = 256 * j + 4 * lane;
        const f32x4 gg = *(const f32x4*)(g_pre2 + c0), sc = *(const f32x4*)(ad + 4096 + c0), sh = *(const f32x4*)(ad + 3072 + c0);
        const f32x4 hv = xv[j] * rstd2 * gg * (1.f + sc) + sh;
        o8[64 * j] = (unsigned long long)pk2(hv.x, hv.y) | ((unsigned long long)pk2(hv.z, hv.w) << 32);
#pragma unroll
        for (int i = 0; i < 4; ++i) { const int c = c0 + i; const float hvv = hv[i];
            const f32x4 wg = *(const f32x4*)(w_group + c * 4);
            lg[0] += hvv * wg.x; lg[1] += hvv * wg.y; lg[2] += hvv * wg.z; lg[3] += hvv * wg.w;
#pragma unroll
            for (int q = 0; q < 8; ++q) { const f32x4 wr = *(const f32x4*)(w_router + c * 32 + q * 4);
                lg[4 + q * 4 + 0] += hvv * wr.x; lg[4 + q * 4 + 1] += hvv * wr.y; lg[4 + q * 4 + 2] += hvv * wr.z; lg[4 + q * 4 + 3] += hvv * wr.w; } } }
#pragma unroll
    for (int o = 0; o < 36; ++o) lg[o] = wave_sum(lg[o]);
    float gl[4];
#pragma unroll
    for (int g = 0; g < 4; ++g) gl[g] = lg[g] + b_group[g];
    int gi = 0; float gm = gl[0];
#pragma unroll
    for (int g = 1; g < 4; ++g) if (gl[g] > gm) { gm = gl[g]; gi = g; }
    float den = 0.f;
#pragma unroll
    for (int g = 0; g < 4; ++g) den += __expf(gl[g] - gm);
    const float grp_p = 1.f / den;
    float in[8];
#pragma unroll
    for (int i = 0; i < 8; ++i) { float v = 0.f;
#pragma unroll
        for (int g = 0; g < 4; ++g) { const float cand = lg[4 + g * 8 + i] + b_router[g * 8 + i]; v = (g == gi) ? cand : v; }
        in[i] = v; }
    int a = 0; float am = in[0];
#pragma unroll
    for (int i = 1; i < 8; ++i) if (in[i] > am) { am = in[i]; a = i; }
    int bidx = -1; float bm = -3.0e38f;
#pragma unroll
    for (int i = 0; i < 8; ++i) if (i != a && in[i] > bm) { bm = in[i]; bidx = i; }
    const float pb = __expf(bm - am), wa = 1.f / (1.f + pb), wb = pb / (1.f + pb);
    if (lane == 0) {
        const int e0 = gi * 8 + a, e1 = gi * 8 + bidx;
        const unsigned p0 = atomicAdd(ctl + CW_CNT + e0, 1u), p1 = atomicAdd(ctl + CW_CNT + e1, 1u);
        list[(size_t)e0 * ECAP + p0] = row; list[(size_t)e1 * ECAP + p1] = row;
        unsigned* ti = tokinfo + (size_t)row * 8;
        ti[0] = (unsigned)e0; ti[1] = p0; ti[2] = (unsigned)e1; ti[3] = p1; ti[4] = __float_as_uint(grp_p * wa); ti[5] = __float_as_uint(grp_p * wb);
    }
}
__global__ void k_offsets(unsigned* ctl) {
    if (threadIdx.x == 0) { unsigned o = 0; for (int e = 0; e < NE; ++e) { ctl[CW_OFF + e] = o; o += (ctl[CW_CNT + e] + 255u) / 256u * 256u; } ctl[CW_OFF + NE] = o; }
}

__global__ __launch_bounds__(256) void k_final(const bf16* __restrict__ y2, const unsigned* __restrict__ tokinfo, const unsigned* __restrict__ ctl, const float* __restrict__ ada, const float* __restrict__ g_post2, float* __restrict__ out) {
    const int lane = threadIdx.x & 63, row = blockIdx.x * 4 + (threadIdx.x >> 6), b = row / SEQ;
    const unsigned* ti = tokinfo + (size_t)row * 8;
    const unsigned s0 = ctl[CW_OFF + ti[0]] + ti[1], s1 = ctl[CW_OFF + ti[2]] + ti[3];
    const float w0 = __uint_as_float(ti[4]), w1 = __uint_as_float(ti[5]);
    f32x4 yv[4]; float s = 0.f;
#pragma unroll
    for (int j = 0; j < 4; ++j) {
        const u32x2 a = ((const u32x2*)(y2 + (size_t)s0 * D) + lane)[64 * j], c = ((const u32x2*)(y2 + (size_t)s1 * D) + lane)[64 * j];
        yv[j].x = w0 * bf2f(a.x & 0xffffu) + w1 * bf2f(c.x & 0xffffu); yv[j].y = w0 * bf2f(a.x >> 16) + w1 * bf2f(c.x >> 16);
        yv[j].z = w0 * bf2f(a.y & 0xffffu) + w1 * bf2f(c.y & 0xffffu); yv[j].w = w0 * bf2f(a.y >> 16) + w1 * bf2f(c.y >> 16);
        s += (yv[j].x * yv[j].x + yv[j].y * yv[j].y) + (yv[j].z * yv[j].z + yv[j].w * yv[j].w); }
    const float rstd = rsqrtf(wave_sum(s) * (1.f / D) + EPS);
#pragma unroll
    for (int j = 0; j < 4; ++j) { const int c0 = 256 * j + 4 * lane;
        const f32x4 gp = *(const f32x4*)(g_post2 + c0), gt = *(const f32x4*)(ada + b * 6144 + 5120 + c0);
        f32x4* op = (f32x4*)(out + (size_t)row * D) + lane;
        op[64 * j] = op[64 * j] + gt * (yv[j] * rstd * gp); }
}

#endif
extern "C" void kernel_launch(void* const* d_in, const int* in_sizes, int n_in, void* d_out, int out_size, void* d_ws, size_t ws_size, hipStream_t stream) {
    static int grid = 0;
    if (grid == 0) {
        if (n_in != 25 || in_sizes[0] != NTOK * D || out_size != NTOK * D || ws_size < WS_END) { fprintf(stderr, "kernel_launch: unexpected problem (n_in %d, ws %zu); nothing launched\n", n_in, ws_size); grid = -1; return; }
        int dev = 0, cus = 0, per_cu = 0;
        if (hipGetDevice(&dev) != hipSuccess || hipDeviceGetAttribute(&cus, hipDeviceAttributeMultiprocessorCount, dev) != hipSuccess) { grid = -1; return; }
        if (hipFuncSetAttribute((const void*)mega_fwd, hipFuncAttributeMaxDynamicSharedMemorySize, LDS_BYTES) != hipSuccess) { fprintf(stderr, "kernel_launch: hipFuncSetAttribute failed\n"); grid = -1; return; }
        if (hipOccupancyMaxActiveBlocksPerMultiprocessor(&per_cu, (const void*)mega_fwd, NTHR, LDS_BYTES) != hipSuccess || per_cu < 1) { fprintf(stderr, "kernel_launch: occupancy query says %d\n", per_cu); grid = -1; return; }
        (void)hipGetLastError();
        if (cus < 256) { fprintf(stderr, "kernel_launch: built for a 256-CU device (one workgroup per CU, 256 workgroups); this one has %d\n", cus); grid = -1; return; }
        grid = 256;
    }
    if (grid < 0) return;
    unsigned char* ws = (unsigned char*)d_ws;
    if (hipMemsetAsync(ws + WS_CTL, 0, CTL_ZERO_BYTES, stream) != hipSuccess) return;
    Args a{};
    for (int i = 0; i < 25; ++i) a.in[i] = (const float*)d_in[i];
    a.out = (float*)d_out; a.ws = ws; a.flags = MK_FLAGS;
#if MK_NPRE == 10 && MK_ONE
    a.ph_lo = 0; a.ph_hi = 10; a.use_bar = 1;
    hipLaunchKernelGGL(mega_fwd, dim3(grid), dim3(NTHR), LDS_BYTES, stream, a);
#else
    for (int p = 0; p < MK_NPRE; ++p) { a.ph_lo = p; a.ph_hi = p + 1; a.use_bar = 0;
#ifdef MK_REP
        if (p == MK_REP) {
            if (p == 9) a.flags |= 4;
#ifdef MK_REPFLAGS
            a.flags |= MK_REPFLAGS;
#endif
            hipLaunchKernelGGL(mega_fwd, dim3(grid), dim3(NTHR), LDS_BYTES, stream, a);
            a.flags = MK_FLAGS;
            if (p == 6) (void)hipMemsetAsync(ws + WS_CTL, 0, 256, stream);
        }
#endif
        hipLaunchKernelGGL(mega_fwd, dim3(grid), dim3(NTHR), LDS_BYTES, stream, a); }
#endif
#if MK_NPRE < 10
    const float* x = (const float*)d_in[0]; const float* w_in = (const float*)d_in[6];
    const float* w_dw = (const float*)d_in[7]; const float* b_dw = (const float*)d_in[8]; const float* cln_g = (const float*)d_in[9]; const float* cln_b = (const float*)d_in[10];
    const float* w_conv_out = (const float*)d_in[11]; const float* q_g = (const float*)d_in[12]; const float* k_g = (const float*)d_in[13]; const float* w_attn_out = (const float*)d_in[14];
    const float* w_out = (const float*)d_in[15]; const float* g_pre_ffn = (const float*)d_in[16]; const float* g_post_ffn = (const float*)d_in[17];
    const float* w_group = (const float*)d_in[18]; const float* b_group = (const float*)d_in[19]; const float* w_router = (const float*)d_in[20]; const float* b_router = (const float*)d_in[21];
    const float* w_e_gate = (const float*)d_in[22]; const float* w_e_up = (const float*)d_in[23]; const float* w_e_down = (const float*)d_in[24];
    float* out = (float*)d_out; unsigned* ctl = (unsigned*)(ws + WS_CTL); float* ada = (float*)(ws + WS_ADA);
    bf16* h1 = (bf16*)(ws + WS_H1); bf16* merged = (bf16*)(ws + WS_H1); bf16* glu = (bf16*)(ws + WS_GLU); bf16* qkv = (bf16*)(ws + WS_QKV);
    bf16* gates = (bf16*)(ws + WS_GATES); bf16* act = (bf16*)(ws + WS_GATES); bf16* ca = (bf16*)(ws + WS_CA); bf16* h2 = (bf16*)(ws + WS_CA);
    float* tmp = (float*)(ws + WS_TMP); int* list = (int*)(ws + WS_LIST); unsigned* tokinfo = (unsigned*)(ws + WS_TOK); bf16* y2 = (bf16*)(ws + WS_Y2);
    if (MK_NPRE <= 0) k_ada<<<dim3(6144 / 256, NB), 256, 0, stream>>>((const float*)d_in[1], (const float*)d_in[2], (const float*)d_in[3], ada);
    if (MK_NPRE <= 1) k_modnorm<<<NTOK / 4, 256, 0, stream>>>(x, (const float*)d_in[4], ada, 0, 1024, h1);
    if (MK_NPRE <= 2) {
        k_gemm<0><<<dim3(NTOK / 64, 1024 / 64), 256, 0, stream>>>(h1, D, nullptr, nullptr, nullptr, w_in + 0, nullptr, INW, tmp, 1024, NTOK, D);
        k_glu<<<NTOK * 512 / 256, 256, 0, stream>>>(tmp, glu);
        k_gemm<0><<<dim3(NTOK / 64, 768 / 64), 256, 0, stream>>>(h1, D, nullptr, nullptr, nullptr, w_in + 1024, nullptr, INW, tmp, 1024, NTOK, D);
        k_qkrope<<<NTOK * 12 / 256, 256, 0, stream>>>(tmp, q_g, k_g, qkv);
        k_gemm<0><<<dim3(NTOK / 64, 1024 / 64), 256, 0, stream>>>(h1, D, nullptr, nullptr, nullptr, w_in + 1792, nullptr, INW, tmp, 1024, NTOK, D);
        k_gate<<<NTOK * 1024 / 256, 256, 0, stream>>>(tmp, gates, 0);
        k_gemm<0><<<dim3(NTOK / 64, 1024 / 64), 256, 0, stream>>>(h1, D, nullptr, nullptr, nullptr, w_in + 2816, nullptr, INW, tmp, 1024, NTOK, D);
        k_gate<<<NTOK * 1024 / 256, 256, 0, stream>>>(tmp, gates, 1024);
    }
    if (MK_NPRE <= 3 || (MK_FLAGS & 1)) k_conv<<<NTOK, 512, 0, stream>>>(glu, w_dw, b_dw, cln_g, cln_b, ca);
    if (MK_NPRE <= 3 || (MK_FLAGS & 2)) k_attn<<<dim3(SEQ / 256, 8, NB), 256, 0, stream>>>(qkv, ca);
    if (MK_NPRE <= 4) {
        k_gemm<0><<<dim3(NTOK / 64, 1024 / 64), 256, 0, stream>>>(ca, 1024, nullptr, nullptr, nullptr, w_conv_out, nullptr, D, tmp, 1024, NTOK, 512);
        k_gemm<0><<<dim3(NTOK / 64, 1024 / 64), 256, 0, stream>>>(ca + 512, 1024, nullptr, nullptr, nullptr, w_attn_out, nullptr, D, out, 1024, NTOK, 512);
        k_merge<<<NTOK * 1024 / 256, 256, 0, stream>>>(tmp, out, gates, merged);
    }
    if (MK_NPRE <= 6) {
        k_gemm<0><<<dim3(NTOK / 64, 1024 / 64), 256, 0, stream>>>(merged, D, nullptr, nullptr, nullptr, w_out, nullptr, D, tmp, 1024, NTOK, D);
        k_postmix<<<NTOK / 4, 256, 0, stream>>>(x, tmp, ada, (const float*)d_in[5], g_pre_ffn, w_group, b_group, w_router, b_router, out, h2, ctl, list, tokinfo);
    }
    k_offsets<<<1, 64, 0, stream>>>(ctl);
    if (MK_NPRE <= 8) {
        for (int e = 0; e < NE; ++e)
            k_gemm<1><<<dim3(NTOK / 64, DE / 64), 256, 0, stream>>>(h2, D, list + (size_t)e * ECAP, (const int*)ctl + CW_CNT + e, (const int*)ctl + CW_OFF + e,
                                                                  w_e_gate + (size_t)e * D * DE, w_e_up + (size_t)e * D * DE, DE, act, DE, 0, D);
        for (int e = 0; e < NE; ++e)
            k_gemm<2><<<dim3(NTOK / 64, D / 64), 256, 0, stream>>>(act, DE, nullptr, (const int*)ctl + CW_CNT + e, (const int*)ctl + CW_OFF + e,
                                                                 w_e_down + (size_t)e * DE * D, nullptr, D, y2, D, 0, DE);
    }
    k_final<<<NTOK / 4, 256, 0, stream>>>(y2, tokinfo, ctl, ada, g_post_ffn, out);
#endif
}
```

```cpp
#define MK_NPRE 10
#define MK_ONE 1
#define MK_FLAGS 0
#include <hip/hip_runtime.h>
#include <hip/hip_bf16.h>
#include <cstdint>
#include <cstdio>
#include <cmath>

#define GAS __attribute__((address_space(1)))
#define LAS __attribute__((address_space(3)))
typedef unsigned short bf16;
typedef float f32x4 __attribute__((ext_vector_type(4)));
typedef float f32x2 __attribute__((ext_vector_type(2)));
typedef unsigned u32x4 __attribute__((ext_vector_type(4)));
typedef unsigned u32x2 __attribute__((ext_vector_type(2)));
typedef short bf16x8 __attribute__((ext_vector_type(8)));
typedef float f32x16 __attribute__((ext_vector_type(16)));

constexpr int NB = 16, SEQ = 2048, D = 1024, NTOK = NB * SEQ;
constexpr int INW = 3840, CW = 512, NE = 32, DE = 512, KS = 31;
constexpr int ECAP = NTOK;
constexpr int MAXSLOT = 73728;
constexpr float EPS = 1e-6f;
constexpr float QSCALE = 0.125f * 1.4426950408889634f;

constexpr size_t MiB = 1u << 20;
constexpr size_t WS_CTL = 0, CTL_ZERO_BYTES = 64 * 1024;
constexpr size_t WS_ADA = 1 * MiB;
constexpr size_t WS_ROPE = WS_ADA + 512 * 1024;
constexpr size_t WS_WR = WS_ADA + 640 * 1024;
constexpr size_t WS_H1 = 2 * MiB;
constexpr size_t WS_GLU = 66 * MiB;
constexpr size_t WS_QKV = 98 * MiB;
constexpr size_t WS_Y1 = 66 * MiB;
constexpr size_t WS_GATES = 146 * MiB;
constexpr size_t WS_X1B = 218 * MiB;
constexpr size_t WS_CA = 282 * MiB;
constexpr size_t WS_WIN = 346 * MiB;
constexpr size_t WS_WCA = WS_WIN + (size_t)INW * D * 2;
constexpr size_t WS_WO = WS_WCA + 2 * MiB;
constexpr size_t WS_W1 = WS_WO + 2 * MiB;
constexpr size_t WS_W2 = WS_W1 + 32 * MiB;
constexpr size_t WS_H2F = WS_W2 + 16 * MiB;
constexpr size_t WS_WINF = WS_H2F + 32 * MiB;
constexpr size_t WS_WEND = WS_WINF + 6 * MiB;
constexpr size_t WS_H1F = 282 * MiB;
constexpr size_t WS_TMP = 346 * MiB;
constexpr size_t WS_LIST = 474 * MiB;
constexpr size_t WS_TOK = 478 * MiB;
constexpr size_t WS_PART = 480 * MiB;
constexpr size_t WS_Y2 = 2 * MiB;
constexpr size_t WS_END = 482 * MiB;
static_assert(WS_WEND <= WS_LIST && WS_Y2 + (size_t)MAXSLOT * D * 2 <= WS_GATES && WS_GATES + (size_t)MAXSLOT * DE * 2 <= WS_X1B && WS_X1B + (size_t)NTOK * D * 2 <= WS_CA && WS_GATES + (size_t)NTOK * 2048 * 2 <= WS_CA && WS_CA + (size_t)NTOK * D * 2 <= WS_WIN, "d_ws map");
constexpr int CW_CNT = 0, CW_OFF = 64, CW_ADA = 128, CW_BAR = 4096;

__device__ __forceinline__ float bf2f(unsigned v) { return __uint_as_float(v << 16); }
__device__ __forceinline__ unsigned f2bf(float f) { unsigned u = __float_as_uint(f); return (u + 0x7fffu + ((u >> 16) & 1u)) >> 16; }
__device__ __forceinline__ unsigned pk2(float lo, float hi) { return f2bf(lo) | (f2bf(hi) << 16); }
__device__ __forceinline__ unsigned cvt_pk_bf16(float lo, float hi) { unsigned r; asm volatile("v_cvt_pk_bf16_f32 %0, %1, %2" : "=v"(r) : "v"(lo), "v"(hi)); return r; }
template <int CTRL> __device__ __forceinline__ float dpp_mov(float v) { return __builtin_bit_cast(float, __builtin_amdgcn_update_dpp(0, __builtin_bit_cast(int, v), CTRL, 0xf, 0xf, true)); }
__device__ __forceinline__ float row16_sum(float v) {
    v += dpp_mov<0xB1>(v);
    v += dpp_mov<0x4E>(v);
    v += dpp_mov<0x141>(v);
    v += dpp_mov<0x140>(v);
    return v;
}
__device__ __forceinline__ float wave_sum(float v) {
    v = row16_sum(v);
    { auto rr = __builtin_amdgcn_permlane16_swap(__float_as_uint(v), __float_as_uint(v), false, false); v = __uint_as_float(rr[0]) + __uint_as_float(rr[1]); }
    { auto rr = __builtin_amdgcn_permlane32_swap(__float_as_uint(v), __float_as_uint(v), false, false); v = __uint_as_float(rr[0]) + __uint_as_float(rr[1]); }
    return v;
}
__device__ __forceinline__ float sigmoidf_(float v) { return 1.f / (1.f + __expf(-v)); }
__device__ __forceinline__ float siluf_(float v) { return v / (1.f + __expf(-v)); }
__device__ __forceinline__ float sig_fast(float v) { return __builtin_amdgcn_rcpf(1.f + __builtin_amdgcn_exp2f(v * -1.4426950408889634f)); }
#define LDS_WAIT() asm volatile("s_waitcnt lgkmcnt(0)" ::: "memory")
#define VM_WAIT() asm volatile("s_waitcnt vmcnt(0)" ::: "memory")

__host__ __device__ __forceinline__ int vmap_win(int n) {
    if (n < 512) return 256 * (n >> 7) + (n & 127);
    if (n < 1024) { const int j = n - 512; return 256 * (j >> 7) + 128 + (j & 127); }
    if (n < 1664) { const int idx = n - 1024, hh = idx >> 6, d = idx & 63, tile = 4 + (hh >> 2), wc = hh & 3, bj = (d >> 4) & 1, e = (d < 32) ? (d & 15) : 16 + (d & 15);
        return 256 * tile + 128 * bj + 32 * wc + e; }
    if (n < 1792) { const int idx = n - 1664, vh = idx >> 6, d = idx & 63; return 256 * 6 + 128 * (d >> 5) + 32 * (2 + vh) + (d & 31); }
    if (n < 2816) { const int j = n - 1792; return 256 * (7 + (j >> 7)) + (j & 127); }
    { const int j = n - 2816; return 256 * (7 + (j >> 7)) + 128 + (j & 127); }
}

namespace pg8 {
constexpr int BM = 256, BK = 64, HALF = 128, HTB = HALF * BK * 2  , STAGE_BYTES = 8 * HTB, NXCD = 8, WGM = 8;
__host__ __device__ __forceinline__ int lds_byte(int r, int c) { const int st = (r >> 4) * 2 + (c >> 5), rr = r & 15, cc = c & 31, ob = rr * 64 + cc * 2; return st * 1024 + (ob ^ (((ob >> 9) & 1) << 5)); }
__host__ __device__ __forceinline__ void stage_rc(int b, int& R, int& C) { const int st = b / 1024, sb = b % 1024, swz = sb ^ (((sb >> 9) & 1) << 5); R = (st >> 1) * 16 + swz / 64; C = (st & 1) * 32 + (swz % 64) / 2; }
__host__ __device__ __forceinline__ int perm32(int rho) { const int n = rho >> 4, i = rho & 15; return 8 * (i >> 2) + 4 * n + (i & 3); }

struct Unit { int pm, pn, e, ord; };

struct StaticOrder {
    const void* Bt; int KB; int nM, nN, nwg, G, c;
    __device__ void init(const void* Bt_, int KB_, int M, int N, int G_, int c_) { Bt = Bt_; KB = KB_; nM = M / BM; nN = N / BM; nwg = nM * nN; G = G_; c = c_; }
    __device__ __forceinline__ bool next(int i, Unit& u) const {
        const long L = (long)i * G + c; if (L >= nwg) return false;
        int wgid = (int)L; { const int q = nwg / NXCD, r = nwg % NXCD, xcd = wgid % NXCD, off = wgid / NXCD; wgid = (xcd < r ? xcd * (q + 1) : r * (q + 1) + (xcd - r) * q) + off; }
        const int nig = WGM * nN, gid = wgid / nig, fm = gid * WGM, gsz = (nM - fm) < WGM ? (nM - fm) : WGM;
        u.pm = fm + ((wgid % nig) % gsz); u.pn = (wgid % nig) / gsz; u.e = 0; u.ord = i; return true;
    }
    static constexpr bool GATHER = false;
    __device__ __forceinline__ int arow(const Unit& u, int r) const { return u.pm * BM + r; }
    __device__ __forceinline__ const char* bbase(const Unit& u) const { return (const char*)Bt + (size_t)u.pn * BM * KB; }
};

typedef int v8i32 __attribute__((ext_vector_type(8)));
typedef int v4i32 __attribute__((ext_vector_type(4)));
__device__ __forceinline__ void mfma_fp8_inplace(f32x4& d, const v8i32 a, const v8i32 b, const int scale) {
    asm volatile("v_mfma_scale_f32_16x16x128_f8f6f4 %0, %1, %2, %0, %3, %3 op_sel_hi:[0,0,0]" : "+v"(d) : "v"(a), "v"(b), "v"(scale));
}
__device__ __forceinline__ void mfma_bf16_inplace(f32x4& d, const bf16x8 a, const bf16x8 b) {
    asm volatile("v_mfma_f32_16x16x32_bf16 %0, %1, %2, %0" : "+v"(d) : "v"(a), "v"(b));
}
template <class Epi, class Sched, bool ALIGN_EPI, int DT = 0>
__device__ __forceinline__ void gemm_phase(LAS unsigned char* lds, const void* A, int ldaB_, int KB, const Sched& S, const Epi& E, const void* A8 = nullptr, int kbytes = 0) {
    const int tid = threadIdx.x, wid = __builtin_amdgcn_readfirstlane(tid >> 6), lane = tid & 63, wr = wid >> 2, wc = wid & 3, fr = lane & 15, fq = lane >> 4;
    const int nt_full = (kbytes ? kbytes : KB) / (BK * 2);
    const unsigned ldaB = (unsigned)ldaB_;
    unsigned voffA[2], voffB[2];
#pragma unroll
    for (int i = 0; i < 2; ++i) { int R, C; stage_rc(tid * 16 + i * 8192, R, C); const int Rb = (R & ~31) + perm32(R & 31);
        voffA[i] = (unsigned)R * ldaB + (unsigned)C * 2u; voffB[i] = (unsigned)(Rb * KB + C * 2); }
    const size_t kstep = (size_t)(BK * 2);
    const size_t hstep = (size_t)HALF * KB;
    const size_t hstepA = (size_t)HALF * ldaB;
    const unsigned ldsw = (unsigned)wid * 1024u;
    const int aoff = lds_byte(wr * 64 + fr, fq * 8), boff = lds_byte(wc * 32 + fr, fq * 8);
#define PG8_SA(b, h) (((b) * 2 + (h)) * HTB)
#define PG8_SB(b, h) ((4 + (b) * 2 + (h)) * HTB)
#define PG8_STAGE(bufoff, gbase, voff) do { _Pragma("unroll") for (int _i = 0; _i < 2; ++_i) \
        __builtin_amdgcn_global_load_lds((const unsigned*)((const char*)(gbase) + (voff)[_i]), (LAS unsigned*)(lds + (bufoff) + ldsw + _i * 8192), 16, 0, 0); } while (0)
#define PG8_LDA(dst, b, h) do { _Pragma("unroll") for (int m = 0; m < 4; ++m) _Pragma("unroll") for (int k = 0; k < 2; ++k) dst[m][k] = *(const LAS bf16x8*)(lds + PG8_SA(b, h) + aoff + m * 2048 + k * 1024); } while (0)
#define PG8_LDB(dst, b, h) do { _Pragma("unroll") for (int n = 0; n < 2; ++n) _Pragma("unroll") for (int k = 0; k < 2; ++k) dst[n][k] = *(const LAS bf16x8*)(lds + PG8_SB(b, h) + boff + n * 2048 + k * 1024); } while (0)
#define PG8_CAT(x) __builtin_shufflevector(__builtin_bit_cast(v4i32, (x)[0]), __builtin_bit_cast(v4i32, (x)[1]), 0, 1, 2, 3, 4, 5, 6, 7)
#define PG8_MMA(ai, bj, At, Bt) do { __builtin_amdgcn_s_setprio(1); \
        if (DT == 1 || (DT == 2 && f8cur)) { _Pragma("unroll") for (int m = 0; m < 4; ++m) _Pragma("unroll") for (int n = 0; n < 2; ++n) \
            mfma_fp8_inplace(acc[ai][bj][m][n], PG8_CAT(Bt[n]), PG8_CAT(At[m]), one_scale); } \
        else { _Pragma("unroll") for (int m = 0; m < 4; ++m) _Pragma("unroll") for (int n = 0; n < 2; ++n) _Pragma("unroll") for (int k = 0; k < 2; ++k) \
            { if constexpr (DT == 2) mfma_bf16_inplace(acc[ai][bj][m][n], Bt[n][k], At[m][k]); else acc[ai][bj][m][n] = __builtin_amdgcn_mfma_f32_16x16x32_bf16(Bt[n][k], At[m][k], acc[ai][bj][m][n], 0, 0, 0); } } \
        __builtin_amdgcn_s_setprio(0); } while (0)
#define PG8_WAIT_V(n) asm volatile("s_waitcnt vmcnt(" #n ")" ::: "memory")
#define PG8_WAIT_L(n) asm volatile("s_waitcnt lgkmcnt(" #n ")" ::: "memory")
#define PG8_BAR __builtin_amdgcn_s_barrier()
#define PG8_SCHED __builtin_amdgcn_sched_barrier(0)
#define PG8_MKVA(dst, u) do { _Pragma("unroll") for (int _h = 0; _h < 2; ++_h) _Pragma("unroll") for (int _p = 0; _p < 2; ++_p) { int _R, _C; stage_rc(tid * 16 + _p * 8192, _R, _C); \
        dst[_h][_p] = (unsigned)S.arow(u, _h * HALF + _R) * ldaB + (unsigned)_C * 2u; } } while (0)
#define PG8_STAGE_AC(bufoff, h, kofs) do { if constexpr (Sched::GATHER) PG8_STAGE(bufoff, Ab + (kofs), vA[h]); else PG8_STAGE(bufoff, cA + (h) * hstepA + (kofs), voffA); } while (0)
#define PG8_STAGE_AN(bufoff, h, kofs) do { if constexpr (Sched::GATHER) PG8_STAGE(bufoff, Ab + (kofs), nvA[h]); else PG8_STAGE(bufoff, nA + (h) * hstepA + (kofs), voffA); } while (0)
#define PG8_STAGE_A23(bufoff, h, w) do { if (last) PG8_STAGE_AN(bufoff, h, (size_t)(w) * kstep); else PG8_STAGE_AC(bufoff, h, (size_t)(t + 2 + (w)) * kstep); } while (0)
    Unit cur, nxt; int ui = 0;
    if (!S.next(0, cur)) return;
    f32x4 acc[2][2][4][2];
#pragma unroll
    for (int a = 0; a < 2; ++a)
#pragma unroll
        for (int b = 0; b < 2; ++b)
#pragma unroll
            for (int m = 0; m < 4; ++m)
#pragma unroll
                for (int n = 0; n < 2; ++n) acc[a][b][m][n] = (f32x4){0.f, 0.f, 0.f, 0.f};
    bf16x8 At[4][2], B0[2][2], B1[2][2];
    int one_scale = 0x7f7f7f7f; asm volatile("" : "+v"(one_scale));
    unsigned vA[2][2], nvA[2][2];
    const char* const Ab = (const char*)A;
    const char* cA = Ab; const char* nA = Ab;
    bool f8cur = (DT == 2) && cur.e != 0; int nt = (DT == 2 && f8cur) ? (nt_full >> 1) : nt_full;
#define PG8_ABASE(u) ((DT == 2 && (u).e != 0) ? (const char*)A8 : Ab)
    if constexpr (Sched::GATHER) { PG8_MKVA(vA, cur); } else { cA = PG8_ABASE(cur) + (size_t)S.arow(cur, 0) * ldaB; }
    const char* cB = S.bbase(cur);
    PG8_STAGE(PG8_SB(0, 0), cB, voffB); PG8_STAGE(PG8_SB(0, 1), cB + hstep, voffB); PG8_STAGE_AC(PG8_SA(0, 0), 0, 0); PG8_STAGE_AC(PG8_SA(0, 1), 1, 0);
    if (wr == 1) PG8_BAR;
    PG8_WAIT_V(2); PG8_BAR;
    PG8_STAGE(PG8_SB(1, 0), cB + kstep, voffB); PG8_STAGE_AC(PG8_SA(1, 0), 0, kstep); PG8_STAGE(PG8_SB(1, 1), cB + hstep + kstep, voffB);
    PG8_WAIT_V(6); PG8_BAR;
    for (;;) {
        const bool has_next = S.next(ui + 1, nxt);
        const char* nB = has_next ? S.bbase(nxt) : cB;
        if constexpr (!Sched::GATHER) nA = has_next ? PG8_ABASE(nxt) + (size_t)S.arow(nxt, 0) * ldaB : cA;
#pragma unroll 1
        for (int t = 0; t < nt; t += 2) {
            const bool last = (t == nt - 2);
            if constexpr (Epi::MID) { if (t == (nt >> 1)) { if (wr == 0) PG8_BAR; if constexpr (DT != 0) asm volatile("s_nop 15\n\ts_nop 15" ::: "memory"); E.mid(acc, cur, wr, wc, fr, fq); if (wr == 1) PG8_BAR; } }
            if constexpr (Sched::GATHER) { if (last) { if (has_next) { PG8_MKVA(nvA, nxt); } else {
#pragma unroll
                    for (int h = 0; h < 2; ++h)
#pragma unroll
                        for (int p = 0; p < 2; ++p) nvA[h][p] = vA[h][p]; } } }
            const char* b2 = last ? nB : cB + (size_t)(t + 2) * kstep; const char* b3 = b2 + kstep;
            PG8_LDB(B0, 0, 0); PG8_LDB(B1, 0, 1); PG8_SCHED; PG8_LDA(At, 0, 0); PG8_STAGE_AC(PG8_SA(1, 1), 1, (size_t)(t + 1) * kstep);
            PG8_WAIT_V(8); PG8_WAIT_L(0); PG8_BAR; PG8_MMA(0, 0, At, B0); PG8_MMA(0, 1, At, B1); PG8_BAR; PG8_SCHED;
            PG8_LDA(At, 0, 1); PG8_STAGE(PG8_SB(0, 0), b2, voffB); PG8_STAGE(PG8_SB(0, 1), b2 + hstep, voffB); PG8_STAGE_A23(PG8_SA(0, 0), 0, 0);
            PG8_WAIT_V(8); PG8_WAIT_L(0); PG8_BAR; PG8_MMA(1, 0, At, B0); PG8_MMA(1, 1, At, B1); PG8_BAR; PG8_SCHED;
            PG8_LDB(B0, 1, 0); PG8_LDB(B1, 1, 1); PG8_SCHED; PG8_LDA(At, 1, 0); PG8_STAGE_A23(PG8_SA(0, 1), 1, 0);
            PG8_WAIT_V(8); PG8_WAIT_L(0); PG8_BAR; PG8_MMA(0, 0, At, B0); PG8_MMA(0, 1, At, B1); PG8_BAR; PG8_SCHED;
            PG8_LDA(At, 1, 1); PG8_STAGE(PG8_SB(1, 0), b3, voffB); PG8_STAGE(PG8_SB(1, 1), b3 + hstep, voffB); PG8_STAGE_A23(PG8_SA(1, 0), 0, 1);
            PG8_WAIT_V(8); PG8_WAIT_L(0); PG8_BAR; PG8_MMA(1, 0, At, B0); PG8_MMA(1, 1, At, B1); PG8_BAR; PG8_SCHED;
        }
        if constexpr (ALIGN_EPI) { if (wr == 0) PG8_BAR; }
        if constexpr (DT != 0) asm volatile("s_nop 15\n\ts_nop 15" ::: "memory");
        E(acc, cur, wr, wc, fr, fq);
        if (!has_next) break;
#pragma unroll
        for (int a = 0; a < 2; ++a)
#pragma unroll
            for (int b = 0; b < 2; ++b)
#pragma unroll
                for (int m = 0; m < 4; ++m)
#pragma unroll
                    for (int n = 0; n < 2; ++n) acc[a][b][m][n] = (f32x4){0.f, 0.f, 0.f, 0.f};
        cur = nxt; cB = nB; ++ui;
        if constexpr (DT == 2) { f8cur = cur.e != 0; nt = f8cur ? (nt_full >> 1) : nt_full; }
        if constexpr (Sched::GATHER) {
#pragma unroll
            for (int h = 0; h < 2; ++h)
#pragma unroll
                for (int p = 0; p < 2; ++p) vA[h][p] = nvA[h][p]; } else cA = nA;
        if constexpr (ALIGN_EPI) { if (wr == 1) PG8_BAR; }
    }
    PG8_WAIT_V(0);
    if constexpr (!ALIGN_EPI) { if (wr == 0) PG8_BAR; }
    PG8_BAR;
#undef PG8_ABASE
#undef PG8_STAGE_AC
#undef PG8_STAGE_AN
#undef PG8_STAGE_A23
#undef PG8_SA
#undef PG8_SB
#undef PG8_STAGE
#undef PG8_LDA
#undef PG8_LDB
#undef PG8_MMA
#undef PG8_WAIT_V
#undef PG8_WAIT_L
#undef PG8_BAR
#undef PG8_SCHED
#undef PG8_MKVA
#undef PG8_CAT
}
}
namespace pg8 {
__host__ __device__ __forceinline__ size_t gate_frag_base(int pm, int t, int w) { return ((size_t)((pm * 8 + t) * 8 + w) * 8) * 1024; }
__host__ __device__ __forceinline__ size_t gate_index(int row, int col) {
    const int pm = row >> 8, t = col >> 7, w = 4 * ((row >> 6) & 1) + ((col >> 5) & 3), k = 4 * ((row >> 7) & 1) + ((row >> 4) & 3), l = 16 * ((col >> 3) & 3) + (row & 15);
    return gate_frag_base(pm, t, w) + (size_t)k * 1024 + l * 16 + (col & 7);
}
__device__ __forceinline__ unsigned q8x4(float a, float b, float c, float d) {
    unsigned r = __builtin_amdgcn_cvt_pk_u8_f32(a * 256.f - 0.5f, 0, 0u); r = __builtin_amdgcn_cvt_pk_u8_f32(b * 256.f - 0.5f, 1, r);
    r = __builtin_amdgcn_cvt_pk_u8_f32(c * 256.f - 0.5f, 2, r); return __builtin_amdgcn_cvt_pk_u8_f32(d * 256.f - 0.5f, 3, r);
}
__device__ __forceinline__ void dq8x4(unsigned w, float (&f)[4]) { f[0] = (float)(w & 0xffu) + 0.5f; f[1] = (float)((w >> 8) & 0xffu) + 0.5f; f[2] = (float)((w >> 16) & 0xffu) + 0.5f; f[3] = (float)(w >> 24) + 0.5f; }
constexpr float WSCIN = 32.f, WSCO = 32.f, MSC = 8.f, WSCCA = 16.f, CSC = 8.f, ASC = 32.f;
__device__ __forceinline__ unsigned pk4_fp8(float a, float b, float c, float d) { int r = __builtin_amdgcn_cvt_pk_fp8_f32(a, b, 0, false); r = __builtin_amdgcn_cvt_pk_fp8_f32(c, d, r, true); return (unsigned)r; }
struct EpiP2 {
    static constexpr bool MID = false;
    bf16* glu; bf16* qkv; bf16* gates; const float* qg; const float* kg; const f32x2* rope;
    __device__ __forceinline__ void operator()(const f32x4 (&acc)[2][2][4][2], const Unit& u, int wr, int wc, int fr, int fq) const {
        const int row0 = u.pm * BM + wr * 64 + fr;
        if (u.pn < 4) {
#pragma unroll
            for (int ai = 0; ai < 2; ++ai)
#pragma unroll
                for (int m = 0; m < 4; ++m) { const size_t row = (size_t)(row0 + ai * HALF + m * 16);
                    constexpr float isg = 1.f / WSCIN;
                    const f32x4 a0 = acc[ai][0][m][0] * isg, a1 = acc[ai][0][m][1] * isg, g0 = acc[ai][1][m][0] * isg, g1 = acc[ai][1][m][1] * isg;
                    u32x4 w; w.x = cvt_pk_bf16(a0[0] * sig_fast(g0[0]), a0[1] * sig_fast(g0[1])); w.y = cvt_pk_bf16(a0[2] * sig_fast(g0[2]), a0[3] * sig_fast(g0[3]));
                    w.z = cvt_pk_bf16(a1[0] * sig_fast(g1[0]), a1[1] * sig_fast(g1[1])); w.w = cvt_pk_bf16(a1[2] * sig_fast(g1[2]), a1[3] * sig_fast(g1[3]));
                    *(u32x4*)(glu + row * CW + u.pn * 128 + wc * 32 + fq * 8) = w; }
        } else if (u.pn < 7) {
            const int hs = (u.pn - 4) * 4 + wc;
            if (hs >= 10) {
#pragma unroll
                for (int ai = 0; ai < 2; ++ai)
#pragma unroll
                    for (int m = 0; m < 4; ++m) { const size_t row = (size_t)(row0 + ai * HALF + m * 16);
#pragma unroll
                        for (int bj = 0; bj < 2; ++bj) { const f32x4 v0 = acc[ai][bj][m][0], v1 = acc[ai][bj][m][1];
                            u32x4 w; w.x = cvt_pk_bf16(v0[0], v0[1]); w.y = cvt_pk_bf16(v0[2], v0[3]); w.z = cvt_pk_bf16(v1[0], v1[1]); w.w = cvt_pk_bf16(v1[2], v1[3]);
                            *(u32x4*)(qkv + row * 768 + hs * 64 + bj * 32 + fq * 8) = w; } }
            } else {
                const float* g = hs < 8 ? qg : kg; const float osc = hs < 8 ? QSCALE : 1.f;
                const int dbase = fq < 2 ? 8 * fq : 8 * fq + 16;
                float g1[8], g2[8];
#pragma unroll
                for (int i = 0; i < 8; ++i) { g1[i] = g[dbase + i] * osc; g2[i] = g[dbase + 16 + i] * osc; }
#pragma unroll
                for (int ai = 0; ai < 2; ++ai)
#pragma unroll
                    for (int m = 0; m < 4; ++m) { const int rowi = row0 + ai * HALF + m * 16; const size_t row = (size_t)rowi;
                        const int s = rowi & (SEQ - 1); const int tabrow = fq < 2 ? (s >> 6) : 32 + (s & 63);
                        const f32x2* tp = rope + tabrow * 16 + 8 * (fq & 1);
                        float ss = 0.f;
#pragma unroll
                        for (int bj = 0; bj < 2; ++bj)
#pragma unroll
                            for (int n = 0; n < 2; ++n) { const f32x4 v = acc[ai][bj][m][n]; ss += (v[0] * v[0] + v[1] * v[1]) + (v[2] * v[2] + v[3] * v[3]); }
                        ss += __shfl_xor(ss, 16); ss += __shfl_xor(ss, 32);
                        const float rstd = rsqrtf(ss * (1.f / 64.f) + EPS);
                        float o1[8], o2[8];
#pragma unroll
                        for (int n = 0; n < 2; ++n)
#pragma unroll
                            for (int j = 0; j < 4; ++j) { const f32x2 cs = tp[4 * n + j];
                                const float x1 = acc[ai][0][m][n][j] * rstd * g1[4 * n + j], x2 = acc[ai][1][m][n][j] * rstd * g2[4 * n + j];
                                o1[4 * n + j] = x1 * cs.x - x2 * cs.y; o2[4 * n + j] = x2 * cs.x + x1 * cs.y; }
                        u32x4 w1, w2;
                        w1.x = cvt_pk_bf16(o1[0], o1[1]); w1.y = cvt_pk_bf16(o1[2], o1[3]); w1.z = cvt_pk_bf16(o1[4], o1[5]); w1.w = cvt_pk_bf16(o1[6], o1[7]);
                        w2.x = cvt_pk_bf16(o2[0], o2[1]); w2.y = cvt_pk_bf16(o2[2], o2[3]); w2.z = cvt_pk_bf16(o2[4], o2[5]); w2.w = cvt_pk_bf16(o2[6], o2[7]);
                        bf16* dst = qkv + row * 768 + hs * 64 + dbase;
                        *(u32x4*)dst = w1; *(u32x4*)(dst + 16) = w2; }
            }
        } else {
            unsigned char* gr = (unsigned char*)gates + gate_frag_base(u.pm, u.pn - 7, wr * 4 + wc) + (fq * 16 + fr) * 16;
#pragma unroll
            for (int ai = 0; ai < 2; ++ai)
#pragma unroll
                for (int m = 0; m < 4; ++m) {
                    float sc[8], sa[8];
#pragma unroll
                    for (int n = 0; n < 2; ++n)
#pragma unroll
                        for (int j = 0; j < 4; ++j) {
                            const float dc = 1.f + __builtin_amdgcn_exp2f(acc[ai][0][m][n][j] * (-1.4426950408889634f / WSCIN)), da = 1.f + __builtin_amdgcn_exp2f(acc[ai][1][m][n][j] * (-1.4426950408889634f / WSCIN));
                            const float rinv = __builtin_amdgcn_rcpf(dc * da); sc[4 * n + j] = rinv * da; sa[4 * n + j] = rinv * dc; }
                    *(u32x4*)(gr + (ai * 4 + m) * 1024) = (u32x4){q8x4(sc[0], sc[1], sc[2], sc[3]), q8x4(sc[4], sc[5], sc[6], sc[7]), q8x4(sa[0], sa[1], sa[2], sa[3]), q8x4(sa[4], sa[5], sa[6], sa[7])}; }
        }
    }
};
__device__ __forceinline__ void unpack8(const u32x4 w, float (&f)[8]) {
    f[0] = bf2f(w.x & 0xffffu); f[1] = bf2f(w.x >> 16); f[2] = bf2f(w.y & 0xffffu); f[3] = bf2f(w.y >> 16);
    f[4] = bf2f(w.z & 0xffffu); f[5] = bf2f(w.z >> 16); f[6] = bf2f(w.w & 0xffffu); f[7] = bf2f(w.w >> 16);
}
struct EpiP4 {
    static constexpr bool MID = true;
    const bf16* gates; bf16* merged;
    __device__ __forceinline__ void mid(f32x4 (&acc)[2][2][4][2], const Unit& u, int wr, int wc, int fr, int fq) const {
        asm volatile("" ::: "memory");
        u32x4 rr[2][8];
#pragma unroll
        for (int bj = 0; bj < 2; ++bj) { const unsigned char* gp = (const unsigned char*)gates + gate_frag_base(u.pm, 2 * u.pn + bj, wr * 4 + wc) + (fq * 16 + fr) * 16;
#pragma unroll
            for (int k = 0; k < 8; ++k) rr[bj][k] = *(const u32x4*)(gp + k * 1024); }
#pragma unroll
        for (int bj = 0; bj < 2; ++bj)
#pragma unroll
            for (int k = 0; k < 8; ++k)
#pragma unroll
                for (int n = 0; n < 2; ++n) { float c[4], a[4]; dq8x4(n ? rr[bj][k].y : rr[bj][k].x, c); dq8x4(n ? rr[bj][k].w : rr[bj][k].z, a);
#pragma unroll
                    for (int j = 0; j < 4; ++j) acc[k >> 2][bj][k & 3][n][j] *= (c[j] * (ASC / CSC)) * __builtin_amdgcn_rcpf(a[j]); }
        asm volatile("" ::: "memory");
    }
    __device__ __forceinline__ void operator()(const f32x4 (&acc)[2][2][4][2], const Unit& u, int wr, int wc, int fr, int fq) const {
        const int row0 = u.pm * BM + wr * 64 + fr, col0 = u.pn * BM + wc * 32 + fq * 8;
        u32x2 rr[2][8];
#pragma unroll
        for (int bj = 0; bj < 2; ++bj) { const unsigned char* gp = (const unsigned char*)gates + gate_frag_base(u.pm, 2 * u.pn + bj, wr * 4 + wc) + (fq * 16 + fr) * 16 + 8;
#pragma unroll
            for (int k = 0; k < 8; ++k) rr[bj][k] = *(const u32x2*)(gp + k * 1024); }
        asm volatile("" ::: "memory");
#pragma unroll
        for (int bj = 0; bj < 2; ++bj)
#pragma unroll
            for (int k = 0; k < 8; ++k) { const size_t row = (size_t)(row0 + (k >> 2) * HALF + (k & 3) * 16);
                float a0[4], a1[4]; dq8x4(rr[bj][k].x, a0); dq8x4(rr[bj][k].y, a1); constexpr float s = MSC / (256.f * ASC * WSCCA);
                const f32x4 v0 = acc[k >> 2][bj][k & 3][0] * s, v1 = acc[k >> 2][bj][k & 3][1] * s;
                *(u32x2*)((unsigned char*)merged + row * D + col0 + bj * HALF) = (u32x2){pk4_fp8(v0[0] * a0[0], v0[1] * a0[1], v0[2] * a0[2], v0[3] * a0[3]), pk4_fp8(v1[0] * a1[0], v1[1] * a1[1], v1[2] * a1[2], v1[3] * a1[3])}; }
    }
};
struct EpiP5 {
    static constexpr bool MID = false;
    bf16* y1; float* part;
    __device__ __forceinline__ void operator()(const f32x4 (&acc)[2][2][4][2], const Unit& u, int wr, int wc, int fr, int fq) const {
        const int row0 = u.pm * BM + wr * 64 + fr, col0 = u.pn * BM + wc * 32 + fq * 8;
#pragma unroll
        for (int ai = 0; ai < 2; ++ai)
#pragma unroll
            for (int m = 0; m < 4; ++m) { const size_t row = (size_t)(row0 + ai * HALF + m * 16); float ss = 0.f;
#pragma unroll
                for (int bj = 0; bj < 2; ++bj) { constexpr float is5 = 1.f / (WSCO * MSC); const f32x4 v0 = acc[ai][bj][m][0] * is5, v1 = acc[ai][bj][m][1] * is5;
                    ss += (v0[0] * v0[0] + v0[1] * v0[1]) + (v0[2] * v0[2] + v0[3] * v0[3]) + (v1[0] * v1[0] + v1[1] * v1[1]) + (v1[2] * v1[2] + v1[3] * v1[3]);
                    u32x4 w; w.x = cvt_pk_bf16(v0[0], v0[1]); w.y = cvt_pk_bf16(v0[2], v0[3]); w.z = cvt_pk_bf16(v1[0], v1[1]); w.w = cvt_pk_bf16(v1[2], v1[3]);
                    *(u32x4*)(y1 + row * D + col0 + bj * HALF) = w; }
                ss += __shfl_xor(ss, 16); ss += __shfl_xor(ss, 32);
                if (fq == 0) part[row * 16 + u.pn * 4 + wc] = ss; }
    }
};
constexpr float WSC1 = 32.f, WSC2 = 16.f;
struct EpiMoe1 {
    static constexpr bool MID = false;
    unsigned char* act;
    __device__ __forceinline__ void operator()(const f32x4 (&acc)[2][2][4][2], const Unit& u, int wr, int wc, int fr, int fq) const {
        const int row0 = u.pm * BM + wr * 64 + fr; constexpr float is = 1.f / WSC1;
#pragma unroll
        for (int ai = 0; ai < 2; ++ai)
#pragma unroll
            for (int m = 0; m < 4; ++m) { const size_t row = (size_t)(row0 + ai * HALF + m * 16);
                const f32x4 g0 = acc[ai][0][m][0] * is, g1 = acc[ai][0][m][1] * is, u0 = acc[ai][1][m][0] * is, u1 = acc[ai][1][m][1] * is;
                u32x2 w; w.x = pk4_fp8(g0[0] * sig_fast(g0[0]) * u0[0], g0[1] * sig_fast(g0[1]) * u0[1], g0[2] * sig_fast(g0[2]) * u0[2], g0[3] * sig_fast(g0[3]) * u0[3]);
                w.y = pk4_fp8(g1[0] * sig_fast(g1[0]) * u1[0], g1[1] * sig_fast(g1[1]) * u1[1], g1[2] * sig_fast(g1[2]) * u1[2], g1[3] * sig_fast(g1[3]) * u1[3]);
                *(u32x2*)(act + row * DE + u.pn * 128 + wc * 32 + fq * 8) = w; }
    }
};
constexpr float YSC = 8.f;
struct EpiMoe2 {
    static constexpr bool MID = false;
    unsigned char* y2;
    __device__ __forceinline__ void operator()(const f32x4 (&acc)[2][2][4][2], const Unit& u, int wr, int wc, int fr, int fq) const {
        const int row0 = u.pm * BM + wr * 64 + fr, col0 = u.pn * BM + wc * 32 + fq * 8; constexpr float is = YSC / WSC2;
#pragma unroll
        for (int ai = 0; ai < 2; ++ai)
#pragma unroll
            for (int m = 0; m < 4; ++m) { const size_t row = (size_t)(row0 + ai * HALF + m * 16);
#pragma unroll
                for (int bj = 0; bj < 2; ++bj) { const f32x4 v0 = acc[ai][bj][m][0] * is, v1 = acc[ai][bj][m][1] * is;
                    *(u32x2*)(y2 + row * D + col0 + bj * HALF) = (u32x2){pk4_fp8(v0[0], v0[1], v0[2], v0[3]), pk4_fp8(v1[0], v1[1], v1[2], v1[3])}; } }
    }
};
constexpr int MOE_MAXU = 8;
template <bool GATHER_> struct MoeOrder {
    static constexpr bool GATHER = GATHER_;
    const LAS int* UT; const LAS int* RT; const void* W; size_t estride; int KB;
    __device__ __forceinline__ bool next(int i, Unit& u) const {
        if (i >= MOE_MAXU) return false;
        const int v = __builtin_amdgcn_readfirstlane(UT[i * 4 + 3]); if (!v) return false;
        u.pm = __builtin_amdgcn_readfirstlane(UT[i * 4 + 0]); u.pn = __builtin_amdgcn_readfirstlane(UT[i * 4 + 1]); u.e = __builtin_amdgcn_readfirstlane(UT[i * 4 + 2]); u.ord = i; return true;
    }
    __device__ __forceinline__ int arow(const Unit& u, int r) const { return GATHER ? RT[u.ord * 256 + r] : u.pm * BM + r; }
    __device__ __forceinline__ const char* bbase(const Unit& u) const { return (const char*)W + (size_t)u.e * estride + (size_t)u.pn * BM * KB; }
};
__host__ __device__ __forceinline__ int winf_row(int vrow) { return vrow < 1024 ? vrow : vrow - 768; }
template <bool F8> struct P2Order {
    static constexpr bool GATHER = false;
    const char* W; int v, G;
    __device__ __forceinline__ bool next(int i, Unit& u) const {
        u.ord = i; u.e = F8 ? 1 : 0;
        if (!F8) { int L;
            if (G == 256) { if (i >= (v < 128 ? 2 : 1)) return false; L = 256 * i + v; } else { L = i * G + v; if (L >= 384) return false; }
            u.pm = L / 3; u.pn = 4 + (L - 3 * u.pm); return true; }
        int f;
        if (G == 256) { if (i >= (v < 128 ? 5 : 7)) return false; f = v >= 128 ? (v - 128) * 7 + i : 896 + 5 * v + i; } else { f = i * G + v; if (f >= 1536) return false; }
        u.pm = f / 12; const int t = f - 12 * u.pm; u.pn = t < 4 ? t : t + 3; return true;
    }
    __device__ __forceinline__ int arow(const Unit& u, int r) const { return u.pm * BM + r; }
    __device__ __forceinline__ const char* bbase(const Unit& u) const { return W + (size_t)(F8 ? winf_row(u.pn * BM) : u.pn * BM) * 2048; }
};
struct PanelOrder {
    static constexpr bool GATHER = false;
    const char* W; int v, G, KB;
    __device__ __forceinline__ bool next(int i, Unit& u) const { const int L = G * i + v; if (L >= (NTOK / BM) * 4) return false; u.pm = L >> 2; u.pn = L & 3; u.e = 0; u.ord = i; return true; }
    __device__ __forceinline__ int arow(const Unit& u, int r) const { return u.pm * BM + r; }
    __device__ __forceinline__ const char* bbase(const Unit& u) const { return W + (size_t)u.pn * BM * KB; }
};
}
namespace attn_body {
using bf16=__hip_bfloat16;
using bf16x8=__attribute__((ext_vector_type(8)))short;
using s16x4=__attribute__((ext_vector_type(4)))short;
using f32x16=__attribute__((ext_vector_type(16)))float;
using u32x4=__attribute__((ext_vector_type(4)))unsigned;
constexpr int BATCH=16,NHEAD=8,SEQ=2048,D=64,DM=768,OPITCH=1024;
constexpr int NW=8,QBLK=32,QB=QBLK*NW,KVBLK=64,NQB=SEQ/QB;
constexpr int ATTN_UNIT_ROWS=QB;
__device__ __forceinline__ int crow(int r,int hi){return (r&3)+8*(r>>2)+4*hi;}
#define SBAR() __builtin_amdgcn_sched_barrier(0)
__device__ __forceinline__ void cmask(f32x16&p0,f32x16&p1,int jb,int qrel,int hi){
  const float NEG=-INFINITY; int kb=64*jb+4*hi;
  #pragma unroll
  for(int r=0;r<16;++r){int kv=kb+(r&3)+8*(r>>2); if(kv>qrel)p0[r]=NEG; if(kv+32>qrel)p1[r]=NEG;}
}

constexpr int NSLOT=3, SLOTB=8192;
constexpr int LDS_K=0, LDS_V=NSLOT*SLOTB, LDS_WS=2*NSLOT*SLOTB, LDS_OST=LDS_WS+NW*64*4, LDS_BYTES=LDS_OST+NW*4096;
constexpr float C2=0.125f*1.4426950408889634f;
__device__ __forceinline__ void glds16(const void*gsrc,unsigned lds_dst){unsigned keep;
  asm volatile("s_mov_b32 %0, m0\n\ts_mov_b32 m0, %2\n\ts_nop 0\n\tglobal_load_lds_dwordx4 %1, off\n\ts_mov_b32 m0, %0":"=&s"(keep):"v"(gsrc),"s"(lds_dst):"memory");}
__device__ __forceinline__ float max3f(float a,float b,float c){float r;asm("v_max3_f32 %0, %1, %2, %3":"=v"(r):"v"(a),"v"(b),"v"(c));return r;}
__device__ __forceinline__ float max2f(float a,float b){float r;asm("v_max_f32_e32 %0, %1, %2":"=v"(r):"v"(a),"v"(b));return r;}
__device__ __forceinline__ float fadd_s(float a,float b){float r;asm("v_add_f32_e32 %0, %1, %2":"=v"(r):"v"(a),"v"(b));return r;}
__device__ __forceinline__ float fsub_s(float a,float b){float r;asm("v_sub_f32_e32 %0, %1, %2":"=v"(r):"v"(a),"v"(b));return r;}
typedef float f32x2_t __attribute__((ext_vector_type(2))); typedef __bf16 bf16x2_t __attribute__((ext_vector_type(2)));
__device__ __forceinline__ unsigned cvtpk_s(float lo,float hi){f32x2_t v={lo,hi};bf16x2_t b=__builtin_convertvector(v,bf16x2_t);return __builtin_bit_cast(unsigned,b);}
#define WAIT_BAR(N) asm volatile("s_waitcnt vmcnt(" #N ") lgkmcnt(0)\n\ts_barrier":::"memory")

__device__ __forceinline__ void qkt(f32x16&p0,f32x16&p1,const char*Kslot,const bf16x8*qr,const f32x16&negm,int r32,int hi){
  const char*kb=Kslot+hi*1024+r32*16;
  #pragma unroll
  for(int d0=0;d0<4;++d0){
    const bf16x8 b0=*reinterpret_cast<const bf16x8*>(kb+d0*2048);
    const bf16x8 b1=*reinterpret_cast<const bf16x8*>(kb+d0*2048+512);
    if(d0==0){p0=__builtin_amdgcn_mfma_f32_32x32x16_bf16(b0,qr[0],negm,0,0,0);p1=__builtin_amdgcn_mfma_f32_32x32x16_bf16(b1,qr[0],negm,0,0,0);}
    else{p0=__builtin_amdgcn_mfma_f32_32x32x16_bf16(b0,qr[d0],p0,0,0,0);p1=__builtin_amdgcn_mfma_f32_32x32x16_bf16(b1,qr[d0],p1,0,0,0);}}
}
typedef __attribute__((address_space(3))) const char* lds_cptr;
typedef short v4i16_t __attribute__((ext_vector_type(4)));
__device__ __forceinline__ void kload8(bf16x8*kf,lds_cptr kp){
  kf[0]=*(const __attribute__((address_space(3))) bf16x8*)(kp);      kf[1]=*(const __attribute__((address_space(3))) bf16x8*)(kp+512);
  kf[2]=*(const __attribute__((address_space(3))) bf16x8*)(kp+2048); kf[3]=*(const __attribute__((address_space(3))) bf16x8*)(kp+2560);
  kf[4]=*(const __attribute__((address_space(3))) bf16x8*)(kp+4096); kf[5]=*(const __attribute__((address_space(3))) bf16x8*)(kp+4608);
  kf[6]=*(const __attribute__((address_space(3))) bf16x8*)(kp+6144); kf[7]=*(const __attribute__((address_space(3))) bf16x8*)(kp+6656);
}
__device__ __forceinline__ void kload2(bf16x8*kf,lds_cptr kp,int j){ kf[2*j]=*(const __attribute__((address_space(3))) bf16x8*)(kp+j*2048); kf[2*j+1]=*(const __attribute__((address_space(3))) bf16x8*)(kp+j*2048+512); }
__device__ __forceinline__ s16x4 vtr(lds_cptr p){ return __builtin_bit_cast(s16x4,__builtin_amdgcn_ds_read_tr16_b64_v4i16((__attribute__((address_space(3))) v4i16_t*)p)); }
__device__ __forceinline__ float rowmax(const f32x16&p0,const f32x16&p1){
  float a=max3f(p0[0],p0[1],p1[0]),b=max3f(p0[2],p0[3],p1[1]);a=max3f(a,p1[2],p1[3]);
  #pragma unroll
  for(int r=4;r<16;r+=4){a=max3f(a,p0[r],p0[r+1]);b=max3f(b,p0[r+2],p0[r+3]);a=max3f(a,p1[r],p1[r+1]);b=max3f(b,p1[r+2],p1[r+3]);}
  const float m=max2f(a,b);
  auto rr=__builtin_amdgcn_permlane32_swap(__float_as_uint(m),__float_as_uint(m),false,false);
  return max2f(__uint_as_float(rr[0]),__uint_as_float(rr[1]));
}
__device__ __forceinline__ void pv(f32x16*o,int vb,bf16x8 pa0,bf16x8 pa1,bf16x8 pa2,bf16x8 pa3){
  #pragma unroll
  for(int d0=0;d0<2;++d0){s16x4 lo[4],hi[4];
    #pragma unroll
    for(int ks=0;ks<4;++ks){
      asm volatile("ds_read_b64_tr_b16 %0,%1 offset:%c2":"=&v"(lo[ks]):"v"(vb),"i"(d0*4096+ks*1024):"memory");
      asm volatile("ds_read_b64_tr_b16 %0,%1 offset:%c2":"=&v"(hi[ks]):"v"(vb),"i"(d0*4096+ks*1024+512):"memory");}
    asm volatile("s_waitcnt lgkmcnt(0)":::"memory");SBAR();
    #define PK(k) (bf16x8){lo[k][0],lo[k][1],lo[k][2],lo[k][3],hi[k][0],hi[k][1],hi[k][2],hi[k][3]}
    o[d0]=__builtin_amdgcn_mfma_f32_32x32x16_bf16(pa0,PK(0),o[d0],0,0,0);
    o[d0]=__builtin_amdgcn_mfma_f32_32x32x16_bf16(pa1,PK(1),o[d0],0,0,0);
    o[d0]=__builtin_amdgcn_mfma_f32_32x32x16_bf16(pa2,PK(2),o[d0],0,0,0);
    o[d0]=__builtin_amdgcn_mfma_f32_32x32x16_bf16(pa3,PK(3),o[d0],0,0,0);
    #undef PK
  }
}

#ifndef ATTN_STORE16
#define ATTN_STORE16(p,v) (*(u32x4*)(p)=(v))
#endif
template<int THRL> __device__ __forceinline__ void attn_unit(int b,int h,int kvh,int qb,const bf16*Q,const bf16*__restrict__ K,const bf16*__restrict__ V,bf16*O,char*shm){
  const int tid=threadIdx.x,lane=tid&63,r32=lane&31,hi=lane>>5; const int wid=__builtin_amdgcn_readfirstlane(tid>>6);
  const long rowbase=(long)b*SEQ; const int q0=qb*QB;
  const bf16*Qw=Q+(rowbase+q0+wid*QBLK)*DM+h*D;
  const bf16*Kh=K+rowbase*DM+kvh*D,*Vh=V+rowbase*DM+kvh*D;
  const unsigned lds0=(unsigned)(uintptr_t)shm;
  float*wsf=(float*)(shm+LDS_WS)+wid*64;
  const bf16*ksrc=Kh+(long)lane*DM+wid*8;
  const bf16*vsrc=Vh+(long)(16*(wid&3)+(lane>>2))*DM+(wid>>2)*32+(lane&3)*8;
  const unsigned kdst=lds0+LDS_K+wid*1024, vdst=lds0+LDS_V+wid*1024;
  #define DMA_K(t,slot) glds16(ksrc+(long)(t)*KVBLK*DM,(unsigned)__builtin_amdgcn_readfirstlane(kdst+(slot)))
  #define DMA_V(t,slot) glds16(vsrc+(long)(t)*KVBLK*DM,(unsigned)__builtin_amdgcn_readfirstlane(vdst+(slot)))
  const int vb0=(int)(lds0+LDS_V)+((lane>>4)&1)*32+(lane&3)*8+(4*hi+((lane&15)>>2))*64;
  const char*Kbase=shm+LDS_K; bf16x8 kf[8];
  const lds_cptr shm3=(lds_cptr)shm; const lds_cptr kp0=shm3+LDS_K+hi*1024+r32*16; const lds_cptr vp0=shm3+LDS_V+((lane>>4)&1)*32+(lane&3)*8+(4*hi+((lane&15)>>2))*64;
  const int NT=SEQ/KVBLK;
  DMA_K(0,0);DMA_V(0,0);DMA_K(1,SLOTB);
  bf16x8 qr[4];
  #pragma unroll
  for(int d0=0;d0<4;++d0)qr[d0]=*reinterpret_cast<const bf16x8*>(&Qw[(long)r32*DM+d0*16+hi*8]);
  float mhat=0.f,l_reg=0.f;f32x16 o[2];o[0]=f32x16{};o[1]=f32x16{};f32x16 negm=f32x16{};asm volatile("":"+v"(negm));

  #define CMASK(P0,P1,t) do{}while(0)
  bool resc=false;
  #define START(P0,P1) do{ const float rm=rowmax(P0,P1); resc=false; \
    { const float dl=rm; mhat=fadd_s(mhat,dl); \
      _Pragma("unroll") for(int r=0;r<16;++r){P0[r]=fsub_s(P0[r],dl);P1[r]=fsub_s(P1[r],dl);} \
      _Pragma("unroll") for(int r=0;r<16;++r)negm[r]=-mhat; asm volatile("":"+v"(negm)); } \
    _Pragma("unroll") for(int r=0;r<16;++r)P0[r]=__builtin_amdgcn_exp2f(P0[r]); }while(0)
  #define RESC() do{ if(resc){ asm volatile("s_waitcnt lgkmcnt(0)":::"memory"); \
      _Pragma("unroll") for(int d_=0;d_<2;++d_) _Pragma("unroll") for(int r=0;r<16;++r)o[d_][r]*=wsf[crow(r,hi)]; } }while(0)
  f32x16 pA0,pA1,pB0,pB1;
  int sl_prev=0,sl_cur=0,sl_next=SLOTB;
  #define ROT() do{sl_prev=sl_cur;sl_cur=sl_next;sl_next=(sl_next==(NSLOT-1)*SLOTB)?0:sl_next+SLOTB;}while(0)
  DMA_K(2,2*SLOTB);
  WAIT_BAR(3);
  qkt(pA0,pA1,Kbase,qr,negm,r32,hi);asm volatile("s_nop 15\n\ts_nop 7":"+v"(pA0),"+v"(pA1));CMASK(pA0,pA1,0);
  START(pA0,pA1);
  _Pragma("unroll") for(int r=0;r<16;++r)pA1[r]=__builtin_amdgcn_exp2f(pA1[r]);
  WAIT_BAR(0);
  DMA_K(3,0);DMA_V(1,SLOTB);
  ROT();
  kload8(kf,kp0+sl_cur);
  WAIT_BAR(2);
  s16x4 vlo[8],vhi[8]; u32x4 pw0,pw1,pw2,pw3;
  #define PKW(P,B) cvtpk_s(P[B],P[B+1])
  #define PAF(k) __builtin_bit_cast(bf16x8,pw##k)
  #define VFR(i) (bf16x8){vlo[i][0],vlo[i][1],vlo[i][2],vlo[i][3],vhi[i][0],vhi[i][1],vhi[i][2],vhi[i][3]}
  #define PIN(x) asm volatile("":"+v"(x))
  #define MX3(a,b,c) __builtin_fmaxf(__builtin_fmaxf((a),(b)),(c))
  #define GAPA(MF,A0,A1,A2,A3,W0,W1,PW) do{ MF; sacc+=A0; sacc+=A1; sacc+=A2; sacc+=A3; PIN(sacc); W0; W1; PIN(PW); SBAR(); }while(0)
  #define EX(v) __builtin_amdgcn_exp2f(v)
  #define GAPB(MF,X,B) do{ MF; X[B]=EX(X[B]); X[B+1]=EX(X[B+1]); X[B+2]=EX(X[B+2]); X[B+3]=EX(X[B+3]); PIN(X); SBAR(); }while(0)
  #define VRD(i) do{ vlo[i]=vtr(vp_+(((i)>>2)*4096+((i)&3)*1024)); vhi[i]=vtr(vp_+(((i)>>2)*4096+((i)&3)*1024+512)); }while(0)
  #define KRD(G,j) do{ if(G){ kload2(kf,kp0+sl_next,j); SBAR(); } }while(0)
  #define STEP(C0,C1,P0,P1,t,GK,GV,GL) do{ SBAR(); \
    const lds_cptr vp_=vp0+sl_prev; \
    VRD(0); SBAR(); float sacc=(P0[0]+P0[1]); \
    GAPA(C0=__builtin_amdgcn_mfma_f32_32x32x16_bf16(kf[0],qr[0],negm,0,0,0), P0[2],P0[3],P0[4],P0[5],     pw0[0]=PKW(P0,0), pw0[1]=PKW(P0,2), pw0); \
    VRD(4); SBAR(); GAPA(C1=__builtin_amdgcn_mfma_f32_32x32x16_bf16(kf[1],qr[0],negm,0,0,0), P0[6],P0[7],P0[8],P0[9],     pw0[2]=PKW(P0,4), pw0[3]=PKW(P0,6), pw0); \
    VRD(1); SBAR(); GAPA(C0=__builtin_amdgcn_mfma_f32_32x32x16_bf16(kf[2],qr[1],C0,0,0,0),   P0[10],P0[11],P0[12],P0[13], pw1[0]=PKW(P0,8), pw1[1]=PKW(P0,10), pw1); \
    VRD(5); SBAR(); GAPA(C1=__builtin_amdgcn_mfma_f32_32x32x16_bf16(kf[3],qr[1],C1,0,0,0),   P0[14],P0[15],P1[0],P1[1],   pw1[2]=PKW(P0,12),pw1[3]=PKW(P0,14), pw1); \
    VRD(2); SBAR(); GAPA(C0=__builtin_amdgcn_mfma_f32_32x32x16_bf16(kf[4],qr[2],C0,0,0,0),   P1[2],P1[3],P1[4],P1[5],     pw2[0]=PKW(P1,0), pw2[1]=PKW(P1,2), pw2); \
    VRD(6); SBAR(); GAPA(C1=__builtin_amdgcn_mfma_f32_32x32x16_bf16(kf[5],qr[2],C1,0,0,0),   P1[6],P1[7],P1[8],P1[9],     pw2[2]=PKW(P1,4), pw2[3]=PKW(P1,6), pw2); \
    VRD(3); SBAR(); GAPA(C0=__builtin_amdgcn_mfma_f32_32x32x16_bf16(kf[6],qr[3],C0,0,0,0),   P1[10],P1[11],P1[12],P1[13], pw3[0]=PKW(P1,8), pw3[1]=PKW(P1,10), pw3); \
    VRD(7); SBAR(); GAPA(C1=__builtin_amdgcn_mfma_f32_32x32x16_bf16(kf[7],qr[3],C1,0,0,0),   P1[14],P1[15],0.f,0.f,       pw3[2]=PKW(P1,12),pw3[3]=PKW(P1,14), pw3); \
    l_reg+=sacc; \
    if(GK){DMA_K((t)+3,sl_cur);} if(GV){DMA_V((t)+1,sl_next);} \
    CMASK(C0,C1,t); \
    { float a=MX3(C0[0],C0[1],C1[0]),b=MX3(C0[2],C0[3],C1[1]); a=MX3(a,C1[2],C1[3]); \
      _Pragma("unroll") for(int r=4;r<16;r+=4){a=MX3(a,C0[r],C0[r+1]);b=MX3(b,C0[r+2],C0[r+3]);a=MX3(a,C1[r],C1[r+1]);b=MX3(b,C1[r+2],C1[r+3]);} \
      float rm=__builtin_fmaxf(a,b); { auto rr=__builtin_amdgcn_permlane32_swap(__float_as_uint(rm),__float_as_uint(rm),false,false); rm=__builtin_fmaxf(__uint_as_float(rr[0]),__uint_as_float(rr[1])); } \
      resc=false; \
      if(__builtin_expect(__any(rm>(float)THRL),0)){ const float dl=__builtin_fmaxf(rm,0.f); mhat+=dl; \
        _Pragma("unroll") for(int r=0;r<16;++r){C0[r]-=dl;C1[r]-=dl;} \
        _Pragma("unroll") for(int r=0;r<16;++r)negm[r]=-mhat; asm volatile("":"+v"(negm)); \
        const float f=__builtin_amdgcn_exp2f(-dl); l_reg*=f; if(hi==0)wsf[r32]=f; resc=true; } } \
    SBAR(); \
    GAPB(o[0]=__builtin_amdgcn_mfma_f32_32x32x16_bf16(PAF(0),VFR(0),o[0],0,0,0), C0,0); \
    GAPB(o[1]=__builtin_amdgcn_mfma_f32_32x32x16_bf16(PAF(0),VFR(4),o[1],0,0,0), C0,4); \
    KRD(GL,0); GAPB(o[0]=__builtin_amdgcn_mfma_f32_32x32x16_bf16(PAF(1),VFR(1),o[0],0,0,0), C0,8); \
    KRD(GL,1); GAPB(o[1]=__builtin_amdgcn_mfma_f32_32x32x16_bf16(PAF(1),VFR(5),o[1],0,0,0), C0,12); \
    KRD(GL,2); GAPB(o[0]=__builtin_amdgcn_mfma_f32_32x32x16_bf16(PAF(2),VFR(2),o[0],0,0,0), C1,0); \
    KRD(GL,3); GAPB(o[1]=__builtin_amdgcn_mfma_f32_32x32x16_bf16(PAF(2),VFR(6),o[1],0,0,0), C1,4); \
    GAPB(o[0]=__builtin_amdgcn_mfma_f32_32x32x16_bf16(PAF(3),VFR(3),o[0],0,0,0), C1,8); \
    GAPB(o[1]=__builtin_amdgcn_mfma_f32_32x32x16_bf16(PAF(3),VFR(7),o[1],0,0,0), C1,12); \
    }while(0)
  int t=1;
  #undef CMASK
  #define CMASK(P0,P1,t) do{}while(0)
  for(;t+5<NT;t+=2){
    STEP(pB0,pB1,pA0,pA1,t,true,true,true);     WAIT_BAR(2); RESC(); ROT();
    STEP(pA0,pA1,pB0,pB1,t+1,true,true,true);   WAIT_BAR(2); RESC(); ROT();
  }
  #undef CMASK
  #define CMASK(P0,P1,t) do{}while(0)
  #define ENDW(tt) do{ if((tt)+3<NT){WAIT_BAR(2);} else if((tt)+2<NT){WAIT_BAR(1);} else {WAIT_BAR(0);} }while(0)
  for(;t+1<NT;t+=2){
    STEP(pB0,pB1,pA0,pA1,t,(t+3<NT),(t+1<NT),(t+1<NT));       ENDW(t);   RESC(); ROT();
    STEP(pA0,pA1,pB0,pB1,t+1,(t+4<NT),(t+2<NT),(t+2<NT));     ENDW(t+1); RESC(); ROT();
  }
  STEP(pB0,pB1,pA0,pA1,NT-1,false,false,false); RESC();
  { float sacc=pB0[0]+pB0[1]; _Pragma("unroll") for(int r=2;r<16;++r)sacc+=pB0[r]; _Pragma("unroll") for(int r=0;r<16;++r)sacc+=pB1[r]; l_reg+=sacc;
    pw0=(u32x4){PKW(pB0,0),PKW(pB0,2),PKW(pB0,4),PKW(pB0,6)};pw1=(u32x4){PKW(pB0,8),PKW(pB0,10),PKW(pB0,12),PKW(pB0,14)};pw2=(u32x4){PKW(pB1,0),PKW(pB1,2),PKW(pB1,4),PKW(pB1,6)};pw3=(u32x4){PKW(pB1,8),PKW(pB1,10),PKW(pB1,12),PKW(pB1,14)};
    SBAR(); pv(o,vb0+sl_cur,PAF(0),PAF(1),PAF(2),PAF(3)); }
  #undef PKW
  #undef PAF
  #undef VFR
  #undef PIN
  #undef MX3
  #undef GAPA
  #undef GAPB
  #undef EX
  #undef VRD
  #undef KRD
  #undef STEP
  #undef ENDW
  {auto rr=__builtin_amdgcn_permlane32_swap(__float_as_uint(l_reg),__float_as_uint(l_reg),false,false);l_reg=__uint_as_float(rr[0])+__uint_as_float(rr[1]);}
  if(hi==0)wsf[32+r32]=l_reg;asm volatile("s_waitcnt lgkmcnt(0)":::"memory");
  float rli[16];
  #pragma unroll
  for(int r=0;r<16;++r)rli[r]=__builtin_amdgcn_rcpf(wsf[32+crow(r,hi)])*pg8::ASC;
  unsigned char*Ow=(unsigned char*)O+(long)(rowbase+q0+wid*QBLK)*OPITCH+h*D;
  { bf16*stg=(bf16*)(shm+LDS_OST)+wid*2048;
    #pragma unroll
    for(int r=0;r<16;++r){const int orow=crow(r,hi);
      #pragma unroll
      for(int d0=0;d0<2;++d0)stg[orow*64+d0*32+r32]=__float2bfloat16(o[d0][r]*rli[r]);}
    asm volatile("s_waitcnt lgkmcnt(0)":::"memory");
    #pragma unroll
    for(int i=0;i<4;++i){const int row=i*8+(lane>>3),ch=lane&7; const u32x4 v=*(const u32x4*)(stg+row*64+ch*8);
      #define BLO(w) __uint_as_float((w)<<16)
      #define BHI(w) __uint_as_float((w)&0xffff0000u)
      *(u32x2*)(Ow+(long)row*OPITCH+ch*8)=(u32x2){pg8::pk4_fp8(BLO(v.x),BHI(v.x),BLO(v.y),BHI(v.y)),pg8::pk4_fp8(BLO(v.z),BHI(v.z),BLO(v.w),BHI(v.w))};
      #undef BLO
      #undef BHI
    } }
  asm volatile("s_waitcnt lgkmcnt(0)\n\ts_barrier":::"memory");
  #undef DMA_K
  #undef DMA_V
  #undef CMASK
  #undef START
  #undef RESC
  #undef ROT
}
constexpr int ATTN_LDS_BYTES=LDS_BYTES;
struct AttnTensors { const bf16* Q; const bf16* K; const bf16* V; bf16* O; };
struct AttnUnit { int bh; int qb; };
struct StaticOrder {
  int vcu, G;
  __device__ __forceinline__ explicit StaticOrder(int grid,int v):vcu(v),G(grid){}
  __device__ __forceinline__ bool next(int i,AttnUnit&u)const{ const int L=i*G+vcu; if(L>=BATCH*NHEAD*NQB)return false; const int blk=L%256, rnd=L/256; u.bh=blk>>1; u.qb=(blk&1)*4+rnd; return true; }
};
template<class Sched,int THRL=8> __device__ __forceinline__ void attn_phase(char*lds,const AttnTensors&T,const Sched&S){
  AttnUnit u;
  for(int i=0;S.next(i,u);++i){ attn_unit<THRL>(u.bh/NHEAD,u.bh%NHEAD,(u.bh%NHEAD)/4,u.qb,T.Q,T.K,T.V,T.O,lds); }
}
#undef SBAR
#undef WAIT_BAR
}
#define XB_TMO      128
#define XB_XCNT(j)  (256  + 64 * (j))
#define XB_XSUB(j)  (1280 + 64 * (j))
#define XB_XGEN(j)  (2304 + 64 * (j))
#define XB_TOP      3328
#define XB_TOPGEN   3392
#define XCD_BAR_WORDS 3456
#define XB_SPIN_CAP (1u << 18)

__device__ __forceinline__ unsigned xb_ld(unsigned* p)              { return __hip_atomic_load(p, __ATOMIC_RELAXED, __HIP_MEMORY_SCOPE_AGENT); }
__device__ __forceinline__ unsigned xb_add(unsigned* p, unsigned v) { return __hip_atomic_fetch_add(p, v, __ATOMIC_RELAXED, __HIP_MEMORY_SCOPE_AGENT); }
__device__ __forceinline__ unsigned xb_xcc_id() { return (unsigned)__builtin_amdgcn_s_getreg((3 << 11) | 20) & 0xFu; }
#define XB_SPIN(cond, bar) do { unsigned _sp = 0; while (cond) { __builtin_amdgcn_s_sleep(1); \
    if ((++_sp & 255u) == 0u) { if (xb_ld(&(bar)[XB_TMO])) break; if (_sp > XB_SPIN_CAP) { atomicAdd(&(bar)[XB_TMO], 1u); break; } } } } while (0)

struct XcdBarrier {
    unsigned* bar; unsigned x;
    volatile LAS unsigned* st;
};

__device__ __forceinline__ XcdBarrier xcd_barrier_post(unsigned* bar, volatile LAS unsigned* st) {
    XcdBarrier b; b.bar = bar; b.x = xb_xcc_id(); b.st = st;
    if (threadIdx.x == 0) (void)xb_add(&bar[XB_XCNT(b.x)], 1u);
    return b;
}
__device__ __forceinline__ void xcd_barrier_complete(unsigned* bar, unsigned x, unsigned& nloc, unsigned& nx) {
    const unsigned G = gridDim.x * gridDim.y * gridDim.z;
    unsigned sum, cnt, mine, sp = 0u;
    for (;;) {
        sum = 0u; cnt = 0u; mine = 0u;
#pragma unroll
        for (unsigned j = 0; j < 16; ++j) { const unsigned c = xb_ld(&bar[XB_XCNT(j)]); sum += c; cnt += (c > 0u) ? 1u : 0u; mine = (j == x) ? c : mine; }
        if (sum == G) break;
        __builtin_amdgcn_s_sleep(1);
        if ((++sp & 255u) == 0u) { if (xb_ld(&bar[XB_TMO])) break; if (sp > XB_SPIN_CAP) { atomicAdd(&bar[XB_TMO], 1u); break; } }
    }
    nloc = mine > 0u ? mine : 1u; nx = cnt > 0u ? cnt : 1u;
}

__device__ __forceinline__ void xcd_barrier(const XcdBarrier& b) {
    asm volatile("s_waitcnt vmcnt(0)" ::: "memory");
    __syncthreads();
    if (threadIdx.x == 0) {
        unsigned* bar = b.bar;
        __builtin_amdgcn_s_waitcnt(0);
        unsigned nloc = b.st[0], nx = b.st[1];
        if (nloc == 0u) { xcd_barrier_complete(bar, b.x, nloc, nx); b.st[0] = nloc; b.st[1] = nx; }
        const unsigned old = xb_add(&bar[XB_XSUB(b.x)], 1u);
        const unsigned gen = old / nloc;
        if (old + 1u == (gen + 1u) * nloc) {
            __builtin_amdgcn_fence(__ATOMIC_RELEASE, "agent");
            asm volatile("s_waitcnt vmcnt(0)" ::: "memory");
            const unsigned og = xb_add(&bar[XB_TOP], 1u);
            const unsigned tg = og / nx;
            if (og + 1u == (tg + 1u) * nx) xb_add(&bar[XB_TOPGEN], 1u);
            else XB_SPIN(xb_ld(&bar[XB_TOPGEN]) == tg, bar);
            __builtin_amdgcn_fence(__ATOMIC_ACQUIRE, "agent");
            xb_add(&bar[XB_XGEN(b.x)], 1u);
            asm volatile("s_waitcnt vmcnt(0)" ::: "memory");
        } else {
            XB_SPIN(xb_ld(&bar[XB_XGEN(b.x)]) == gen, bar);
            __builtin_amdgcn_fence(__ATOMIC_ACQUIRE, "agent");
            asm volatile("s_waitcnt vmcnt(0)" ::: "memory");
        }
    }
    __syncthreads();
}
constexpr int NWAVES = 8, NTHR = NWAVES * 64;
constexpr int N_PHASES = 10;
constexpr int RING_OFF = 0, RING_BYTES = 131072;
constexpr int LDSCTL_OFF = RING_BYTES, MISC_OFF = LDSCTL_OFF + 320;
constexpr int TS_OFF = LDSCTL_OFF + 512;
constexpr int UT_OFF = TS_OFF + 256;
constexpr int RT_OFF = UT_OFF + 256;
constexpr int LDS_BYTES = 147456;
static_assert(RT_OFF + pg8::MOE_MAXU * 1024 <= LDS_BYTES, "LDS map");

struct Frame {
    LAS unsigned char* lds; volatile LAS unsigned* MISC; unsigned* ctl; unsigned char* ws;
    int tid, lane, wave, vcu, G;
    float* out;
};

enum { I_X = 0, I_C, I_WADA, I_BADA, I_GPRE1, I_GPOST1, I_WIN, I_WDW, I_BDW, I_CLNG, I_CLNB, I_WCO, I_QG, I_KG, I_WAO, I_WOUT, I_GPRE2, I_GPOST2, I_WGRP, I_BGRP, I_WRT, I_BRT, I_WEG, I_WEU, I_WED };

struct Args { const float* in[25]; float* out; unsigned char* ws; int ph_lo, ph_hi, use_bar, flags; };
#define CAS __attribute__((address_space(4)))
__device__ __forceinline__ const float* fin(int i) { unsigned long long p = (unsigned long long)__builtin_amdgcn_kernarg_segment_ptr(); asm volatile("" : "+s"(p)); return ((const CAS Args*)p)->in[i]; }
template <int MAP> __device__ __forceinline__ int maprow(int n) {
    if (MAP == 1) return vmap_win(n);
    if (MAP == 2) return 256 * (n >> 7) + (n & 127);
    if (MAP == 3) return 256 * (n >> 7) + 128 + (n & 127);
    return n;
}
template <int MAP>
__device__ __forceinline__ void p0_transpose_item(const float* W, int N, bf16* WT, int pitch, int koff, LAS float* scr, int item, int lane) {
    const int nblk = N / 64, kb = item / nblk, nb = item % nblk, k0 = 64 * kb, n0 = 64 * nb, lr = lane >> 4, lc = lane & 15;
    const float* src = W + (size_t)(k0 + lr) * N + n0 + 4 * lc;
    f32x4 v[16];
#pragma unroll
    for (int i = 0; i < 16; ++i) v[i] = *(const f32x4*)(src + (size_t)(4 * i) * N);
#pragma unroll
    for (int i = 0; i < 16; ++i) { const int kk = lr + 4 * i; *(LAS f32x4*)(scr + kk * 64 + 4 * (lc ^ ((kk >> 3) & 7))) = v[i]; }
    LDS_WAIT(); asm volatile("" ::: "memory");
    const int c = lane & 7;
#pragma unroll
    for (int jj = 0; jj < 8; ++jj) { const int n = (lane >> 3) + 8 * jj; const LAS float* sp = scr + (8 * c) * 64 + (n ^ (4 * c));
        u32x4 o; o.x = cvt_pk_bf16(sp[0 * 64], sp[1 * 64]); o.y = cvt_pk_bf16(sp[2 * 64], sp[3 * 64]); o.z = cvt_pk_bf16(sp[4 * 64], sp[5 * 64]); o.w = cvt_pk_bf16(sp[6 * 64], sp[7 * 64]);
        *(u32x4*)(WT + (size_t)maprow<MAP>(n0 + n) * pitch + koff + k0 + 8 * c) = o; }
    LDS_WAIT(); asm volatile("" ::: "memory");
}
struct TrDesc { const float* src; unsigned char* dst; int N, pitch; float sc; };
__device__ __forceinline__ TrDesc tr_desc(int it, const float* pweg, const float* pweu, const float* pwed, unsigned char* W1, unsigned char* W2) {
    constexpr int I_G1 = (D / 64) * (DE / 64), I_D1 = (DE / 64) * (D / 64), PER = 2 * I_G1 + I_D1;
    const int e = it / PER; int r = it - e * PER; TrDesc d;
    if (r < 2 * I_G1) { const bool up = r >= I_G1; if (up) r -= I_G1; const int nblk = DE / 64, kb = r / nblk, nb = r % nblk;
        d.src = (up ? pweu : pweg) + (size_t)e * D * DE + (size_t)(64 * kb) * DE + 64 * nb; d.N = DE; d.pitch = D; d.sc = pg8::WSC1;
        d.dst = W1 + (size_t)e * D * D + (size_t)(256 * ((64 * nb) >> 7) + (up ? 128 : 0) + ((64 * nb) & 127)) * D + 64 * kb; }
    else { r -= 2 * I_G1; const int nblk = D / 64, kb = r / nblk, nb = r % nblk;
        d.src = pwed + (size_t)e * DE * D + (size_t)(64 * kb) * D + 64 * nb; d.N = D; d.pitch = DE; d.sc = pg8::WSC2;
        d.dst = W2 + (size_t)e * D * DE + (size_t)(64 * nb) * DE + 64 * kb; }
    return d;
}
__device__ __forceinline__ void tr_load(const TrDesc& d, int lane, f32x4 (&v)[16]) {
    const float* src = d.src + (size_t)(lane >> 4) * d.N + 4 * (lane & 15);
#pragma unroll
    for (int i = 0; i < 16; ++i) v[i] = *(const f32x4*)(src + (size_t)(4 * i) * d.N);
}
__device__ __forceinline__ void tr_finish(const TrDesc& d, int lane, const f32x4 (&v)[16], LAS float* scr) {
    const int lr = lane >> 4, lc = lane & 15;
#pragma unroll
    for (int i = 0; i < 16; ++i) { const int kk = lr + 4 * i; *(LAS f32x4*)(scr + kk * 64 + 4 * (lc ^ ((kk >> 3) & 7))) = v[i] * d.sc; }
    LDS_WAIT(); asm volatile("" ::: "memory");
    const int c4 = lane & 3;
#pragma unroll
    for (int jj = 0; jj < 4; ++jj) { const int n = (lane >> 2) + 16 * jj; const LAS float* s0 = scr + (16 * c4) * 64 + (n ^ (4 * (2 * c4))), * s1 = scr + (16 * c4 + 8) * 64 + (n ^ (4 * (2 * c4 + 1)));
        u32x4 o; o.x = pg8::pk4_fp8(s0[0 * 64], s0[1 * 64], s0[2 * 64], s0[3 * 64]); o.y = pg8::pk4_fp8(s0[4 * 64], s0[5 * 64], s0[6 * 64], s0[7 * 64]);
        o.z = pg8::pk4_fp8(s1[0 * 64], s1[1 * 64], s1[2 * 64], s1[3 * 64]); o.w = pg8::pk4_fp8(s1[4 * 64], s1[5 * 64], s1[6 * 64], s1[7 * 64]);
        *(u32x4*)(d.dst + (size_t)n * d.pitch + 16 * c4) = o; }
    LDS_WAIT(); asm volatile("" ::: "memory");
}
__device__ __forceinline__ void p0_prologue(Frame& F) {
    const float* c = fin(I_C); const float* wada = fin(I_WADA); const float* bada = fin(I_BADA);
    if (blockIdx.x < 192) {
        const int cg = blockIdx.x, kh = F.lane >> 5, col = F.lane & 31;
        LAS float* scs = (LAS float*)F.lds; LAS float* red = (LAS float*)(F.lds + 65536);
        { float cv[32];
#pragma unroll
          for (int i = 0; i < 32; ++i) cv[i] = c[F.tid + NTHR * i];
#pragma unroll
          for (int i = 0; i < 32; ++i) scs[F.tid + NTHR * i] = cv[i] * sig_fast(cv[i]); }
        __syncthreads();
        float acc[16];
#pragma unroll
        for (int b = 0; b < 16; ++b) acc[b] = 0.f;
        const int kbase = 128 * F.wave + 64 * kh;
        const float* w = wada + (size_t)kbase * 6144 + 32 * cg + col;
        { float wv[64];
#pragma unroll
          for (int k = 0; k < 64; ++k) wv[k] = w[(size_t)k * 6144];
#pragma unroll
          for (int k = 0; k < 64; ++k)
#pragma unroll
              for (int b = 0; b < 16; ++b) acc[b] += scs[b * D + kbase + k] * wv[k]; }
#pragma unroll
        for (int b = 0; b < 16; ++b) red[((F.wave * 2 + kh) * 16 + b) * 32 + col] = acc[b];
        __syncthreads();
        float* ada = (float*)(F.ws + WS_ADA);
        { const int b = F.tid >> 5, l = F.tid & 31; float sm = 0.f;
#pragma unroll
          for (int p = 0; p < 16; ++p) sm += red[(p * 16 + b) * 32 + l];
          __hip_atomic_store(ada + b * 6144 + 32 * cg + l, sm + bada[32 * cg + l], __ATOMIC_RELAXED, __HIP_MEMORY_SCOPE_AGENT); }
        VM_WAIT();
        __syncthreads();
        if (F.tid == 0) __hip_atomic_fetch_add(F.ctl + CW_ADA, 1u, __ATOMIC_RELAXED, __HIP_MEMORY_SCOPE_AGENT);
    }
    {
        const int gt = F.vcu * NTHR + F.tid, NGT = F.G * NTHR; const float* wgrp = fin(I_WGRP); const float* wrt = fin(I_WRT);
        f32x2* rope = (f32x2*)(F.ws + WS_ROPE);
        for (int i = gt; i < 96 * 16; i += NGT) { const int r = i >> 4, e = i & 15; const float pos = (float)(r < 32 ? r : r - 32);
            const float invf = powf(10000.f, -(float)e / 16.f); float sn, cs; sincosf(pos * invf, &sn, &cs); rope[i] = (f32x2){cs, sn}; }
        bf16* wr = (bf16*)(F.ws + WS_WR);
        for (int i = gt; i < 64 * 1024; i += NGT) { const int n = i >> 10, k = i & 1023;
            const float v = n < 4 ? wgrp[k * 4 + n] : (n < 36 ? wrt[k * 32 + (n - 4)] : 0.f); wr[i] = (bf16)f2bf(v); }
    }
    LAS float* scr = (LAS float*)(F.lds + RING_OFF + F.wave * 16384);
    const int gw = F.vcu * NWAVES + F.wave, NGW = F.G * NWAVES;
    constexpr int I_WIN_ = (D / 64) * (INW / 64), I_WC_ = (CW / 64) * (D / 64), I_WO_ = (D / 64) * (D / 64);
    constexpr int NITEMS = I_WIN_ + 2 * I_WC_ + I_WO_;
    bf16* WIN = (bf16*)(F.ws + WS_WIN); bf16* WCA = (bf16*)(F.ws + WS_WCA); bf16* WO = (bf16*)(F.ws + WS_WO);
    const float* pwin = fin(I_WIN); const float* pwco = fin(I_WCO); const float* pwao = fin(I_WAO); const float* pwout = fin(I_WOUT);
    for (int it = gw; it < NITEMS; it += NGW) {
        int r = it;
        if (r < I_WIN_) { const int kb = r / 60, nb = r % 60;
            if (nb >= 16 && nb < 28) p0_transpose_item<1>(pwin, INW, WIN, D, 0, scr, kb * 60 + nb, F.lane);
            else { TrDesc d; const int n0 = 64 * nb; d.src = pwin + (size_t)(64 * kb) * INW + n0; d.N = INW; d.pitch = 2048; d.sc = pg8::WSCIN; d.dst = F.ws + WS_WINF + (size_t)pg8::winf_row(vmap_win(n0)) * 2048 + 64 * kb;
                   f32x4 tv[16]; tr_load(d, F.lane, tv); tr_finish(d, F.lane, tv, scr); }
            continue; } r -= I_WIN_;
        if (r < 2 * I_WC_) { const bool at = r >= I_WC_; if (at) r -= I_WC_;
            TrDesc d; const int kb = r / (D / 64), nb = r % (D / 64); d.src = (at ? pwao : pwco) + (size_t)(64 * kb) * D + 64 * nb; d.N = D; d.pitch = D; d.sc = pg8::WSCCA;
            d.dst = F.ws + WS_WCA + (size_t)(64 * nb) * D + (at ? 512 : 0) + 64 * kb;
            f32x4 tv[16]; tr_load(d, F.lane, tv); tr_finish(d, F.lane, tv, scr); continue; } r -= 2 * I_WC_;
        { TrDesc d; const int kb = r / (D / 64), nb = r % (D / 64); d.src = pwout + (size_t)(64 * kb) * D + 64 * nb; d.N = D; d.pitch = D; d.sc = pg8::WSCO; d.dst = F.ws + WS_WO + (size_t)(64 * nb) * D + 64 * kb;
          f32x4 tv[16]; tr_load(d, F.lane, tv); tr_finish(d, F.lane, tv, scr); }
    }
}
constexpr int XCONV_ITEMS = NE * (2 * (D / 64) * (DE / 64) + (DE / 64) * (D / 64));
__device__ __forceinline__ void p0_convert_experts(Frame& F, int lo, int hi, int rank, int nconv) {
    LAS float* scr = (LAS float*)(F.lds + RING_OFF + F.wave * 16384);
    constexpr int I_G1 = (D / 64) * (DE / 64), I_D1 = (DE / 64) * (D / 64), PER = 2 * I_G1 + I_D1;
    unsigned char* W1 = F.ws + WS_W1; unsigned char* W2 = F.ws + WS_W2;
    const float* pweg = fin(I_WEG); const float* pweu = fin(I_WEU); const float* pwed = fin(I_WED);
    const int step = nconv * NWAVES;
    for (int it = lo + rank * NWAVES + F.wave; it < hi; it += 2 * step) {
        const TrDesc d0 = tr_desc(it, pweg, pweu, pwed, W1, W2); const bool two = it + step < hi;
        const TrDesc d1 = tr_desc(two ? it + step : it, pweg, pweu, pwed, W1, W2);
        f32x4 v0[16], v1[16];
        tr_load(d0, F.lane, v0); tr_load(d1, F.lane, v1);
        __builtin_amdgcn_sched_barrier(0);
        tr_finish(d0, F.lane, v0, scr);
        if (two) tr_finish(d1, F.lane, v1, scr);
    }
}

__device__ __forceinline__ int rcol(int lane, int q) { return 512 * (q >> 1) + 8 * lane + 4 * (q & 1); }
__device__ __forceinline__ void row_ld_f32(const float* p, int lane, f32x4 (&v)[4]) {
#pragma unroll
    for (int q = 0; q < 4; ++q) v[q] = *(const f32x4*)(p + rcol(lane, q)); }
__device__ __forceinline__ void row_st_f32(float* p, int lane, const f32x4 (&v)[4]) {
#pragma unroll
    for (int q = 0; q < 4; ++q) *(f32x4*)(p + rcol(lane, q)) = v[q]; }
__device__ __forceinline__ void row_ld_bf16(const bf16* p, int lane, f32x4 (&v)[4]) {
#pragma unroll
    for (int j = 0; j < 2; ++j) { const u32x4 w = *(const u32x4*)(p + 512 * j + 8 * lane);
        v[2 * j] = (f32x4){bf2f(w.x & 0xffffu), bf2f(w.x >> 16), bf2f(w.y & 0xffffu), bf2f(w.y >> 16)}; v[2 * j + 1] = (f32x4){bf2f(w.z & 0xffffu), bf2f(w.z >> 16), bf2f(w.w & 0xffffu), bf2f(w.w >> 16)}; } }
__device__ __forceinline__ u32x4 row_pack(const f32x4 a, const f32x4 b) { return (u32x4){cvt_pk_bf16(a.x, a.y), cvt_pk_bf16(a.z, a.w), cvt_pk_bf16(b.x, b.y), cvt_pk_bf16(b.z, b.w)}; }
__device__ __forceinline__ float row_ss(const f32x4 (&v)[4]) { float s = 0.f;
#pragma unroll
    for (int q = 0; q < 4; ++q) s += (v[q].x * v[q].x + v[q].y * v[q].y) + (v[q].z * v[q].z + v[q].w * v[q].w);
    return s; }

__device__ __forceinline__ void p1_modnorm(Frame& F) {
    const float* x = fin(I_X); const float* g = fin(I_GPRE1); const float* ada = (const float*)(F.ws + WS_ADA); bf16* h1 = (bf16*)(F.ws + WS_H1); unsigned char* h1f = F.ws + WS_H1F;
    bool waited = false;
    for (int chunk = blockIdx.x; chunk < NTOK / 128; chunk += F.G) {
        const int R0 = chunk * 128, b = R0 / SEQ; const float* ad = ada + b * 6144;
        const int rw = R0 + 16 * F.wave;
        f32x4 n0[4], n1[4];
        row_ld_f32(x + (size_t)rw * D, F.lane, n0); row_ld_f32(x + (size_t)(rw + 1) * D, F.lane, n1);
        __builtin_amdgcn_sched_barrier(0);
        if (!waited) { waited = true;
            if (F.tid == 0) { unsigned sp = 0; while (__hip_atomic_load(F.ctl + CW_ADA, __ATOMIC_RELAXED, __HIP_MEMORY_SCOPE_AGENT) < 192u) { __builtin_amdgcn_s_sleep(2); if (++sp > (1u << 22)) break; }
                __builtin_amdgcn_fence(__ATOMIC_ACQUIRE, "agent"); VM_WAIT(); }
            __syncthreads(); }
        f32x4 ca[4], cb[4];
#pragma unroll
        for (int q = 0; q < 4; ++q) { const int c0 = rcol(F.lane, q); ca[q] = *(const f32x4*)(g + c0) * (1.f + *(const f32x4*)(ad + 1024 + c0)); cb[q] = *(const f32x4*)(ad + c0); }
#pragma unroll
        for (int i = 0; i < 16; i += 2) {
            const int row = rw + i;
            f32x4 v0[4], v1[4];
#pragma unroll
            for (int q = 0; q < 4; ++q) { v0[q] = n0[q]; v1[q] = n1[q]; }
            if (i + 2 < 16) { row_ld_f32(x + (size_t)(row + 2) * D, F.lane, n0); row_ld_f32(x + (size_t)(row + 3) * D, F.lane, n1); }
            __builtin_amdgcn_sched_barrier(0);
            const float r0 = rsqrtf(wave_sum(row_ss(v0)) * (1.f / D) + EPS), r1 = rsqrtf(wave_sum(row_ss(v1)) * (1.f / D) + EPS);
#pragma unroll
            for (int j = 0; j < 2; ++j) {
                const f32x4 a0 = v0[2 * j] * r0 * ca[2 * j] + cb[2 * j], a1 = v0[2 * j + 1] * r0 * ca[2 * j + 1] + cb[2 * j + 1], b0 = v1[2 * j] * r1 * ca[2 * j] + cb[2 * j], b1 = v1[2 * j + 1] * r1 * ca[2 * j + 1] + cb[2 * j + 1];
                *(u32x4*)(h1 + (size_t)row * D + 512 * j + 8 * F.lane) = row_pack(a0, a1); *(u32x4*)(h1 + (size_t)(row + 1) * D + 512 * j + 8 * F.lane) = row_pack(b0, b1);
                *(u32x2*)(h1f + (size_t)row * 2048 + 512 * j + 8 * F.lane) = (u32x2){pg8::pk4_fp8(a0.x, a0.y, a0.z, a0.w), pg8::pk4_fp8(a1.x, a1.y, a1.z, a1.w)};
                *(u32x2*)(h1f + (size_t)(row + 1) * 2048 + 512 * j + 8 * F.lane) = (u32x2){pg8::pk4_fp8(b0.x, b0.y, b0.z, b0.w), pg8::pk4_fp8(b1.x, b1.y, b1.z, b1.w)}; }
            __builtin_amdgcn_sched_barrier(0);
        }
    }
}

constexpr int CV_T = 32, CV_IN = 0, CV_UT = (CV_T + KS - 1) * 1024;
static_assert(CV_UT + CV_T * CW * 4 <= RING_BYTES, "conv LDS map");
__device__ __forceinline__ void p3_conv(Frame& F) {
    const bf16* glu = (const bf16*)(F.ws + WS_GLU); bf16* ca = (bf16*)(F.ws + WS_CA);
    LAS unsigned char* IN = F.lds + RING_OFF + CV_IN; LAS float* UT = (LAS float*)(F.lds + RING_OFF + CV_UT);
#define CV_LOAD(unx) do { const int b_ = (unx) / (SEQ / CV_T), s0_ = ((unx) % (SEQ / CV_T)) * CV_T; _Pragma("unroll") for (int i = 0; i < 8; ++i) { \
        const int s_ = s0_ - KS / 2 + F.wave + NWAVES * i, sc_ = s_ < 0 ? 0 : (s_ >= SEQ ? SEQ - 1 : s_); sv[i] = *(const u32x4*)(glu + (size_t)(b_ * SEQ + sc_) * CW + F.lane * 8); } } while (0)
#define CV_LOAD0 do { if (F.vcu < NTOK / CV_T) CV_LOAD(F.vcu); } while (0)
    const int cp = F.tid & 255, th = F.tid >> 8;
    u32x4 sv[8];
    CV_LOAD0;
    __builtin_amdgcn_sched_barrier(0);
    f32x2 w[KS];
#pragma unroll
    for (int j = 0; j < KS; ++j) w[j] = *(const f32x2*)(fin(I_WDW) + j * CW + 2 * cp);
    const f32x2 bias = *(const f32x2*)(fin(I_BDW) + 2 * cp);
    float lg[8], lb[8];
#pragma unroll
    for (int i = 0; i < 8; ++i) { lg[i] = fin(I_CLNG)[F.lane * 8 + i]; lb[i] = fin(I_CLNB)[F.lane * 8 + i]; }
    for (int un = F.vcu; un < NTOK / CV_T; un += F.G) {
        const int b = un / (SEQ / CV_T), s0 = (un % (SEQ / CV_T)) * CV_T;
#pragma unroll
        for (int i = 0; i < 8; ++i) { const int r = F.wave + NWAVES * i, s = s0 - KS / 2 + r;
            if (r < CV_T + KS - 1) *(LAS u32x4*)(IN + r * 1024 + F.lane * 16) = (s >= 0 && s < SEQ) ? sv[i] : (u32x4){0u, 0u, 0u, 0u}; }
        __syncthreads();
        if (un + F.G < NTOK / CV_T) CV_LOAD(un + F.G);
        __builtin_amdgcn_sched_barrier(0);
#pragma unroll
        for (int g = 0; g < 2; ++g) {
            f32x2 win[38];
#pragma unroll
            for (int i = 0; i < 38; ++i) { const unsigned pw = *(const LAS unsigned*)(IN + (16 * th + 8 * g + i) * 1024 + cp * 4); win[i] = (f32x2){__uint_as_float(pw << 16), __uint_as_float(pw & 0xffff0000u)}; }
#pragma unroll
            for (int o = 0; o < 8; ++o) { f32x2 a = bias;
#pragma unroll
                for (int j = 0; j < KS; ++j) a = __builtin_elementwise_fma(win[o + j], w[j], a);
                *(LAS f32x2*)(UT + (16 * th + 8 * g + o) * CW + 2 * cp) = a; }
        }
        __syncthreads();
#pragma unroll
        for (int i = 0; i < 4; ++i) { const int t = F.wave * 4 + i;
            const f32x4 v0 = *(const LAS f32x4*)(UT + t * CW + F.lane * 8), v1 = *(const LAS f32x4*)(UT + t * CW + F.lane * 8 + 4);
            const float mu = wave_sum((v0.x + v0.y) + (v0.z + v0.w) + (v1.x + v1.y) + (v1.z + v1.w)) * (1.f / CW);
            const f32x4 d0 = v0 - mu, d1 = v1 - mu;
            const float var = wave_sum((d0.x * d0.x + d0.y * d0.y) + (d0.z * d0.z + d0.w * d0.w) + (d1.x * d1.x + d1.y * d1.y) + (d1.z * d1.z + d1.w * d1.w)) * (1.f / CW);
            const float rstd = rsqrtf(var + EPS);
            float o[8];
#pragma unroll
            for (int k = 0; k < 4; ++k) { const float a = d0[k] * rstd * lg[k] + lb[k], bq = d1[k] * rstd * lg[4 + k] + lb[4 + k]; o[k] = a * sig_fast(a); o[4 + k] = bq * sig_fast(bq); }
            *(u32x2*)((unsigned char*)ca + (size_t)(b * SEQ + s0 + t) * D + F.lane * 8) = (u32x2){pg8::pk4_fp8(o[0] * pg8::CSC, o[1] * pg8::CSC, o[2] * pg8::CSC, o[3] * pg8::CSC),
                                                                                                  pg8::pk4_fp8(o[4] * pg8::CSC, o[5] * pg8::CSC, o[6] * pg8::CSC, o[7] * pg8::CSC)}; }
        __syncthreads();
    }
#undef CV_LOAD
#undef CV_LOAD0
}

constexpr int WRP = 2064;
constexpr int P6_WR = 0, P6_LGW = 48 * WRP, P6_EA = P6_LGW + 8 * 16 * 48 * 4, P6_HIST = P6_EA + 128 * 32, P6_BASE = P6_HIST + 128, P6_END = P6_BASE + 128;
constexpr int P6_RS2 = P6_END, P6_BIAS = P6_RS2 + 512, P6_BPART = P6_BIAS + 256, P6_END2 = P6_BPART + 8 * 48 * 4;
static_assert(P6_END2 <= RING_BYTES, "P6 LDS map");
struct P6Row { float pv; u32x4 y[2]; f32x4 x[4]; };
__device__ __forceinline__ void p6_ld(P6Row& r, const float* x, const bf16* y1, const float* part, int row, int lane) {
    r.pv = part[(size_t)row * 16 + (lane & 15)];
#pragma unroll
    for (int j = 0; j < 2; ++j) r.y[j] = *(const u32x4*)(y1 + (size_t)row * D + 512 * j + 8 * lane);
    row_ld_f32(x + (size_t)row * D, lane, r.x);
}
__device__ __forceinline__ void p6_do(P6Row& r, const f32x4 (&c1)[4], const f32x4 (&c2)[4], const f32x4 (&c3)[4], bf16* x1b, unsigned char* h2f, LAS float* rs2, int row, int lane) {
    const float pv = row16_sum(r.pv);
    const float ra = rsqrtf(pv * (1.f / D) + EPS);
    f32x4 xv[4];
#pragma unroll
    for (int j = 0; j < 2; ++j) { const u32x4 w = r.y[j];
        const f32x4 ya = (f32x4){bf2f(w.x & 0xffffu), bf2f(w.x >> 16), bf2f(w.y & 0xffffu), bf2f(w.y >> 16)}, yb = (f32x4){bf2f(w.z & 0xffffu), bf2f(w.z >> 16), bf2f(w.w & 0xffffu), bf2f(w.w >> 16)};
        xv[2 * j] = r.x[2 * j] + c1[2 * j] * (ya * ra); xv[2 * j + 1] = r.x[2 * j + 1] + c1[2 * j + 1] * (yb * ra);
        *(u32x4*)(x1b + (size_t)row * D + 512 * j + 8 * lane) = row_pack(xv[2 * j], xv[2 * j + 1]); }
    const float sa = rsqrtf(wave_sum(row_ss(xv)) * (1.f / D) + EPS);
    if (lane == 0) *rs2 = sa;
#pragma unroll
    for (int j = 0; j < 2; ++j) { const f32x4 ha = xv[2 * j] * sa * c2[2 * j] + c3[2 * j], hb = xv[2 * j + 1] * sa * c2[2 * j + 1] + c3[2 * j + 1];
        *(u32x2*)(h2f + (size_t)row * D + 512 * j + 8 * lane) = (u32x2){pg8::pk4_fp8(ha.x, ha.y, ha.z, ha.w), pg8::pk4_fp8(hb.x, hb.y, hb.z, hb.w)}; }
}
__device__ __forceinline__ void p6_postmix_router(Frame& F) {
    const float* x = fin(I_X); const bf16* y1 = (const bf16*)(F.ws + WS_Y1); const float* part = (const float*)(F.ws + WS_PART); const float* ada = (const float*)(F.ws + WS_ADA);
    unsigned char* h2f = F.ws + WS_H2F; bf16* x1b = (bf16*)(F.ws + WS_X1B); int* list = (int*)(F.ws + WS_LIST); unsigned* tokinfo = (unsigned*)(F.ws + WS_TOK);
    LAS unsigned char* WR = F.lds + P6_WR; LAS float* LGW = (LAS float*)(F.lds + P6_LGW) + F.wave * 16 * 48;
    LAS unsigned* EA = (LAS unsigned*)(F.lds + P6_EA); LAS unsigned* HIST = (LAS unsigned*)(F.lds + P6_HIST); LAS unsigned* BASE = (LAS unsigned*)(F.lds + P6_BASE);
    LAS float* RS2 = (LAS float*)(F.lds + P6_RS2) + F.wave * 16; LAS float* BIAS = (LAS float*)(F.lds + P6_BIAS); LAS float* BPART = (LAS float*)(F.lds + P6_BPART);
    const int fr = F.lane & 15, fq = F.lane >> 4;
    const float* gpost1 = fin(I_GPOST1); const float* gpre2 = fin(I_GPRE2); const float* bgrp = fin(I_BGRP); const float* brt = fin(I_BRT); const float* wgrp = fin(I_WGRP); const float* wrt = fin(I_WRT);
    for (int i = F.tid; i < 12 * WRP / 4; i += NTHR) ((LAS unsigned*)(WR + 36 * WRP))[i] = 0u;
    for (int chunk = blockIdx.x; chunk < NTOK / 128; chunk += F.G) {
        const int R0 = chunk * 128, b = R0 / SEQ, rw = R0 + 16 * F.wave; const float* ad = ada + b * 6144;
        if (F.tid < 32) HIST[F.tid] = 0u;
        P6Row na, nb;
        p6_ld(na, x, y1, part, rw, F.lane); p6_ld(nb, x, y1, part, rw + 1, F.lane);
        __builtin_amdgcn_sched_barrier(0);
        {
            float bp[36];
#pragma unroll
            for (int n = 0; n < 36; ++n) bp[n] = 0.f;
#pragma unroll
            for (int h = 0; h < 2; ++h) { const int kk = F.tid + NTHR * h; const float c2k = gpre2[kk] * (1.f + ad[4096 + kk]), c3k = ad[3072 + kk];
                const f32x4 wg = *(const f32x4*)(wgrp + kk * 4);
#pragma unroll
                for (int n = 0; n < 4; ++n) { *(LAS unsigned short*)(WR + n * WRP + kk * 2) = (unsigned short)f2bf(wg[n] * c2k); bp[n] += c3k * wg[n]; }
#pragma unroll
                for (int q = 0; q < 8; ++q) { const f32x4 wv = *(const f32x4*)(wrt + kk * 32 + q * 4);
#pragma unroll
                    for (int n = 0; n < 4; ++n) { *(LAS unsigned short*)(WR + (4 + 4 * q + n) * WRP + kk * 2) = (unsigned short)f2bf(wv[n] * c2k); bp[4 + 4 * q + n] += c3k * wv[n]; } } }
#pragma unroll
            for (int n = 0; n < 36; ++n) { const float t = wave_sum(bp[n]); if (F.lane == 0) BPART[F.wave * 48 + n] = t; }
        }
        f32x4 c1[4], c2[4], c3[4];
#pragma unroll
        for (int q = 0; q < 4; ++q) { const int c0 = rcol(F.lane, q);
            c1[q] = *(const f32x4*)(gpost1 + c0) * *(const f32x4*)(ad + 2048 + c0);
            c2[q] = *(const f32x4*)(gpre2 + c0) * (1.f + *(const f32x4*)(ad + 4096 + c0)); c3[q] = *(const f32x4*)(ad + 3072 + c0); }
        __syncthreads();
        if (F.tid < 48) { float t = 0.f;
            if (F.tid < 36) {
#pragma unroll
                for (int w = 0; w < 8; ++w) t += BPART[w * 48 + F.tid];
                t += F.tid < 4 ? bgrp[F.tid] : brt[F.tid - 4]; }
            BIAS[F.tid] = t; }
        {
#pragma unroll
            for (int i = 0; i < 16; i += 2) {
                P6Row ra = na, rb = nb;
                if (i + 2 < 16) { p6_ld(na, x, y1, part, rw + i + 2, F.lane); p6_ld(nb, x, y1, part, rw + i + 3, F.lane); }
                __builtin_amdgcn_sched_barrier(0);
                p6_do(ra, c1, c2, c3, x1b, h2f, RS2 + i, rw + i, F.lane); p6_do(rb, c1, c2, c3, x1b, h2f, RS2 + i + 1, rw + i + 1, F.lane);
                __builtin_amdgcn_sched_barrier(0);
            }
        }
        VM_WAIT();
        __syncthreads();
        {
            f32x4 acc[3] = {(f32x4){0.f, 0.f, 0.f, 0.f}, (f32x4){0.f, 0.f, 0.f, 0.f}, (f32x4){0.f, 0.f, 0.f, 0.f}};
            bf16x8 af[32];
#pragma unroll
            for (int ks = 0; ks < 32; ++ks) af[ks] = *(const bf16x8*)(x1b + (size_t)(rw + fr) * D + 32 * ks + 8 * fq);
#pragma unroll
            for (int ks = 0; ks < 32; ++ks)
#pragma unroll
                for (int nb = 0; nb < 3; ++nb) { const bf16x8 bf = *(const LAS bf16x8*)(WR + (16 * nb + fr) * WRP + (32 * ks + 8 * fq) * 2);
                    acc[nb] = __builtin_amdgcn_mfma_f32_16x16x32_bf16(af[ks], bf, acc[nb], 0, 0, 0); }
#pragma unroll
            for (int nb = 0; nb < 3; ++nb)
#pragma unroll
                for (int j = 0; j < 4; ++j) LGW[(4 * fq + j) * 48 + 16 * nb + fr] = acc[nb][j] * RS2[4 * fq + j] + BIAS[16 * nb + fr];
        }
        LDS_WAIT();
        if (F.lane < 16) {
            const LAS float* L = LGW + F.lane * 48;
            float gl[4];
#pragma unroll
            for (int g = 0; g < 4; ++g) gl[g] = L[g];
            int gi = 0; float gm = gl[0];
#pragma unroll
            for (int g = 1; g < 4; ++g) if (gl[g] > gm) { gm = gl[g]; gi = g; }
            float den = 0.f;
#pragma unroll
            for (int g = 0; g < 4; ++g) den += __expf(gl[g] - gm);
            const float grp_p = 1.f / den;
            float E[8];
#pragma unroll
            for (int i = 0; i < 8; ++i) E[i] = L[4 + gi * 8 + i];
            int a = 0; float am = E[0];
#pragma unroll
            for (int i = 1; i < 8; ++i) if (E[i] > am) { am = E[i]; a = i; }
            int bi = -1; float bm = -3.0e38f;
#pragma unroll
            for (int i = 0; i < 8; ++i) if (i != a && E[i] > bm) { bm = E[i]; bi = i; }
            if (bi < 0) { bi = (a == 0) ? 1 : 0; bm = E[bi]; }
            const float pb = __expf(bm - am), wa = 1.f / (1.f + pb), wb = pb / (1.f + pb);
            const unsigned e0 = (unsigned)(gi * 8 + a), e1 = (unsigned)(gi * 8 + bi);
            const unsigned k0 = __hip_atomic_fetch_add(HIST + e0, 1u, __ATOMIC_RELAXED, __HIP_MEMORY_SCOPE_WORKGROUP), k1 = __hip_atomic_fetch_add(HIST + e1, 1u, __ATOMIC_RELAXED, __HIP_MEMORY_SCOPE_WORKGROUP);
            LAS unsigned* ea = EA + (16 * F.wave + F.lane) * 8;
            ea[0] = e0; ea[1] = k0; ea[2] = e1; ea[3] = k1; ea[4] = __float_as_uint(grp_p * wa); ea[5] = __float_as_uint(grp_p * wb);
        }
        __syncthreads();
        if (F.tid < 32) BASE[F.tid] = __hip_atomic_fetch_add(F.ctl + CW_CNT + F.tid, HIST[F.tid], __ATOMIC_RELAXED, __HIP_MEMORY_SCOPE_AGENT);
        __syncthreads();
        if (F.tid < 128) { const LAS unsigned* ea = EA + F.tid * 8; const int tok = R0 + F.tid;
            const unsigned e0 = ea[0], e1 = ea[2], p0 = BASE[e0] + ea[1], p1 = BASE[e1] + ea[3];
            list[(size_t)e0 * ECAP + p0] = tok; list[(size_t)e1 * ECAP + p1] = tok;
            unsigned* ti = tokinfo + (size_t)tok * 8; *(u32x4*)ti = (u32x4){e0, p0, e1, p1}; *(u32x2*)(ti + 4) = (u32x2){ea[4], ea[5]}; }
        __syncthreads();
    }
}

__device__ __forceinline__ void moe_tstart(Frame& F) {
    LAS int* TS = (LAS int*)(F.lds + TS_OFF);
    if (F.tid == 0) { int o = 0; for (int e = 0; e < NE; ++e) { TS[e] = o; o += (int)((__hip_atomic_load(F.ctl + CW_CNT + e, __ATOMIC_RELAXED, __HIP_MEMORY_SCOPE_AGENT) + 255u) >> 8); } TS[NE] = o; }
    __syncthreads();
}
template <bool GATHER>
__device__ __forceinline__ void moe_setup(Frame& F) {
    moe_tstart(F);
    LAS int* TS = (LAS int*)(F.lds + TS_OFF); LAS int* UT = (LAS int*)(F.lds + UT_OFF); LAS int* RT = (LAS int*)(F.lds + RT_OFF);
    const int* list = (const int*)(F.ws + WS_LIST);
    if (F.tid < pg8::MOE_MAXU) {
        const int u = F.tid * F.G + F.vcu, T4 = 4 * TS[NE]; int pm = 0, pn = 0, e = 0, valid = 0;
        if (u < T4) { pm = u >> 2; pn = u & 3; valid = 1; for (int k = 1; k < NE; ++k) if (TS[k] <= pm) e = k; }
        UT[F.tid * 4 + 0] = pm; UT[F.tid * 4 + 1] = pn; UT[F.tid * 4 + 2] = e; UT[F.tid * 4 + 3] = valid;
    }
    __syncthreads();
    if (GATHER) {
        for (int idx = F.tid; idx < pg8::MOE_MAXU * 256; idx += NTHR) { const int i = idx >> 8, r = idx & 255;
            if (UT[i * 4 + 3]) { const int e = UT[i * 4 + 2], pos = (UT[i * 4 + 0] - TS[e]) * 256 + r;
                const int cnt = (int)__hip_atomic_load(F.ctl + CW_CNT + e, __ATOMIC_RELAXED, __HIP_MEMORY_SCOPE_AGENT);
                RT[idx] = pos < cnt ? list[(size_t)e * ECAP + pos] : 0; } }
        VM_WAIT();
    }
    __syncthreads();
}

struct P9Row { u32x2 ya[2], yb[2]; u32x4 xb[2]; };
__device__ __forceinline__ void p9_ld(P9Row& r, const unsigned char* y2, const bf16* x1b, unsigned s0, unsigned s1, int row, int lane) {
#pragma unroll
    for (int j = 0; j < 2; ++j) { r.ya[j] = *(const u32x2*)(y2 + (size_t)s0 * D + 512 * j + 8 * lane); r.yb[j] = *(const u32x2*)(y2 + (size_t)s1 * D + 512 * j + 8 * lane);
        r.xb[j] = *(const u32x4*)(x1b + (size_t)row * D + 512 * j + 8 * lane); }
}
__device__ __forceinline__ void up8(const u32x4 w, f32x4& a, f32x4& b) {
    a = (f32x4){bf2f(w.x & 0xffffu), bf2f(w.x >> 16), bf2f(w.y & 0xffffu), bf2f(w.y >> 16)}; b = (f32x4){bf2f(w.z & 0xffffu), bf2f(w.z >> 16), bf2f(w.w & 0xffffu), bf2f(w.w >> 16)}; }
__device__ __forceinline__ f32x4 up4_fp8(unsigned w) { const f32x2 lo = __builtin_amdgcn_cvt_pk_f32_fp8((int)w, false), hi = __builtin_amdgcn_cvt_pk_f32_fp8((int)w, true); return (f32x4){lo.x, lo.y, hi.x, hi.y}; }
__device__ __forceinline__ void p9_do(const P9Row& r, float w0, float w1, const f32x4 (&cg)[4], float* orow, int lane) {
    f32x4 y[4], xv[4];
#pragma unroll
    for (int j = 0; j < 2; ++j) { y[2 * j] = up4_fp8(r.ya[j].x) * w0 + up4_fp8(r.yb[j].x) * w1; y[2 * j + 1] = up4_fp8(r.ya[j].y) * w0 + up4_fp8(r.yb[j].y) * w1; up8(r.xb[j], xv[2 * j], xv[2 * j + 1]); }
    const float rs = rsqrtf(wave_sum(row_ss(y)) * (1.f / D) + EPS);
#pragma unroll
    for (int q = 0; q < 4; ++q) xv[q] = xv[q] + cg[q] * (y[q] * rs);
    row_st_f32(orow, lane, xv);
}
__device__ __forceinline__ void p9_final(Frame& F, bool dry) {
    moe_tstart(F);
    const LAS int* TS = (const LAS int*)(F.lds + TS_OFF);
    const unsigned char* y2 = F.ws + WS_Y2; const bf16* x1b = (const bf16*)(F.ws + WS_X1B); const unsigned* tokinfo = (const unsigned*)(F.ws + WS_TOK); const float* ada = (const float*)(F.ws + WS_ADA);
    float* obase = dry ? (float*)(F.ws + WS_CA) : F.out; const float* gpost2 = fin(I_GPOST2);
    for (int chunk = blockIdx.x; chunk < NTOK / 128; chunk += F.G) {
        const int R0 = chunk * 128, b = R0 / SEQ, rw = R0 + 16 * F.wave; const float* ad = ada + b * 6144;
        f32x4 cg[4];
#pragma unroll
        for (int q = 0; q < 4; ++q) { const int c0 = rcol(F.lane, q); cg[q] = *(const f32x4*)(gpost2 + c0) * *(const f32x4*)(ad + 5120 + c0); }
        const u32x4 ti = *(const u32x4*)(tokinfo + (size_t)(rw + (F.lane & 15)) * 8); const u32x2 tw = *(const u32x2*)(tokinfo + (size_t)(rw + (F.lane & 15)) * 8 + 4);
        const unsigned sl0 = (unsigned)TS[ti.x] * 256u + ti.y, sl1 = (unsigned)TS[ti.z] * 256u + ti.w;
#define P9_S0(i) ((unsigned)__builtin_amdgcn_readlane((int)sl0, (i)))
#define P9_S1(i) ((unsigned)__builtin_amdgcn_readlane((int)sl1, (i)))
#define P9_W0(i) (__uint_as_float((unsigned)__builtin_amdgcn_readlane((int)tw.x, (i))) * (1.f / pg8::YSC))
#define P9_W1(i) (__uint_as_float((unsigned)__builtin_amdgcn_readlane((int)tw.y, (i))) * (1.f / pg8::YSC))
        P9Row na, nb;
        p9_ld(na, y2, x1b, P9_S0(0), P9_S1(0), rw, F.lane); p9_ld(nb, y2, x1b, P9_S0(1), P9_S1(1), rw + 1, F.lane);
#pragma unroll
        for (int i = 0; i < 16; i += 2) {
            const P9Row ra = na, rb = nb;
            if (i + 2 < 16) { p9_ld(na, y2, x1b, P9_S0(i + 2), P9_S1(i + 2), rw + i + 2, F.lane); p9_ld(nb, y2, x1b, P9_S0(i + 3), P9_S1(i + 3), rw + i + 3, F.lane); }
            __builtin_amdgcn_sched_barrier(0);
            p9_do(ra, P9_W0(i), P9_W1(i), cg, obase + (size_t)(rw + i) * D, F.lane); p9_do(rb, P9_W0(i + 1), P9_W1(i + 1), cg, obase + (size_t)(rw + i + 1) * D, F.lane);
            __builtin_amdgcn_sched_barrier(0);
        }
#undef P9_S0
#undef P9_S1
#undef P9_W0
#undef P9_W1
    }
}

#ifndef MK_STAG
#define MK_STAG 0
#endif
#ifndef MK_STAGMASK
#define MK_STAGMASK 0x3ff
#endif
#ifndef MK_STAGGRP
#define MK_STAGGRP 3
#endif
#define STAG_AT(p) (((MK_STAGMASK >> (p)) & 1) ? MK_STAG : 0)
__device__ __forceinline__ void stagger(int ticks) {
    if (ticks > 0) { const unsigned long long t0 = __builtin_amdgcn_s_memrealtime(); const unsigned long long d = (unsigned long long)(((blockIdx.x >> 3) & MK_STAGGRP) * ticks);
        while (__builtin_amdgcn_s_memrealtime() - t0 < d) __builtin_amdgcn_s_sleep(4); }
}

__global__ void __launch_bounds__(NTHR, 2) mega_fwd(Args args) {
    extern __shared__ __attribute__((aligned(16))) unsigned char lds_raw[];
    Frame F;
    F.lds = (LAS unsigned char*)lds_raw; F.MISC = (volatile LAS unsigned*)(F.lds + MISC_OFF);
    F.tid = threadIdx.x; F.lane = F.tid & 63; F.wave = __builtin_amdgcn_readfirstlane(F.tid >> 6);
    F.G = gridDim.x; { const int bx = blockIdx.x; F.vcu = (F.G % 8 == 0) ? (bx % 8) * (F.G / 8) + bx / 8 : bx; }
    F.ws = args.ws; F.ctl = (unsigned*)(args.ws + WS_CTL); F.out = args.out;
    for (int u = F.tid; u < (LDS_BYTES - LDSCTL_OFF) / 4; u += NTHR) ((LAS unsigned*)(F.lds + LDSCTL_OFF))[u] = 0u;
    __syncthreads();
    XcdBarrier bar; bar.bar = F.ctl + CW_BAR; bar.x = 0; bar.st = nullptr;
    if (args.use_bar) bar = xcd_barrier_post(F.ctl + CW_BAR, F.MISC + 8);
    const int lo = args.ph_lo, hi = args.ph_hi;
#ifndef MK_PHMASK
#define MK_PHMASK 0x3ff
#endif
#define IN(k) (((MK_PHMASK >> (k)) & 1) && lo <= (k) && (k) < hi)
#define SEAM(k) do { if (IN(k) && IN((k) + 1)) xcd_barrier(bar); } while (0)

    if (IN(0)) { p0_prologue(F); }
    if (IN(1)) { p1_modnorm(F); } SEAM(1);
    if (IN(2)) {
        pg8::EpiP2 E{(bf16*)(F.ws + WS_GLU), (bf16*)(F.ws + WS_QKV), (bf16*)(F.ws + WS_GATES), fin(I_QG), fin(I_KG), (const f32x2*)(F.ws + WS_ROPE)};
        stagger(STAG_AT(2));
        { pg8::P2Order<false> S{(const char*)(F.ws + WS_WIN), F.vcu, F.G};
          pg8::gemm_phase<pg8::EpiP2, pg8::P2Order<false>, true, 0>(F.lds + RING_OFF, F.ws + WS_H1, D * 2, D * 2, S, E); }
        { pg8::P2Order<true> S{(const char*)(F.ws + WS_WINF), F.vcu, F.G};
          pg8::gemm_phase<pg8::EpiP2, pg8::P2Order<true>, true, 1>(F.lds + RING_OFF, F.ws + WS_H1F, D * 2, D * 2, S, E, nullptr, D); }
    } SEAM(2);
    if (IN(3)) {
        if (!(args.flags & 1)) p3_conv(F);
        if (!(args.flags & 2)) {
            const attn_body::bf16* qkv = (const attn_body::bf16*)(F.ws + WS_QKV);
            const attn_body::AttnTensors AT{qkv, qkv + 512, qkv + 640, (attn_body::bf16*)(F.ws + WS_CA + 512)};
            const attn_body::StaticOrder S((int)F.G, F.vcu);
            attn_body::AttnUnit au;
            for (int i = 0; S.next(i, au); ++i) {
                if (i == (F.vcu & 3)) { p0_convert_experts(F, 0, XCONV_ITEMS, F.vcu, F.G); VM_WAIT(); __syncthreads(); }
                attn_body::attn_unit<8>(au.bh / attn_body::NHEAD, au.bh % attn_body::NHEAD, (au.bh % attn_body::NHEAD) / 4, au.qb, AT.Q, AT.K, AT.V, AT.O, (char*)lds_raw + RING_OFF);
            }
        }
    } SEAM(3);
    if (IN(4)) {
        pg8::PanelOrder S{(const char*)(F.ws + WS_WCA), F.vcu, F.G, D};
        pg8::EpiP4 E{(const bf16*)(F.ws + WS_GATES), (bf16*)(F.ws + WS_H1)};
        stagger(STAG_AT(4));
        pg8::gemm_phase<pg8::EpiP4, pg8::PanelOrder, true, 1>(F.lds + RING_OFF, F.ws + WS_CA, D, D, S, E);
    } SEAM(4);
    if (IN(5)) {
        pg8::PanelOrder S{(const char*)(F.ws + WS_WO), F.vcu, F.G, D};
        pg8::EpiP5 E{(bf16*)(F.ws + WS_Y1), (float*)(F.ws + WS_PART)};
        stagger(STAG_AT(5));
        pg8::gemm_phase<pg8::EpiP5, pg8::PanelOrder, true, 1>(F.lds + RING_OFF, F.ws + WS_H1, D, D, S, E);
    } SEAM(5);
    if (IN(6)) { p6_postmix_router(F); } SEAM(6);
    if (IN(7)) {
        moe_setup<true>(F);
        pg8::MoeOrder<true> S{(const LAS int*)(F.lds + UT_OFF), (const LAS int*)(F.lds + RT_OFF), F.ws + WS_W1, (size_t)D * D, D};
        pg8::EpiMoe1 E{F.ws + WS_GATES};
        stagger(STAG_AT(7));
        pg8::gemm_phase<pg8::EpiMoe1, pg8::MoeOrder<true>, true, true>(F.lds + RING_OFF, F.ws + WS_H2F, D, D, S, E);
    } SEAM(7);
    if (IN(8)) {
        moe_setup<false>(F);
        pg8::MoeOrder<false> S{(const LAS int*)(F.lds + UT_OFF), (const LAS int*)(F.lds + RT_OFF), F.ws + WS_W2, (size_t)D * DE, DE};
        pg8::EpiMoe2 E{F.ws + WS_Y2};
        stagger(STAG_AT(8));
        pg8::gemm_phase<pg8::EpiMoe2, pg8::MoeOrder<false>, true, true>(F.lds + RING_OFF, F.ws + WS_GATES, DE, DE, S, E);
    } SEAM(8);
    if (IN(9)) { p9_final(F, (args.flags & 4) != 0); }
#undef IN
#undef SEAM
}
#if MK_NPRE < 10
__global__ __launch_bounds__(256) void k_ada(const float* __restrict__ c, const float* __restrict__ w, const float* __restrict__ bb, float* __restrict__ ada) {
    const int j = blockIdx.x * 256 + threadIdx.x, b = blockIdx.y;
    float acc = 0.f;
    for (int k = 0; k < D; ++k) { const float cv = c[b * D + k]; acc += siluf_(cv) * w[(size_t)k * 6144 + j]; }
    ada[b * 6144 + j] = acc + bb[j];
}

__global__ __launch_bounds__(256) void k_modnorm(const float* __restrict__ x, const float* __restrict__ g, const float* __restrict__ ada, int sh_off, int sc_off, bf16* __restrict__ out) {
    const int lane = threadIdx.x & 63, row = blockIdx.x * 4 + (threadIdx.x >> 6), b = row / SEQ;
    const f32x4* xr = (const f32x4*)(x + (size_t)row * D) + lane;
    f32x4 v[4]; float s = 0.f;
#pragma unroll
    for (int j = 0; j < 4; ++j) { v[j] = xr[64 * j]; s += (v[j].x * v[j].x + v[j].y * v[j].y) + (v[j].z * v[j].z + v[j].w * v[j].w); }
    const float rstd = rsqrtf(wave_sum(s) * (1.f / D) + EPS);
    unsigned long long* o8 = (unsigned long long*)(out + (size_t)row * D) + lane;
#pragma unroll
    for (int j = 0; j < 4; ++j) {
        const int c0 = 256 * j + 4 * lane;
        const f32x4 gg = *(const f32x4*)(g + c0), sc = *(const f32x4*)(ada + b * 6144 + sc_off + c0), sh = *(const f32x4*)(ada + b * 6144 + sh_off + c0);
        const f32x4 r = v[j] * rstd * gg * (1.f + sc) + sh;
        o8[64 * j] = (unsigned long long)pk2(r.x, r.y) | ((unsigned long long)pk2(r.z, r.w) << 32);
    }
}

template <int MODE>
__global__ __launch_bounds__(256) void k_gemm(const bf16* __restrict__ A, int lda, const int* __restrict__ rowidx, const int* __restrict__ cntp, const int* __restrict__ offp,
                                              const float* __restrict__ W, const float* __restrict__ W2, int ldw, void* Cv, int ldc, int M, int K) {
    __shared__ float As[16][68];
    __shared__ float Bs[16][68];
    __shared__ float Bs2[MODE == 1 ? 16 : 1][68];
    const int Mcnt = cntp ? *cntp : M, off = offp ? *offp : 0;
    const int m0 = blockIdx.x * 64, n0 = blockIdx.y * 64;
    if (m0 >= Mcnt) return;
    const int tid = threadIdx.x, tx = tid & 15, ty = tid >> 4;
    float acc[4][4], acc2[4][4];
#pragma unroll
    for (int i = 0; i < 4; ++i)
#pragma unroll
        for (int j = 0; j < 4; ++j) { acc[i][j] = 0.f; acc2[i][j] = 0.f; }
    const int ar = tid >> 2, ak = (tid & 3) * 4, arow = m0 + ar;
    const bool av = arow < Mcnt;
    const size_t asrc = av ? (rowidx ? (size_t)rowidx[arow] : (size_t)(off + arow)) : 0;
    const int bk = tid >> 4, bn = (tid & 15) * 4;
    for (int k0 = 0; k0 < K; k0 += 16) {
        u32x2 raw = (u32x2){0u, 0u};
        if (av) raw = *(const u32x2*)(A + asrc * lda + k0 + ak);
        As[ak + 0][ar] = bf2f(raw.x & 0xffffu); As[ak + 1][ar] = bf2f(raw.x >> 16); As[ak + 2][ar] = bf2f(raw.y & 0xffffu); As[ak + 3][ar] = bf2f(raw.y >> 16);
        const f32x4 w = *(const f32x4*)(W + (size_t)(k0 + bk) * ldw + n0 + bn);
        Bs[bk][bn + 0] = w.x; Bs[bk][bn + 1] = w.y; Bs[bk][bn + 2] = w.z; Bs[bk][bn + 3] = w.w;
        if (MODE == 1) { const f32x4 w2 = *(const f32x4*)(W2 + (size_t)(k0 + bk) * ldw + n0 + bn);
            Bs2[bk][bn + 0] = w2.x; Bs2[bk][bn + 1] = w2.y; Bs2[bk][bn + 2] = w2.z; Bs2[bk][bn + 3] = w2.w; }
        __syncthreads();
#pragma unroll
        for (int kk = 0; kk < 16; ++kk) {
            float a[4], b[4], b2[4];
#pragma unroll
            for (int i = 0; i < 4; ++i) { a[i] = As[kk][ty * 4 + i]; b[i] = Bs[kk][tx * 4 + i]; b2[i] = (MODE == 1) ? Bs2[kk][tx * 4 + i] : 0.f; }
#pragma unroll
            for (int i = 0; i < 4; ++i)
#pragma unroll
                for (int j = 0; j < 4; ++j) { acc[i][j] += a[i] * b[j]; if (MODE == 1) acc2[i][j] += a[i] * b2[j]; }
        }
        __syncthreads();
    }
#pragma unroll
    for (int i = 0; i < 4; ++i) {
        const int r = m0 + ty * 4 + i;
        if (r < Mcnt) {
            const size_t crow = (size_t)(off + r);
            if (MODE == 0) { *(f32x4*)((float*)Cv + crow * ldc + n0 + tx * 4) = (f32x4){acc[i][0], acc[i][1], acc[i][2], acc[i][3]}; }
            else {
                float o[4];
#pragma unroll
                for (int j = 0; j < 4; ++j) o[j] = (MODE == 1) ? siluf_(acc[i][j]) * acc2[i][j] : acc[i][j];
                *(u32x2*)((bf16*)Cv + crow * ldc + n0 + tx * 4) = (u32x2){pk2(o[0], o[1]), pk2(o[2], o[3])};
            }
        }
    }
}

__global__ __launch_bounds__(256) void k_glu(const float* __restrict__ t, bf16* __restrict__ glu) {
    const size_t i = (size_t)blockIdx.x * 256 + threadIdx.x;
    const size_t r = i / 512; const int c = (int)(i % 512);
    const float a = t[r * 1024 + c], ag = t[r * 1024 + 512 + c];
    glu[i] = (bf16)f2bf(a * sigmoidf_(ag));
}
__global__ __launch_bounds__(256) void k_gate(const float* __restrict__ t, bf16* __restrict__ gates, int goff) {
    const size_t i = (size_t)blockIdx.x * 256 + threadIdx.x;
    const size_t r = i / 1024; const int c = (int)(i % 1024);
    gates[r * 2048 + goff + c] = (bf16)f2bf(sigmoidf_(t[i]));
}

__global__ __launch_bounds__(512) void k_conv(const bf16* __restrict__ glu, const float* __restrict__ w_dw, const float* __restrict__ b_dw, const float* __restrict__ lg, const float* __restrict__ lb, bf16* __restrict__ ca) {
    __shared__ float red[16];
    const int t = blockIdx.x, c = threadIdx.x, b = t / SEQ, s = t % SEQ;
    float acc = b_dw[c];
    for (int j = 0; j < KS; ++j) { const int s2 = s + j - KS / 2; if (s2 >= 0 && s2 < SEQ) acc += bf2f(glu[(size_t)(b * SEQ + s2) * CW + c]) * w_dw[j * CW + c]; }
    float sm = wave_sum(acc);
    if ((c & 63) == 0) red[c >> 6] = sm;
    __syncthreads();
    float mu = 0.f;
#pragma unroll
    for (int i = 0; i < 8; ++i) mu += red[i];
    mu *= (1.f / CW);
    const float d = acc - mu;
    float sq = wave_sum(d * d);
    if ((c & 63) == 0) red[8 + (c >> 6)] = sq;
    __syncthreads();
    float var = 0.f;
#pragma unroll
    for (int i = 0; i < 8; ++i) var += red[8 + i];
    var *= (1.f / CW);
    const float u = d * rsqrtf(var + EPS) * lg[c] + lb[c];
    ca[(size_t)t * 1024 + c] = (bf16)f2bf(siluf_(u));
}

__global__ __launch_bounds__(256) void k_qkrope(const float* __restrict__ t, const float* __restrict__ qg, const float* __restrict__ kg, bf16* __restrict__ qkv) {
    const size_t i = (size_t)blockIdx.x * 256 + threadIdx.x;
    const size_t r = i / 12; const int hs = (int)(i % 12);
    const float* src = t + r * 1024 + hs * 64; bf16* dst = qkv + r * 768 + hs * 64;
    if (hs >= 10) { for (int d = 0; d < 64; ++d) dst[d] = (bf16)f2bf(src[d]); return; }
    const float* g = hs < 8 ? qg : kg;
    float ss = 0.f;
    for (int d = 0; d < 64; ++d) ss += src[d] * src[d];
    const float rstd = rsqrtf(ss * (1.f / 64.f) + EPS) , osc = hs < 8 ? QSCALE : 1.f;
    const int s = (int)(r % SEQ); const float prow = (float)(s / 64), pcol = (float)(s % 64);
    for (int half = 0; half < 2; ++half) {
        const float pos = half == 0 ? prow : pcol;
        for (int e = 0; e < 16; ++e) {
            const float invf = powf(10000.f, -(float)(2 * e) / 32.f);
            const float ang = pos * invf; float sn, cs; sincosf(ang, &sn, &cs);
            const int d1 = half * 32 + e, d2 = d1 + 16;
            const float x1 = src[d1] * rstd * g[d1], x2 = src[d2] * rstd * g[d2];
            dst[d1] = (bf16)f2bf((x1 * cs - x2 * sn) * osc);
            dst[d2] = (bf16)f2bf((x2 * cs + x1 * sn) * osc);
        }
    }
}

__global__ __launch_bounds__(256) void k_attn(const bf16* __restrict__ qkv, bf16* __restrict__ ca) {
    const int qi = blockIdx.x * 256 + threadIdx.x;
    const int h = blockIdx.y, b = blockIdx.z, kvh = h / 4;
    const size_t row = (size_t)b * SEQ + qi;
    float q[64], o[64];
    {
        const u32x4* qp = (const u32x4*)(qkv + row * 768 + h * 64);
#pragma unroll
        for (int c = 0; c < 8; ++c) { const u32x4 v = qp[c];
            q[c * 8 + 0] = bf2f(v.x & 0xffffu); q[c * 8 + 1] = bf2f(v.x >> 16); q[c * 8 + 2] = bf2f(v.y & 0xffffu); q[c * 8 + 3] = bf2f(v.y >> 16);
            q[c * 8 + 4] = bf2f(v.z & 0xffffu); q[c * 8 + 5] = bf2f(v.z >> 16); q[c * 8 + 6] = bf2f(v.w & 0xffffu); q[c * 8 + 7] = bf2f(v.w >> 16); }
    }
#pragma unroll
    for (int d = 0; d < 64; ++d) o[d] = 0.f;
    float m = -1e30f, l = 0.f;
    for (int s = 0; s < SEQ; ++s) {
        const u32x4* kp = (const u32x4*)(qkv + ((size_t)b * SEQ + s) * 768 + 512 + kvh * 64);
        const u32x4* vp = (const u32x4*)(qkv + ((size_t)b * SEQ + s) * 768 + 640 + kvh * 64);
        float sc = 0.f;
#pragma unroll
        for (int c = 0; c < 8; ++c) { const u32x4 v = kp[c];
            sc += q[c * 8 + 0] * bf2f(v.x & 0xffffu) + q[c * 8 + 1] * bf2f(v.x >> 16) + q[c * 8 + 2] * bf2f(v.y & 0xffffu) + q[c * 8 + 3] * bf2f(v.y >> 16)
                + q[c * 8 + 4] * bf2f(v.z & 0xffffu) + q[c * 8 + 5] * bf2f(v.z >> 16) + q[c * 8 + 6] * bf2f(v.w & 0xffffu) + q[c * 8 + 7] * bf2f(v.w >> 16); }
        if (sc > m) { const float f = exp2f(m - sc); l *= f;
#pragma unroll
            for (int d = 0; d < 64; ++d) o[d] *= f;
            m = sc; }
        const float p = exp2f(sc - m); l += p;
#pragma unroll
        for (int c = 0; c < 8; ++c) { const u32x4 v = vp[c];
            o[c * 8 + 0] += p * bf2f(v.x & 0xffffu); o[c * 8 + 1] += p * bf2f(v.x >> 16); o[c * 8 + 2] += p * bf2f(v.y & 0xffffu); o[c * 8 + 3] += p * bf2f(v.y >> 16);
            o[c * 8 + 4] += p * bf2f(v.z & 0xffffu); o[c * 8 + 5] += p * bf2f(v.z >> 16); o[c * 8 + 6] += p * bf2f(v.w & 0xffffu); o[c * 8 + 7] += p * bf2f(v.w >> 16); }
    }
    const float il = 1.f / l;
    u32x4* op = (u32x4*)(ca + row * 1024 + 512 + h * 64);
#pragma unroll
    for (int c = 0; c < 8; ++c) op[c] = (u32x4){pk2(o[c * 8 + 0] * il, o[c * 8 + 1] * il), pk2(o[c * 8 + 2] * il, o[c * 8 + 3] * il), pk2(o[c * 8 + 4] * il, o[c * 8 + 5] * il), pk2(o[c * 8 + 6] * il, o[c * 8 + 7] * il)};
}

__global__ __launch_bounds__(256) void k_merge(const float* __restrict__ t1, const float* __restrict__ t2, const bf16* __restrict__ gates, bf16* __restrict__ merged) {
    const size_t i = (size_t)blockIdx.x * 256 + threadIdx.x;
    const size_t r = i / 1024; const int c = (int)(i % 1024);
    if (MK_NPRE >= 3) { const unsigned char* gq = (const unsigned char*)gates; const size_t gi = pg8::gate_index((int)r, c); const float sc = ((float)gq[gi] + 0.5f) * (1.f / 256.f), sa = ((float)gq[gi + 8] + 0.5f) * (1.f / 256.f); merged[i] = (bf16)f2bf(sc * t1[i] + sa * t2[i]); }
    else merged[i] = (bf16)f2bf(bf2f(gates[r * 2048 + c]) * t1[i] + bf2f(gates[r * 2048 + 1024 + c]) * t2[i]);
}

__global__ __launch_bounds__(256) void k_postmix(const float* __restrict__ x, const float* __restrict__ y1, const float* __restrict__ ada, const float* __restrict__ g_post, const float* __restrict__ g_pre2,
                                                 const float* __restrict__ w_group, const float* __restrict__ b_group, const float* __restrict__ w_router, const float* __restrict__ b_router,
                                                 float* __restrict__ x1out, bf16* __restrict__ h2, unsigned* __restrict__ ctl, int* __restrict__ list, unsigned* __restrict__ tokinfo) {
    const int lane = threadIdx.x & 63, row = blockIdx.x * 4 + (threadIdx.x >> 6), b = row / SEQ;
    const float* ad = ada + b * 6144;
    f32x4 yv[4], xv[4]; float s = 0.f;
#pragma unroll
    for (int j = 0; j < 4; ++j) { yv[j] = ((const f32x4*)(y1 + (size_t)row * D) + lane)[64 * j]; xv[j] = ((const f32x4*)(x + (size_t)row * D) + lane)[64 * j];
        s += (yv[j].x * yv[j].x + yv[j].y * yv[j].y) + (yv[j].z * yv[j].z + yv[j].w * yv[j].w); }
    const float rstd1 = rsqrtf(wave_sum(s) * (1.f / D) + EPS);
    float s2 = 0.f;
#pragma unroll
    for (int j = 0; j < 4; ++j) { const int c0 = 256 * j + 4 * lane;
        const f32x4 gp = *(const f32x4*)(g_post + c0), gt = *(const f32x4*)(ad + 2048 + c0);
        xv[j] = xv[j] + gt * (yv[j] * rstd1 * gp);
        ((f32x4*)(x1out + (size_t)row * D) + lane)[64 * j] = xv[j];
        s2 += (xv[j].x * xv[j].x + xv[j].y * xv[j].y) + (xv[j].z * xv[j].z + xv[j].w * xv[j].w); }
    const float rstd2 = rsqrtf(wave_sum(s2) * (1.f / D) + EPS);
    float lg[36];
#pragma unroll
    for (int o = 0; o < 36; ++o) lg[o] = 0.f;
    unsigned long long* o8 = (unsigned long long*)(h2 + (size_t)row * D) + lane;
#pragma unroll
    for (int j = 0; j < 4; ++j) { const int c0 = 256 * j + 4 * lane;
        const f32x4 gg = *(const f32x4*)(g_pre2 + c0), sc = *(const f32x4*)(ad + 4096 + c0), sh = *(const f32x4*)(ad + 3072 + c0);
        const f32x4 hv = xv[j] * rstd2 * gg * (1.f + sc) + sh;
        o8[64 * j] = (unsigned long long)pk2(hv.x, hv.y) | ((unsigned long long)pk2(hv.z, hv.w) << 32);
#pragma unroll
        for (int i = 0; i < 4; ++i) { const int c = c0 + i; const float hvv = hv[i];
            const f32x4 wg = *(const f32x4*)(w_group + c * 4);
            lg[0] += hvv * wg.x; lg[1] += hvv * wg.y; lg[2] += hvv * wg.z; lg[3] += hvv * wg.w;
#pragma unroll
            for (int q = 0; q < 8; ++q) { const f32x4 wr = *(const f32x4*)(w_router + c * 32 + q * 4);
                lg[4 + q * 4 + 0] += hvv * wr.x; lg[4 + q * 4 + 1] += hvv * wr.y; lg[4 + q * 4 + 2] += hvv * wr.z; lg[4 + q * 4 + 3] += hvv * wr.w; } } }
#pragma unroll
    for (int o = 0; o < 36; ++o) lg[o] = wave_sum(lg[o]);
    float gl[4];
#pragma unroll
    for (int g = 0; g < 4; ++g) gl[g] = lg[g] + b_group[g];
    int gi = 0; float gm = gl[0];
#pragma unroll
    for (int g = 1; g < 4; ++g) if (gl[g] > gm) { gm = gl[g]; gi = g; }
    float den = 0.f;
#pragma unroll
    for (int g = 0; g < 4; ++g) den += __expf(gl[g] - gm);
    const float grp_p = 1.f / den;
    float in[8];
#pragma unroll
    for (int i = 0; i < 8; ++i) { float v = 0.f;
#pragma unroll
        for (int g = 0; g < 4; ++g) { const float cand = lg[4 + g * 8 + i] + b_router[g * 8 + i]; v = (g == gi) ? cand : v; }
        in[i] = v; }
    int a = 0; float am = in[0];
#pragma unroll
    for (int i = 1; i < 8; ++i) if (in[i] > am) { am = in[i]; a = i; }
    int bidx = -1; float bm = -3.0e38f;
#pragma unroll
    for (int i = 0; i < 8; ++i) if (i != a && in[i] > bm) { bm = in[i]; bidx = i; }
    const float pb = __expf(bm - am), wa = 1.f / (1.f + pb), wb = pb / (1.f + pb);
    if (lane == 0) {
        const int e0 = gi * 8 + a, e1 = gi * 8 + bidx;
        const unsigned p0 = atomicAdd(ctl + CW_CNT + e0, 1u), p1 = atomicAdd(ctl + CW_CNT + e1, 1u);
        list[(size_t)e0 * ECAP + p0] = row; list[(size_t)e1 * ECAP + p1] = row;
        unsigned* ti = tokinfo + (size_t)row * 8;
        ti[0] = (unsigned)e0; ti[1] = p0; ti[2] = (unsigned)e1; ti[3] = p1; ti[4] = __float_as_uint(grp_p * wa); ti[5] = __float_as_uint(grp_p * wb);
    }
}
__global__ void k_offsets(unsigned* ctl) {
    if (threadIdx.x == 0) { unsigned o = 0; for (int e = 0; e < NE; ++e) { ctl[CW_OFF + e] = o; o += (ctl[CW_CNT + e] + 255u) / 256u * 256u; } ctl[CW_OFF + NE] = o; }
}

__global__ __launch_bounds__(256) void k_final(const bf16* __restrict__ y2, const unsigned* __restrict__ tokinfo, const unsigned* __restrict__ ctl, const float* __restrict__ ada, const float* __restrict__ g_post2, float* __restrict__ out) {
    const int lane = threadIdx.x & 63, row = blockIdx.x * 4 + (threadIdx.x >> 6), b = row / SEQ;
    const unsigned* ti = tokinfo + (size_t)row * 8;
    const unsigned s0 = ctl[CW_OFF + ti[0]] + ti[1], s1 = ctl[CW_OFF + ti[2]] + ti[3];
    const float w0 = __uint_as_float(ti[4]), w1 = __uint_as_float(ti[5]);
    f32x4 yv[4]; float s = 0.f;
#pragma unroll
    for (int j = 0; j < 4; ++j) {
        const u32x2 a = ((const u32x2*)(y2 + (size_t)s0 * D) + lane)[64 * j], c = ((const u32x2*)(y2 + (size_t)s1 * D) + lane)[64 * j];
        yv[j].x = w0 * bf2f(a.x & 0xffffu) + w1 * bf2f(c.x & 0xffffu); yv[j].y = w0 * bf2f(a.x >> 16) + w1 * bf2f(c.x >> 16);
        yv[j].z = w0 * bf2f(a.y & 0xffffu) + w1 * bf2f(c.y & 0xffffu); yv[j].w = w0 * bf2f(a.y >> 16) + w1 * bf2f(c.y >> 16);
        s += (yv[j].x * yv[j].x + yv[j].y * yv[j].y) + (yv[j].z * yv[j].z + yv[j].w * yv[j].w); }
    const float rstd = rsqrtf(wave_sum(s) * (1.f / D) + EPS);
#pragma unroll
    for (int j = 0; j < 4; ++j) { const int c0 = 256 * j + 4 * lane;
        const f32x4 gp = *(const f32x4*)(g_post2 + c0), gt = *(const f32x4*)(ada + b * 6144 + 5120 + c0);
        f32x4* op = (f32x4*)(out + (size_t)row * D) + lane;
        op[64 * j] = op[64 * j] + gt * (yv[j] * rstd * gp); }
}

#endif
extern "C" void kernel_launch(void* const* d_in, const int* in_sizes, int n_in, void* d_out, int out_size, void* d_ws, size_t ws_size, hipStream_t stream) {
    static int grid = 0;
    if (grid == 0) {
        if (n_in != 25 || in_sizes[0] != NTOK * D || out_size != NTOK * D || ws_size < WS_END) { fprintf(stderr, "kernel_launch: unexpected problem (n_in %d, ws %zu); nothing launched\n", n_in, ws_size); grid = -1; return; }
        int dev = 0, cus = 0, per_cu = 0;
        if (hipGetDevice(&dev) != hipSuccess || hipDeviceGetAttribute(&cus, hipDeviceAttributeMultiprocessorCount, dev) != hipSuccess) { grid = -1; return; }
        if (hipFuncSetAttribute((const void*)mega_fwd, hipFuncAttributeMaxDynamicSharedMemorySize, LDS_BYTES) != hipSuccess) { fprintf(stderr, "kernel_launch: hipFuncSetAttribute failed\n"); grid = -1; return; }
        if (hipOccupancyMaxActiveBlocksPerMultiprocessor(&per_cu, (const void*)mega_fwd, NTHR, LDS_BYTES) != hipSuccess || per_cu < 1) { fprintf(stderr, "kernel_launch: occupancy query says %d\n", per_cu); grid = -1; return; }
        (void)hipGetLastError();
        if (cus < 256) { fprintf(stderr, "kernel_launch: built for a 256-CU device (one workgroup per CU, 256 workgroups); this one has %d\n", cus); grid = -1; return; }
        grid = 256;
    }
    if (grid < 0) return;
    unsigned char* ws = (unsigned char*)d_ws;
    if (hipMemsetAsync(ws + WS_CTL, 0, CTL_ZERO_BYTES, stream) != hipSuccess) return;
    Args a{};
    for (int i = 0; i < 25; ++i) a.in[i] = (const float*)d_in[i];
    a.out = (float*)d_out; a.ws = ws; a.flags = MK_FLAGS;
#if MK_NPRE == 10 && MK_ONE
    a.ph_lo = 0; a.ph_hi = 10; a.use_bar = 1;
    hipLaunchKernelGGL(mega_fwd, dim3(grid), dim3(NTHR), LDS_BYTES, stream, a);
#else
    for (int p = 0; p < MK_NPRE; ++p) { a.ph_lo = p; a.ph_hi = p + 1; a.use_bar = 0;
#ifdef MK_REP
        if (p == MK_REP) {
            if (p == 9) a.flags |= 4;
#ifdef MK_REPFLAGS
            a.flags |= MK_REPFLAGS;
#endif
            hipLaunchKernelGGL(mega_fwd, dim3(grid), dim3(NTHR), LDS_BYTES, stream, a);
            a.flags = MK_FLAGS;
            if (p == 6) (void)hipMemsetAsync(ws + WS_CTL, 0, 256, stream);
        }
#endif
        hipLaunchKernelGGL(mega_fwd, dim3(grid), dim3(NTHR), LDS_BYTES, stream, a); }
#endif
#if MK_NPRE < 10
    const float* x = (const float*)d_in[0]; const float* w_in = (const float*)d_in[6];
    const float* w_dw = (const float*)d_in[7]; const float* b_dw = (const float*)d_in[8]; const float* cln_g = (const float*)d_in[9]; const float* cln_b = (const float*)d_in[10];
    const float* w_conv_out = (const float*)d_in[11]; const float* q_g = (const float*)d_in[12]; const float* k_g = (const float*)d_in[13]; const float* w_attn_out = (const float*)d_in[14];
    const float* w_out = (const float*)d_in[15]; const float* g_pre_ffn = (const float*)d_in[16]; const float* g_post_ffn = (const float*)d_in[17];
    const float* w_group = (const float*)d_in[18]; const float* b_group = (const float*)d_in[19]; const float* w_router = (const float*)d_in[20]; const float* b_router = (const float*)d_in[21];
    const float* w_e_gate = (const float*)d_in[22]; const float* w_e_up = (const float*)d_in[23]; const float* w_e_down = (const float*)d_in[24];
    float* out = (float*)d_out; unsigned* ctl = (unsigned*)(ws + WS_CTL); float* ada = (float*)(ws + WS_ADA);
    bf16* h1 = (bf16*)(ws + WS_H1); bf16* merged = (bf16*)(ws + WS_H1); bf16* glu = (bf16*)(ws + WS_GLU); bf16* qkv = (bf16*)(ws + WS_QKV);
    bf16* gates = (bf16*)(ws + WS_GATES); bf16* act = (bf16*)(ws + WS_GATES); bf16* ca = (bf16*)(ws + WS_CA); bf16* h2 = (bf16*)(ws + WS_CA);
    float* tmp = (float*)(ws + WS_TMP); int* list = (int*)(ws + WS_LIST); unsigned* tokinfo = (unsigned*)(ws + WS_TOK); bf16* y2 = (bf16*)(ws + WS_Y2);
    if (MK_NPRE <= 0) k_ada<<<dim3(6144 / 256, NB), 256, 0, stream>>>((const float*)d_in[1], (const float*)d_in[2], (const float*)d_in[3], ada);
    if (MK_NPRE <= 1) k_modnorm<<<NTOK / 4, 256, 0, stream>>>(x, (const float*)d_in[4], ada, 0, 1024, h1);
    if (MK_NPRE <= 2) {
        k_gemm<0><<<dim3(NTOK / 64, 1024 / 64), 256, 0, stream>>>(h1, D, nullptr, nullptr, nullptr, w_in + 0, nullptr, INW, tmp, 1024, NTOK, D);
        k_glu<<<NTOK * 512 / 256, 256, 0, stream>>>(tmp, glu);
        k_gemm<0><<<dim3(NTOK / 64, 768 / 64), 256, 0, stream>>>(h1, D, nullptr, nullptr, nullptr, w_in + 1024, nullptr, INW, tmp, 1024, NTOK, D);
        k_qkrope<<<NTOK * 12 / 256, 256, 0, stream>>>(tmp, q_g, k_g, qkv);
        k_gemm<0><<<dim3(NTOK / 64, 1024 / 64), 256, 0, stream>>>(h1, D, nullptr, nullptr, nullptr, w_in + 1792, nullptr, INW, tmp, 1024, NTOK, D);
        k_gate<<<NTOK * 1024 / 256, 256, 0, stream>>>(tmp, gates, 0);
        k_gemm<0><<<dim3(NTOK / 64, 1024 / 64), 256, 0, stream>>>(h1, D, nullptr, nullptr, nullptr, w_in + 2816, nullptr, INW, tmp, 1024, NTOK, D);
        k_gate<<<NTOK * 1024 / 256, 256, 0, stream>>>(tmp, gates, 1024);
    }
    if (MK_NPRE <= 3 || (MK_FLAGS & 1)) k_conv<<<NTOK, 512, 0, stream>>>(glu, w_dw, b_dw, cln_g, cln_b, ca);
    if (MK_NPRE <= 3 || (MK_FLAGS & 2)) k_attn<<<dim3(SEQ / 256, 8, NB), 256, 0, stream>>>(qkv, ca);
    if (MK_NPRE <= 4) {
        k_gemm<0><<<dim3(NTOK / 64, 1024 / 64), 256, 0, stream>>>(ca, 1024, nullptr, nullptr, nullptr, w_conv_out, nullptr, D, tmp, 1024, NTOK, 512);
        k_gemm<0><<<dim3(NTOK / 64, 1024 / 64), 256, 0, stream>>>(ca + 512, 1024, nullptr, nullptr, nullptr, w_attn_out, nullptr, D, out, 1024, NTOK, 512);
        k_merge<<<NTOK * 1024 / 256, 256, 0, stream>>>(tmp, out, gates, merged);
    }
    if (MK_NPRE <= 6) {
        k_gemm<0><<<dim3(NTOK / 64, 1024 / 64), 256, 0, stream>>>(merged, D, nullptr, nullptr, nullptr, w_out, nullptr, D, tmp, 1024, NTOK, D);
        k_postmix<<<NTOK / 4, 256, 0, stream>>>(x, tmp, ada, (const float*)d_in[5], g_pre_ffn, w_group, b_group, w_router, b_router, out, h2, ctl, list, tokinfo);
    }
    k_offsets<<<1, 64, 0, stream>>>(ctl);
    if (MK_NPRE <= 8) {
        for (int e = 0; e < NE; ++e)
            k_gemm<1><<<dim3(NTOK / 64, DE / 64), 256, 0, stream>>>(h2, D, list + (size_t)e * ECAP, (const int*)ctl + CW_CNT + e, (const int*)ctl + CW_OFF + e,
                                                                  w_e_gate + (size_t)e * D * DE, w_e_up + (size_t)e * D * DE, DE, act, DE, 0, D);
        for (int e = 0; e < NE; ++e)
            k_gemm<2><<<dim3(NTOK / 64, D / 64), 256, 0, stream>>>(act, DE, nullptr, (const int*)ctl + CW_CNT + e, (const int*)ctl + CW_OFF + e,
                                                                 w_e_down + (size_t)e * DE * D, nullptr, D, y2, D, 0, DE);
    }
    k_final<<<NTOK / 4, 256, 0, stream>>>(y2, tokinfo, ctl, ada, g_post_ffn, out);
#endif
}
```

```cpp
#define MK_NPRE 10
#define MK_ONE 1
#define MK_FLAGS 0
#include <hip/hip_runtime.h>
#include <hip/hip_bf16.h>
#include <cstdint>
#include <cstdio>
#include <cmath>

#define GAS __attribute__((address_space(1)))
#define LAS __attribute__((address_space(3)))
typedef unsigned short bf16;
typedef float f32x4 __attribute__((ext_vector_type(4)));
typedef float f32x2 __attribute__((ext_vector_type(2)));
typedef unsigned u32x4 __attribute__((ext_vector_type(4)));
typedef unsigned u32x2 __attribute__((ext_vector_type(2)));
typedef short bf16x8 __attribute__((ext_vector_type(8)));
typedef float f32x16 __attribute__((ext_vector_type(16)));

constexpr int NB = 16, SEQ = 2048, D = 1024, NTOK = NB * SEQ;
constexpr int INW = 3840, CW = 512, NE = 32, DE = 512, KS = 31;
constexpr int ECAP = NTOK;
constexpr int MAXSLOT = 73728;
constexpr float EPS = 1e-6f;
constexpr float QSCALE = 0.125f * 1.4426950408889634f;

constexpr size_t MiB = 1u << 20;
constexpr size_t WS_CTL = 0, CTL_ZERO_BYTES = 64 * 1024;
constexpr size_t WS_ADA = 1 * MiB;
constexpr size_t WS_ROPE = WS_ADA + 512 * 1024;
constexpr size_t WS_WR = WS_ADA + 640 * 1024;
constexpr size_t WS_H1 = 2 * MiB;
constexpr size_t WS_GLU = 66 * MiB;
constexpr size_t WS_QKV = 98 * MiB;
constexpr size_t WS_Y1 = 66 * MiB;
constexpr size_t WS_GATES = 146 * MiB;
constexpr size_t WS_X1B = 218 * MiB;
constexpr size_t WS_CA = 282 * MiB;
constexpr size_t WS_WIN = 346 * MiB;
constexpr size_t WS_WCA = WS_WIN + (size_t)INW * D * 2;
constexpr size_t WS_WO = WS_WCA + 2 * MiB;
constexpr size_t WS_W1 = WS_WO + 2 * MiB;
constexpr size_t WS_W2 = WS_W1 + 32 * MiB;
constexpr size_t WS_H2F = WS_W2 + 16 * MiB;
constexpr size_t WS_WINF = WS_H2F + 32 * MiB;
constexpr size_t WS_WEND = WS_WINF + 6 * MiB;
constexpr size_t WS_H1F = 282 * MiB;
constexpr size_t WS_TMP = 346 * MiB;
constexpr size_t WS_LIST = 474 * MiB;
constexpr size_t WS_TOK = 478 * MiB;
constexpr size_t WS_PART = 480 * MiB;
constexpr size_t WS_Y2 = 2 * MiB;
constexpr size_t WS_END = 482 * MiB;
static_assert(WS_WEND <= WS_LIST && WS_Y2 + (size_t)MAXSLOT * D * 2 <= WS_GATES && WS_GATES + (size_t)MAXSLOT * DE * 2 <= WS_X1B && WS_X1B + (size_t)NTOK * D * 2 <= WS_CA && WS_GATES + (size_t)NTOK * 2048 * 2 <= WS_CA && WS_CA + (size_t)NTOK * D * 2 <= WS_WIN, "d_ws map");
constexpr int CW_CNT = 0, CW_OFF = 64, CW_ADA = 128, CW_BAR = 4096;

__device__ __forceinline__ float bf2f(unsigned v) { return __uint_as_float(v << 16); }
__device__ __forceinline__ unsigned f2bf(float f) { unsigned u = __float_as_uint(f); return (u + 0x7fffu + ((u >> 16) & 1u)) >> 16; }
__device__ __forceinline__ unsigned pk2(float lo, float hi) { return f2bf(lo) | (f2bf(hi) << 16); }
__device__ __forceinline__ unsigned cvt_pk_bf16(float lo, float hi) { unsigned r; asm volatile("v_cvt_pk_bf16_f32 %0, %1, %2" : "=v"(r) : "v"(lo), "v"(hi)); return r; }
template <int CTRL> __device__ __forceinline__ float dpp_mov(float v) { return __builtin_bit_cast(float, __builtin_amdgcn_update_dpp(0, __builtin_bit_cast(int, v), CTRL, 0xf, 0xf, true)); }
__device__ __forceinline__ float row16_sum(float v) {
    v += dpp_mov<0xB1>(v);
    v += dpp_mov<0x4E>(v);
    v += dpp_mov<0x141>(v);
    v += dpp_mov<0x140>(v);
    return v;
}
__device__ __forceinline__ float wave_sum(float v) {
    v = row16_sum(v);
    { auto rr = __builtin_amdgcn_permlane16_swap(__float_as_uint(v), __float_as_uint(v), false, false); v = __uint_as_float(rr[0]) + __uint_as_float(rr[1]); }
    { auto rr = __builtin_amdgcn_permlane32_swap(__float_as_uint(v), __float_as_uint(v), false, false); v = __uint_as_float(rr[0]) + __uint_as_float(rr[1]); }
    return v;
}
__device__ __forceinline__ float sigmoidf_(float v) { return 1.f / (1.f + __expf(-v)); }
__device__ __forceinline__ float siluf_(float v) { return v / (1.f + __expf(-v)); }
__device__ __forceinline__ float sig_fast(float v) { return __builtin_amdgcn_rcpf(1.f + __builtin_amdgcn_exp2f(v * -1.4426950408889634f)); }
#define LDS_WAIT() asm volatile("s_waitcnt lgkmcnt(0)" ::: "memory")
#define VM_WAIT() asm volatile("s_waitcnt vmcnt(0)" ::: "memory")

__host__ __device__ __forceinline__ int vmap_win(int n) {
    if (n < 512) return 256 * (n >> 7) + (n & 127);
    if (n < 1024) { const int j = n - 512; return 256 * (j >> 7) + 128 + (j & 127); }
    if (n < 1664) { const int idx = n - 1024, hh = idx >> 6, d = idx & 63, tile = 4 + (hh >> 2), wc = hh & 3, bj = (d >> 4) & 1, e = (d < 32) ? (d & 15) : 16 + (d & 15);
        return 256 * tile + 128 * bj + 32 * wc + e; }
    if (n < 1792) { const int idx = n - 1664, vh = idx >> 6, d = idx & 63; return 256 * 6 + 128 * (d >> 5) + 32 * (2 + vh) + (d & 31); }
    if (n < 2816) { const int j = n - 1792; return 256 * (7 + (j >> 7)) + (j & 127); }
    { const int j = n - 2816; return 256 * (7 + (j >> 7)) + 128 + (j & 127); }
}

namespace pg8 {
constexpr int BM = 256, BK = 64, HALF = 128, HTB = HALF * BK * 2  , STAGE_BYTES = 8 * HTB, NXCD = 8, WGM = 8;
__host__ __device__ __forceinline__ int lds_byte(int r, int c) { const int st = (r >> 4) * 2 + (c >> 5), rr = r & 15, cc = c & 31, ob = rr * 64 + cc * 2; return st * 1024 + (ob ^ (((ob >> 9) & 1) << 5)); }
__host__ __device__ __forceinline__ void stage_rc(int b, int& R, int& C) { const int st = b / 1024, sb = b % 1024, swz = sb ^ (((sb >> 9) & 1) << 5); R = (st >> 1) * 16 + swz / 64; C = (st & 1) * 32 + (swz % 64) / 2; }
__host__ __device__ __forceinline__ int perm32(int rho) { const int n = rho >> 4, i = rho & 15; return 8 * (i >> 2) + 4 * n + (i & 3); }

struct Unit { int pm, pn, e, ord; };

struct StaticOrder {
    const void* Bt; int KB; int nM, nN, nwg, G, c;
    __device__ void init(const void* Bt_, int KB_, int M, int N, int G_, int c_) { Bt = Bt_; KB = KB_; nM = M / BM; nN = N / BM; nwg = nM * nN; G = G_; c = c_; }
    __device__ __forceinline__ bool next(int i, Unit& u) const {
        const long L = (long)i * G + c; if (L >= nwg) return false;
        int wgid = (int)L; { const int q = nwg / NXCD, r = nwg % NXCD, xcd = wgid % NXCD, off = wgid / NXCD; wgid = (xcd < r ? xcd * (q + 1) : r * (q + 1) + (xcd - r) * q) + off; }
        const int nig = WGM * nN, gid = wgid / nig, fm = gid * WGM, gsz = (nM - fm) < WGM ? (nM - fm) : WGM;
        u.pm = fm + ((wgid % nig) % gsz); u.pn = (wgid % nig) / gsz; u.e = 0; u.ord = i; return true;
    }
    static constexpr bool GATHER = false;
    __device__ __forceinline__ int arow(const Unit& u, int r) const { return u.pm * BM + r; }
    __device__ __forceinline__ const char* bbase(const Unit& u) const { return (const char*)Bt + (size_t)u.pn * BM * KB; }
};

typedef int v8i32 __attribute__((ext_vector_type(8)));
typedef int v4i32 __attribute__((ext_vector_type(4)));
__device__ __forceinline__ void mfma_fp8_inplace(f32x4& d, const v8i32 a, const v8i32 b, const int scale) {
    asm volatile("v_mfma_scale_f32_16x16x128_f8f6f4 %0, %1, %2, %0, %3, %3 op_sel_hi:[0,0,0]" : "+v"(d) : "v"(a), "v"(b), "v"(scale));
}
__device__ __forceinline__ void mfma_bf16_inplace(f32x4& d, const bf16x8 a, const bf16x8 b) {
    asm volatile("v_mfma_f32_16x16x32_bf16 %0, %1, %2, %0" : "+v"(d) : "v"(a), "v"(b));
}
template <class Epi, class Sched, bool ALIGN_EPI, int DT = 0>
__device__ __forceinline__ void gemm_phase(LAS unsigned char* lds, const void* A, int ldaB_, int KB, const Sched& S, const Epi& E, const void* A8 = nullptr, int kbytes = 0) {
    const int tid = threadIdx.x, wid = __builtin_amdgcn_readfirstlane(tid >> 6), lane = tid & 63, wr = wid >> 2, wc = wid & 3, fr = lane & 15, fq = lane >> 4;
    const int nt_full = (kbytes ? kbytes : KB) / (BK * 2);
    const unsigned ldaB = (unsigned)ldaB_;
    unsigned voffA[2], voffB[2];
#pragma unroll
    for (int i = 0; i < 2; ++i) { int R, C; stage_rc(tid * 16 + i * 8192, R, C); const int Rb = (R & ~31) + perm32(R & 31);
        voffA[i] = (unsigned)R * ldaB + (unsigned)C * 2u; voffB[i] = (unsigned)(Rb * KB + C * 2); }
    const size_t kstep = (size_t)(BK * 2);
    const size_t hstep = (size_t)HALF * KB;
    const size_t hstepA = (size_t)HALF * ldaB;
    const unsigned ldsw = (unsigned)wid * 1024u;
    const int aoff = lds_byte(wr * 64 + fr, fq * 8), boff = lds_byte(wc * 32 + fr, fq * 8);
#define PG8_SA(b, h) (((b) * 2 + (h)) * HTB)
#define PG8_SB(b, h) ((4 + (b) * 2 + (h)) * HTB)
#define PG8_STAGE(bufoff, gbase, voff) do { _Pragma("unroll") for (int _i = 0; _i < 2; ++_i) \
        __builtin_amdgcn_global_load_lds((const unsigned*)((const char*)(gbase) + (voff)[_i]), (LAS unsigned*)(lds + (bufoff) + ldsw + _i * 8192), 16, 0, 0); } while (0)
#define PG8_LDA(dst, b, h) do { _Pragma("unroll") for (int m = 0; m < 4; ++m) _Pragma("unroll") for (int k = 0; k < 2; ++k) dst[m][k] = *(const LAS bf16x8*)(lds + PG8_SA(b, h) + aoff + m * 2048 + k * 1024); } while (0)
#define PG8_LDB(dst, b, h) do { _Pragma("unroll") for (int n = 0; n < 2; ++n) _Pragma("unroll") for (int k = 0; k < 2; ++k) dst[n][k] = *(const LAS bf16x8*)(lds + PG8_SB(b, h) + boff + n * 2048 + k * 1024); } while (0)
#define PG8_CAT(x) __builtin_shufflevector(__builtin_bit_cast(v4i32, (x)[0]), __builtin_bit_cast(v4i32, (x)[1]), 0, 1, 2, 3, 4, 5, 6, 7)
#define PG8_MMA(ai, bj, At, Bt) do { __builtin_amdgcn_s_setprio(1); \
        if (DT == 1 || (DT == 2 && f8cur)) { _Pragma("unroll") for (int m = 0; m < 4; ++m) _Pragma("unroll") for (int n = 0; n < 2; ++n) \
            mfma_fp8_inplace(acc[ai][bj][m][n], PG8_CAT(Bt[n]), PG8_CAT(At[m]), one_scale); } \
        else { _Pragma("unroll") for (int m = 0; m < 4; ++m) _Pragma("unroll") for (int n = 0; n < 2; ++n) _Pragma("unroll") for (int k = 0; k < 2; ++k) \
            { if constexpr (DT == 2) mfma_bf16_inplace(acc[ai][bj][m][n], Bt[n][k], At[m][k]); else acc[ai][bj][m][n] = __builtin_amdgcn_mfma_f32_16x16x32_bf16(Bt[n][k], At[m][k], acc[ai][bj][m][n], 0, 0, 0); } } \
        __builtin_amdgcn_s_setprio(0); } while (0)
#define PG8_WAIT_V(n) asm volatile("s_waitcnt vmcnt(" #n ")" ::: "memory")
#define PG8_WAIT_L(n) asm volatile("s_waitcnt lgkmcnt(" #n ")" ::: "memory")
#define PG8_BAR __builtin_amdgcn_s_barrier()
#define PG8_SCHED __builtin_amdgcn_sched_barrier(0)
#define PG8_MKVA(dst, u) do { _Pragma("unroll") for (int _h = 0; _h < 2; ++_h) _Pragma("unroll") for (int _p = 0; _p < 2; ++_p) { int _R, _C; stage_rc(tid * 16 + _p * 8192, _R, _C); \
        dst[_h][_p] = (unsigned)S.arow(u, _h * HALF + _R) * ldaB + (unsigned)_C * 2u; } } while (0)
#define PG8_STAGE_AC(bufoff, h, kofs) do { if constexpr (Sched::GATHER) PG8_STAGE(bufoff, Ab + (kofs), vA[h]); else PG8_STAGE(bufoff, cA + (h) * hstepA + (kofs), voffA); } while (0)
#define PG8_STAGE_AN(bufoff, h, kofs) do { if constexpr (Sched::GATHER) PG8_STAGE(bufoff, Ab + (kofs), nvA[h]); else PG8_STAGE(bufoff, nA + (h) * hstepA + (kofs), voffA); } while (0)
#define PG8_STAGE_A23(bufoff, h, w) do { if (last) PG8_STAGE_AN(bufoff, h, (size_t)(w) * kstep); else PG8_STAGE_AC(bufoff, h, (size_t)(t + 2 + (w)) * kstep); } while (0)
    Unit cur, nxt; int ui = 0;
    if (!S.next(0, cur)) return;
    f32x4 acc[2][2][4][2];
#pragma unroll
    for (int a = 0; a < 2; ++a)
#pragma unroll
        for (int b = 0; b < 2; ++b)
#pragma unroll
            for (int m = 0; m < 4; ++m)
#pragma unroll
                for (int n = 0; n < 2; ++n) acc[a][b][m][n] = (f32x4){0.f, 0.f, 0.f, 0.f};
    bf16x8 At[4][2], B0[2][2], B1[2][2];
    int one_scale = 0x7f7f7f7f; asm volatile("" : "+v"(one_scale));
    unsigned vA[2][2], nvA[2][2];
    const char* const Ab = (const char*)A;
    const char* cA = Ab; const char* nA = Ab;
    bool f8cur = (DT == 2) && cur.e != 0; int nt = (DT == 2 && f8cur) ? (nt_full >> 1) : nt_full;
#define PG8_ABASE(u) ((DT == 2 && (u).e != 0) ? (const char*)A8 : Ab)
    if constexpr (Sched::GATHER) { PG8_MKVA(vA, cur); } else { cA = PG8_ABASE(cur) + (size_t)S.arow(cur, 0) * ldaB; }
    const char* cB = S.bbase(cur);
    PG8_STAGE(PG8_SB(0, 0), cB, voffB); PG8_STAGE(PG8_SB(0, 1), cB + hstep, voffB); PG8_STAGE_AC(PG8_SA(0, 0), 0, 0); PG8_STAGE_AC(PG8_SA(0, 1), 1, 0);
    if (wr == 1) PG8_BAR;
    PG8_WAIT_V(2); PG8_BAR;
    PG8_STAGE(PG8_SB(1, 0), cB + kstep, voffB); PG8_STAGE_AC(PG8_SA(1, 0), 0, kstep); PG8_STAGE(PG8_SB(1, 1), cB + hstep + kstep, voffB);
    PG8_WAIT_V(6); PG8_BAR;
    for (;;) {
        const bool has_next = S.next(ui + 1, nxt);
        const char* nB = has_next ? S.bbase(nxt) : cB;
        if constexpr (!Sched::GATHER) nA = has_next ? PG8_ABASE(nxt) + (size_t)S.arow(nxt, 0) * ldaB : cA;
#pragma unroll 1
        for (int t = 0; t < nt; t += 2) {
            const bool last = (t == nt - 2);
            if constexpr (Epi::MID) { if (t == (nt >> 1)) { if (wr == 0) PG8_BAR; if constexpr (DT != 0) asm volatile("s_nop 15\n\ts_nop 15" ::: "memory"); E.mid(acc, cur, wr, wc, fr, fq); if (wr == 1) PG8_BAR; } }
            if constexpr (Sched::GATHER) { if (last) { if (has_next) { PG8_MKVA(nvA, nxt); } else {
#pragma unroll
                    for (int h = 0; h < 2; ++h)
#pragma unroll
                        for (int p = 0; p < 2; ++p) nvA[h][p] = vA[h][p]; } } }
            const char* b2 = last ? nB : cB + (size_t)(t + 2) * kstep; const char* b3 = b2 + kstep;
            PG8_LDB(B0, 0, 0); PG8_LDB(B1, 0, 1); PG8_SCHED; PG8_LDA(At, 0, 0); PG8_STAGE_AC(PG8_SA(1, 1), 1, (size_t)(t + 1) * kstep);
            PG8_WAIT_V(8); PG8_WAIT_L(0); PG8_BAR; PG8_MMA(0, 0, At, B0); PG8_MMA(0, 1, At, B1); PG8_BAR; PG8_SCHED;
            PG8_LDA(At, 0, 1); PG8_STAGE(PG8_SB(0, 0), b2, voffB); PG8_STAGE(PG8_SB(0, 1), b2 + hstep, voffB); PG8_STAGE_A23(PG8_SA(0, 0), 0, 0);
            PG8_WAIT_V(8); PG8_WAIT_L(0); PG8_BAR; PG8_MMA(1, 0, At, B0); PG8_MMA(1, 1, At, B1); PG8_BAR; PG8_SCHED;
            PG8_LDB(B0, 1, 0); PG8_LDB(B1, 1, 1); PG8_SCHED; PG8_LDA(At, 1, 0); PG8_STAGE_A23(PG8_SA(0, 1), 1, 0);
            PG8_WAIT_V(8); PG8_WAIT_L(0); PG8_BAR; PG8_MMA(0, 0, At, B0); PG8_MMA(0, 1, At, B1); PG8_BAR; PG8_SCHED;
            PG8_LDA(At, 1, 1); PG8_STAGE(PG8_SB(1, 0), b3, voffB); PG8_STAGE(PG8_SB(1, 1), b3 + hstep, voffB); PG8_STAGE_A23(PG8_SA(1, 0), 0, 1);
            PG8_WAIT_V(8); PG8_WAIT_L(0); PG8_BAR; PG8_MMA(1, 0, At, B0); PG8_MMA(1, 1, At, B1); PG8_BAR; PG8_SCHED;
        }
        if constexpr (ALIGN_EPI) { if (wr == 0) PG8_BAR; }
        if constexpr (DT != 0) asm volatile("s_nop 15\n\ts_nop 15" ::: "memory");
        E(acc, cur, wr, wc, fr, fq);
        if (!has_next) break;
#pragma unroll
        for (int a = 0; a < 2; ++a)
#pragma unroll
            for (int b = 0; b < 2; ++b)
#pragma unroll
                for (int m = 0; m < 4; ++m)
#pragma unroll
                    for (int n = 0; n < 2; ++n) acc[a][b][m][n] = (f32x4){0.f, 0.f, 0.f, 0.f};
        cur = nxt; cB = nB; ++ui;
        if constexpr (DT == 2) { f8cur = cur.e != 0; nt = f8cur ? (nt_full >> 1) : nt_full; }
        if constexpr (Sched::GATHER) {
#pragma unroll
            for (int h = 0; h < 2; ++h)
#pragma unroll
                for (int p = 0; p < 2; ++p) vA[h][p] = nvA[h][p]; } else cA = nA;
        if constexpr (ALIGN_EPI) { if (wr == 1) PG8_BAR; }
    }
    PG8_WAIT_V(0);
    if constexpr (!ALIGN_EPI) { if (wr == 0) PG8_BAR; }
    PG8_BAR;
#undef PG8_ABASE
#undef PG8_STAGE_AC
#undef PG8_STAGE_AN
#undef PG8_STAGE_A23
#undef PG8_SA
#undef PG8_SB
#undef PG8_STAGE
#undef PG8_LDA
#undef PG8_LDB
#undef PG8_MMA
#undef PG8_WAIT_V
#undef PG8_WAIT_L
#undef PG8_BAR
#undef PG8_SCHED
#undef PG8_MKVA
#undef PG8_CAT
}
}
namespace pg8 {
__host__ __device__ __forceinline__ size_t gate_frag_base(int pm, int t, int w) { return ((size_t)((pm * 8 + t) * 8 + w) * 8) * 1024; }
__host__ __device__ __forceinline__ size_t gate_index(int row, int col) {
    const int pm = row >> 8, t = col >> 7, w = 4 * ((row >> 6) & 1) + ((col >> 5) & 3), k = 4 * ((row >> 7) & 1) + ((row >> 4) & 3), l = 16 * ((col >> 3) & 3) + (row & 15);
    return gate_frag_base(pm, t, w) + (size_t)k * 1024 + l * 16 + (col & 7);
}
__device__ __forceinline__ unsigned q8x4(float a, float b, float c, float d) {
    unsigned r = __builtin_amdgcn_cvt_pk_u8_f32(a * 256.f - 0.5f, 0, 0u); r = __builtin_amdgcn_cvt_pk_u8_f32(b * 256.f - 0.5f, 1, r);
    r = __builtin_amdgcn_cvt_pk_u8_f32(c * 256.f - 0.5f, 2, r); return __builtin_amdgcn_cvt_pk_u8_f32(d * 256.f - 0.5f, 3, r);
}
__device__ __forceinline__ void dq8x4(unsigned w, float (&f)[4]) { f[0] = (float)(w & 0xffu) + 0.5f; f[1] = (float)((w >> 8) & 0xffu) + 0.5f; f[2] = (float)((w >> 16) & 0xffu) + 0.5f; f[3] = (float)(w >> 24) + 0.5f; }
constexpr float WSCIN = 32.f, WSCO = 32.f, MSC = 8.f, WSCCA = 16.f, CSC = 8.f, ASC = 32.f;
__device__ __forceinline__ unsigned pk4_fp8(float a, float b, float c, float d) { int r = __builtin_amdgcn_cvt_pk_fp8_f32(a, b, 0, false); r = __builtin_amdgcn_cvt_pk_fp8_f32(c, d, r, true); return (unsigned)r; }
struct EpiP2 {
    static constexpr bool MID = false;
    bf16* glu; bf16* qkv; bf16* gates; const float* qg; const float* kg; const f32x2* rope;
    __device__ __forceinline__ void operator()(const f32x4 (&acc)[2][2][4][2], const Unit& u, int wr, int wc, int fr, int fq) const {
        const int row0 = u.pm * BM + wr * 64 + fr;
        if (u.pn < 4) {
#pragma unroll
            for (int ai = 0; ai < 2; ++ai)
#pragma unroll
                for (int m = 0; m < 4; ++m) { const size_t row = (size_t)(row0 + ai * HALF + m * 16);
                    constexpr float isg = 1.f / WSCIN;
                    const f32x4 a0 = acc[ai][0][m][0] * isg, a1 = acc[ai][0][m][1] * isg, g0 = acc[ai][1][m][0] * isg, g1 = acc[ai][1][m][1] * isg;
                    u32x4 w; w.x = cvt_pk_bf16(a0[0] * sig_fast(g0[0]), a0[1] * sig_fast(g0[1])); w.y = cvt_pk_bf16(a0[2] * sig_fast(g0[2]), a0[3] * sig_fast(g0[3]));
                    w.z = cvt_pk_bf16(a1[0] * sig_fast(g1[0]), a1[1] * sig_fast(g1[1])); w.w = cvt_pk_bf16(a1[2] * sig_fast(g1[2]), a1[3] * sig_fast(g1[3]));
                    *(u32x4*)(glu + row * CW + u.pn * 128 + wc * 32 + fq * 8) = w; }
        } else if (u.pn < 7) {
            const int hs = (u.pn - 4) * 4 + wc;
            if (hs >= 10) {
#pragma unroll
                for (int ai = 0; ai < 2; ++ai)
#pragma unroll
                    for (int m = 0; m < 4; ++m) { const size_t row = (size_t)(row0 + ai * HALF + m * 16);
#pragma unroll
                        for (int bj = 0; bj < 2; ++bj) { const f32x4 v0 = acc[ai][bj][m][0], v1 = acc[ai][bj][m][1];
                            u32x4 w; w.x = cvt_pk_bf16(v0[0], v0[1]); w.y = cvt_pk_bf16(v0[2], v0[3]); w.z = cvt_pk_bf16(v1[0], v1[1]); w.w = cvt_pk_bf16(v1[2], v1[3]);
                            *(u32x4*)(qkv + row * 768 + hs * 64 + bj * 32 + fq * 8) = w; } }
            } else {
                const float* g = hs < 8 ? qg : kg; const float osc = hs < 8 ? QSCALE : 1.f;
                const int dbase = fq < 2 ? 8 * fq : 8 * fq + 16;
                float g1[8], g2[8];
#pragma unroll
                for (int i = 0; i < 8; ++i) { g1[i] = g[dbase + i] * osc; g2[i] = g[dbase + 16 + i] * osc; }
#pragma unroll
                for (int ai = 0; ai < 2; ++ai)
#pragma unroll
                    for (int m = 0; m < 4; ++m) { const int rowi = row0 + ai * HALF + m * 16; const size_t row = (size_t)rowi;
                        const int s = rowi & (SEQ - 1); const int tabrow = fq < 2 ? (s >> 6) : 32 + (s & 63);
                        const f32x2* tp = rope + tabrow * 16 + 8 * (fq & 1);
                        float ss = 0.f;
#pragma unroll
                        for (int bj = 0; bj < 2; ++bj)
#pragma unroll
                            for (int n = 0; n < 2; ++n) { const f32x4 v = acc[ai][bj][m][n]; ss += (v[0] * v[0] + v[1] * v[1]) + (v[2] * v[2] + v[3] * v[3]); }
                        ss += __shfl_xor(ss, 16); ss += __shfl_xor(ss, 32);
                        const float rstd = rsqrtf(ss * (1.f / 64.f) + EPS);
                        float o1[8], o2[8];
#pragma unroll
                        for (int n = 0; n < 2; ++n)
#pragma unroll
                            for (int j = 0; j < 4; ++j) { const f32x2 cs = tp[4 * n + j];
                                const float x1 = acc[ai][0][m][n][j] * rstd * g1[4 * n + j], x2 = acc[ai][1][m][n][j] * rstd * g2[4 * n + j];
                                o1[4 * n + j] = x1 * cs.x - x2 * cs.y; o2[4 * n + j] = x2 * cs.x + x1 * cs.y; }
                        u32x4 w1, w2;
                        w1.x = cvt_pk_bf16(o1[0], o1[1]); w1.y = cvt_pk_bf16(o1[2], o1[3]); w1.z = cvt_pk_bf16(o1[4], o1[5]); w1.w = cvt_pk_bf16(o1[6], o1[7]);
                        w2.x = cvt_pk_bf16(o2[0], o2[1]); w2.y = cvt_pk_bf16(o2[2], o2[3]); w2.z = cvt_pk_bf16(o2[4], o2[5]); w2.w = cvt_pk_bf16(o2[6], o2[7]);
                        bf16* dst = qkv + row * 768 + hs * 64 + dbase;
                        *(u32x4*)dst = w1; *(u32x4*)(dst + 16) = w2; }
            }
        } else {
            unsigned char* gr = (unsigned char*)gates + gate_frag_base(u.pm, u.pn - 7, wr * 4 + wc) + (fq * 16 + fr) * 16;
#pragma unroll
            for (int ai = 0; ai < 2; ++ai)
#pragma unroll
                for (int m = 0; m < 4; ++m) {
                    float sc[8], sa[8];
#pragma unroll
                    for (int n = 0; n < 2; ++n)
#pragma unroll
                        for (int j = 0; j < 4; ++j) {
                            const float dc = 1.f + __builtin_amdgcn_exp2f(acc[ai][0][m][n][j] * (-1.4426950408889634f / WSCIN)), da = 1.f + __builtin_amdgcn_exp2f(acc[ai][1][m][n][j] * (-1.4426950408889634f / WSCIN));
                            const float rinv = __builtin_amdgcn_rcpf(dc * da); sc[4 * n + j] = rinv * da; sa[4 * n + j] = rinv * dc; }
                    *(u32x4*)(gr + (ai * 4 + m) * 1024) = (u32x4){q8x4(sc[0], sc[1], sc[2], sc[3]), q8x4(sc[4], sc[5], sc[6], sc[7]), q8x4(sa[0], sa[1], sa[2], sa[3]), q8x4(sa[4], sa[5], sa[6], sa[7])}; }
        }
    }
};
__device__ __forceinline__ void unpack8(const u32x4 w, float (&f)[8]) {
    f[0] = bf2f(w.x & 0xffffu); f[1] = bf2f(w.x >> 16); f[2] = bf2f(w.y & 0xffffu); f[3] = bf2f(w.y >> 16);
    f[4] = bf2f(w.z & 0xffffu); f[5] = bf2f(w.z >> 16); f[6] = bf2f(w.w & 0xffffu); f[7] = bf2f(w.w >> 16);
}
struct EpiP4 {
    static constexpr bool MID = true;
    const bf16* gates; bf16* merged;
    __device__ __forceinline__ void mid(f32x4 (&acc)[2][2][4][2], const Unit& u, int wr, int wc, int fr, int fq) const {
        asm volatile("" ::: "memory");
        u32x4 rr[2][8];
#pragma unroll
        for (int bj = 0; bj < 2; ++bj) { const unsigned char* gp = (const unsigned char*)gates + gate_frag_base(u.pm, 2 * u.pn + bj, wr * 4 + wc) + (fq * 16 + fr) * 16;
#pragma unroll
            for (int k = 0; k < 8; ++k) rr[bj][k] = *(const u32x4*)(gp + k * 1024); }
#pragma unroll
        for (int bj = 0; bj < 2; ++bj)
#pragma unroll
            for (int k = 0; k < 8; ++k)
#pragma unroll
                for (int n = 0; n < 2; ++n) { float c[4], a[4]; dq8x4(n ? rr[bj][k].y : rr[bj][k].x, c); dq8x4(n ? rr[bj][k].w : rr[bj][k].z, a);
#pragma unroll
                    for (int j = 0; j < 4; ++j) acc[k >> 2][bj][k & 3][n][j] *= (c[j] * (ASC / CSC)) * __builtin_amdgcn_rcpf(a[j]); }
        asm volatile("" ::: "memory");
    }
    __device__ __forceinline__ void operator()(const f32x4 (&acc)[2][2][4][2], const Unit& u, int wr, int wc, int fr, int fq) const {
        const int row0 = u.pm * BM + wr * 64 + fr, col0 = u.pn * BM + wc * 32 + fq * 8;
        u32x2 rr[2][8];
#pragma unroll
        for (int bj = 0; bj < 2; ++bj) { const unsigned char* gp = (const unsigned char*)gates + gate_frag_base(u.pm, 2 * u.pn + bj, wr * 4 + wc) + (fq * 16 + fr) * 16 + 8;
#pragma unroll
            for (int k = 0; k < 8; ++k) rr[bj][k] = *(const u32x2*)(gp + k * 1024); }
        asm volatile("" ::: "memory");
#pragma unroll
        for (int bj = 0; bj < 2; ++bj)
#pragma unroll
            for (int k = 0; k < 8; ++k) { const size_t row = (size_t)(row0 + (k >> 2) * HALF + (k & 3) * 16);
                float a0[4], a1[4]; dq8x4(rr[bj][k].x, a0); dq8x4(rr[bj][k].y, a1); constexpr float s = MSC / (256.f * ASC * WSCCA);
                const f32x4 v0 = acc[k >> 2][bj][k & 3][0] * s, v1 = acc[k >> 2][bj][k & 3][1] * s;
                *(u32x2*)((unsigned char*)merged + row * D + col0 + bj * HALF) = (u32x2){pk4_fp8(v0[0] * a0[0], v0[1] * a0[1], v0[2] * a0[2], v0[3] * a0[3]), pk4_fp8(v1[0] * a1[0], v1[1] * a1[1], v1[2] * a1[2], v1[3] * a1[3])}; }
    }
};
struct EpiP5 {
    static constexpr bool MID = false;
    bf16* y1; float* part;
    __device__ __forceinline__ void operator()(const f32x4 (&acc)[2][2][4][2], const Unit& u, int wr, int wc, int fr, int fq) const {
        const int row0 = u.pm * BM + wr * 64 + fr, col0 = u.pn * BM + wc * 32 + fq * 8;
#pragma unroll
        for (int ai = 0; ai < 2; ++ai)
#pragma unroll
            for (int m = 0; m < 4; ++m) { const size_t row = (size_t)(row0 + ai * HALF + m * 16); float ss = 0.f;
#pragma unroll
                for (int bj = 0; bj < 2; ++bj) { constexpr float is5 = 1.f / (WSCO * MSC); const f32x4 v0 = acc[ai][bj][m][0] * is5, v1 = acc[ai][bj][m][1] * is5;
                    ss += (v0[0] * v0[0] + v0[1] * v0[1]) + (v0[2] * v0[2] + v0[3] * v0[3]) + (v1[0] * v1[0] + v1[1] * v1[1]) + (v1[2] * v1[2] + v1[3] * v1[3]);
                    u32x4 w; w.x = cvt_pk_bf16(v0[0], v0[1]); w.y = cvt_pk_bf16(v0[2], v0[3]); w.z = cvt_pk_bf16(v1[0], v1[1]); w.w = cvt_pk_bf16(v1[2], v1[3]);
                    *(u32x4*)(y1 + row * D + col0 + bj * HALF) = w; }
                ss += __shfl_xor(ss, 16); ss += __shfl_xor(ss, 32);
                if (fq == 0) part[row * 16 + u.pn * 4 + wc] = ss; }
    }
};
constexpr float WSC1 = 32.f, WSC2 = 16.f;
struct EpiMoe1 {
    static constexpr bool MID = false;
    unsigned char* act;
    __device__ __forceinline__ void operator()(const f32x4 (&acc)[2][2][4][2], const Unit& u, int wr, int wc, int fr, int fq) const {
        const int row0 = u.pm * BM + wr * 64 + fr; constexpr float is = 1.f / WSC1;
#pragma unroll
        for (int ai = 0; ai < 2; ++ai)
#pragma unroll
            for (int m = 0; m < 4; ++m) { const size_t row = (size_t)(row0 + ai * HALF + m * 16);
                const f32x4 g0 = acc[ai][0][m][0] * is, g1 = acc[ai][0][m][1] * is, u0 = acc[ai][1][m][0] * is, u1 = acc[ai][1][m][1] * is;
                u32x2 w; w.x = pk4_fp8(g0[0] * sig_fast(g0[0]) * u0[0], g0[1] * sig_fast(g0[1]) * u0[1], g0[2] * sig_fast(g0[2]) * u0[2], g0[3] * sig_fast(g0[3]) * u0[3]);
                w.y = pk4_fp8(g1[0] * sig_fast(g1[0]) * u1[0], g1[1] * sig_fast(g1[1]) * u1[1], g1[2] * sig_fast(g1[2]) * u1[2], g1[3] * sig_fast(g1[3]) * u1[3]);
                *(u32x2*)(act + row * DE + u.pn * 128 + wc * 32 + fq * 8) = w; }
    }
};
constexpr float YSC = 8.f;
struct EpiMoe2 {
    static constexpr bool MID = false;
    unsigned char* y2;
    __device__ __forceinline__ void operator()(const f32x4 (&acc)[2][2][4][2], const Unit& u, int wr, int wc, int fr, int fq) const {
        const int row0 = u.pm * BM + wr * 64 + fr, col0 = u.pn * BM + wc * 32 + fq * 8; constexpr float is = YSC / WSC2;
#pragma unroll
        for (int ai = 0; ai < 2; ++ai)
#pragma unroll
            for (int m = 0; m < 4; ++m) { const size_t row = (size_t)(row0 + ai * HALF + m * 16);
#pragma unroll
                for (int bj = 0; bj < 2; ++bj) { const f32x4 v0 = acc[ai][bj][m][0] * is, v1 = acc[ai][bj][m][1] * is;
                    *(u32x2*)(y2 + row * D + col0 + bj * HALF) = (u32x2){pk4_fp8(v0[0], v0[1], v0[2], v0[3]), pk4_fp8(v1[0], v1[1], v1[2], v1[3])}; } }
    }
};
constexpr int MOE_MAXU = 8;
template <bool GATHER_> struct MoeOrder {
    static constexpr bool GATHER = GATHER_;
    const LAS int* UT; const LAS int* RT; const void* W; size_t estride; int KB;
    __device__ __forceinline__ bool next(int i, Unit& u) const {
        if (i >= MOE_MAXU) return false;
        const int v = __builtin_amdgcn_readfirstlane(UT[i * 4 + 3]); if (!v) return false;
        u.pm = __builtin_amdgcn_readfirstlane(UT[i * 4 + 0]); u.pn = __builtin_amdgcn_readfirstlane(UT[i * 4 + 1]); u.e = __builtin_amdgcn_readfirstlane(UT[i * 4 + 2]); u.ord = i; return true;
    }
    __device__ __forceinline__ int arow(const Unit& u, int r) const { return GATHER ? RT[u.ord * 256 + r] : u.pm * BM + r; }
    __device__ __forceinline__ const char* bbase(const Unit& u) const { return (const char*)W + (size_t)u.e * estride + (size_t)u.pn * BM * KB; }
};
__host__ __device__ __forceinline__ int winf_row(int vrow) { return vrow < 1024 ? vrow : vrow - 768; }
template <bool F8> struct P2Order {
    static constexpr bool GATHER = false;
    const char* W; int v, G;
    __device__ __forceinline__ bool next(int i, Unit& u) const {
        u.ord = i; u.e = F8 ? 1 : 0;
        if (!F8) { int L;
            if (G == 256) { if (i >= (v < 128 ? 2 : 1)) return false; L = 256 * i + v; } else { L = i * G + v; if (L >= 384) return false; }
            u.pm = L / 3; u.pn = 4 + (L - 3 * u.pm); return true; }
        int f;
        if (G == 256) { if (i >= (v < 128 ? 5 : 7)) return false; f = v >= 128 ? (v - 128) * 7 + i : 896 + 5 * v + i; } else { f = i * G + v; if (f >= 1536) return false; }
        u.pm = f / 12; const int t = f - 12 * u.pm; u.pn = t < 4 ? t : t + 3; return true;
    }
    __device__ __forceinline__ int arow(const Unit& u, int r) const { return u.pm * BM + r; }
    __device__ __forceinline__ const char* bbase(const Unit& u) const { return W + (size_t)(F8 ? winf_row(u.pn * BM) : u.pn * BM) * 2048; }
};
struct PanelOrder {
    static constexpr bool GATHER = false;
    const char* W; int v, G, KB;
    __device__ __forceinline__ bool next(int i, Unit& u) const { const int L = G * i + v; if (L >= (NTOK / BM) * 4) return false; u.pm = L >> 2; u.pn = L & 3; u.e = 0; u.ord = i; return true; }
    __device__ __forceinline__ int arow(const Unit& u, int r) const { return u.pm * BM + r; }
    __device__ __forceinline__ const char* bbase(const Unit& u) const { return W + (size_t)u.pn * BM * KB; }
};
}
namespace attn_body {
using bf16=__hip_bfloat16;
using bf16x8=__attribute__((ext_vector_type(8)))short;
using s16x4=__attribute__((ext_vector_type(4)))short;
using f32x16=__attribute__((ext_vector_type(16)))float;
using u32x4=__attribute__((ext_vector_type(4)))unsigned;
constexpr int BATCH=16,NHEAD=8,SEQ=2048,D=64,DM=768,OPITCH=1024;
constexpr int NW=8,QBLK=32,QB=QBLK*NW,KVBLK=64,NQB=SEQ/QB;
constexpr int ATTN_UNIT_ROWS=QB;
__device__ __forceinline__ int crow(int r,int hi){return (r&3)+8*(r>>2)+4*hi;}
#define SBAR() __builtin_amdgcn_sched_barrier(0)
__device__ __forceinline__ void cmask(f32x16&p0,f32x16&p1,int jb,int qrel,int hi){
  const float NEG=-INFINITY; int kb=64*jb+4*hi;
  #pragma unroll
  for(int r=0;r<16;++r){int kv=kb+(r&3)+8*(r>>2); if(kv>qrel)p0[r]=NEG; if(kv+32>qrel)p1[r]=NEG;}
}

constexpr int NSLOT=3, SLOTB=8192;
constexpr int LDS_K=0, LDS_V=NSLOT*SLOTB, LDS_WS=2*NSLOT*SLOTB, LDS_OST=LDS_WS+NW*64*4, LDS_BYTES=LDS_OST+NW*4096;
constexpr float C2=0.125f*1.4426950408889634f;
__device__ __forceinline__ void glds16(const void*gsrc,unsigned lds_dst){unsigned keep;
  asm volatile("s_mov_b32 %0, m0\n\ts_mov_b32 m0, %2\n\ts_nop 0\n\tglobal_load_lds_dwordx4 %1, off\n\ts_mov_b32 m0, %0":"=&s"(keep):"v"(gsrc),"s"(lds_dst):"memory");}
__device__ __forceinline__ float max3f(float a,float b,float c){float r;asm("v_max3_f32 %0, %1, %2, %3":"=v"(r):"v"(a),"v"(b),"v"(c));return r;}
__device__ __forceinline__ float max2f(float a,float b){float r;asm("v_max_f32_e32 %0, %1, %2":"=v"(r):"v"(a),"v"(b));return r;}
__device__ __forceinline__ float fadd_s(float a,float b){float r;asm("v_add_f32_e32 %0, %1, %2":"=v"(r):"v"(a),"v"(b));return r;}
__device__ __forceinline__ float fsub_s(float a,float b){float r;asm("v_sub_f32_e32 %0, %1, %2":"=v"(r):"v"(a),"v"(b));return r;}
typedef float f32x2_t __attribute__((ext_vector_type(2))); typedef __bf16 bf16x2_t __attribute__((ext_vector_type(2)));
__device__ __forceinline__ unsigned cvtpk_s(float lo,float hi){f32x2_t v={lo,hi};bf16x2_t b=__builtin_convertvector(v,bf16x2_t);return __builtin_bit_cast(unsigned,b);}
#define WAIT_BAR(N) asm volatile("s_waitcnt vmcnt(" #N ") lgkmcnt(0)\n\ts_barrier":::"memory")

__device__ __forceinline__ void qkt(f32x16&p0,f32x16&p1,const char*Kslot,const bf16x8*qr,const f32x16&negm,int r32,int hi){
  const char*kb=Kslot+hi*1024+r32*16;
  #pragma unroll
  for(int d0=0;d0<4;++d0){
    const bf16x8 b0=*reinterpret_cast<const bf16x8*>(kb+d0*2048);
    const bf16x8 b1=*reinterpret_cast<const bf16x8*>(kb+d0*2048+512);
    if(d0==0){p0=__builtin_amdgcn_mfma_f32_32x32x16_bf16(b0,qr[0],negm,0,0,0);p1=__builtin_amdgcn_mfma_f32_32x32x16_bf16(b1,qr[0],negm,0,0,0);}
    else{p0=__builtin_amdgcn_mfma_f32_32x32x16_bf16(b0,qr[d0],p0,0,0,0);p1=__builtin_amdgcn_mfma_f32_32x32x16_bf16(b1,qr[d0],p1,0,0,0);}}
}
typedef __attribute__((address_space(3))) const char* lds_cptr;
typedef short v4i16_t __attribute__((ext_vector_type(4)));
__device__ __forceinline__ void kload8(bf16x8*kf,lds_cptr kp){
  kf[0]=*(const __attribute__((address_space(3))) bf16x8*)(kp);      kf[1]=*(const __attribute__((address_space(3))) bf16x8*)(kp+512);
  kf[2]=*(const __attribute__((address_space(3))) bf16x8*)(kp+2048); kf[3]=*(const __attribute__((address_space(3))) bf16x8*)(kp+2560);
  kf[4]=*(const __attribute__((address_space(3))) bf16x8*)(kp+4096); kf[5]=*(const __attribute__((address_space(3))) bf16x8*)(kp+4608);
  kf[6]=*(const __attribute__((address_space(3))) bf16x8*)(kp+6144); kf[7]=*(const __attribute__((address_space(3))) bf16x8*)(kp+6656);
}
__device__ __forceinline__ void kload2(bf16x8*kf,lds_cptr kp,int j){ kf[2*j]=*(const __attribute__((address_space(3))) bf16x8*)(kp+j*2048); kf[2*j+1]=*(const __attribute__((address_space(3))) bf16x8*)(kp+j*2048+512); }
__device__ __forceinline__ s16x4 vtr(lds_cptr p){ return __builtin_bit_cast(s16x4,__builtin_amdgcn_ds_read_tr16_b64_v4i16((__attribute__((address_space(3))) v4i16_t*)p)); }
__device__ __forceinline__ float rowmax(const f32x16&p0,const f32x16&p1){
  float a=max3f(p0[0],p0[1],p1[0]),b=max3f(p0[2],p0[3],p1[1]);a=max3f(a,p1[2],p1[3]);
  #pragma unroll
  for(int r=4;r<16;r+=4){a=max3f(a,p0[r],p0[r+1]);b=max3f(b,p0[r+2],p0[r+3]);a=max3f(a,p1[r],p1[r+1]);b=max3f(b,p1[r+2],p1[r+3]);}
  const float m=max2f(a,b);
  auto rr=__builtin_amdgcn_permlane32_swap(__float_as_uint(m),__float_as_uint(m),false,false);
  return max2f(__uint_as_float(rr[0]),__uint_as_float(rr[1]));
}
__device__ __forceinline__ void pv(f32x16*o,int vb,bf16x8 pa0,bf16x8 pa1,bf16x8 pa2,bf16x8 pa3){
  #pragma unroll
  for(int d0=0;d0<2;++d0){s16x4 lo[4],hi[4];
    #pragma unroll
    for(int ks=0;ks<4;++ks){
      asm volatile("ds_read_b64_tr_b16 %0,%1 offset:%c2":"=&v"(lo[ks]):"v"(vb),"i"(d0*4096+ks*1024):"memory");
      asm volatile("ds_read_b64_tr_b16 %0,%1 offset:%c2":"=&v"(hi[ks]):"v"(vb),"i"(d0*4096+ks*1024+512):"memory");}
    asm volatile("s_waitcnt lgkmcnt(0)":::"memory");SBAR();
    #define PK(k) (bf16x8){lo[k][0],lo[k][1],lo[k][2],lo[k][3],hi[k][0],hi[k][1],hi[k][2],hi[k][3]}
    o[d0]=__builtin_amdgcn_mfma_f32_32x32x16_bf16(pa0,PK(0),o[d0],0,0,0);
    o[d0]=__builtin_amdgcn_mfma_f32_32x32x16_bf16(pa1,PK(1),o[d0],0,0,0);
    o[d0]=__builtin_amdgcn_mfma_f32_32x32x16_bf16(pa2,PK(2),o[d0],0,0,0);
    o[d0]=__builtin_amdgcn_mfma_f32_32x32x16_bf16(pa3,PK(3),o[d0],0,0,0);
    #undef PK
  }
}

#ifndef ATTN_STORE16
#define ATTN_STORE16(p,v) (*(u32x4*)(p)=(v))
#endif
template<int THRL> __device__ __forceinline__ void attn_unit(int b,int h,int kvh,int qb,const bf16*Q,const bf16*__restrict__ K,const bf16*__restrict__ V,bf16*O,char*shm){
  const int tid=threadIdx.x,lane=tid&63,r32=lane&31,hi=lane>>5; const int wid=__builtin_amdgcn_readfirstlane(tid>>6);
  const long rowbase=(long)b*SEQ; const int q0=qb*QB;
  const bf16*Qw=Q+(rowbase+q0+wid*QBLK)*DM+h*D;
  const bf16*Kh=K+rowbase*DM+kvh*D,*Vh=V+rowbase*DM+kvh*D;
  const unsigned lds0=(unsigned)(uintptr_t)shm;
  float*wsf=(float*)(shm+LDS_WS)+wid*64;
  const bf16*ksrc=Kh+(long)lane*DM+wid*8;
  const bf16*vsrc=Vh+(long)(16*(wid&3)+(lane>>2))*DM+(wid>>2)*32+(lane&3)*8;
  const unsigned kdst=lds0+LDS_K+wid*1024, vdst=lds0+LDS_V+wid*1024;
  #define DMA_K(t,slot) glds16(ksrc+(long)(t)*KVBLK*DM,(unsigned)__builtin_amdgcn_readfirstlane(kdst+(slot)))
  #define DMA_V(t,slot) glds16(vsrc+(long)(t)*KVBLK*DM,(unsigned)__builtin_amdgcn_readfirstlane(vdst+(slot)))
  const int vb0=(int)(lds0+LDS_V)+((lane>>4)&1)*32+(lane&3)*8+(4*hi+((lane&15)>>2))*64;
  const char*Kbase=shm+LDS_K; bf16x8 kf[8];
  const lds_cptr shm3=(lds_cptr)shm; const lds_cptr kp0=shm3+LDS_K+hi*1024+r32*16; const lds_cptr vp0=shm3+LDS_V+((lane>>4)&1)*32+(lane&3)*8+(4*hi+((lane&15)>>2))*64;
  const int NT=SEQ/KVBLK;
  DMA_K(0,0);DMA_V(0,0);DMA_K(1,SLOTB);
  bf16x8 qr[4];
  #pragma unroll
  for(int d0=0;d0<4;++d0)qr[d0]=*reinterpret_cast<const bf16x8*>(&Qw[(long)r32*DM+d0*16+hi*8]);
  float mhat=0.f,l_reg=0.f;f32x16 o[2];o[0]=f32x16{};o[1]=f32x16{};f32x16 negm=f32x16{};asm volatile("":"+v"(negm));

  #define CMASK(P0,P1,t) do{}while(0)
  bool resc=false;
  #define START(P0,P1) do{ const float rm=rowmax(P0,P1); resc=false; \
    { const float dl=rm; mhat=fadd_s(mhat,dl); \
      _Pragma("unroll") for(int r=0;r<16;++r){P0[r]=fsub_s(P0[r],dl);P1[r]=fsub_s(P1[r],dl);} \
      _Pragma("unroll") for(int r=0;r<16;++r)negm[r]=-mhat; asm volatile("":"+v"(negm)); } \
    _Pragma("unroll") for(int r=0;r<16;++r)P0[r]=__builtin_amdgcn_exp2f(P0[r]); }while(0)
  #define RESC() do{ if(resc){ asm volatile("s_waitcnt lgkmcnt(0)":::"memory"); \
      _Pragma("unroll") for(int d_=0;d_<2;++d_) _Pragma("unroll") for(int r=0;r<16;++r)o[d_][r]*=wsf[crow(r,hi)]; } }while(0)
  f32x16 pA0,pA1,pB0,pB1;
  int sl_prev=0,sl_cur=0,sl_next=SLOTB;
  #define ROT() do{sl_prev=sl_cur;sl_cur=sl_next;sl_next=(sl_next==(NSLOT-1)*SLOTB)?0:sl_next+SLOTB;}while(0)
  DMA_K(2,2*SLOTB);
  WAIT_BAR(3);
  qkt(pA0,pA1,Kbase,qr,negm,r32,hi);asm volatile("s_nop 15\n\ts_nop 7":"+v"(pA0),"+v"(pA1));CMASK(pA0,pA1,0);
  START(pA0,pA1);
  _Pragma("unroll") for(int r=0;r<16;++r)pA1[r]=__builtin_amdgcn_exp2f(pA1[r]);
  WAIT_BAR(0);
  DMA_K(3,0);DMA_V(1,SLOTB);
  ROT();
  kload8(kf,kp0+sl_cur);
  WAIT_BAR(2);
  s16x4 vlo[8],vhi[8]; u32x4 pw0,pw1,pw2,pw3;
  #define PKW(P,B) cvtpk_s(P[B],P[B+1])
  #define PAF(k) __builtin_bit_cast(bf16x8,pw##k)
  #define VFR(i) (bf16x8){vlo[i][0],vlo[i][1],vlo[i][2],vlo[i][3],vhi[i][0],vhi[i][1],vhi[i][2],vhi[i][3]}
  #define PIN(x) asm volatile("":"+v"(x))
  #define MX3(a,b,c) __builtin_fmaxf(__builtin_fmaxf((a),(b)),(c))
  #define GAPA(MF,A0,A1,A2,A3,W0,W1,PW) do{ MF; sacc+=A0; sacc+=A1; sacc+=A2; sacc+=A3; PIN(sacc); W0; W1; PIN(PW); SBAR(); }while(0)
  #define EX(v) __builtin_amdgcn_exp2f(v)
  #define GAPB(MF,X,B) do{ MF; X[B]=EX(X[B]); X[B+1]=EX(X[B+1]); X[B+2]=EX(X[B+2]); X[B+3]=EX(X[B+3]); PIN(X); SBAR(); }while(0)
  #define VRD(i) do{ vlo[i]=vtr(vp_+(((i)>>2)*4096+((i)&3)*1024)); vhi[i]=vtr(vp_+(((i)>>2)*4096+((i)&3)*1024+512)); }while(0)
  #define KRD(G,j) do{ if(G){ kload2(kf,kp0+sl_next,j); SBAR(); } }while(0)
  #define STEP(C0,C1,P0,P1,t,GK,GV,GL) do{ SBAR(); \
    const lds_cptr vp_=vp0+sl_prev; \
    VRD(0); SBAR(); float sacc=(P0[0]+P0[1]); \
    GAPA(C0=__builtin_amdgcn_mfma_f32_32x32x16_bf16(kf[0],qr[0],negm,0,0,0), P0[2],P0[3],P0[4],P0[5],     pw0[0]=PKW(P0,0), pw0[1]=PKW(P0,2), pw0); \
    VRD(4); SBAR(); GAPA(C1=__builtin_amdgcn_mfma_f32_32x32x16_bf16(kf[1],qr[0],negm,0,0,0), P0[6],P0[7],P0[8],P0[9],     pw0[2]=PKW(P0,4), pw0[3]=PKW(P0,6), pw0); \
    VRD(1); SBAR(); GAPA(C0=__builtin_amdgcn_mfma_f32_32x32x16_bf16(kf[2],qr[1],C0,0,0,0),   P0[10],P0[11],P0[12],P0[13], pw1[0]=PKW(P0,8), pw1[1]=PKW(P0,10), pw1); \
    VRD(5); SBAR(); GAPA(C1=__builtin_amdgcn_mfma_f32_32x32x16_bf16(kf[3],qr[1],C1,0,0,0),   P0[14],P0[15],P1[0],P1[1],   pw1[2]=PKW(P0,12),pw1[3]=PKW(P0,14), pw1); \
    VRD(2); SBAR(); GAPA(C0=__builtin_amdgcn_mfma_f32_32x32x16_bf16(kf[4],qr[2],C0,0,0,0),   P1[2],P1[3],P1[4],P1[5],     pw2[0]=PKW(P1,0), pw2[1]=PKW(P1,2), pw2); \
    VRD(6); SBAR(); GAPA(C1=__builtin_amdgcn_mfma_f32_32x32x16_bf16(kf[5],qr[2],C1,0,0,0),   P1[6],P1[7],P1[8],P1[9],     pw2[2]=PKW(P1,4), pw2[3]=PKW(P1,6), pw2); \
    VRD(3); SBAR(); GAPA(C0=__builtin_amdgcn_mfma_f32_32x32x16_bf16(kf[6],qr[3],C0,0,0,0),   P1[10],P1[11],P1[12],P1[13], pw3[0]=PKW(P1,8), pw3[1]=PKW(P1,10), pw3); \
    VRD(7); SBAR(); GAPA(C1=__builtin_amdgcn_mfma_f32_32x32x16_bf16(kf[7],qr[3],C1,0,0,0),   P1[14],P1[15],0.f,0.f,       pw3[2]=PKW(P1,12),pw3[3]=PKW(P1,14), pw3); \
    l_reg+=sacc; \
    if(GK){DMA_K((t)+3,sl_cur);} if(GV){DMA_V((t)+1,sl_next);} \
    CMASK(C0,C1,t); \
    { float a=MX3(C0[0],C0[1],C1[0]),b=MX3(C0[2],C0[3],C1[1]); a=MX3(a,C1[2],C1[3]); \
      _Pragma("unroll") for(int r=4;r<16;r+=4){a=MX3(a,C0[r],C0[r+1]);b=MX3(b,C0[r+2],C0[r+3]);a=MX3(a,C1[r],C1[r+1]);b=MX3(b,C1[r+2],C1[r+3]);} \
      float rm=__builtin_fmaxf(a,b); { auto rr=__builtin_amdgcn_permlane32_swap(__float_as_uint(rm),__float_as_uint(rm),false,false); rm=__builtin_fmaxf(__uint_as_float(rr[0]),__uint_as_float(rr[1])); } \
      resc=false; \
      if(__builtin_expect(__any(rm>(float)THRL),0)){ const float dl=__builtin_fmaxf(rm,0.f); mhat+=dl; \
        _Pragma("unroll") for(int r=0;r<16;++r){C0[r]-=dl;C1[r]-=dl;} \
        _Pragma("unroll") for(int r=0;r<16;++r)negm[r]=-mhat; asm volatile("":"+v"(negm)); \
        const float f=__builtin_amdgcn_exp2f(-dl); l_reg*=f; if(hi==0)wsf[r32]=f; resc=true; } } \
    SBAR(); \
    GAPB(o[0]=__builtin_amdgcn_mfma_f32_32x32x16_bf16(PAF(0),VFR(0),o[0],0,0,0), C0,0); \
    GAPB(o[1]=__builtin_amdgcn_mfma_f32_32x32x16_bf16(PAF(0),VFR(4),o[1],0,0,0), C0,4); \
    KRD(GL,0); GAPB(o[0]=__builtin_amdgcn_mfma_f32_32x32x16_bf16(PAF(1),VFR(1),o[0],0,0,0), C0,8); \
    KRD(GL,1); GAPB(o[1]=__builtin_amdgcn_mfma_f32_32x32x16_bf16(PAF(1),VFR(5),o[1],0,0,0), C0,12); \
    KRD(GL,2); GAPB(o[0]=__builtin_amdgcn_mfma_f32_32x32x16_bf16(PAF(2),VFR(2),o[0],0,0,0), C1,0); \
    KRD(GL,3); GAPB(o[1]=__builtin_amdgcn_mfma_f32_32x32x16_bf16(PAF(2),VFR(6),o[1],0,0,0), C1,4); \
    GAPB(o[0]=__builtin_amdgcn_mfma_f32_32x32x16_bf16(PAF(3),VFR(3),o[0],0,0,0), C1,8); \
    GAPB(o[1]=__builtin_amdgcn_mfma_f32_32x32x16_bf16(PAF(3),VFR(7),o[1],0,0,0), C1,12); \
    }while(0)
  int t=1;
  #undef CMASK
  #define CMASK(P0,P1,t) do{}while(0)
  for(;t+5<NT;t+=2){
    STEP(pB0,pB1,pA0,pA1,t,true,true,true);     WAIT_BAR(2); RESC(); ROT();
    STEP(pA0,pA1,pB0,pB1,t+1,true,true,true);   WAIT_BAR(2); RESC(); ROT();
  }
  #undef CMASK
  #define CMASK(P0,P1,t) do{}while(0)
  #define ENDW(tt) do{ if((tt)+3<NT){WAIT_BAR(2);} else if((tt)+2<NT){WAIT_BAR(1);} else {WAIT_BAR(0);} }while(0)
  for(;t+1<NT;t+=2){
    STEP(pB0,pB1,pA0,pA1,t,(t+3<NT),(t+1<NT),(t+1<NT));       ENDW(t);   RESC(); ROT();
    STEP(pA0,pA1,pB0,pB1,t+1,(t+4<NT),(t+2<NT),(t+2<NT));     ENDW(t+1); RESC(); ROT();
  }
  STEP(pB0,pB1,pA0,pA1,NT-1,false,false,false); RESC();
  { float sacc=pB0[0]+pB0[1]; _Pragma("unroll") for(int r=2;r<16;++r)sacc+=pB0[r]; _Pragma("unroll") for(int r=0;r<16;++r)sacc+=pB1[r]; l_reg+=sacc;
    pw0=(u32x4){PKW(pB0,0),PKW(pB0,2),PKW(pB0,4),PKW(pB0,6)};pw1=(u32x4){PKW(pB0,8),PKW(pB0,10),PKW(pB0,12),PKW(pB0,14)};pw2=(u32x4){PKW(pB1,0),PKW(pB1,2),PKW(pB1,4),PKW(pB1,6)};pw3=(u32x4){PKW(pB1,8),PKW(pB1,10),PKW(pB1,12),PKW(pB1,14)};
    SBAR(); pv(o,vb0+sl_cur,PAF(0),PAF(1),PAF(2),PAF(3)); }
  #undef PKW
  #undef PAF
  #undef VFR
  #undef PIN
  #undef MX3
  #undef GAPA
  #undef GAPB
  #undef EX
  #undef VRD
  #undef KRD
  #undef STEP
  #undef ENDW
  {auto rr=__builtin_amdgcn_permlane32_swap(__float_as_uint(l_reg),__float_as_uint(l_reg),false,false);l_reg=__uint_as_float(rr[0])+__uint_as_float(rr[1]);}
  if(hi==0)wsf[32+r32]=l_reg;asm volatile("s_waitcnt lgkmcnt(0)":::"memory");
  float rli[16];
  #pragma unroll
  for(int r=0;r<16;++r)rli[r]=__builtin_amdgcn_rcpf(wsf[32+crow(r,hi)])*pg8::ASC;
  unsigned char*Ow=(unsigned char*)O+(long)(rowbase+q0+wid*QBLK)*OPITCH+h*D;
  { bf16*stg=(bf16*)(shm+LDS_OST)+wid*2048;
    #pragma unroll
    for(int r=0;r<16;++r){const int orow=crow(r,hi);
      #pragma unroll
      for(int d0=0;d0<2;++d0)stg[orow*64+d0*32+r32]=__float2bfloat16(o[d0][r]*rli[r]);}
    asm volatile("s_waitcnt lgkmcnt(0)":::"memory");
    #pragma unroll
    for(int i=0;i<4;++i){const int row=i*8+(lane>>3),ch=lane&7; const u32x4 v=*(const u32x4*)(stg+row*64+ch*8);
      #define BLO(w) __uint_as_float((w)<<16)
      #define BHI(w) __uint_as_float((w)&0xffff0000u)
      *(u32x2*)(Ow+(long)row*OPITCH+ch*8)=(u32x2){pg8::pk4_fp8(BLO(v.x),BHI(v.x),BLO(v.y),BHI(v.y)),pg8::pk4_fp8(BLO(v.z),BHI(v.z),BLO(v.w),BHI(v.w))};
      #undef BLO
      #undef BHI
    } }
  asm volatile("s_waitcnt lgkmcnt(0)\n\ts_barrier":::"memory");
  #undef DMA_K
  #undef DMA_V
  #undef CMASK
  #undef START
  #undef RESC
  #undef ROT
}
constexpr int ATTN_LDS_BYTES=LDS_BYTES;
struct AttnTensors { const bf16* Q; const bf16* K; const bf16* V; bf16* O; };
struct AttnUnit { int bh; int qb; };
struct StaticOrder {
  int vcu, G;
  __device__ __forceinline__ explicit StaticOrder(int grid,int v):vcu(v),G(grid){}
  __device__ __forceinline__ bool next(int i,AttnUnit&u)const{ const int L=i*G+vcu; if(L>=BATCH*NHEAD*NQB)return false; const int blk=L%256, rnd=L/256; u.bh=blk>>1; u.qb=(blk&1)*4+rnd; return true; }
};
template<class Sched,int THRL=8> __device__ __forceinline__ void attn_phase(char*lds,const AttnTensors&T,const Sched&S){
  AttnUnit u;
  for(int i=0;S.next(i,u);++i){ attn_unit<THRL>(u.bh/NHEAD,u.bh%NHEAD,(u.bh%NHEAD)/4,u.qb,T.Q,T.K,T.V,T.O,lds); }
}
#undef SBAR
#undef WAIT_BAR
}
#define XB_TMO      128
#define XB_XCNT(j)  (256  + 64 * (j))
#define XB_XSUB(j)  (1280 + 64 * (j))
#define XB_XGEN(j)  (2304 + 64 * (j))
#define XB_TOP      3328
#define XB_TOPGEN   3392
#define XCD_BAR_WORDS 3456
#define XB_SPIN_CAP (1u << 18)

__device__ __forceinline__ unsigned xb_ld(unsigned* p)              { return __hip_atomic_load(p, __ATOMIC_RELAXED, __HIP_MEMORY_SCOPE_AGENT); }
__device__ __forceinline__ unsigned xb_add(unsigned* p, unsigned v) { return __hip_atomic_fetch_add(p, v, __ATOMIC_RELAXED, __HIP_MEMORY_SCOPE_AGENT); }
__device__ __forceinline__ unsigned xb_xcc_id() { return (unsigned)__builtin_amdgcn_s_getreg((3 << 11) | 20) & 0xFu; }
#define XB_SPIN(cond, bar) do { unsigned _sp = 0; while (cond) { __builtin_amdgcn_s_sleep(1); \
    if ((++_sp & 255u) == 0u) { if (xb_ld(&(bar)[XB_TMO])) break; if (_sp > XB_SPIN_CAP) { atomicAdd(&(bar)[XB_TMO], 1u); break; } } } } while (0)

struct XcdBarrier {
    unsigned* bar; unsigned x;
    volatile LAS unsigned* st;
};

__device__ __forceinline__ XcdBarrier xcd_barrier_post(unsigned* bar, volatile LAS unsigned* st) {
    XcdBarrier b; b.bar = bar; b.x = xb_xcc_id(); b.st = st;
    if (threadIdx.x == 0) (void)xb_add(&bar[XB_XCNT(b.x)], 1u);
    return b;
}
__device__ __forceinline__ void xcd_barrier_complete(unsigned* bar, unsigned x, unsigned& nloc, unsigned& nx) {
    const unsigned G = gridDim.x * gridDim.y * gridDim.z;
    unsigned sum, cnt, mine, sp = 0u;
    for (;;) {
        sum = 0u; cnt = 0u; mine = 0u;
#pragma unroll
        for (unsigned j = 0; j < 16; ++j) { const unsigned c = xb_ld(&bar[XB_XCNT(j)]); sum += c; cnt += (c > 0u) ? 1u : 0u; mine = (j == x) ? c : mine; }
        if (sum == G) break;
        __builtin_amdgcn_s_sleep(1);
        if ((++sp & 255u) == 0u) { if (xb_ld(&bar[XB_TMO])) break; if (sp > XB_SPIN_CAP) { atomicAdd(&bar[XB_TMO], 1u); break; } }
    }
    nloc = mine > 0u ? mine : 1u; nx = cnt > 0u ? cnt : 1u;
}

__device__ __forceinline__ void xcd_barrier(const XcdBarrier& b) {
    asm volatile("s_waitcnt vmcnt(0)" ::: "memory");
    __syncthreads();
    if (threadIdx.x == 0) {
        unsigned* bar = b.bar;
        __builtin_amdgcn_s_waitcnt(0);
        unsigned nloc = b.st[0], nx = b.st[1];
        if (nloc == 0u) { xcd_barrier_complete(bar, b.x, nloc, nx); b.st[0] = nloc; b.st[1] = nx; }
        const unsigned old = xb_add(&bar[XB_XSUB(b.x)], 1u);
        const unsigned gen = old / nloc;
        if (old + 1u == (gen + 1u) * nloc) {
            __builtin_amdgcn_fence(__ATOMIC_RELEASE, "agent");
            asm volatile("s_waitcnt vmcnt(0)" ::: "memory");
            const unsigned og = xb_add(&bar[XB_TOP], 1u);
            const unsigned tg = og / nx;
            if (og + 1u == (tg + 1u) * nx) xb_add(&bar[XB_TOPGEN], 1u);
            else XB_SPIN(xb_ld(&bar[XB_TOPGEN]) == tg, bar);
            __builtin_amdgcn_fence(__ATOMIC_ACQUIRE, "agent");
            xb_add(&bar[XB_XGEN(b.x)], 1u);
            asm volatile("s_waitcnt vmcnt(0)" ::: "memory");
        } else {
            XB_SPIN(xb_ld(&bar[XB_XGEN(b.x)]) == gen, bar);
            __builtin_amdgcn_fence(__ATOMIC_ACQUIRE, "agent");
            asm volatile("s_waitcnt vmcnt(0)" ::: "memory");
        }
    }
    __syncthreads();
}
constexpr int NWAVES = 8, NTHR = NWAVES * 64;
constexpr int N_PHASES = 10;
constexpr int RING_OFF = 0, RING_BYTES = 131072;
constexpr int LDSCTL_OFF = RING_BYTES, MISC_OFF = LDSCTL_OFF + 320;
constexpr int TS_OFF = LDSCTL_OFF + 512;
constexpr int UT_OFF = TS_OFF + 256;
constexpr int RT_OFF = UT_OFF + 256;
constexpr int LDS_BYTES = 147456;
static_assert(RT_OFF + pg8::MOE_MAXU * 1024 <= LDS_BYTES, "LDS map");

struct Frame {
    LAS unsigned char* lds; volatile LAS unsigned* MISC; unsigned* ctl; unsigned char* ws;
    int tid, lane, wave, vcu, G;
    float* out;
};

enum { I_X = 0, I_C, I_WADA, I_BADA, I_GPRE1, I_GPOST1, I_WIN, I_WDW, I_BDW, I_CLNG, I_CLNB, I_WCO, I_QG, I_KG, I_WAO, I_WOUT, I_GPRE2, I_GPOST2, I_WGRP, I_BGRP, I_WRT, I_BRT, I_WEG, I_WEU, I_WED };

struct Args { const float* in[25]; float* out; unsigned char* ws; int ph_lo, ph_hi, use_bar, flags; };
#define CAS __attribute__((address_space(4)))
__device__ __forceinline__ const float* fin(int i) { unsigned long long p = (unsigned long long)__builtin_amdgcn_kernarg_segment_ptr(); asm volatile("" : "+s"(p)); return ((const CAS Args*)p)->in[i]; }
template <int MAP> __device__ __forceinline__ int maprow(int n) {
    if (MAP == 1) return vmap_win(n);
    if (MAP == 2) return 256 * (n >> 7) + (n & 127);
    if (MAP == 3) return 256 * (n >> 7) + 128 + (n & 127);
    return n;
}
template <int MAP>
__device__ __forceinline__ void p0_transpose_item(const float* W, int N, bf16* WT, int pitch, int koff, LAS float* scr, int item, int lane) {
    const int nblk = N / 64, kb = item / nblk, nb = item % nblk, k0 = 64 * kb, n0 = 64 * nb, lr = lane >> 4, lc = lane & 15;
    const float* src = W + (size_t)(k0 + lr) * N + n0 + 4 * lc;
    f32x4 v[16];
#pragma unroll
    for (int i = 0; i < 16; ++i) v[i] = *(const f32x4*)(src + (size_t)(4 * i) * N);
#pragma unroll
    for (int i = 0; i < 16; ++i) { const int kk = lr + 4 * i; *(LAS f32x4*)(scr + kk * 64 + 4 * (lc ^ ((kk >> 3) & 7))) = v[i]; }
    LDS_WAIT(); asm volatile("" ::: "memory");
    const int c = lane & 7;
#pragma unroll
    for (int jj = 0; jj < 8; ++jj) { const int n = (lane >> 3) + 8 * jj; const LAS float* sp = scr + (8 * c) * 64 + (n ^ (4 * c));
        u32x4 o; o.x = cvt_pk_bf16(sp[0 * 64], sp[1 * 64]); o.y = cvt_pk_bf16(sp[2 * 64], sp[3 * 64]); o.z = cvt_pk_bf16(sp[4 * 64], sp[5 * 64]); o.w = cvt_pk_bf16(sp[6 * 64], sp[7 * 64]);
        *(u32x4*)(WT + (size_t)maprow<MAP>(n0 + n) * pitch + koff + k0 + 8 * c) = o; }
    LDS_WAIT(); asm volatile("" ::: "memory");
}
struct TrDesc { const float* src; unsigned char* dst; int N, pitch; float sc; };
__device__ __forceinline__ TrDesc tr_desc(int it, const float* pweg, const float* pweu, const float* pwed, unsigned char* W1, unsigned char* W2) {
    constexpr int I_G1 = (D / 64) * (DE / 64), I_D1 = (DE / 64) * (D / 64), PER = 2 * I_G1 + I_D1;
    const int e = it / PER; int r = it - e * PER; TrDesc d;
    if (r < 2 * I_G1) { const bool up = r >= I_G1; if (up) r -= I_G1; const int nblk = DE / 64, kb = r / nblk, nb = r % nblk;
        d.src = (up ? pweu : pweg) + (size_t)e * D * DE + (size_t)(64 * kb) * DE + 64 * nb; d.N = DE; d.pitch = D; d.sc = pg8::WSC1;
        d.dst = W1 + (size_t)e * D * D + (size_t)(256 * ((64 * nb) >> 7) + (up ? 128 : 0) + ((64 * nb) & 127)) * D + 64 * kb; }
    else { r -= 2 * I_G1; const int nblk = D / 64, kb = r / nblk, nb = r % nblk;
        d.src = pwed + (size_t)e * DE * D + (size_t)(64 * kb) * D + 64 * nb; d.N = D; d.pitch = DE; d.sc = pg8::WSC2;
        d.dst = W2 + (size_t)e * D * DE + (size_t)(64 * nb) * DE + 64 * kb; }
    return d;
}
__device__ __forceinline__ void tr_load(const TrDesc& d, int lane, f32x4 (&v)[16]) {
    const float* src = d.src + (size_t)(lane >> 4) * d.N + 4 * (lane & 15);
#pragma unroll
    for (int i = 0; i < 16; ++i) v[i] = *(const f32x4*)(src + (size_t)(4 * i) * d.N);
}
__device__ __forceinline__ void tr_finish(const TrDesc& d, int lane, const f32x4 (&v)[16], LAS float* scr) {
    const int lr = lane >> 4, lc = lane & 15;
#pragma unroll
    for (int i = 0; i < 16; ++i) { const int kk = lr + 4 * i; *(LAS f32x4*)(scr + kk * 64 + 4 * (lc ^ ((kk >> 3) & 7))) = v[i] * d.sc; }
    LDS_WAIT(); asm volatile("" ::: "memory");
    const int c4 = lane & 3;
#pragma unroll
    for (int jj = 0; jj < 4; ++jj) { const int n = (lane >> 2) + 16 * jj; const LAS float* s0 = scr + (16 * c4) * 64 + (n ^ (4 * (2 * c4))), * s1 = scr + (16 * c4 + 8) * 64 + (n ^ (4 * (2 * c4 + 1)));
        u32x4 o; o.x = pg8::pk4_fp8(s0[0 * 64], s0[1 * 64], s0[2 * 64], s0[3 * 64]); o.y = pg8::pk4_fp8(s0[4 * 64], s0[5 * 64], s0[6 * 64], s0[7 * 64]);
        o.z = pg8::pk4_fp8(s1[0 * 64], s1[1 * 64], s1[2 * 64], s1[3 * 64]); o.w = pg8::pk4_fp8(s1[4 * 64], s1[5 * 64], s1[6 * 64], s1[7 * 64]);
        *(u32x4*)(d.dst + (size_t)n * d.pitch + 16 * c4) = o; }
    LDS_WAIT(); asm volatile("" ::: "memory");
}
__device__ __forceinline__ void p0_prologue(Frame& F) {
    const float* c = fin(I_C); const float* wada = fin(I_WADA); const float* bada = fin(I_BADA);
    if (blockIdx.x < 192) {
        const int cg = blockIdx.x, kh = F.lane >> 5, col = F.lane & 31;
        LAS float* scs = (LAS float*)F.lds; LAS float* red = (LAS float*)(F.lds + 65536);
        { float cv[32];
#pragma unroll
          for (int i = 0; i < 32; ++i) cv[i] = c[F.tid + NTHR * i];
#pragma unroll
          for (int i = 0; i < 32; ++i) scs[F.tid + NTHR * i] = cv[i] * sig_fast(cv[i]); }
        __syncthreads();
        float acc[16];
#pragma unroll
        for (int b = 0; b < 16; ++b) acc[b] = 0.f;
        const int kbase = 128 * F.wave + 64 * kh;
        const float* w = wada + (size_t)kbase * 6144 + 32 * cg + col;
        { float wv[64];
#pragma unroll
          for (int k = 0; k < 64; ++k) wv[k] = w[(size_t)k * 6144];
#pragma unroll
          for (int k = 0; k < 64; ++k)
#pragma unroll
              for (int b = 0; b < 16; ++b) acc[b] += scs[b * D + kbase + k] * wv[k]; }
#pragma unroll
        for (int b = 0; b < 16; ++b) red[((F.wave * 2 + kh) * 16 + b) * 32 + col] = acc[b];
        __syncthreads();
        float* ada = (float*)(F.ws + WS_ADA);
        { const int b = F.tid >> 5, l = F.tid & 31; float sm = 0.f;
#pragma unroll
          for (int p = 0; p < 16; ++p) sm += red[(p * 16 + b) * 32 + l];
          __hip_atomic_store(ada + b * 6144 + 32 * cg + l, sm + bada[32 * cg + l], __ATOMIC_RELAXED, __HIP_MEMORY_SCOPE_AGENT); }
        VM_WAIT();
        __syncthreads();
        if (F.tid == 0) __hip_atomic_fetch_add(F.ctl + CW_ADA, 1u, __ATOMIC_RELAXED, __HIP_MEMORY_SCOPE_AGENT);
    }
    {
        const int gt = F.vcu * NTHR + F.tid, NGT = F.G * NTHR; const float* wgrp = fin(I_WGRP); const float* wrt = fin(I_WRT);
        f32x2* rope = (f32x2*)(F.ws + WS_ROPE);
        for (int i = gt; i < 96 * 16; i += NGT) { const int r = i >> 4, e = i & 15; const float pos = (float)(r < 32 ? r : r - 32);
            const float invf = powf(10000.f, -(float)e / 16.f); float sn, cs; sincosf(pos * invf, &sn, &cs); rope[i] = (f32x2){cs, sn}; }
        bf16* wr = (bf16*)(F.ws + WS_WR);
        for (int i = gt; i < 64 * 1024; i += NGT) { const int n = i >> 10, k = i & 1023;
            const float v = n < 4 ? wgrp[k * 4 + n] : (n < 36 ? wrt[k * 32 + (n - 4)] : 0.f); wr[i] = (bf16)f2bf(v); }
    }
    LAS float* scr = (LAS float*)(F.lds + RING_OFF + F.wave * 16384);
    const int gw = F.vcu * NWAVES + F.wave, NGW = F.G * NWAVES;
    constexpr int I_WIN_ = (D / 64) * (INW / 64), I_WC_ = (CW / 64) * (D / 64), I_WO_ = (D / 64) * (D / 64);
    constexpr int NITEMS = I_WIN_ + 2 * I_WC_ + I_WO_;
    bf16* WIN = (bf16*)(F.ws + WS_WIN); bf16* WCA = (bf16*)(F.ws + WS_WCA); bf16* WO = (bf16*)(F.ws + WS_WO);
    const float* pwin = fin(I_WIN); const float* pwco = fin(I_WCO); const float* pwao = fin(I_WAO); const float* pwout = fin(I_WOUT);
    for (int it = gw; it < NITEMS; it += NGW) {
        int r = it;
        if (r < I_WIN_) { const int kb = r / 60, nb = r % 60;
            if (nb >= 16 && nb < 28) p0_transpose_item<1>(pwin, INW, WIN, D, 0, scr, kb * 60 + nb, F.lane);
            else { TrDesc d; const int n0 = 64 * nb; d.src = pwin + (size_t)(64 * kb) * INW + n0; d.N = INW; d.pitch = 2048; d.sc = pg8::WSCIN; d.dst = F.ws + WS_WINF + (size_t)pg8::winf_row(vmap_win(n0)) * 2048 + 64 * kb;
                   f32x4 tv[16]; tr_load(d, F.lane, tv); tr_finish(d, F.lane, tv, scr); }
            continue; } r -= I_WIN_;
        if (r < 2 * I_WC_) { const bool at = r >= I_WC_; if (at) r -= I_WC_;
            TrDesc d; const int kb = r / (D / 64), nb = r % (D / 64); d.src = (at ? pwao : pwco) + (size_t)(64 * kb) * D + 64 * nb; d.N = D; d.pitch = D; d.sc = pg8::WSCCA;
            d.dst = F.ws + WS_WCA + (size_t)(64 * nb) * D + (at ? 512 : 0) + 64 * kb;
            f32x4 tv[16]; tr_load(d, F.lane, tv); tr_finish(d, F.lane, tv, scr); continue; } r -= 2 * I_WC_;
        { TrDesc d; const int kb = r / (D / 64), nb = r % (D / 64); d.src = pwout + (size_t)(64 * kb) * D + 64 * nb; d.N = D; d.pitch = D; d.sc = pg8::WSCO; d.dst = F.ws + WS_WO + (size_t)(64 * nb) * D + 64 * kb;
          f32x4 tv[16]; tr_load(d, F.lane, tv); tr_finish(d, F.lane, tv, scr); }
    }
}
constexpr int XCONV_ITEMS = NE * (2 * (D / 64) * (DE / 64) + (DE / 64) * (D / 64));
__device__ __forceinline__ void p0_convert_experts(Frame& F, int lo, int hi, int rank, int nconv) {
    LAS float* scr = (LAS float*)(F.lds + RING_OFF + F.wave * 16384);
    constexpr int I_G1 = (D / 64) * (DE / 64), I_D1 = (DE / 64) * (D / 64), PER = 2 * I_G1 + I_D1;
    unsigned char* W1 = F.ws + WS_W1; unsigned char* W2 = F.ws + WS_W2;
    const float* pweg = fin(I_WEG); const float* pweu = fin(I_WEU); const float* pwed = fin(I_WED);
    const int step = nconv * NWAVES;
    for (int it = lo + rank * NWAVES + F.wave; it < hi; it += 2 * step) {
        const TrDesc d0 = tr_desc(it, pweg, pweu, pwed, W1, W2); const bool two = it + step < hi;
        const TrDesc d1 = tr_desc(two ? it + step : it, pweg, pweu, pwed, W1, W2);
        f32x4 v0[16], v1[16];
        tr_load(d0, F.lane, v0); tr_load(d1, F.lane, v1);
        __builtin_amdgcn_sched_barrier(0);
        tr_finish(d0, F.lane, v0, scr);
        if (two) tr_finish(d1, F.lane, v1, scr);
    }
}

__device__ __forceinline__ int rcol(int lane, int q) { return 512 * (q >> 1) + 8 * lane + 4 * (q & 1); }
__device__ __forceinline__ void row_ld_f32(const float* p, int lane, f32x4 (&v)[4]) {
#pragma unroll
    for (int q = 0; q < 4; ++q) v[q] = *(const f32x4*)(p + rcol(lane, q)); }
__device__ __forceinline__ void row_st_f32(float* p, int lane, const f32x4 (&v)[4]) {
#pragma unroll
    for (int q = 0; q < 4; ++q) *(f32x4*)(p + rcol(lane, q)) = v[q]; }
__device__ __forceinline__ void row_ld_bf16(const bf16* p, int lane, f32x4 (&v)[4]) {
#pragma unroll
    for (int j = 0; j < 2; ++j) { const u32x4 w = *(const u32x4*)(p + 512 * j + 8 * lane);
        v[2 * j] = (f32x4){bf2f(w.x & 0xffffu), bf2f(w.x >> 16), bf2f(w.y & 0xffffu), bf2f(w.y >> 16)}; v[2 * j + 1] = (f32x4){bf2f(w.z & 0xffffu), bf2f(w.z >> 16), bf2f(w.w & 0xffffu), bf2f(w.w >> 16)}; } }
__device__ __forceinline__ u32x4 row_pack(const f32x4 a, const f32x4 b) { return (u32x4){cvt_pk_bf16(a.x, a.y), cvt_pk_bf16(a.z, a.w), cvt_pk_bf16(b.x, b.y), cvt_pk_bf16(b.z, b.w)}; }
__device__ __forceinline__ float row_ss(const f32x4 (&v)[4]) { float s = 0.f;
#pragma unroll
    for (int q = 0; q < 4; ++q) s += (v[q].x * v[q].x + v[q].y * v[q].y) + (v[q].z * v[q].z + v[q].w * v[q].w);
    return s; }

__device__ __forceinline__ void p1_modnorm(Frame& F) {
    const float* x = fin(I_X); const float* g = fin(I_GPRE1); const float* ada = (const float*)(F.ws + WS_ADA); bf16* h1 = (bf16*)(F.ws + WS_H1); unsigned char* h1f = F.ws + WS_H1F;
    bool waited = false;
    for (int chunk = blockIdx.x; chunk < NTOK / 128; chunk += F.G) {
        const int R0 = chunk * 128, b = R0 / SEQ; const float* ad = ada + b * 6144;
        const int rw = R0 + 16 * F.wave;
        f32x4 n0[4], n1[4];
        row_ld_f32(x + (size_t)rw * D, F.lane, n0); row_ld_f32(x + (size_t)(rw + 1) * D, F.lane, n1);
        __builtin_amdgcn_sched_barrier(0);
        if (!waited) { waited = true;
            if (F.tid == 0) { unsigned sp = 0; while (__hip_atomic_load(F.ctl + CW_ADA, __ATOMIC_RELAXED, __HIP_MEMORY_SCOPE_AGENT) < 192u) { __builtin_amdgcn_s_sleep(2); if (++sp > (1u << 22)) break; }
                __builtin_amdgcn_fence(__ATOMIC_ACQUIRE, "agent"); VM_WAIT(); }
            __syncthreads(); }
        f32x4 ca[4], cb[4];
#pragma unroll
        for (int q = 0; q < 4; ++q) { const int c0 = rcol(F.lane, q); ca[q] = *(const f32x4*)(g + c0) * (1.f + *(const f32x4*)(ad + 1024 + c0)); cb[q] = *(const f32x4*)(ad + c0); }
#pragma unroll
        for (int i = 0; i < 16; i += 2) {
            const int row = rw + i;
            f32x4 v0[4], v1[4];
#pragma unroll
            for (int q = 0; q < 4; ++q) { v0[q] = n0[q]; v1[q] = n1[q]; }
            if (i + 2 < 16) { row_ld_f32(x + (size_t)(row + 2) * D, F.lane, n0); row_ld_f32(x + (size_t)(row + 3) * D, F.lane, n1); }
            __builtin_amdgcn_sched_barrier(0);
            const float r0 = rsqrtf(wave_sum(row_ss(v0)) * (1.f / D) + EPS), r1 = rsqrtf(wave_sum(row_ss(v1)) * (1.f / D) + EPS);
#pragma unroll
            for (int j = 0; j < 2; ++j) {
                const f32x4 a0 = v0[2 * j] * r0 * ca[2 * j] + cb[2 * j], a1 = v0[2 * j + 1] * r0 * ca[2 * j + 1] + cb[2 * j + 1], b0 = v1[2 * j] * r1 * ca[2 * j] + cb[2 * j], b1 = v1[2 * j + 1] * r1 * ca[2 * j + 1] + cb[2 * j + 1];
                *(u32x4*)(h1 + (size_t)row * D + 512 * j + 8 * F.lane) = row_pack(a0, a1); *(u32x4*)(h1 + (size_t)(row + 1) * D + 512 * j + 8 * F.lane) = row_pack(b0, b1);
                *(u32x2*)(h1f + (size_t)row * 2048 + 512 * j + 8 * F.lane) = (u32x2){pg8::pk4_fp8(a0.x, a0.y, a0.z, a0.w), pg8::pk4_fp8(a1.x, a1.y, a1.z, a1.w)};
                *(u32x2*)(h1f + (size_t)(row + 1) * 2048 + 512 * j + 8 * F.lane) = (u32x2){pg8::pk4_fp8(b0.x, b0.y, b0.z, b0.w), pg8::pk4_fp8(b1.x, b1.y, b1.z, b1.w)}; }
            __builtin_amdgcn_sched_barrier(0);
        }
    }
}

constexpr int CV_T = 32, CV_IN = 0, CV_UT = (CV_T + KS - 1) * 1024;
static_assert(CV_UT + CV_T * CW * 4 <= RING_BYTES, "conv LDS map");
__device__ __forceinline__ void p3_conv(Frame& F) {
    const bf16* glu = (const bf16*)(F.ws + WS_GLU); bf16* ca = (bf16*)(F.ws + WS_CA);
    LAS unsigned char* IN = F.lds + RING_OFF + CV_IN; LAS float* UT = (LAS float*)(F.lds + RING_OFF + CV_UT);
#define CV_LOAD(SV, unx) do { const int b_ = (unx) / (SEQ / CV_T), s0_ = ((unx) % (SEQ / CV_T)) * CV_T; _Pragma("unroll") for (int i = 0; i < 8; ++i) { \
        const int s_ = s0_ - KS / 2 + F.wave + NWAVES * i, sc_ = s_ < 0 ? 0 : (s_ >= SEQ ? SEQ - 1 : s_); SV[i] = *(const u32x4*)(glu + (size_t)(b_ * SEQ + sc_) * CW + F.lane * 8); } } while (0)
    const int cp = F.tid & 255, th = F.tid >> 8;
    constexpr int NUN = NTOK / CV_T;
    u32x4 svA[8], svB[8];
    if (F.vcu < NUN) CV_LOAD(svA, F.vcu);
    if (F.vcu + F.G < NUN) CV_LOAD(svB, F.vcu + F.G);
    __builtin_amdgcn_sched_barrier(0);
    f32x2 w[KS];
#pragma unroll
    for (int j = 0; j < KS; ++j) w[j] = *(const f32x2*)(fin(I_WDW) + j * CW + 2 * cp);
    const f32x2 bias = *(const f32x2*)(fin(I_BDW) + 2 * cp);
    LAS float* LG = (LAS float*)(F.lds + RT_OFF);
    LG[F.tid] = fin(I_CLNG)[F.tid]; LG[CW + F.tid] = fin(I_CLNB)[F.tid];
#define CV_BAR() asm volatile("s_waitcnt lgkmcnt(0)\n\ts_barrier" ::: "memory")
#define CV_UNIT(SV, un) do { \
        const int b = (un) / (SEQ / CV_T), s0 = ((un) % (SEQ / CV_T)) * CV_T; \
        _Pragma("unroll") for (int i = 0; i < 8; ++i) { const int r = F.wave + NWAVES * i, s = s0 - KS / 2 + r; \
            if (r < CV_T + KS - 1) *(LAS u32x4*)(IN + r * 1024 + F.lane * 16) = (s >= 0 && s < SEQ) ? SV[i] : (u32x4){0u, 0u, 0u, 0u}; } \
        CV_BAR(); \
        if ((un) + 2 * F.G < NUN) CV_LOAD(SV, (un) + 2 * F.G); \
        __builtin_amdgcn_sched_barrier(0); \
        _Pragma("unroll") for (int g = 0; g < 2; ++g) { \
            f32x2 win[38]; \
            _Pragma("unroll") for (int i = 0; i < 38; ++i) { const unsigned pw = *(const LAS unsigned*)(IN + (16 * th + 8 * g + i) * 1024 + cp * 4); win[i] = (f32x2){__uint_as_float(pw << 16), __uint_as_float(pw & 0xffff0000u)}; } \
            _Pragma("unroll") for (int o = 0; o < 8; ++o) { f32x2 a = bias; \
                _Pragma("unroll") for (int j = 0; j < KS; ++j) a = __builtin_elementwise_fma(win[o + j], w[j], a); \
                *(LAS f32x2*)(UT + (16 * th + 8 * g + o) * CW + 2 * cp) = a; } \
        } \
        CV_BAR(); \
        _Pragma("unroll") for (int i = 0; i < 4; ++i) { const int t = F.wave * 4 + i; \
            const f32x4 v0 = *(const LAS f32x4*)(UT + t * CW + F.lane * 8), v1 = *(const LAS f32x4*)(UT + t * CW + F.lane * 8 + 4); \
            const float mu = wave_sum((v0.x + v0.y) + (v0.z + v0.w) + (v1.x + v1.y) + (v1.z + v1.w)) * (1.f / CW); \
            const f32x4 d0 = v0 - mu, d1 = v1 - mu; \
            const float var = wave_sum((d0.x * d0.x + d0.y * d0.y) + (d0.z * d0.z + d0.w * d0.w) + (d1.x * d1.x + d1.y * d1.y) + (d1.z * d1.z + d1.w * d1.w)) * (1.f / CW); \
            const float rstd = rsqrtf(var + EPS); \
            float o[8]; const f32x4 g0 = *(const LAS f32x4*)(LG + F.lane * 8), g1 = *(const LAS f32x4*)(LG + F.lane * 8 + 4), b0 = *(const LAS f32x4*)(LG + CW + F.lane * 8), b1 = *(const LAS f32x4*)(LG + CW + F.lane * 8 + 4); \
            _Pragma("unroll") for (int k = 0; k < 4; ++k) { const float a = d0[k] * rstd * g0[k] + b0[k], bq = d1[k] * rstd * g1[k] + b1[k]; o[k] = a * sig_fast(a); o[4 + k] = bq * sig_fast(bq); } \
            *(u32x2*)((unsigned char*)ca + (size_t)(b * SEQ + s0 + t) * D + F.lane * 8) = (u32x2){pg8::pk4_fp8(o[0] * pg8::CSC, o[1] * pg8::CSC, o[2] * pg8::CSC, o[3] * pg8::CSC), \
                                                                                              pg8::pk4_fp8(o[4] * pg8::CSC, o[5] * pg8::CSC, o[6] * pg8::CSC, o[7] * pg8::CSC)}; }     \
        CV_BAR(); \
    } while (0)
    for (int un = F.vcu; un < NUN; un += 2 * F.G) {
        CV_UNIT(svA, un);
        if (un + F.G < NUN) CV_UNIT(svB, un + F.G);
    }
#undef CV_UNIT
#undef CV_BAR
#undef CV_LOAD
}

constexpr int WRP = 2064;
constexpr int P6_WR = 0, P6_LGW = 48 * WRP, P6_EA = P6_LGW + 8 * 16 * 48 * 4, P6_HIST = P6_EA + 128 * 32, P6_BASE = P6_HIST + 128, P6_END = P6_BASE + 128;
constexpr int P6_RS2 = P6_END, P6_BIAS = P6_RS2 + 512, P6_BPART = P6_BIAS + 256, P6_END2 = P6_BPART + 8 * 48 * 4;
static_assert(P6_END2 <= RING_BYTES, "P6 LDS map");
struct P6Row { float pv; u32x4 y[2]; f32x4 x[4]; };
__device__ __forceinline__ void p6_ld(P6Row& r, const float* x, const bf16* y1, const float* part, int row, int lane) {
    r.pv = part[(size_t)row * 16 + (lane & 15)];
#pragma unroll
    for (int j = 0; j < 2; ++j) r.y[j] = *(const u32x4*)(y1 + (size_t)row * D + 512 * j + 8 * lane);
    row_ld_f32(x + (size_t)row * D, lane, r.x);
}
__device__ __forceinline__ void p6_do(P6Row& r, const f32x4 (&c1)[4], const f32x4 (&c2)[4], const f32x4 (&c3)[4], bf16* x1b, unsigned char* h2f, LAS float* rs2, int row, int lane) {
    const float pv = row16_sum(r.pv);
    const float ra = rsqrtf(pv * (1.f / D) + EPS);
    f32x4 xv[4];
#pragma unroll
    for (int j = 0; j < 2; ++j) { const u32x4 w = r.y[j];
        const f32x4 ya = (f32x4){bf2f(w.x & 0xffffu), bf2f(w.x >> 16), bf2f(w.y & 0xffffu), bf2f(w.y >> 16)}, yb = (f32x4){bf2f(w.z & 0xffffu), bf2f(w.z >> 16), bf2f(w.w & 0xffffu), bf2f(w.w >> 16)};
        xv[2 * j] = r.x[2 * j] + c1[2 * j] * (ya * ra); xv[2 * j + 1] = r.x[2 * j + 1] + c1[2 * j + 1] * (yb * ra);
        *(u32x4*)(x1b + (size_t)row * D + 512 * j + 8 * lane) = row_pack(xv[2 * j], xv[2 * j + 1]); }
    const float sa = rsqrtf(wave_sum(row_ss(xv)) * (1.f / D) + EPS);
    if (lane == 0) *rs2 = sa;
#pragma unroll
    for (int j = 0; j < 2; ++j) { const f32x4 ha = xv[2 * j] * sa * c2[2 * j] + c3[2 * j], hb = xv[2 * j + 1] * sa * c2[2 * j + 1] + c3[2 * j + 1];
        *(u32x2*)(h2f + (size_t)row * D + 512 * j + 8 * lane) = (u32x2){pg8::pk4_fp8(ha.x, ha.y, ha.z, ha.w), pg8::pk4_fp8(hb.x, hb.y, hb.z, hb.w)}; }
}
__device__ __forceinline__ void p6_postmix_router(Frame& F) {
    const float* x = fin(I_X); const bf16* y1 = (const bf16*)(F.ws + WS_Y1); const float* part = (const float*)(F.ws + WS_PART); const float* ada = (const float*)(F.ws + WS_ADA);
    unsigned char* h2f = F.ws + WS_H2F; bf16* x1b = (bf16*)(F.ws + WS_X1B); int* list = (int*)(F.ws + WS_LIST); unsigned* tokinfo = (unsigned*)(F.ws + WS_TOK);
    LAS unsigned char* WR = F.lds + P6_WR; LAS float* LGW = (LAS float*)(F.lds + P6_LGW) + F.wave * 16 * 48;
    LAS unsigned* EA = (LAS unsigned*)(F.lds + P6_EA); LAS unsigned* HIST = (LAS unsigned*)(F.lds + P6_HIST); LAS unsigned* BASE = (LAS unsigned*)(F.lds + P6_BASE);
    LAS float* RS2 = (LAS float*)(F.lds + P6_RS2) + F.wave * 16; LAS float* BIAS = (LAS float*)(F.lds + P6_BIAS); LAS float* BPART = (LAS float*)(F.lds + P6_BPART);
    const int fr = F.lane & 15, fq = F.lane >> 4;
    const float* gpost1 = fin(I_GPOST1); const float* gpre2 = fin(I_GPRE2); const float* bgrp = fin(I_BGRP); const float* brt = fin(I_BRT); const float* wgrp = fin(I_WGRP); const float* wrt = fin(I_WRT);
    for (int i = F.tid; i < 12 * WRP / 4; i += NTHR) ((LAS unsigned*)(WR + 36 * WRP))[i] = 0u;
    for (int chunk = blockIdx.x; chunk < NTOK / 128; chunk += F.G) {
        const int R0 = chunk * 128, b = R0 / SEQ, rw = R0 + 16 * F.wave; const float* ad = ada + b * 6144;
        if (F.tid < 32) HIST[F.tid] = 0u;
        P6Row na, nb;
        p6_ld(na, x, y1, part, rw, F.lane); p6_ld(nb, x, y1, part, rw + 1, F.lane);
        __builtin_amdgcn_sched_barrier(0);
        {
            float bp[36];
#pragma unroll
            for (int n = 0; n < 36; ++n) bp[n] = 0.f;
#pragma unroll
            for (int h = 0; h < 2; ++h) { const int kk = F.tid + NTHR * h; const float c2k = gpre2[kk] * (1.f + ad[4096 + kk]), c3k = ad[3072 + kk];
                const f32x4 wg = *(const f32x4*)(wgrp + kk * 4);
#pragma unroll
                for (int n = 0; n < 4; ++n) { *(LAS unsigned short*)(WR + n * WRP + kk * 2) = (unsigned short)f2bf(wg[n] * c2k); bp[n] += c3k * wg[n]; }
#pragma unroll
                for (int q = 0; q < 8; ++q) { const f32x4 wv = *(const f32x4*)(wrt + kk * 32 + q * 4);
#pragma unroll
                    for (int n = 0; n < 4; ++n) { *(LAS unsigned short*)(WR + (4 + 4 * q + n) * WRP + kk * 2) = (unsigned short)f2bf(wv[n] * c2k); bp[4 + 4 * q + n] += c3k * wv[n]; } } }
#pragma unroll
            for (int n = 0; n < 36; ++n) { const float t = wave_sum(bp[n]); if (F.lane == 0) BPART[F.wave * 48 + n] = t; }
        }
        f32x4 c1[4], c2[4], c3[4];
#pragma unroll
        for (int q = 0; q < 4; ++q) { const int c0 = rcol(F.lane, q);
            c1[q] = *(const f32x4*)(gpost1 + c0) * *(const f32x4*)(ad + 2048 + c0);
            c2[q] = *(const f32x4*)(gpre2 + c0) * (1.f + *(const f32x4*)(ad + 4096 + c0)); c3[q] = *(const f32x4*)(ad + 3072 + c0); }
        __syncthreads();
        if (F.tid < 48) { float t = 0.f;
            if (F.tid < 36) {
#pragma unroll
                for (int w = 0; w < 8; ++w) t += BPART[w * 48 + F.tid];
                t += F.tid < 4 ? bgrp[F.tid] : brt[F.tid - 4]; }
            BIAS[F.tid] = t; }
        {
#pragma unroll
            for (int i = 0; i < 16; i += 2) {
                P6Row ra = na, rb = nb;
                if (i + 2 < 16) { p6_ld(na, x, y1, part, rw + i + 2, F.lane); p6_ld(nb, x, y1, part, rw + i + 3, F.lane); }
                __builtin_amdgcn_sched_barrier(0);
                p6_do(ra, c1, c2, c3, x1b, h2f, RS2 + i, rw + i, F.lane); p6_do(rb, c1, c2, c3, x1b, h2f, RS2 + i + 1, rw + i + 1, F.lane);
                __builtin_amdgcn_sched_barrier(0);
            }
        }
        VM_WAIT();
        __syncthreads();
        {
            f32x4 acc[3] = {(f32x4){0.f, 0.f, 0.f, 0.f}, (f32x4){0.f, 0.f, 0.f, 0.f}, (f32x4){0.f, 0.f, 0.f, 0.f}};
            bf16x8 af[32];
#pragma unroll
            for (int ks = 0; ks < 32; ++ks) af[ks] = *(const bf16x8*)(x1b + (size_t)(rw + fr) * D + 32 * ks + 8 * fq);
#pragma unroll
            for (int ks = 0; ks < 32; ++ks)
#pragma unroll
                for (int nb = 0; nb < 3; ++nb) { const bf16x8 bf = *(const LAS bf16x8*)(WR + (16 * nb + fr) * WRP + (32 * ks + 8 * fq) * 2);
                    acc[nb] = __builtin_amdgcn_mfma_f32_16x16x32_bf16(af[ks], bf, acc[nb], 0, 0, 0); }
#pragma unroll
            for (int nb = 0; nb < 3; ++nb)
#pragma unroll
                for (int j = 0; j < 4; ++j) LGW[(4 * fq + j) * 48 + 16 * nb + fr] = acc[nb][j] * RS2[4 * fq + j] + BIAS[16 * nb + fr];
        }
        LDS_WAIT();
        if (F.lane < 16) {
            const LAS float* L = LGW + F.lane * 48;
            float gl[4];
#pragma unroll
            for (int g = 0; g < 4; ++g) gl[g] = L[g];
            int gi = 0; float gm = gl[0];
#pragma unroll
            for (int g = 1; g < 4; ++g) if (gl[g] > gm) { gm = gl[g]; gi = g; }
            float den = 0.f;
#pragma unroll
            for (int g = 0; g < 4; ++g) den += __expf(gl[g] - gm);
            const float grp_p = 1.f / den;
            float E[8];
#pragma unroll
            for (int i = 0; i < 8; ++i) E[i] = L[4 + gi * 8 + i];
            int a = 0; float am = E[0];
#pragma unroll
            for (int i = 1; i < 8; ++i) if (E[i] > am) { am = E[i]; a = i; }
            int bi = -1; float bm = -3.0e38f;
#pragma unroll
            for (int i = 0; i < 8; ++i) if (i != a && E[i] > bm) { bm = E[i]; bi = i; }
            if (bi < 0) { bi = (a == 0) ? 1 : 0; bm = E[bi]; }
            const float pb = __expf(bm - am), wa = 1.f / (1.f + pb), wb = pb / (1.f + pb);
            const unsigned e0 = (unsigned)(gi * 8 + a), e1 = (unsigned)(gi * 8 + bi);
            const unsigned k0 = __hip_atomic_fetch_add(HIST + e0, 1u, __ATOMIC_RELAXED, __HIP_MEMORY_SCOPE_WORKGROUP), k1 = __hip_atomic_fetch_add(HIST + e1, 1u, __ATOMIC_RELAXED, __HIP_MEMORY_SCOPE_WORKGROUP);
            LAS unsigned* ea = EA + (16 * F.wave + F.lane) * 8;
            ea[0] = e0; ea[1] = k0; ea[2] = e1; ea[3] = k1; ea[4] = __float_as_uint(grp_p * wa); ea[5] = __float_as_uint(grp_p * wb);
        }
        __syncthreads();
        if (F.tid < 32) BASE[F.tid] = __hip_atomic_fetch_add(F.ctl + CW_CNT + F.tid, HIST[F.tid], __ATOMIC_RELAXED, __HIP_MEMORY_SCOPE_AGENT);
        __syncthreads();
        if (F.tid < 128) { const LAS unsigned* ea = EA + F.tid * 8; const int tok = R0 + F.tid;
            const unsigned e0 = ea[0], e1 = ea[2], p0 = BASE[e0] + ea[1], p1 = BASE[e1] + ea[3];
            list[(size_t)e0 * ECAP + p0] = tok; list[(size_t)e1 * ECAP + p1] = tok;
            unsigned* ti = tokinfo + (size_t)tok * 8; *(u32x4*)ti = (u32x4){e0, p0, e1, p1}; *(u32x2*)(ti + 4) = (u32x2){ea[4], ea[5]}; }
        __syncthreads();
    }
}

__device__ __forceinline__ void moe_tstart(Frame& F) {
    LAS int* TS = (LAS int*)(F.lds + TS_OFF);
    if (F.tid == 0) { int o = 0; for (int e = 0; e < NE; ++e) { TS[e] = o; o += (int)((__hip_atomic_load(F.ctl + CW_CNT + e, __ATOMIC_RELAXED, __HIP_MEMORY_SCOPE_AGENT) + 255u) >> 8); } TS[NE] = o; }
    __syncthreads();
}
template <bool GATHER>
__device__ __forceinline__ void moe_setup(Frame& F) {
    moe_tstart(F);
    LAS int* TS = (LAS int*)(F.lds + TS_OFF); LAS int* UT = (LAS int*)(F.lds + UT_OFF); LAS int* RT = (LAS int*)(F.lds + RT_OFF);
    const int* list = (const int*)(F.ws + WS_LIST);
    if (F.tid < pg8::MOE_MAXU) {
        const int u = F.tid * F.G + F.vcu, T4 = 4 * TS[NE]; int pm = 0, pn = 0, e = 0, valid = 0;
        if (u < T4) { pm = u >> 2; pn = u & 3; valid = 1; for (int k = 1; k < NE; ++k) if (TS[k] <= pm) e = k; }
        UT[F.tid * 4 + 0] = pm; UT[F.tid * 4 + 1] = pn; UT[F.tid * 4 + 2] = e; UT[F.tid * 4 + 3] = valid;
    }
    __syncthreads();
    if (GATHER) {
        for (int idx = F.tid; idx < pg8::MOE_MAXU * 256; idx += NTHR) { const int i = idx >> 8, r = idx & 255;
            if (UT[i * 4 + 3]) { const int e = UT[i * 4 + 2], pos = (UT[i * 4 + 0] - TS[e]) * 256 + r;
                const int cnt = (int)__hip_atomic_load(F.ctl + CW_CNT + e, __ATOMIC_RELAXED, __HIP_MEMORY_SCOPE_AGENT);
                RT[idx] = pos < cnt ? list[(size_t)e * ECAP + pos] : 0; } }
        VM_WAIT();
    }
    __syncthreads();
}

struct P9Row { u32x2 ya[2], yb[2]; u32x4 xb[2]; };
__device__ __forceinline__ void p9_ld(P9Row& r, const unsigned char* y2, const bf16* x1b, unsigned s0, unsigned s1, int row, int lane) {
#pragma unroll
    for (int j = 0; j < 2; ++j) { r.ya[j] = *(const u32x2*)(y2 + (size_t)s0 * D + 512 * j + 8 * lane); r.yb[j] = *(const u32x2*)(y2 + (size_t)s1 * D + 512 * j + 8 * lane);
        r.xb[j] = *(const u32x4*)(x1b + (size_t)row * D + 512 * j + 8 * lane); }
}
__device__ __forceinline__ void up8(const u32x4 w, f32x4& a, f32x4& b) {
    a = (f32x4){bf2f(w.x & 0xffffu), bf2f(w.x >> 16), bf2f(w.y & 0xffffu), bf2f(w.y >> 16)}; b = (f32x4){bf2f(w.z & 0xffffu), bf2f(w.z >> 16), bf2f(w.w & 0xffffu), bf2f(w.w >> 16)}; }
__device__ __forceinline__ f32x4 up4_fp8(unsigned w) { const f32x2 lo = __builtin_amdgcn_cvt_pk_f32_fp8((int)w, false), hi = __builtin_amdgcn_cvt_pk_f32_fp8((int)w, true); return (f32x4){lo.x, lo.y, hi.x, hi.y}; }
__device__ __forceinline__ void p9_do(const P9Row& r, float w0, float w1, const f32x4 (&cg)[4], float* orow, int lane) {
    f32x4 y[4], xv[4];
#pragma unroll
    for (int j = 0; j < 2; ++j) { y[2 * j] = up4_fp8(r.ya[j].x) * w0 + up4_fp8(r.yb[j].x) * w1; y[2 * j + 1] = up4_fp8(r.ya[j].y) * w0 + up4_fp8(r.yb[j].y) * w1; up8(r.xb[j], xv[2 * j], xv[2 * j + 1]); }
    const float rs = rsqrtf(wave_sum(row_ss(y)) * (1.f / D) + EPS);
#pragma unroll
    for (int q = 0; q < 4; ++q) xv[q] = xv[q] + cg[q] * (y[q] * rs);
    row_st_f32(orow, lane, xv);
}
__device__ __forceinline__ void p9_final(Frame& F, bool dry) {
    moe_tstart(F);
    const LAS int* TS = (const LAS int*)(F.lds + TS_OFF);
    const unsigned char* y2 = F.ws + WS_Y2; const bf16* x1b = (const bf16*)(F.ws + WS_X1B); const unsigned* tokinfo = (const unsigned*)(F.ws + WS_TOK); const float* ada = (const float*)(F.ws + WS_ADA);
    float* obase = dry ? (float*)(F.ws + WS_CA) : F.out; const float* gpost2 = fin(I_GPOST2);
    for (int chunk = blockIdx.x; chunk < NTOK / 128; chunk += F.G) {
        const int R0 = chunk * 128, b = R0 / SEQ, rw = R0 + 16 * F.wave; const float* ad = ada + b * 6144;
        f32x4 cg[4];
#pragma unroll
        for (int q = 0; q < 4; ++q) { const int c0 = rcol(F.lane, q); cg[q] = *(const f32x4*)(gpost2 + c0) * *(const f32x4*)(ad + 5120 + c0); }
        const u32x4 ti = *(const u32x4*)(tokinfo + (size_t)(rw + (F.lane & 15)) * 8); const u32x2 tw = *(const u32x2*)(tokinfo + (size_t)(rw + (F.lane & 15)) * 8 + 4);
        const unsigned sl0 = (unsigned)TS[ti.x] * 256u + ti.y, sl1 = (unsigned)TS[ti.z] * 256u + ti.w;
#define P9_S0(i) ((unsigned)__builtin_amdgcn_readlane((int)sl0, (i)))
#define P9_S1(i) ((unsigned)__builtin_amdgcn_readlane((int)sl1, (i)))
#define P9_W0(i) (__uint_as_float((unsigned)__builtin_amdgcn_readlane((int)tw.x, (i))) * (1.f / pg8::YSC))
#define P9_W1(i) (__uint_as_float((unsigned)__builtin_amdgcn_readlane((int)tw.y, (i))) * (1.f / pg8::YSC))
        P9Row na, nb;
        p9_ld(na, y2, x1b, P9_S0(0), P9_S1(0), rw, F.lane); p9_ld(nb, y2, x1b, P9_S0(1), P9_S1(1), rw + 1, F.lane);
#pragma unroll
        for (int i = 0; i < 16; i += 2) {
            const P9Row ra = na, rb = nb;
            if (i + 2 < 16) { p9_ld(na, y2, x1b, P9_S0(i + 2), P9_S1(i + 2), rw + i + 2, F.lane); p9_ld(nb, y2, x1b, P9_S0(i + 3), P9_S1(i + 3), rw + i + 3, F.lane); }
            __builtin_amdgcn_sched_barrier(0);
            p9_do(ra, P9_W0(i), P9_W1(i), cg, obase + (size_t)(rw + i) * D, F.lane); p9_do(rb, P9_W0(i + 1), P9_W1(i + 1), cg, obase + (size_t)(rw + i + 1) * D, F.lane);
            __builtin_amdgcn_sched_barrier(0);
        }
#undef P9_S0
#undef P9_S1
#undef P9_W0
#undef P9_W1
    }
}

#ifndef MK_STAG
#define MK_STAG 0
#endif
#ifndef MK_STAGMASK
#define MK_STAGMASK 0x3ff
#endif
#ifndef MK_STAGGRP
#define MK_STAGGRP 3
#endif
#define STAG_AT(p) (((MK_STAGMASK >> (p)) & 1) ? MK_STAG : 0)
__device__ __forceinline__ void stagger(int ticks) {
    if (ticks > 0) { const unsigned long long t0 = __builtin_amdgcn_s_memrealtime(); const unsigned long long d = (unsigned long long)(((blockIdx.x >> 3) & MK_STAGGRP) * ticks);
        while (__builtin_amdgcn_s_memrealtime() - t0 < d) __builtin_amdgcn_s_sleep(4); }
}

__global__ void __launch_bounds__(NTHR, 2) mega_fwd(Args args) {
    extern __shared__ __attribute__((aligned(16))) unsigned char lds_raw[];
    Frame F;
    F.lds = (LAS unsigned char*)lds_raw; F.MISC = (volatile LAS unsigned*)(F.lds + MISC_OFF);
    F.tid = threadIdx.x; F.lane = F.tid & 63; F.wave = __builtin_amdgcn_readfirstlane(F.tid >> 6);
    F.G = gridDim.x; { const int bx = blockIdx.x; F.vcu = (F.G % 8 == 0) ? (bx % 8) * (F.G / 8) + bx / 8 : bx; }
    F.ws = args.ws; F.ctl = (unsigned*)(args.ws + WS_CTL); F.out = args.out;
    for (int u = F.tid; u < (LDS_BYTES - LDSCTL_OFF) / 4; u += NTHR) ((LAS unsigned*)(F.lds + LDSCTL_OFF))[u] = 0u;
    __syncthreads();
    XcdBarrier bar; bar.bar = F.ctl + CW_BAR; bar.x = 0; bar.st = nullptr;
    if (args.use_bar) bar = xcd_barrier_post(F.ctl + CW_BAR, F.MISC + 8);
    const int lo = args.ph_lo, hi = args.ph_hi;
#ifndef MK_PHMASK
#define MK_PHMASK 0x3ff
#endif
#define IN(k) (((MK_PHMASK >> (k)) & 1) && lo <= (k) && (k) < hi)
#define SEAM(k) do { if (IN(k) && IN((k) + 1)) xcd_barrier(bar); } while (0)

    if (IN(0)) { p0_prologue(F); }
    if (IN(1)) { p1_modnorm(F); } SEAM(1);
    if (IN(2)) {
        pg8::EpiP2 E{(bf16*)(F.ws + WS_GLU), (bf16*)(F.ws + WS_QKV), (bf16*)(F.ws + WS_GATES), fin(I_QG), fin(I_KG), (const f32x2*)(F.ws + WS_ROPE)};
        stagger(STAG_AT(2));
        { pg8::P2Order<false> S{(const char*)(F.ws + WS_WIN), F.vcu, F.G};
          pg8::gemm_phase<pg8::EpiP2, pg8::P2Order<false>, true, 0>(F.lds + RING_OFF, F.ws + WS_H1, D * 2, D * 2, S, E); }
        { pg8::P2Order<true> S{(const char*)(F.ws + WS_WINF), F.vcu, F.G};
          pg8::gemm_phase<pg8::EpiP2, pg8::P2Order<true>, true, 1>(F.lds + RING_OFF, F.ws + WS_H1F, D * 2, D * 2, S, E, nullptr, D); }
    } SEAM(2);
    if (IN(3)) {
        if (!(args.flags & 1)) p3_conv(F);
        if (!(args.flags & 2)) {
            const attn_body::bf16* qkv = (const attn_body::bf16*)(F.ws + WS_QKV);
            const attn_body::AttnTensors AT{qkv, qkv + 512, qkv + 640, (attn_body::bf16*)(F.ws + WS_CA + 512)};
            const attn_body::StaticOrder S((int)F.G, F.vcu);
            attn_body::AttnUnit au;
            for (int i = 0; S.next(i, au); ++i) {
                if (i == (F.vcu & 3)) { p0_convert_experts(F, 0, XCONV_ITEMS, F.vcu, F.G); VM_WAIT(); __syncthreads(); }
                attn_body::attn_unit<8>(au.bh / attn_body::NHEAD, au.bh % attn_body::NHEAD, (au.bh % attn_body::NHEAD) / 4, au.qb, AT.Q, AT.K, AT.V, AT.O, (char*)lds_raw + RING_OFF);
            }
        }
    } SEAM(3);
    if (IN(4)) {
        pg8::PanelOrder S{(const char*)(F.ws + WS_WCA), F.vcu, F.G, D};
        pg8::EpiP4 E{(const bf16*)(F.ws + WS_GATES), (bf16*)(F.ws + WS_H1)};
        stagger(STAG_AT(4));
        pg8::gemm_phase<pg8::EpiP4, pg8::PanelOrder, true, 1>(F.lds + RING_OFF, F.ws + WS_CA, D, D, S, E);
    } SEAM(4);
    if (IN(5)) {
        pg8::PanelOrder S{(const char*)(F.ws + WS_WO), F.vcu, F.G, D};
        pg8::EpiP5 E{(bf16*)(F.ws + WS_Y1), (float*)(F.ws + WS_PART)};
        stagger(STAG_AT(5));
        pg8::gemm_phase<pg8::EpiP5, pg8::PanelOrder, true, 1>(F.lds + RING_OFF, F.ws + WS_H1, D, D, S, E);
    } SEAM(5);
    if (IN(6)) { p6_postmix_router(F); } SEAM(6);
    if (IN(7)) {
        moe_setup<true>(F);
        pg8::MoeOrder<true> S{(const LAS int*)(F.lds + UT_OFF), (const LAS int*)(F.lds + RT_OFF), F.ws + WS_W1, (size_t)D * D, D};
        pg8::EpiMoe1 E{F.ws + WS_GATES};
        stagger(STAG_AT(7));
        pg8::gemm_phase<pg8::EpiMoe1, pg8::MoeOrder<true>, true, true>(F.lds + RING_OFF, F.ws + WS_H2F, D, D, S, E);
    } SEAM(7);
    if (IN(8)) {
        moe_setup<false>(F);
        pg8::MoeOrder<false> S{(const LAS int*)(F.lds + UT_OFF), (const LAS int*)(F.lds + RT_OFF), F.ws + WS_W2, (size_t)D * DE, DE};
        pg8::EpiMoe2 E{F.ws + WS_Y2};
        stagger(STAG_AT(8));
        pg8::gemm_phase<pg8::EpiMoe2, pg8::MoeOrder<false>, true, true>(F.lds + RING_OFF, F.ws + WS_GATES, DE, DE, S, E);
    } SEAM(8);
    if (IN(9)) { p9_final(F, (args.flags & 4) != 0); }
#undef IN
#undef SEAM
}
#if MK_NPRE < 10
__global__ __launch_bounds__(256) void k_ada(const float* __restrict__ c, const float* __restrict__ w, const float* __restrict__ bb, float* __restrict__ ada) {
    const int j = blockIdx.x * 256 + threadIdx.x, b = blockIdx.y;
    float acc = 0.f;
    for (int k = 0; k < D; ++k) { const float cv = c[b * D + k]; acc += siluf_(cv) * w[(size_t)k * 6144 + j]; }
    ada[b * 6144 + j] = acc + bb[j];
}

__global__ __launch_bounds__(256) void k_modnorm(const float* __restrict__ x, const float* __restrict__ g, const float* __restrict__ ada, int sh_off, int sc_off, bf16* __restrict__ out) {
    const int lane = threadIdx.x & 63, row = blockIdx.x * 4 + (threadIdx.x >> 6), b = row / SEQ;
    const f32x4* xr = (const f32x4*)(x + (size_t)row * D) + lane;
    f32x4 v[4]; float s = 0.f;
#pragma unroll
    for (int j = 0; j < 4; ++j) { v[j] = xr[64 * j]; s += (v[j].x * v[j].x + v[j].y * v[j].y) + (v[j].z * v[j].z + v[j].w * v[j].w); }
    const float rstd = rsqrtf(wave_sum(s) * (1.f / D) + EPS);
    unsigned long long* o8 = (unsigned long long*)(out + (size_t)row * D) + lane;
#pragma unroll
    for (int j = 0; j < 4; ++j) {
        const int c0 = 256 * j + 4 * lane;
        const f32x4 gg = *(const f32x4*)(g + c0), sc = *(const f32x4*)(ada + b * 6144 + sc_off + c0), sh = *(const f32x4*)(ada + b * 6144 + sh_off + c0);
        const f32x4 r = v[j] * rstd * gg * (1.f + sc) + sh;
        o8[64 * j] = (unsigned long long)pk2(r.x, r.y) | ((unsigned long long)pk2(r.z, r.w) << 32);
    }
}

template <int MODE>
__global__ __launch_bounds__(256) void k_gemm(const bf16* __restrict__ A, int lda, const int* __restrict__ rowidx, const int* __restrict__ cntp, const int* __restrict__ offp,
                                              const float* __restrict__ W, const float* __restrict__ W2, int ldw, void* Cv, int ldc, int M, int K) {
    __shared__ float As[16][68];
    __shared__ float Bs[16][68];
    __shared__ float Bs2[MODE == 1 ? 16 : 1][68];
    const int Mcnt = cntp ? *cntp : M, off = offp ? *offp : 0;
    const int m0 = blockIdx.x * 64, n0 = blockIdx.y * 64;
    if (m0 >= Mcnt) return;
    const int tid = threadIdx.x, tx = tid & 15, ty = tid >> 4;
    float acc[4][4], acc2[4][4];
#pragma unroll
    for (int i = 0; i < 4; ++i)
#pragma unroll
        for (int j = 0; j < 4; ++j) { acc[i][j] = 0.f; acc2[i][j] = 0.f; }
    const int ar = tid >> 2, ak = (tid & 3) * 4, arow = m0 + ar;
    const bool av = arow < Mcnt;
    const size_t asrc = av ? (rowidx ? (size_t)rowidx[arow] : (size_t)(off + arow)) : 0;
    const int bk = tid >> 4, bn = (tid & 15) * 4;
    for (int k0 = 0; k0 < K; k0 += 16) {
        u32x2 raw = (u32x2){0u, 0u};
        if (av) raw = *(const u32x2*)(A + asrc * lda + k0 + ak);
        As[ak + 0][ar] = bf2f(raw.x & 0xffffu); As[ak + 1][ar] = bf2f(raw.x >> 16); As[ak + 2][ar] = bf2f(raw.y & 0xffffu); As[ak + 3][ar] = bf2f(raw.y >> 16);
        const f32x4 w = *(const f32x4*)(W + (size_t)(k0 + bk) * ldw + n0 + bn);
        Bs[bk][bn + 0] = w.x; Bs[bk][bn + 1] = w.y; Bs[bk][bn + 2] = w.z; Bs[bk][bn + 3] = w.w;
        if (MODE == 1) { const f32x4 w2 = *(const f32x4*)(W2 + (size_t)(k0 + bk) * ldw + n0 + bn);
            Bs2[bk][bn + 0] = w2.x; Bs2[bk][bn + 1] = w2.y; Bs2[bk][bn + 2] = w2.z; Bs2[bk][bn + 3] = w2.w; }
        __syncthreads();
#pragma unroll
        for (int kk = 0; kk < 16; ++kk) {
            float a[4], b[4], b2[4];
#pragma unroll
            for (int i = 0; i < 4; ++i) { a[i] = As[kk][ty * 4 + i]; b[i] = Bs[kk][tx * 4 + i]; b2[i] = (MODE == 1) ? Bs2[kk][tx * 4 + i] : 0.f; }
#pragma unroll
            for (int i = 0; i < 4; ++i)
#pragma unroll
                for (int j = 0; j < 4; ++j) { acc[i][j] += a[i] * b[j]; if (MODE == 1) acc2[i][j] += a[i] * b2[j]; }
        }
        __syncthreads();
    }
#pragma unroll
    for (int i = 0; i < 4; ++i) {
        const int r = m0 + ty * 4 + i;
        if (r < Mcnt) {
            const size_t crow = (size_t)(off + r);
            if (MODE == 0) { *(f32x4*)((float*)Cv + crow * ldc + n0 + tx * 4) = (f32x4){acc[i][0], acc[i][1], acc[i][2], acc[i][3]}; }
            else {
                float o[4];
#pragma unroll
                for (int j = 0; j < 4; ++j) o[j] = (MODE == 1) ? siluf_(acc[i][j]) * acc2[i][j] : acc[i][j];
                *(u32x2*)((bf16*)Cv + crow * ldc + n0 + tx * 4) = (u32x2){pk2(o[0], o[1]), pk2(o[2], o[3])};
            }
        }
    }
}

__global__ __launch_bounds__(256) void k_glu(const float* __restrict__ t, bf16* __restrict__ glu) {
    const size_t i = (size_t)blockIdx.x * 256 + threadIdx.x;
    const size_t r = i / 512; const int c = (int)(i % 512);
    const float a = t[r * 1024 + c], ag = t[r * 1024 + 512 + c];
    glu[i] = (bf16)f2bf(a * sigmoidf_(ag));
}
__global__ __launch_bounds__(256) void k_gate(const float* __restrict__ t, bf16* __restrict__ gates, int goff) {
    const size_t i = (size_t)blockIdx.x * 256 + threadIdx.x;
    const size_t r = i / 1024; const int c = (int)(i % 1024);
    gates[r * 2048 + goff + c] = (bf16)f2bf(sigmoidf_(t[i]));
}

__global__ __launch_bounds__(512) void k_conv(const bf16* __restrict__ glu, const float* __restrict__ w_dw, const float* __restrict__ b_dw, const float* __restrict__ lg, const float* __restrict__ lb, bf16* __restrict__ ca) {
    __shared__ float red[16];
    const int t = blockIdx.x, c = threadIdx.x, b = t / SEQ, s = t % SEQ;
    float acc = b_dw[c];
    for (int j = 0; j < KS; ++j) { const int s2 = s + j - KS / 2; if (s2 >= 0 && s2 < SEQ) acc += bf2f(glu[(size_t)(b * SEQ + s2) * CW + c]) * w_dw[j * CW + c]; }
    float sm = wave_sum(acc);
    if ((c & 63) == 0) red[c >> 6] = sm;
    __syncthreads();
    float mu = 0.f;
#pragma unroll
    for (int i = 0; i < 8; ++i) mu += red[i];
    mu *= (1.f / CW);
    const float d = acc - mu;
    float sq = wave_sum(d * d);
    if ((c & 63) == 0) red[8 + (c >> 6)] = sq;
    __syncthreads();
    float var = 0.f;
#pragma unroll
    for (int i = 0; i < 8; ++i) var += red[8 + i];
    var *= (1.f / CW);
    const float u = d * rsqrtf(var + EPS) * lg[c] + lb[c];
    ca[(size_t)t * 1024 + c] = (bf16)f2bf(siluf_(u));
}

__global__ __launch_bounds__(256) void k_qkrope(const float* __restrict__ t, const float* __restrict__ qg, const float* __restrict__ kg, bf16* __restrict__ qkv) {
    const size_t i = (size_t)blockIdx.x * 256 + threadIdx.x;
    const size_t r = i / 12; const int hs = (int)(i % 12);
    const float* src = t + r * 1024 + hs * 64; bf16* dst = qkv + r * 768 + hs * 64;
    if (hs >= 10) { for (int d = 0; d < 64; ++d) dst[d] = (bf16)f2bf(src[d]); return; }
    const float* g = hs < 8 ? qg : kg;
    float ss = 0.f;
    for (int d = 0; d < 64; ++d) ss += src[d] * src[d];
    const float rstd = rsqrtf(ss * (1.f / 64.f) + EPS) , osc = hs < 8 ? QSCALE : 1.f;
    const int s = (int)(r % SEQ); const float prow = (float)(s / 64), pcol = (float)(s % 64);
    for (int half = 0; half < 2; ++half) {
        const float pos = half == 0 ? prow : pcol;
        for (int e = 0; e < 16; ++e) {
            const float invf = powf(10000.f, -(float)(2 * e) / 32.f);
            const float ang = pos * invf; float sn, cs; sincosf(ang, &sn, &cs);
            const int d1 = half * 32 + e, d2 = d1 + 16;
            const float x1 = src[d1] * rstd * g[d1], x2 = src[d2] * rstd * g[d2];
            dst[d1] = (bf16)f2bf((x1 * cs - x2 * sn) * osc);
            dst[d2] = (bf16)f2bf((x2 * cs + x1 * sn) * osc);
        }
    }
}

__global__ __launch_bounds__(256) void k_attn(const bf16* __restrict__ qkv, bf16* __restrict__ ca) {
    const int qi = blockIdx.x * 256 + threadIdx.x;
    const int h = blockIdx.y, b = blockIdx.z, kvh = h / 4;
    const size_t row = (size_t)b * SEQ + qi;
    float q[64], o[64];
    {
        const u32x4* qp = (const u32x4*)(qkv + row * 768 + h * 64);
#pragma unroll
        for (int c = 0; c < 8; ++c) { const u32x4 v = qp[c];
            q[c * 8 + 0] = bf2f(v.x & 0xffffu); q[c * 8 + 1] = bf2f(v.x >> 16); q[c * 8 + 2] = bf2f(v.y & 0xffffu); q[c * 8 + 3] = bf2f(v.y >> 16);
            q[c * 8 + 4] = bf2f(v.z & 0xffffu); q[c * 8 + 5] = bf2f(v.z >> 16); q[c * 8 + 6] = bf2f(v.w & 0xffffu); q[c * 8 + 7] = bf2f(v.w >> 16); }
    }
#pragma unroll
    for (int d = 0; d < 64; ++d) o[d] = 0.f;
    float m = -1e30f, l = 0.f;
    for (int s = 0; s < SEQ; ++s) {
        const u32x4* kp = (const u32x4*)(qkv + ((size_t)b * SEQ + s) * 768 + 512 + kvh * 64);
        const u32x4* vp = (const u32x4*)(qkv + ((size_t)b * SEQ + s) * 768 + 640 + kvh * 64);
        float sc = 0.f;
#pragma unroll
        for (int c = 0; c < 8; ++c) { const u32x4 v = kp[c];
            sc += q[c * 8 + 0] * bf2f(v.x & 0xffffu) + q[c * 8 + 1] * bf2f(v.x >> 16) + q[c * 8 + 2] * bf2f(v.y & 0xffffu) + q[c * 8 + 3] * bf2f(v.y >> 16)
                + q[c * 8 + 4] * bf2f(v.z & 0xffffu) + q[c * 8 + 5] * bf2f(v.z >> 16) + q[c * 8 + 6] * bf2f(v.w & 0xffffu) + q[c * 8 + 7] * bf2f(v.w >> 16); }
        if (sc > m) { const float f = exp2f(m - sc); l *= f;
#pragma unroll
            for (int d = 0; d < 64; ++d) o[d] *= f;
            m = sc; }
        const float p = exp2f(sc - m); l += p;
#pragma unroll
        for (int c = 0; c < 8; ++c) { const u32x4 v = vp[c];
            o[c * 8 + 0] += p * bf2f(v.x & 0xffffu); o[c * 8 + 1] += p * bf2f(v.x >> 16); o[c * 8 + 2] += p * bf2f(v.y & 0xffffu); o[c * 8 + 3] += p * bf2f(v.y >> 16);
            o[c * 8 + 4] += p * bf2f(v.z & 0xffffu); o[c * 8 + 5] += p * bf2f(v.z >> 16); o[c * 8 + 6] += p * bf2f(v.w & 0xffffu); o[c * 8 + 7] += p * bf2f(v.w >> 16); }
    }
    const float il = 1.f / l;
    u32x4* op = (u32x4*)(ca + row * 1024 + 512 + h * 64);
#pragma unroll
    for (int c = 0; c < 8; ++c) op[c] = (u32x4){pk2(o[c * 8 + 0] * il, o[c * 8 + 1] * il), pk2(o[c * 8 + 2] * il, o[c * 8 + 3] * il), pk2(o[c * 8 + 4] * il, o[c * 8 + 5] * il), pk2(o[c * 8 + 6] * il, o[c * 8 + 7] * il)};
}

__global__ __launch_bounds__(256) void k_merge(const float* __restrict__ t1, const float* __restrict__ t2, const bf16* __restrict__ gates, bf16* __restrict__ merged) {
    const size_t i = (size_t)blockIdx.x * 256 + threadIdx.x;
    const size_t r = i / 1024; const int c = (int)(i % 1024);
    if (MK_NPRE >= 3) { const unsigned char* gq = (const unsigned char*)gates; const size_t gi = pg8::gate_index((int)r, c); const float sc = ((float)gq[gi] + 0.5f) * (1.f / 256.f), sa = ((float)gq[gi + 8] + 0.5f) * (1.f / 256.f); merged[i] = (bf16)f2bf(sc * t1[i] + sa * t2[i]); }
    else merged[i] = (bf16)f2bf(bf2f(gates[r * 2048 + c]) * t1[i] + bf2f(gates[r * 2048 + 1024 + c]) * t2[i]);
}

__global__ __launch_bounds__(256) void k_postmix(const float* __restrict__ x, const float* __restrict__ y1, const float* __restrict__ ada, const float* __restrict__ g_post, const float* __restrict__ g_pre2,
                                                 const float* __restrict__ w_group, const float* __restrict__ b_group, const float* __restrict__ w_router, const float* __restrict__ b_router,
                                                 float* __restrict__ x1out, bf16* __restrict__ h2, unsigned* __restrict__ ctl, int* __restrict__ list, unsigned* __restrict__ tokinfo) {
    const int lane = threadIdx.x & 63, row = blockIdx.x * 4 + (threadIdx.x >> 6), b = row / SEQ;
    const float* ad = ada + b * 6144;
    f32x4 yv[4], xv[4]; float s = 0.f;
#pragma unroll
    for (int j = 0; j < 4; ++j) { yv[j] = ((const f32x4*)(y1 + (size_t)row * D) + lane)[64 * j]; xv[j] = ((const f32x4*)(x + (size_t)row * D) + lane)[64 * j];
        s += (yv[j].x * yv[j].x + yv[j].y * yv[j].y) + (yv[j].z * yv[j].z + yv[j].w * yv[j].w); }
    const float rstd1 = rsqrtf(wave_sum(s) * (1.f / D) + EPS);
    float s2 = 0.f;
#pragma unroll
    for (int j = 0; j < 4; ++j) { const int c0 = 256 * j + 4 * lane;
        const f32x4 gp = *(const f32x4*)(g_post + c0), gt = *(const f32x4*)(ad + 2048 + c0);
        xv[j] = xv[j] + gt * (yv[j] * rstd1 * gp);
        ((f32x4*)(x1out + (size_t)row * D) + lane)[64 * j] = xv[j];
        s2 += (xv[j].x * xv[j].x + xv[j].y * xv[j].y) + (xv[j].z * xv[j].z + xv[j].w * xv[j].w); }
    const float rstd2 = rsqrtf(wave_sum(s2) * (1.f / D) + EPS);
    float lg[36];
#pragma unroll
    for (int o = 0; o < 36; ++o) lg[o] = 0.f;
    unsigned long long* o8 = (unsigned long long*)(h2 + (size_t)row * D) + lane;
#pragma unroll
    for (int j = 0; j < 4; ++j) { const int c0 = 256 * j + 4 * lane;
        const f32x4 gg = *(const f32x4*)(g_pre2 + c0), sc = *(const f32x4*)(ad + 4096 + c0), sh = *(const f32x4*)(ad + 3072 + c0);
        const f32x4 hv = xv[j] * rstd2 * gg * (1.f + sc) + sh;
        o8[64 * j] = (unsigned long long)pk2(hv.x, hv.y) | ((unsigned long long)pk2(hv.z, hv.w) << 32);
#pragma unroll
        for (int i = 0; i < 4; ++i) { const int c = c0 + i; const float hvv = hv[i];
            const f32x4 wg = *(const f32x4*)(w_group + c * 4);
            lg[0] += hvv * wg.x; lg[1] += hvv * wg.y; lg[2] += hvv * wg.z; lg[3] += hvv * wg.w;
#pragma unroll
            for (int q = 0; q < 8; ++q) { const f32x4 wr = *(const f32x4*)(w_router + c * 32 + q * 4);
                lg[4 + q * 4 + 0] += hvv * wr.x; lg[4 + q * 4 + 1] += hvv * wr.y; lg[4 + q * 4 + 2] += hvv * wr.z; lg[4 + q * 4 + 3] += hvv * wr.w; } } }
#pragma unroll
    for (int o = 0; o < 36; ++o) lg[o] = wave_sum(lg[o]);
    float gl[4];
#pragma unroll
    for (int g = 0; g < 4; ++g) gl[g] = lg[g] + b_group[g];
    int gi = 0; float gm = gl[0];
#pragma unroll
    for (int g = 1; g < 4; ++g) if (gl[g] > gm) { gm = gl[g]; gi = g; }
    float den = 0.f;
#pragma unroll
    for (int g = 0; g < 4; ++g) den += __expf(gl[g] - gm);
    const float grp_p = 1.f / den;
    float in[8];
#pragma unroll
    for (int i = 0; i < 8; ++i) { float v = 0.f;
#pragma unroll
        for (int g = 0; g < 4; ++g) { const float cand = lg[4 + g * 8 + i] + b_router[g * 8 + i]; v = (g == gi) ? cand : v; }
        in[i] = v; }
    int a = 0; float am = in[0];
#pragma unroll
    for (int i = 1; i < 8; ++i) if (in[i] > am) { am = in[i]; a = i; }
    int bidx = -1; float bm = -3.0e38f;
#pragma unroll
    for (int i = 0; i < 8; ++i) if (i != a && in[i] > bm) { bm = in[i]; bidx = i; }
    const float pb = __expf(bm - am), wa = 1.f / (1.f + pb), wb = pb / (1.f + pb);
    if (lane == 0) {
        const int e0 = gi * 8 + a, e1 = gi * 8 + bidx;
        const unsigned p0 = atomicAdd(ctl + CW_CNT + e0, 1u), p1 = atomicAdd(ctl + CW_CNT + e1, 1u);
        list[(size_t)e0 * ECAP + p0] = row; list[(size_t)e1 * ECAP + p1] = row;
        unsigned* ti = tokinfo + (size_t)row * 8;
        ti[0] = (unsigned)e0; ti[1] = p0; ti[2] = (unsigned)e1; ti[3] = p1; ti[4] = __float_as_uint(grp_p * wa); ti[5] = __float_as_uint(grp_p * wb);
    }
}
__global__ void k_offsets(unsigned* ctl) {
    if (threadIdx.x == 0) { unsigned o = 0; for (int e = 0; e < NE; ++e) { ctl[CW_OFF + e] = o; o += (ctl[CW_CNT + e] + 255u) / 256u * 256u; } ctl[CW_OFF + NE] = o; }
}

__global__ __launch_bounds__(256) void k_final(const bf16* __restrict__ y2, const unsigned* __restrict__ tokinfo, const unsigned* __restrict__ ctl, const float* __restrict__ ada, const float* __restrict__ g_post2, float* __restrict__ out) {
    const int lane = threadIdx.x & 63, row = blockIdx.x * 4 + (threadIdx.x >> 6), b = row / SEQ;
    const unsigned* ti = tokinfo + (size_t)row * 8;
    const unsigned s0 = ctl[CW_OFF + ti[0]] + ti[1], s1 = ctl[CW_OFF + ti[2]] + ti[3];
    const float w0 = __uint_as_float(ti[4]), w1 = __uint_as_float(ti[5]);
    f32x4 yv[4]; float s = 0.f;
#pragma unroll
    for (int j = 0; j < 4; ++j) {
        const u32x2 a = ((const u32x2*)(y2 + (size_t)s0 * D) + lane)[64 * j], c = ((const u32x2*)(y2 + (size_t)s1 * D) + lane)[64 * j];
        yv[j].x = w0 * bf2f(a.x & 0xffffu) + w1 * bf2f(c.x & 0xffffu); yv[j].y = w0 * bf2f(a.x >> 16) + w1 * bf2f(c.x >> 16);
        yv[j].z = w0 * bf2f(a.y & 0xffffu) + w1 * bf2f(c.y & 0xffffu); yv[j].w = w0 * bf2f(a.y >> 16) + w1 * bf2f(c.y >> 16);
        s += (yv[j].x * yv[j].x + yv[j].y * yv[j].y) + (yv[j].z * yv[j].z + yv[j].w * yv[j].w); }
    const float rstd = rsqrtf(wave_sum(s) * (1.f / D) + EPS);
#pragma unroll
    for (int j = 0; j < 4; ++j) { const int c0 = 256 * j + 4 * lane;
        const f32x4 gp = *(const f32x4*)(g_post2 + c0), gt = *(const f32x4*)(ada + b * 6144 + 5120 + c0);
        f32x4* op = (f32x4*)(out + (size_t)row * D) + lane;
        op[64 * j] = op[64 * j] + gt * (yv[j] * rstd * gp); }
}

#endif
extern "C" void kernel_launch(void* const* d_in, const int* in_sizes, int n_in, void* d_out, int out_size, void* d_ws, size_t ws_size, hipStream_t stream) {
    static int grid = 0;
    if (grid == 0) {
        if (n_in != 25 || in_sizes[0] != NTOK * D || out_size != NTOK * D || ws_size < WS_END) { fprintf(stderr, "kernel_launch: unexpected problem (n_in %d, ws %zu); nothing launched\n", n_in, ws_size); grid = -1; return; }
        int dev = 0, cus = 0, per_cu = 0;
        if (hipGetDevice(&dev) != hipSuccess || hipDeviceGetAttribute(&cus, hipDeviceAttributeMultiprocessorCount, dev) != hipSuccess) { grid = -1; return; }
        if (hipFuncSetAttribute((const void*)mega_fwd, hipFuncAttributeMaxDynamicSharedMemorySize, LDS_BYTES) != hipSuccess) { fprintf(stderr, "kernel_launch: hipFuncSetAttribute failed\n"); grid = -1; return; }
        if (hipOccupancyMaxActiveBlocksPerMultiprocessor(&per_cu, (const void*)mega_fwd, NTHR, LDS_BYTES) != hipSuccess || per_cu < 1) { fprintf(stderr, "kernel_launch: occupancy query says %d\n", per_cu); grid = -1; return; }
        (void)hipGetLastError();
        if (cus < 256) { fprintf(stderr, "kernel_launch: built for a 256-CU device (one workgroup per CU, 256 workgroups); this one has %d\n", cus); grid = -1; return; }
        grid = 256;
    }
    if (grid < 0) return;
    unsigned char* ws = (unsigned char*)d_ws;
    if (hipMemsetAsync(ws + WS_CTL, 0, CTL_ZERO_BYTES, stream) != hipSuccess) return;
    Args a{};
    for (int i = 0; i < 25; ++i) a.in[i] = (const float*)d_in[i];
    a.out = (float*)d_out; a.ws = ws; a.flags = MK_FLAGS;
#if MK_NPRE == 10 && MK_ONE
    a.ph_lo = 0; a.ph_hi = 10; a.use_bar = 1;
    hipLaunchKernelGGL(mega_fwd, dim3(grid), dim3(NTHR), LDS_BYTES, stream, a);
#else
    for (int p = 0; p < MK_NPRE; ++p) { a.ph_lo = p; a.ph_hi = p + 1; a.use_bar = 0;
#ifdef MK_REP
        if (p == MK_REP) {
            if (p == 9) a.flags |= 4;
#ifdef MK_REPFLAGS
            a.flags |= MK_REPFLAGS;
#endif
            hipLaunchKernelGGL(mega_fwd, dim3(grid), dim3(NTHR), LDS_BYTES, stream, a);
            a.flags = MK_FLAGS;
            if (p == 6) (void)hipMemsetAsync(ws + WS_CTL, 0, 256, stream);
        }
#endif
        hipLaunchKernelGGL(mega_fwd, dim3(grid), dim3(NTHR), LDS_BYTES, stream, a); }
#endif
#if MK_NPRE < 10
    const float* x = (const float*)d_in[0]; const float* w_in = (const float*)d_in[6];
    const float* w_dw = (const float*)d_in[7]; const float* b_dw = (const float*)d_in[8]; const float* cln_g = (const float*)d_in[9]; const float* cln_b = (const float*)d_in[10];
    const float* w_conv_out = (const float*)d_in[11]; const float* q_g = (const float*)d_in[12]; const float* k_g = (const float*)d_in[13]; const float* w_attn_out = (const float*)d_in[14];
    const float* w_out = (const float*)d_in[15]; const float* g_pre_ffn = (const float*)d_in[16]; const float* g_post_ffn = (const float*)d_in[17];
    const float* w_group = (const float*)d_in[18]; const float* b_group = (const float*)d_in[19]; const float* w_router = (const float*)d_in[20]; const float* b_router = (const float*)d_in[21];
    const float* w_e_gate = (const float*)d_in[22]; const float* w_e_up = (const float*)d_in[23]; const float* w_e_down = (const float*)d_in[24];
    float* out = (float*)d_out; unsigned* ctl = (unsigned*)(ws + WS_CTL); float* ada = (float*)(ws + WS_ADA);
    bf16* h1 = (bf16*)(ws + WS_H1); bf16* merged = (bf16*)(ws + WS_H1); bf16* glu = (bf16*)(ws + WS_GLU); bf16* qkv = (bf16*)(ws + WS_QKV);
    bf16* gates = (bf16*)(ws + WS_GATES); bf16* act = (bf16*)(ws + WS_GATES); bf16* ca = (bf16*)(ws + WS_CA); bf16* h2 = (bf16*)(ws + WS_CA);
    float* tmp = (float*)(ws + WS_TMP); int* list = (int*)(ws + WS_LIST); unsigned* tokinfo = (unsigned*)(ws + WS_TOK); bf16* y2 = (bf16*)(ws + WS_Y2);
    if (MK_NPRE <= 0) k_ada<<<dim3(6144 / 256, NB), 256, 0, stream>>>((const float*)d_in[1], (const float*)d_in[2], (const float*)d_in[3], ada);
    if (MK_NPRE <= 1) k_modnorm<<<NTOK / 4, 256, 0, stream>>>(x, (const float*)d_in[4], ada, 0, 1024, h1);
    if (MK_NPRE <= 2) {
        k_gemm<0><<<dim3(NTOK / 64, 1024 / 64), 256, 0, stream>>>(h1, D, nullptr, nullptr, nullptr, w_in + 0, nullptr, INW, tmp, 1024, NTOK, D);
        k_glu<<<NTOK * 512 / 256, 256, 0, stream>>>(tmp, glu);
        k_gemm<0><<<dim3(NTOK / 64, 768 / 64), 256, 0, stream>>>(h1, D, nullptr, nullptr, nullptr, w_in + 1024, nullptr, INW, tmp, 1024, NTOK, D);
        k_qkrope<<<NTOK * 12 / 256, 256, 0, stream>>>(tmp, q_g, k_g, qkv);
        k_gemm<0><<<dim3(NTOK / 64, 1024 / 64), 256, 0, stream>>>(h1, D, nullptr, nullptr, nullptr, w_in + 1792, nullptr, INW, tmp, 1024, NTOK, D);
        k_gate<<<NTOK * 1024 / 256, 256, 0, stream>>>(tmp, gates, 0);
        k_gemm<0><<<dim3(NTOK / 64, 1024 / 64), 256, 0, stream>>>(h1, D, nullptr, nullptr, nullptr, w_in + 2816, nullptr, INW, tmp, 1024, NTOK, D);
        k_gate<<<NTOK * 1024 / 256, 256, 0, stream>>>(tmp, gates, 1024);
    }
    if (MK_NPRE <= 3 || (MK_FLAGS & 1)) k_conv<<<NTOK, 512, 0, stream>>>(glu, w_dw, b_dw, cln_g, cln_b, ca);
    if (MK_NPRE <= 3 || (MK_FLAGS & 2)) k_attn<<<dim3(SEQ / 256, 8, NB), 256, 0, stream>>>(qkv, ca);
    if (MK_NPRE <= 4) {
        k_gemm<0><<<dim3(NTOK / 64, 1024 / 64), 256, 0, stream>>>(ca, 1024, nullptr, nullptr, nullptr, w_conv_out, nullptr, D, tmp, 1024, NTOK, 512);
        k_gemm<0><<<dim3(NTOK / 64, 1024 / 64), 256, 0, stream>>>(ca + 512, 1024, nullptr, nullptr, nullptr, w_attn_out, nullptr, D, out, 1024, NTOK, 512);
        k_merge<<<NTOK * 1024 / 256, 256, 0, stream>>>(tmp, out, gates, merged);
    }
    if (MK_NPRE <= 6) {
        k_gemm<0><<<dim3(NTOK / 64, 1024 / 64), 256, 0, stream>>>(merged, D, nullptr, nullptr, nullptr, w_out, nullptr, D, tmp, 1024, NTOK, D);
        k_postmix<<<NTOK / 4, 256, 0, stream>>>(x, tmp, ada, (const float*)d_in[5], g_pre_ffn, w_group, b_group, w_router, b_router, out, h2, ctl, list, tokinfo);
    }
    k_offsets<<<1, 64, 0, stream>>>(ctl);
    if (MK_NPRE <= 8) {
        for (int e = 0; e < NE; ++e)
            k_gemm<1><<<dim3(NTOK / 64, DE / 64), 256, 0, stream>>>(h2, D, list + (size_t)e * ECAP, (const int*)ctl + CW_CNT + e, (const int*)ctl + CW_OFF + e,
                                                                  w_e_gate + (size_t)e * D * DE, w_e_up + (size_t)e * D * DE, DE, act, DE, 0, D);
        for (int e = 0; e < NE; ++e)
            k_gemm<2><<<dim3(NTOK / 64, D / 64), 256, 0, stream>>>(act, DE, nullptr, (const int*)ctl + CW_CNT + e, (const int*)ctl + CW_OFF + e,
                                                                 w_e_down + (size_t)e * DE * D, nullptr, D, y2, D, 0, DE);
    }
    k_final<<<NTOK / 4, 256, 0, stream>>>(y2, tokinfo, ctl, ada, g_post_ffn, out);
#endif
}
```
